# Optimizing an MI355X kernel written in HIP

```python
import math
import numpy as np
import jax
import jax.numpy as jnp
from jax import lax

D_MODEL = 1024
BATCH = 2
SEQ = 8192
DEPTH = 1

HEAD_DIM = 64
DIFF_WIDTH = D_MODEL // 2
NSA_WIDTH = D_MODEL - DIFF_WIDTH
DIFF_HEADS = DIFF_WIDTH // (2 * HEAD_DIM)
DIFF_V_DIM = 2 * HEAD_DIM
NSA_HEADS = NSA_WIDTH // HEAD_DIM
NSA_KV_HEADS = 2
NSA_GROUP = NSA_HEADS // NSA_KV_HEADS
CMP_BLOCK = 32
CMP_STRIDE = 16
CMP_HIDDEN = 2 * HEAD_DIM
SLC_BLOCK = 64
SLC_TOP = 16
WINDOW = 512
Q_BLOCK = 128
N_GROUPS = 8
EXPERTS_PER_GROUP = 8
N_EXPERTS = N_GROUPS * EXPERTS_PER_GROUP
TOP_K = 2
D_EXPERT = D_MODEL // 2
MOE_BLOCK = 128
NEG = -1e30
FORCE_BONUS = 1e4
EPS = 1e-6

IN_SPLITS = (DIFF_HEADS * 2 * HEAD_DIM, DIFF_HEADS * 2 * HEAD_DIM, DIFF_HEADS * DIFF_V_DIM,
             NSA_HEADS * HEAD_DIM) + (NSA_KV_HEADS * HEAD_DIM,) * 6 + (3 * NSA_HEADS,)
IN_COLS = sum(IN_SPLITS)

kernel_name = 'hymba_diffattn_nsa_hiermoe_block'


def rmsnorm(x, g):
    xf = x.astype(jnp.float32)
    y = xf * lax.rsqrt(jnp.mean(xf * xf, axis=-1, keepdims=True) + EPS)
    return (y * g.astype(jnp.float32)).astype(x.dtype)


def masked_softmax(s, mask):
    s = jnp.where(mask, s.astype(jnp.float32), NEG)
    m = jnp.max(s, axis=-1, keepdims=True)
    e = jnp.where(mask, jnp.exp(s - m), 0.0)
    return e / jnp.maximum(jnp.sum(e, axis=-1, keepdims=True), 1e-30)


def alibi_slopes(n):
    return np.array([2.0 ** (-8.0 * (i + 1) / n) for i in range(n)], dtype=np.float32)


def diff_attention(q, k, v, lam_q1, lam_k1, lam_q2, lam_k2, g_subln, lambda_init):
    B, S = q.shape[0], q.shape[1]
    nblk = S // Q_BLOCK
    scale = HEAD_DIM ** -0.5
    f32 = jnp.float32
    lam = (jnp.exp(jnp.sum(lam_q1.astype(f32) * lam_k1.astype(f32)))
           - jnp.exp(jnp.sum(lam_q2.astype(f32) * lam_k2.astype(f32))) + lambda_init)
    slopes = jnp.asarray(alibi_slopes(DIFF_HEADS))[:, None, None, None]
    qb = q.reshape(B, nblk, Q_BLOCK, DIFF_HEADS, 2, HEAD_DIM).transpose(1, 0, 3, 4, 2, 5)
    kt = k.transpose(0, 2, 3, 1, 4)
    vt = v.transpose(0, 2, 1, 3)
    kpos = jnp.arange(S)

    def block(args):
        q_blk, i = args
        qpos = i * Q_BLOCK + jnp.arange(Q_BLOCK)
        dist = qpos[:, None] - kpos[None, :]
        s = jnp.einsum('bhcqd,bhckd->bhcqk', q_blk, kt).astype(f32) * scale
        s = s - slopes * dist.astype(f32)
        p = masked_softmax(s, dist >= 0)
        a = p[:, :, 0] - lam * p[:, :, 1]
        return jnp.einsum('bhqk,bhkd->bhqd', a.astype(vt.dtype), vt)

    o = lax.map(block, (qb, jnp.arange(nblk)))
    o = o.transpose(1, 0, 3, 2, 4).reshape(B, S, DIFF_HEADS, DIFF_V_DIM)
    o = rmsnorm(o, g_subln) * (1.0 - lambda_init)
    return o.reshape(B, S, DIFF_WIDTH)


def nsa_attention(q, k_cmp, v_cmp, k_slc, v_slc, k_win, v_win, gates,
                  pos_k, pos_v, w1_k, w1_v, w2_k, w2_v):
    B, S = q.shape[0], q.shape[1]
    nblk = S // Q_BLOCK
    scale = HEAD_DIM ** -0.5
    f32 = jnp.float32
    slopes = jnp.asarray(alibi_slopes(NSA_HEADS).reshape(NSA_KV_HEADS, NSA_GROUP))[None, :, :, None, None]

    n_cmp = (S - CMP_BLOCK) // CMP_STRIDE + 1
    cidx = np.arange(n_cmp)[:, None] * CMP_STRIDE + np.arange(CMP_BLOCK)[None, :]
    cend = jnp.asarray(cidx[:, -1])

    def compress(t, pos, w1, w2):
        blocks = t[:, cidx] + pos[None, None, :, None, :]
        flat = blocks.transpose(0, 1, 3, 2, 4).reshape(B, n_cmp, NSA_KV_HEADS, CMP_BLOCK * HEAD_DIM)
        return jax.nn.gelu(flat @ w1) @ w2

    kc = compress(k_cmp, pos_k, w1_k, w2_k)
    vc = compress(v_cmp, pos_v, w1_v, w2_v)

    n_slc = S // SLC_BLOCK
    n_top = min(SLC_TOP, n_slc)
    cstart = cidx[:, 0]
    sstart = np.arange(n_slc) * SLC_BLOCK
    overlap = jnp.asarray(((cstart[:, None] < sstart[None, :] + SLC_BLOCK)
                           & (cstart[:, None] + CMP_BLOCK > sstart[None, :])).astype(np.float32))
    jblk = jnp.arange(n_slc)
    slc_kt = k_slc.transpose(0, 2, 1, 3)
    slc_vt = v_slc.transpose(0, 2, 1, 3)
    bi = jnp.arange(B)[:, None, None, None]
    hi = jnp.arange(NSA_KV_HEADS)[None, :, None, None]

    pad = ((0, 0), (WINDOW, 0), (0, 0), (0, 0))
    kw_pad = jnp.pad(k_win, pad)
    vw_pad = jnp.pad(v_win, pad)

    qb = q.reshape(B, nblk, Q_BLOCK, NSA_KV_HEADS, NSA_GROUP, HEAD_DIM).transpose(1, 0, 2, 3, 4, 5)
    gb = gates.reshape(B, nblk, Q_BLOCK, NSA_KV_HEADS, NSA_GROUP, 3).transpose(1, 0, 2, 3, 4, 5)

    def block(args):
        q_blk, g_blk, i = args
        q0 = i * Q_BLOCK
        qpos = q0 + jnp.arange(Q_BLOCK)
        dc = qpos[:, None] - cend[None, :]
        s = jnp.einsum('bqhgd,bkhd->bhgqk', q_blk, kc).astype(f32) * scale - slopes * dc.astype(f32)
        p_c = masked_softmax(s, dc >= 0)
        o_c = jnp.einsum('bhgqk,bkhd->bqhgd', p_c.astype(vc.dtype), vc)
        imp = jnp.einsum('bhgqk,kj->bhqj', p_c, overlap)
        cur = qpos[:, None] // SLC_BLOCK
        forced = (jblk[None, :] == 0) | (jblk[None, :] == cur) | (jblk[None, :] == cur - 1)
        valid = jblk[None, :] * SLC_BLOCK <= qpos[:, None]
        score = jnp.where(valid, imp + FORCE_BONUS * forced.astype(f32), NEG)
        _, top = lax.top_k(score, n_top)
        tok = (top[..., None] * SLC_BLOCK + jnp.arange(SLC_BLOCK)).reshape(
            B, NSA_KV_HEADS, Q_BLOCK, n_top * SLC_BLOCK)
        k_sel = slc_kt[bi, hi, tok]
        v_sel = slc_vt[bi, hi, tok]
        ds = qpos[None, None, :, None] - tok
        s = (jnp.einsum('bqhgd,bhqnd->bhgqn', q_blk, k_sel).astype(f32) * scale
             - slopes * ds[:, :, None].astype(f32))
        p_s = masked_softmax(s, (ds >= 0)[:, :, None])
        o_s = jnp.einsum('bhgqn,bhqnd->bqhgd', p_s.astype(v_sel.dtype), v_sel)
        kw = lax.dynamic_slice_in_dim(kw_pad, q0, WINDOW + Q_BLOCK, axis=1)
        vw = lax.dynamic_slice_in_dim(vw_pad, q0, WINDOW + Q_BLOCK, axis=1)
        wpos = q0 - WINDOW + jnp.arange(WINDOW + Q_BLOCK)
        dw = qpos[:, None] - wpos[None, :]
        s = jnp.einsum('bqhgd,bkhd->bhgqk', q_blk, kw).astype(f32) * scale - slopes * dw.astype(f32)
        p_w = masked_softmax(s, (dw >= 0) & (dw < WINDOW) & (wpos[None, :] >= 0))
        o_w = jnp.einsum('bhgqk,bkhd->bqhgd', p_w.astype(vw.dtype), vw)
        return g_blk[..., 0:1] * o_c + g_blk[..., 1:2] * o_s + g_blk[..., 2:3] * o_w

    o = lax.map(block, (qb, gb, jnp.arange(nblk)))
    return o.transpose(1, 0, 2, 3, 4, 5).reshape(B, S, NSA_WIDTH)


def hier_moe(h, w_rg, b_rg, w_re, b_re, w_gate, w_up, w_down):
    B, S, D = h.shape
    f32 = jnp.float32
    t = h.reshape(-1, D)
    T = t.shape[0]
    lg = (t @ w_rg).astype(f32) + b_rg.astype(f32)
    pg = jax.nn.softmax(lg, axis=-1)
    grp = jnp.argmax(lg, axis=-1)
    p_grp = jnp.take_along_axis(pg, grp[:, None], axis=-1)
    le = ((t @ w_re).astype(f32) + b_re.astype(f32)).reshape(T, N_GROUPS, EXPERTS_PER_GROUP)
    le = jnp.take_along_axis(le, grp[:, None, None], axis=1)[:, 0]
    top_v, top_i = lax.top_k(le, TOP_K)
    wts = jax.nn.softmax(top_v, axis=-1) * p_grp
    eidx = grp[:, None] * EXPERTS_PER_GROUP + top_i

    A = T * TOP_K
    flat_e = eidx.reshape(-1)
    order = jnp.argsort(flat_e)
    sorted_e = flat_e[order]
    counts = jnp.zeros((N_EXPERTS,), jnp.int32).at[flat_e].add(1)
    padded = (counts + MOE_BLOCK - 1) // MOE_BLOCK * MOE_BLOCK
    pad_end = jnp.cumsum(padded)
    pad_start = pad_end - padded
    start = jnp.cumsum(counts) - counts
    dest = pad_start[sorted_e] + (jnp.arange(A) - start[sorted_e])
    n_blocks = -(-A // MOE_BLOCK) + N_EXPERTS
    R = n_blocks * MOE_BLOCK
    xbuf = jnp.zeros((R, D), t.dtype).at[dest].set(t[order // TOP_K])
    blk_e = jnp.minimum(jnp.searchsorted(pad_end, jnp.arange(n_blocks) * MOE_BLOCK, side='right'),
                        N_EXPERTS - 1)

    def expert_block(args):
        xb, e = args
        hid = jax.nn.silu(xb @ w_gate[e]) * (xb @ w_up[e])
        return hid @ w_down[e]

    ybuf = lax.map(expert_block, (xbuf.reshape(n_blocks, MOE_BLOCK, D), blk_e)).reshape(R, D)
    y = jnp.zeros((A, D), ybuf.dtype).at[order].set(ybuf[dest])
    out = jnp.einsum('tkd,tk->td', y.reshape(T, TOP_K, D), wts.astype(y.dtype))
    return out.reshape(B, S, D)


def setup_inputs(seed: int = 0) -> dict:
    key = jax.random.key(seed)
    ks = jax.random.split(key, 32)
    f32 = jnp.float32
    L, D = DEPTH, D_MODEL

    def nrm(k, shape, scale):
        return jax.random.normal(k, shape, f32) * scale

    return {
        'x': nrm(ks[0], (BATCH, SEQ, D), 1.0),
        'c': nrm(ks[1], (BATCH, D), 1.0),
        'w_ada': nrm(ks[2], (L, D, 6 * D), 0.5 * D ** -0.5),
        'b_ada': nrm(ks[3], (L, 6 * D), 0.02),
        'g_pre_mix': 1.0 + nrm(ks[4], (L, D), 0.05),
        'g_post_mix': 1.0 + nrm(ks[5], (L, D), 0.05),
        'g_pre_ffn': 1.0 + nrm(ks[6], (L, D), 0.05),
        'g_post_ffn': 1.0 + nrm(ks[7], (L, D), 0.05),
        'w_in': nrm(ks[8], (L, D, IN_COLS), D ** -0.5),
        'lam_q1': nrm(ks[9], (L, HEAD_DIM), 0.1),
        'lam_k1': nrm(ks[10], (L, HEAD_DIM), 0.1),
        'lam_q2': nrm(ks[11], (L, HEAD_DIM), 0.1),
        'lam_k2': nrm(ks[12], (L, HEAD_DIM), 0.1),
        'g_subln': 1.0 + nrm(ks[13], (L, DIFF_V_DIM), 0.05),
        'cmp_pos_k': nrm(ks[14], (L, CMP_BLOCK, HEAD_DIM), 0.1),
        'cmp_pos_v': nrm(ks[15], (L, CMP_BLOCK, HEAD_DIM), 0.1),
        'cmp_w1_k': nrm(ks[16], (L, CMP_BLOCK * HEAD_DIM, CMP_HIDDEN), (CMP_BLOCK * HEAD_DIM) ** -0.5),
        'cmp_w1_v': nrm(ks[17], (L, CMP_BLOCK * HEAD_DIM, CMP_HIDDEN), (CMP_BLOCK * HEAD_DIM) ** -0.5),
        'cmp_w2_k': nrm(ks[18], (L, CMP_HIDDEN, HEAD_DIM), CMP_HIDDEN ** -0.5),
        'cmp_w2_v': nrm(ks[19], (L, CMP_HIDDEN, HEAD_DIM), CMP_HIDDEN ** -0.5),
        'w_out': nrm(ks[20], (L, D, D), D ** -0.5),
        'w_router_grp': nrm(ks[21], (L, D, N_GROUPS), D ** -0.5),
        'b_router_grp': nrm(ks[22], (L, N_GROUPS), 0.01),
        'w_router_exp': nrm(ks[23], (L, D, N_EXPERTS), D ** -0.5),
        'b_router_exp': nrm(ks[24], (L, N_EXPERTS), 0.01),
        'w_exp_gate': nrm(ks[25], (L, N_EXPERTS, D, D_EXPERT), D ** -0.5),
        'w_exp_up': nrm(ks[26], (L, N_EXPERTS, D, D_EXPERT), D ** -0.5),
        'w_exp_down': nrm(ks[27], (L, N_EXPERTS, D_EXPERT, D), D_EXPERT ** -0.5),
    }


def reference(x, c, w_ada, b_ada, g_pre_mix, g_post_mix, g_pre_ffn, g_post_ffn, w_in,
              lam_q1, lam_k1, lam_q2, lam_k2, g_subln, cmp_pos_k, cmp_pos_v,
              cmp_w1_k, cmp_w1_v, cmp_w2_k, cmp_w2_v, w_out,
              w_router_grp, b_router_grp, w_router_exp, b_router_exp,
              w_exp_gate, w_exp_up, w_exp_down):
    B, S = x.shape[0], x.shape[1]
    split_at = np.cumsum(IN_SPLITS)[:-1].tolist()
    for l in range(DEPTH):
        lambda_init = 0.8 - 0.6 * math.exp(-0.3 * l)
        mod = jax.nn.silu(c) @ w_ada[l] + b_ada[l]
        sh_a, sc_a, gt_a, sh_f, sc_f, gt_f = jnp.split(mod, 6, axis=-1)

        h = rmsnorm(x, g_pre_mix[l]) * (1.0 + sc_a[:, None, :]) + sh_a[:, None, :]
        u = jnp.einsum('bsd,de->bse', h, w_in[l])
        dq, dk, dv, nq, ck, cv, sk, sv, wk, wv, ng = jnp.split(u, split_at, axis=-1)
        kvs = (B, S, NSA_KV_HEADS, HEAD_DIM)
        o_a = diff_attention(dq.reshape(B, S, DIFF_HEADS, 2, HEAD_DIM),
                             dk.reshape(B, S, DIFF_HEADS, 2, HEAD_DIM),
                             dv.reshape(B, S, DIFF_HEADS, DIFF_V_DIM),
                             lam_q1[l], lam_k1[l], lam_q2[l], lam_k2[l], g_subln[l], lambda_init)
        gates = jax.nn.sigmoid(ng.astype(jnp.float32)).astype(u.dtype).reshape(B, S, NSA_HEADS, 3)
        o_b = nsa_attention(nq.reshape(B, S, NSA_HEADS, HEAD_DIM),
                            ck.reshape(kvs), cv.reshape(kvs), sk.reshape(kvs), sv.reshape(kvs),
                            wk.reshape(kvs), wv.reshape(kvs), gates,
                            cmp_pos_k[l], cmp_pos_v[l], cmp_w1_k[l], cmp_w1_v[l],
                            cmp_w2_k[l], cmp_w2_v[l])
        mix = jnp.concatenate([o_a, o_b], axis=-1) @ w_out[l]
        x = x + gt_a[:, None, :] * rmsnorm(mix, g_post_mix[l])

        h = rmsnorm(x, g_pre_ffn[l]) * (1.0 + sc_f[:, None, :]) + sh_f[:, None, :]
        f = hier_moe(h, w_router_grp[l], b_router_grp[l], w_router_exp[l], b_router_exp[l],
                     w_exp_gate[l], w_exp_up[l], w_exp_down[l])
        x = x + gt_f[:, None, :] * rmsnorm(f, g_post_ffn[l])
    return x
```

```cpp
#include <hip/hip_runtime.h>
#include <hip/hip_cooperative_groups.h>
#include <cstdio>
#include <cstdint>
namespace cg = cooperative_groups;

#ifndef MK_FUSED
#define MK_FUSED 0
#endif

typedef unsigned short bf16_t;
typedef short bf16x8 __attribute__((ext_vector_type(8)));
typedef float f32x4 __attribute__((ext_vector_type(4)));
typedef unsigned u32x4 __attribute__((ext_vector_type(4)));
typedef unsigned u32x2 __attribute__((ext_vector_type(2)));

constexpr int NT = 512, NW = 8;
constexpr int BATCH = 2, SEQ = 8192, DM = 1024, M = BATCH * SEQ;
constexpr int UC = 3072, IN_COLS = 2840;
constexpr int C_DQ = 0, C_DK = 512, C_DV = 1024, C_NQ = 1536, C_CK = 2048, C_CV = 2176, C_SK = 2304, C_SV = 2432, C_WK = 2560, C_WV = 2688, C_NG = 2816;
constexpr int NEXP = 64, RMAX = 49152, NCMP = 511;
constexpr int LDS_BYTES = 147456;

constexpr size_t MiB = 1u << 20;
constexpr size_t WS_CTL = 0;
constexpr size_t WS_MOD = 1 * MiB;
constexpr size_t WS_KC = 2 * MiB;
constexpr size_t WS_VC = 3 * MiB;
constexpr size_t WS_LOG = 4 * MiB;
constexpr size_t WS_TOKE = 10 * MiB;
constexpr size_t WS_TOKP = WS_TOKE + 128 * 1024;
constexpr size_t WS_TOKW = WS_TOKP + 128 * 1024;
constexpr size_t WS_TOKR = WS_TOKW + 128 * 1024;
constexpr size_t WS_ROWT = 11 * MiB;
constexpr size_t WS_WR = 14 * MiB;
constexpr size_t WS_WTIN = 16 * MiB;
constexpr size_t WS_WTOUT = 22 * MiB;
constexpr size_t WS_WTGU = 24 * MiB;
constexpr size_t WS_WTDN = 152 * MiB;
constexpr size_t WS_XN = 216 * MiB;
constexpr size_t WS_U = 248 * MiB;
constexpr size_t WS_OC = 344 * MiB;
constexpr size_t WS_AO = 408 * MiB;
constexpr size_t WS_MIX = 440 * MiB;
constexpr size_t WS_H2 = WS_XN;
constexpr size_t WS_H2F = WS_OC;
constexpr size_t WS_HID = WS_U;
constexpr size_t WS_Y = 296 * MiB;
constexpr size_t WS_END = 504 * MiB;

struct Params { const float* in[28]; float* out; unsigned char* ws; };

__device__ __forceinline__ float bf2f(bf16_t v) { return __uint_as_float(((unsigned)v) << 16); }
__device__ __forceinline__ bf16_t f2bf(float f) { unsigned u = __float_as_uint(f); return (bf16_t)((u + 0x7fffu + ((u >> 16) & 1u)) >> 16); }
__device__ __forceinline__ unsigned pk2(float lo, float hi) { return (unsigned)f2bf(lo) | ((unsigned)f2bf(hi) << 16); }
__device__ __forceinline__ float wave_sum(float v) {
#pragma unroll
    for (int o = 32; o > 0; o >>= 1) v += __shfl_xor(v, o);
    return v;
}
__device__ __forceinline__ float wave_max(float v) {
#pragma unroll
    for (int o = 32; o > 0; o >>= 1) v = fmaxf(v, __shfl_xor(v, o));
    return v;
}
__device__ __forceinline__ void lds_fence() { asm volatile("s_waitcnt lgkmcnt(0)" ::: "memory"); }
__device__ __forceinline__ float silu_f(float x) { return x / (1.f + __expf(-x)); }
__device__ __forceinline__ float gelu_tanh(float x) { return 0.5f * x * (1.f + tanhf(0.7978845608028654f * (x + 0.044715f * x * x * x))); }
__device__ __forceinline__ void unpack8(const u32x4 w, float* v) {
    v[0] = __uint_as_float(w.x << 16); v[1] = __uint_as_float(w.x & 0xffff0000u);
    v[2] = __uint_as_float(w.y << 16); v[3] = __uint_as_float(w.y & 0xffff0000u);
    v[4] = __uint_as_float(w.z << 16); v[5] = __uint_as_float(w.z & 0xffff0000u);
    v[6] = __uint_as_float(w.w << 16); v[7] = __uint_as_float(w.w & 0xffff0000u);
}

template <class AF, class Epi>
__device__ __forceinline__ void gemm128(const AF& arow, const bf16_t* Bt, int K, const Epi& epi) {
    const int tid = threadIdx.x, wid = tid >> 6, lane = tid & 63, fr = lane & 15, fq = lane >> 4, wr = wid >> 2, wc = wid & 3;
    const bf16_t* ap[4]; const bf16_t* bp[2];
#pragma unroll
    for (int m = 0; m < 4; ++m) ap[m] = arow(wr * 64 + m * 16 + fr) + fq * 8;
#pragma unroll
    for (int n = 0; n < 2; ++n) bp[n] = Bt + (size_t)(wc * 32 + n * 16 + fr) * K + fq * 8;
    f32x4 acc[4][2];
#pragma unroll
    for (int m = 0; m < 4; ++m)
#pragma unroll
        for (int n = 0; n < 2; ++n) acc[m][n] = (f32x4){0.f, 0.f, 0.f, 0.f};
#pragma unroll 2
    for (int k0 = 0; k0 < K; k0 += 32) {
        bf16x8 a[4], b[2];
#pragma unroll
        for (int m = 0; m < 4; ++m) a[m] = *(const bf16x8*)(ap[m] + k0);
#pragma unroll
        for (int n = 0; n < 2; ++n) b[n] = *(const bf16x8*)(bp[n] + k0);
#pragma unroll
        for (int m = 0; m < 4; ++m)
#pragma unroll
            for (int n = 0; n < 2; ++n) acc[m][n] = __builtin_amdgcn_mfma_f32_16x16x32_bf16(b[n], a[m], acc[m][n], 0, 0, 0);
    }
#pragma unroll
    for (int m = 0; m < 4; ++m)
#pragma unroll
        for (int n = 0; n < 2; ++n) epi(wr * 64 + m * 16 + fr, wc * 32 + n * 16 + fq * 4, acc[m][n]);
}

__device__ __forceinline__ void transpose_item(const float* W, int K, int Nsrc, bf16_t* WT, int roff, int rmul, float* scr, int kb, int nb, int lane) {
    const int k0 = 64 * kb, n0 = 32 * nb;
#pragma unroll 8
    for (int i = 0; i < 32; ++i) { const int kk = 2 * i + (lane >> 5), n = n0 + (lane & 31); scr[kk * 33 + (lane & 31)] = (n < Nsrc) ? W[(size_t)(k0 + kk) * Nsrc + n] : 0.f; }
    lds_fence();
    const int c = lane & 7;
#pragma unroll
    for (int j = 0; j < 4; ++j) { const int n = (lane >> 3) + 8 * j; const float* s = scr + (8 * c) * 33 + n;
        u32x4 o; o.x = pk2(s[0 * 33], s[1 * 33]); o.y = pk2(s[2 * 33], s[3 * 33]); o.z = pk2(s[4 * 33], s[5 * 33]); o.w = pk2(s[6 * 33], s[7 * 33]);
        *(u32x4*)(WT + (size_t)(roff + (n0 + n) * rmul) * K + k0 + 8 * c) = o; }
    lds_fence();
}

__device__ __forceinline__ void stage0(const Params& p, unsigned char* smem) {
    const int tid = threadIdx.x, wid = tid >> 6, lane = tid & 63, G = gridDim.x;
    unsigned char* ws = p.ws;
    for (int vb = blockIdx.x; vb < 96; vb += G) {
        float* ssl = (float*)smem; float* red = (float*)(smem + 8192);
        for (int i = tid; i < 2048; i += NT) ssl[i] = silu_f(p.in[1][i]);
        __syncthreads();
        const int j = vb * 64 + lane; float a0 = 0.f, a1 = 0.f;
        const float* wa = p.in[2];
        for (int k = wid * 128; k < wid * 128 + 128; ++k) { const float w = wa[(size_t)k * 6144 + j]; a0 += ssl[k] * w; a1 += ssl[1024 + k] * w; }
        red[(wid * 2 + 0) * 64 + lane] = a0; red[(wid * 2 + 1) * 64 + lane] = a1;
        __syncthreads();
        if (wid == 0) { float s0 = 0.f, s1 = 0.f;
            for (int w = 0; w < 8; ++w) { s0 += red[(w * 2) * 64 + lane]; s1 += red[(w * 2 + 1) * 64 + lane]; }
            float* mod = (float*)(ws + WS_MOD); mod[j] = s0 + p.in[3][j]; mod[6144 + j] = s1 + p.in[3][j]; }
        __syncthreads();
    }
    {
        float* scr = (float*)(smem + wid * 8448);
        const int gw = blockIdx.x * NW + wid, NGW = G * NW;
        constexpr int I_IN = 16 * 96, I_OUT = 16 * 32, I_E = 256;
        constexpr int NITEMS = I_IN + I_OUT + 64 * 3 * I_E;
        for (int it = gw; it < NITEMS; it += NGW) {
            int r = it;
            if (r < I_IN) { transpose_item(p.in[8], 1024, IN_COLS, (bf16_t*)(ws + WS_WTIN), 0, 1, scr, r / 96, r % 96, lane); continue; } r -= I_IN;
            if (r < I_OUT) { transpose_item(p.in[20], 1024, 1024, (bf16_t*)(ws + WS_WTOUT), 0, 1, scr, r / 32, r % 32, lane); continue; } r -= I_OUT;
            const int e = r / (3 * I_E), q = r % (3 * I_E), kind = q / I_E, ii = q % I_E;
            if (kind == 0) transpose_item(p.in[25] + (size_t)e * 1024 * 512, 1024, 512, (bf16_t*)(ws + WS_WTGU) + (size_t)e * 1024 * 1024, 0, 2, scr, ii / 16, ii % 16, lane);
            else if (kind == 1) transpose_item(p.in[26] + (size_t)e * 1024 * 512, 1024, 512, (bf16_t*)(ws + WS_WTGU) + (size_t)e * 1024 * 1024, 1, 2, scr, ii / 16, ii % 16, lane);
            else transpose_item(p.in[27] + (size_t)e * 512 * 1024, 512, 1024, (bf16_t*)(ws + WS_WTDN) + (size_t)e * 1024 * 512, 0, 1, scr, ii / 32, ii % 32, lane);
        }
    }
    {
        const int gt = blockIdx.x * NT + tid, NGT = G * NT;
        float* wr = (float*)(ws + WS_WR);
        for (int i = gt; i < 1024 * 80; i += NGT) { const int k = i / 80, c = i % 80; wr[i] = c < 64 ? p.in[23][k * 64 + c] : (c < 72 ? p.in[21][k * 8 + (c - 64)] : 0.f); }
        int* rowt = (int*)(ws + WS_ROWT);
        for (int i = gt; i < RMAX; i += NGT) rowt[i] = -1;
    }
}

__device__ __forceinline__ void stage1(const Params& p) {
    const int tid = threadIdx.x, wid = tid >> 6, lane = tid & 63;
    const float* mod = (const float*)(p.ws + WS_MOD);
    bf16_t* xn = (bf16_t*)(p.ws + WS_XN);
    for (int row = blockIdx.x * NW + wid; row < M; row += gridDim.x * NW) {
        const int b = row / SEQ;
        const f32x4* xr = (const f32x4*)(p.in[0] + (size_t)row * DM) + lane;
        f32x4 v[4]; float ss = 0.f;
#pragma unroll
        for (int j = 0; j < 4; ++j) { v[j] = xr[64 * j]; ss += v[j].x * v[j].x + v[j].y * v[j].y + v[j].z * v[j].z + v[j].w * v[j].w; }
        const float rstd = rsqrtf(wave_sum(ss) * (1.f / DM) + 1e-6f);
#pragma unroll
        for (int j = 0; j < 4; ++j) { const int col = lane * 4 + 256 * j;
            const f32x4 g = *(const f32x4*)(p.in[4] + col), sc = *(const f32x4*)(mod + b * 6144 + 1024 + col), sh = *(const f32x4*)(mod + b * 6144 + col);
            const f32x4 h = v[j] * rstd * g * (sc + 1.f) + sh;
            u32x2 o; o.x = pk2(h.x, h.y); o.y = pk2(h.z, h.w);
            *(u32x2*)(xn + (size_t)row * DM + col) = o; }
    }
}

__device__ __forceinline__ void stage2(const Params& p) {
    const bf16_t* xn = (const bf16_t*)(p.ws + WS_XN); const bf16_t* wt = (const bf16_t*)(p.ws + WS_WTIN); bf16_t* U = (bf16_t*)(p.ws + WS_U);
    for (int vb = blockIdx.x; vb < (M / 128) * (UC / 128); vb += gridDim.x) {
        const int tn = vb % (UC / 128), tm = vb / (UC / 128);
        auto arow = [&](int r) { return xn + (size_t)(tm * 128 + r) * DM; };
        auto epi = [&](int r, int c, f32x4 v) { u32x2 o; o.x = pk2(v[0], v[1]); o.y = pk2(v[2], v[3]); *(u32x2*)(U + (size_t)(tm * 128 + r) * UC + tn * 128 + c) = o; };
        gemm128(arow, wt + (size_t)tn * 128 * DM, DM, epi);
    }
}

__device__ __forceinline__ void diff_attn_block(const Params& p, unsigned char* smem, int vb) {
    const int tid = threadIdx.x;
    const int qb = 15 - vb / 32, rest = vb % 32, b = rest >> 4, h = (rest >> 2) & 3, c = (rest >> 1) & 1, vh = rest & 1;
    const bf16_t* U = (const bf16_t*)(p.ws + WS_U);
    float* Ks = (float*)smem;
    float* Vs = (float*)(smem + 16384);
    const int qrow = qb * 512 + tid; const size_t row = (size_t)b * SEQ + qrow;
    float q[64];
    {
        const u32x4* qp = (const u32x4*)(U + row * UC + C_DQ + h * 128 + c * 64);
#pragma unroll
        for (int i = 0; i < 8; ++i) unpack8(qp[i], q + 8 * i);
#pragma unroll
        for (int i = 0; i < 64; ++i) q[i] *= 0.125f;
    }
    float o[64];
#pragma unroll
    for (int i = 0; i < 64; ++i) o[i] = 0.f;
    float m = -1e30f, l = 0.f;
    const float slope = exp2f(-2.f * (float)(h + 1));
    const int ntiles = (qb * 512 + 512) / 64;
    for (int tile = ntiles - 1; tile >= 0; --tile) {
        __syncthreads();
        {
            const int key = tid >> 3, ch = tid & 7; const size_t krow = (size_t)b * SEQ + tile * 64 + key;
            float t8[8];
            unpack8(*(const u32x4*)(U + krow * UC + C_DK + h * 128 + c * 64 + ch * 8), t8);
#pragma unroll
            for (int e = 0; e < 8; ++e) Ks[key * 64 + ch * 8 + e] = t8[e];
            unpack8(*(const u32x4*)(U + krow * UC + C_DV + h * 128 + vh * 64 + ch * 8), t8);
#pragma unroll
            for (int e = 0; e < 8; ++e) Vs[key * 64 + ch * 8 + e] = t8[e];
        }
        __syncthreads();
        const int k0 = tile * 64;
        if (k0 <= qrow) {
#pragma unroll 1
            for (int j = 63; j >= 0; --j) {
                const int kpos = k0 + j;
                if (kpos <= qrow) {
                    const f32x4* kr = (const f32x4*)(Ks + j * 64);
                    float s0 = 0.f, s1 = 0.f;
#pragma unroll
                    for (int d = 0; d < 16; d += 2) { const f32x4 ka = kr[d], kb = kr[d + 1];
                        s0 += q[4 * d] * ka.x + q[4 * d + 1] * ka.y + q[4 * d + 2] * ka.z + q[4 * d + 3] * ka.w;
                        s1 += q[4 * d + 4] * kb.x + q[4 * d + 5] * kb.y + q[4 * d + 6] * kb.z + q[4 * d + 7] * kb.w; }
                    const float s = s0 + s1 - slope * (float)(qrow - kpos);
                    if (s > m) { const float corr = __expf(m - s); l *= corr;
#pragma unroll
                        for (int e = 0; e < 64; ++e) o[e] *= corr;
                        m = s; }
                    const float pr = __expf(s - m); l += pr;
                    const f32x4* vr = (const f32x4*)(Vs + j * 64);
#pragma unroll
                    for (int e = 0; e < 16; ++e) { const f32x4 vv = vr[e]; o[4 * e] += pr * vv.x; o[4 * e + 1] += pr * vv.y; o[4 * e + 2] += pr * vv.z; o[4 * e + 3] += pr * vv.w; }
                }
            }
        }
    }
    const float il = 1.f / l;
    f32x4* op = (f32x4*)((float*)(p.ws + WS_OC) + ((row * 4 + h) * 2 + c) * 128 + vh * 64);
#pragma unroll
    for (int e = 0; e < 16; ++e) op[e] = (f32x4){o[4 * e] * il, o[4 * e + 1] * il, o[4 * e + 2] * il, o[4 * e + 3] * il};
}

__device__ __forceinline__ void compress_block(const Params& p, unsigned char* smem, int idx) {
    const int tid = threadIdx.x;
    const int kv = idx >> 8, b = (idx >> 7) & 1, hkv = (idx >> 6) & 1, n_first = (idx & 63) * 8;
    const bf16_t* U = (const bf16_t*)(p.ws + WS_U);
    const int col = (kv ? C_CV : C_CK) + hkv * 64;
    float* ts = (float*)smem;
    float* ps = (float*)(smem + 36864);
    float* hs = (float*)(smem + 36864 + 8192);
    const float* pos = p.in[kv ? 15 : 14]; const float* w1 = p.in[kv ? 17 : 16]; const float* w2 = p.in[kv ? 19 : 18];
    __syncthreads();
    for (int i = tid; i < 144 * 64; i += NT) { const int tk = 16 * n_first + (i >> 6); ts[i] = tk < SEQ ? bf2f(U[((size_t)b * SEQ + tk) * UC + col + (i & 63)]) : 0.f; }
    for (int i = tid; i < 2048; i += NT) ps[i] = pos[i];
    __syncthreads();
    const int jh = tid & 127, sub = tid >> 7, r0 = sub * 2, r1 = r0 + 1;
    float a0 = 0.f, a1 = 0.f;
    for (int i = 0; i < 32; ++i)
#pragma unroll 8
        for (int d = 0; d < 64; ++d) { const float w = w1[(size_t)(i * 64 + d) * 128 + jh], pv = ps[i * 64 + d];
            a0 += (ts[(16 * r0 + i) * 64 + d] + pv) * w; a1 += (ts[(16 * r1 + i) * 64 + d] + pv) * w; }
    hs[r0 * 128 + jh] = gelu_tanh(a0); hs[r1 * 128 + jh] = gelu_tanh(a1);
    __syncthreads();
    { const int r = tid >> 6, d = tid & 63; float s = 0.f;
        for (int j = 0; j < 128; ++j) s += hs[r * 128 + j] * w2[j * 64 + d];
        const int n = n_first + r;
        if (n < NCMP) ((bf16_t*)(p.ws + (kv ? WS_VC : WS_KC)))[((size_t)(b * 512 + n) * 2 + hkv) * 64 + d] = f2bf(s); }
}

__device__ __forceinline__ void stage3(const Params& p, unsigned char* smem) {
    for (int vb = blockIdx.x; vb < 512; vb += gridDim.x) diff_attn_block(p, smem, vb);
    for (int vb = blockIdx.x; vb < 512; vb += gridDim.x) compress_block(p, smem, vb);
    __syncthreads();
}

__device__ __forceinline__ void qk4(const bf16_t* krow, const float* qs, float* s) {
    s[0] = s[1] = s[2] = s[3] = 0.f;
#pragma unroll 2
    for (int c = 0; c < 8; ++c) { float kd[8]; unpack8(*(const u32x4*)(krow + c * 8), kd);
#pragma unroll
        for (int g = 0; g < 4; ++g) { const f32x4 qa = *(const f32x4*)(qs + g * 64 + c * 8), qb = *(const f32x4*)(qs + g * 64 + c * 8 + 4);
            s[g] += kd[0] * qa.x + kd[1] * qa.y + kd[2] * qa.z + kd[3] * qa.w + kd[4] * qb.x + kd[5] * qb.y + kd[6] * qb.z + kd[7] * qb.w; } }
}
__device__ __forceinline__ void pv_block(const float* pw, int pstride, const bf16_t* vbase, size_t vstride, int nrows, float (&os)[4][8], int lane) {
    const int jr = lane >> 3, ch = lane & 7;
#pragma unroll 2
    for (int i = 0; i < 8; ++i) { const int j = jr + 8 * i;
        if (j < nrows) { float vd[8]; unpack8(*(const u32x4*)(vbase + (size_t)j * vstride + ch * 8), vd);
#pragma unroll
            for (int g = 0; g < 4; ++g) { const float pr = pw[g * pstride + j];
#pragma unroll
                for (int e = 0; e < 8; ++e) os[g][e] += pr * vd[e]; } } }
}

__device__ __forceinline__ void nsa_item(const Params& p, float* wl, int item, int lane) {
    const int hkv = item & 1, t = (item >> 1) % SEQ, b = (item >> 1) / SEQ;
    const bf16_t* U = (const bf16_t*)(p.ws + WS_U);
    const bf16_t* KC = (const bf16_t*)(p.ws + WS_KC); const bf16_t* VC = (const bf16_t*)(p.ws + WS_VC);
    const size_t row = (size_t)b * SEQ + t;
    float* qs = wl;
    float* ps = wl + 256;
    lds_fence();
#pragma unroll
    for (int g = 0; g < 4; ++g) qs[g * 64 + lane] = bf2f(U[row * UC + C_NQ + (hkv * 4 + g) * 64 + lane]);
    lds_fence();
    float slope[4], gate[4][3];
#pragma unroll
    for (int g = 0; g < 4; ++g) { slope[g] = exp2f(-(float)(hkv * 4 + g + 1));
#pragma unroll
        for (int i = 0; i < 3; ++i) { const float x = bf2f(U[row * UC + C_NG + (hkv * 4 + g) * 3 + i]); gate[g][i] = 1.f / (1.f + __expf(-x)); } }
    float tot[4][8];
#pragma unroll
    for (int g = 0; g < 4; ++g)
#pragma unroll
        for (int e = 0; e < 8; ++e) tot[g][e] = 0.f;
    const int nvalid = t >= 31 ? min((t - 31) / 16 + 1, NCMP) : 0;
    float cinv[4];
    {
        float mx[4] = {-1e30f, -1e30f, -1e30f, -1e30f};
#pragma unroll 1
        for (int i = 0; i < 8; ++i) { const int n = lane + 64 * i;
            asm volatile("" ::: "memory");
            if (n < nvalid) { float s[4]; qk4(KC + ((size_t)(b * 512 + n) * 2 + hkv) * 64, qs, s);
#pragma unroll
                for (int g = 0; g < 4; ++g) { const float v = s[g] * 0.125f - slope[g] * (float)(t - (16 * n + 31)); ps[g * 512 + n] = v; mx[g] = fmaxf(mx[g], v); } }
            else {
#pragma unroll
                for (int g = 0; g < 4; ++g) ps[g * 512 + n] = -1e30f; } }
        lds_fence();
#pragma unroll
        for (int g = 0; g < 4; ++g) { mx[g] = wave_max(mx[g]); float sum = 0.f;
#pragma unroll 1
            for (int i = 0; i < 8; ++i) { const int n = lane + 64 * i; const float e = n < nvalid ? __expf(ps[g * 512 + n] - mx[g]) : 0.f; ps[g * 512 + n] = e; sum += e; }
            sum = wave_sum(sum); cinv[g] = 1.f / fmaxf(sum, 1e-30f); }
        lds_fence();
        float oc[4][8];
#pragma unroll
        for (int g = 0; g < 4; ++g)
#pragma unroll
            for (int e = 0; e < 8; ++e) oc[g][e] = 0.f;
#pragma unroll 1
        for (int n0 = 0; n0 < nvalid; n0 += 64) pv_block(ps + n0, 512, VC + ((size_t)(b * 512 + n0) * 2 + hkv) * 64, 128, min(64, nvalid - n0), oc, lane);
#pragma unroll
        for (int g = 0; g < 4; ++g)
#pragma unroll
            for (int e = 0; e < 8; ++e) tot[g][e] += gate[g][0] * cinv[g] * oc[g][e];
    }
    const int cur = t >> 6;
    int mysel = 0;
    {
        float sc0, sc1;
        { float i0 = 0.f, i1 = 0.f;
#pragma unroll
            for (int g = 0; g < 4; ++g)
#pragma unroll
                for (int d = -1; d <= 3; ++d) { const int n0 = 4 * lane + d, n1 = 4 * (lane + 64) + d;
                    if (n0 >= 0 && n0 < NCMP) i0 += cinv[g] * ps[g * 512 + n0];
                    if (n1 < NCMP) i1 += cinv[g] * ps[g * 512 + n1]; }
            const int j0 = lane, j1 = lane + 64;
            const bool f0 = (j0 == 0) || (j0 == cur) || (j0 == cur - 1), f1 = (j1 == cur) || (j1 == cur - 1);
            sc0 = (j0 <= cur) ? i0 + (f0 ? 1e4f : 0.f) : -1e30f;
            sc1 = (j1 <= cur) ? i1 + (f1 ? 1e4f : 0.f) : -1e30f; }
        for (int r = 0; r < 16; ++r) {
            float v; int idx;
            if (sc0 >= sc1) { v = sc0; idx = lane; } else { v = sc1; idx = lane + 64; }
#pragma unroll
            for (int o = 32; o > 0; o >>= 1) { const float ov = __shfl_xor(v, o); const int oi = __shfl_xor(idx, o); if (ov > v || (ov == v && oi < idx)) { v = ov; idx = oi; } }
            if (idx == lane) sc0 = -3e38f; else if (idx == lane + 64) sc1 = -3e38f;
            if (lane == r) mysel = idx;
        }
    }
#pragma unroll 1
    for (int br = 0; br < 2; ++br) {
        float ms[4], ls[4], os[4][8];
#pragma unroll
        for (int g = 0; g < 4; ++g) { ms[g] = -1e30f; ls[g] = 0.f;
#pragma unroll
            for (int e = 0; e < 8; ++e) os[g][e] = 0.f; }
        const int kcol = (br == 0 ? C_SK : C_WK) + hkv * 64, vcol = (br == 0 ? C_SV : C_WV) + hkv * 64;
        const int lo = br == 0 ? 0 : max(t - 511, 0);
        const int nb = br == 0 ? 16 : (cur - (lo >> 6) + 1);
#pragma unroll 1
        for (int r = 0; r < nb; ++r) {
            int blk;
            if (br == 0) { blk = __shfl(mysel, r); if (blk > cur) continue; } else blk = (lo >> 6) + r;
            const int tok = blk * 64 + lane; const bool valid = tok <= t && tok >= lo;
            float s[4]; qk4(U + ((size_t)b * SEQ + tok) * UC + kcol, qs, s);
            lds_fence();
#pragma unroll
            for (int g = 0; g < 4; ++g) {
                const float sv = valid ? s[g] * 0.125f - slope[g] * (float)(t - tok) : -1e30f;
                const float mx = wave_max(sv), mnew = fmaxf(ms[g], mx), corr = __expf(ms[g] - mnew);
                const float pr = valid ? __expf(sv - mnew) : 0.f;
                ls[g] = ls[g] * corr + wave_sum(pr); ms[g] = mnew;
#pragma unroll
                for (int e = 0; e < 8; ++e) os[g][e] *= corr;
                ps[g * 64 + lane] = pr; }
            lds_fence();
            pv_block(ps, 64, U + ((size_t)b * SEQ + blk * 64) * UC + vcol, UC, 64, os, lane);
        }
#pragma unroll
        for (int g = 0; g < 4; ++g) { const float gsel = br == 0 ? gate[g][1] : gate[g][2]; const float w = ls[g] > 0.f ? gsel / ls[g] : 0.f;
#pragma unroll
            for (int e = 0; e < 8; ++e) tot[g][e] += w * os[g][e]; }
    }
#pragma unroll
    for (int g = 0; g < 4; ++g)
#pragma unroll
        for (int e = 0; e < 8; ++e) { float v = tot[g][e]; v += __shfl_xor(v, 8); v += __shfl_xor(v, 16); v += __shfl_xor(v, 32); tot[g][e] = v; }
    if (lane < 8) { bf16_t* ao = (bf16_t*)(p.ws + WS_AO) + row * DM + 512;
#pragma unroll
        for (int g = 0; g < 4; ++g) { u32x4 o; o.x = pk2(tot[g][0], tot[g][1]); o.y = pk2(tot[g][2], tot[g][3]); o.z = pk2(tot[g][4], tot[g][5]); o.w = pk2(tot[g][6], tot[g][7]);
            *(u32x4*)(ao + (hkv * 4 + g) * 64 + lane * 8) = o; } }
}

__device__ __forceinline__ void diffc_item(const Params& p, int item, int lane) {
    const int h = item & 3; const size_t row = item >> 2;
    float a = p.in[9][lane] * p.in[10][lane], c = p.in[11][lane] * p.in[12][lane];
    const float lam = __expf(wave_sum(a)) - __expf(wave_sum(c)) + 0.2f;
    const float* oc = (const float*)(p.ws + WS_OC) + (row * 4 + h) * 256;
    const float v0 = oc[lane] - lam * oc[128 + lane], v1 = oc[64 + lane] - lam * oc[192 + lane];
    const float rstd = rsqrtf(wave_sum(v0 * v0 + v1 * v1) * (1.f / 128.f) + 1e-6f);
    bf16_t* ao = (bf16_t*)(p.ws + WS_AO) + row * DM + h * 128;
    ao[lane] = f2bf(v0 * rstd * p.in[13][lane] * 0.8f); ao[64 + lane] = f2bf(v1 * rstd * p.in[13][64 + lane] * 0.8f);
}

__device__ __forceinline__ void stage4(const Params& p, unsigned char* smem) {
    const int tid = threadIdx.x, wid = tid >> 6, lane = tid & 63;
    const int gw = blockIdx.x * NW + wid, NGW = gridDim.x * NW;
    float* wl = (float*)(smem + wid * 9216);
    for (int it = gw; it < M * 2; it += NGW) nsa_item(p, wl, it, lane);
    for (int it = gw; it < M * 4; it += NGW) diffc_item(p, it, lane);
}

__device__ __forceinline__ void stage5(const Params& p) {
    const bf16_t* ao = (const bf16_t*)(p.ws + WS_AO); const bf16_t* wt = (const bf16_t*)(p.ws + WS_WTOUT); float* mix = (float*)(p.ws + WS_MIX);
    for (int vb = blockIdx.x; vb < (M / 128) * 8; vb += gridDim.x) {
        const int tn = vb % 8, tm = vb / 8;
        auto arow = [&](int r) { return ao + (size_t)(tm * 128 + r) * DM; };
        auto epi = [&](int r, int c, f32x4 v) { *(f32x4*)(mix + (size_t)(tm * 128 + r) * DM + tn * 128 + c) = v; };
        gemm128(arow, wt + (size_t)tn * 128 * DM, DM, epi);
    }
}

__device__ __forceinline__ void stage6(const Params& p) {
    const int tid = threadIdx.x, wid = tid >> 6, lane = tid & 63;
    const float* mod = (const float*)(p.ws + WS_MOD); const float* mix = (const float*)(p.ws + WS_MIX);
    bf16_t* h2 = (bf16_t*)(p.ws + WS_H2); float* h2f = (float*)(p.ws + WS_H2F);
    for (int row = blockIdx.x * NW + wid; row < M; row += gridDim.x * NW) {
        const int b = row / SEQ; const float* mb = mod + b * 6144;
        f32x4 v[4], x1[4]; float ss = 0.f;
#pragma unroll
        for (int j = 0; j < 4; ++j) { v[j] = *((const f32x4*)(mix + (size_t)row * DM) + lane + 64 * j); ss += v[j].x * v[j].x + v[j].y * v[j].y + v[j].z * v[j].z + v[j].w * v[j].w; }
        const float rstd = rsqrtf(wave_sum(ss) * (1.f / DM) + 1e-6f); float s2 = 0.f;
#pragma unroll
        for (int j = 0; j < 4; ++j) { const int col = lane * 4 + 256 * j;
            const f32x4 xv = *(const f32x4*)(p.in[0] + (size_t)row * DM + col), g = *(const f32x4*)(p.in[5] + col), gt = *(const f32x4*)(mb + 2048 + col);
            x1[j] = xv + gt * (v[j] * rstd * g);
            *(f32x4*)(p.out + (size_t)row * DM + col) = x1[j];
            s2 += x1[j].x * x1[j].x + x1[j].y * x1[j].y + x1[j].z * x1[j].z + x1[j].w * x1[j].w; }
        const float rstd2 = rsqrtf(wave_sum(s2) * (1.f / DM) + 1e-6f);
#pragma unroll
        for (int j = 0; j < 4; ++j) { const int col = lane * 4 + 256 * j;
            const f32x4 g = *(const f32x4*)(p.in[6] + col), sc = *(const f32x4*)(mb + 4096 + col), sh = *(const f32x4*)(mb + 3072 + col);
            const f32x4 h = x1[j] * rstd2 * g * (sc + 1.f) + sh;
            *(f32x4*)(h2f + (size_t)row * DM + col) = h;
            u32x2 o; o.x = pk2(h.x, h.y); o.y = pk2(h.z, h.w); *(u32x2*)(h2 + (size_t)row * DM + col) = o; }
    }
}

__device__ __forceinline__ void stage7(const Params& p) {
    const int tid = threadIdx.x, wid = tid >> 6, lane = tid & 63, r = lane & 15, q = lane >> 4;
    const float* h2f = (const float*)(p.ws + WS_H2F); const float* wr = (const float*)(p.ws + WS_WR); float* lg = (float*)(p.ws + WS_LOG);
    for (int it = blockIdx.x * NW + wid; it < M / 16; it += gridDim.x * NW) {
        const int row0 = it * 16;
        f32x4 acc[5];
#pragma unroll
        for (int j = 0; j < 5; ++j) acc[j] = (f32x4){0.f, 0.f, 0.f, 0.f};
        for (int k0 = 0; k0 < DM; k0 += 16) {
            const f32x4 a = *(const f32x4*)(h2f + (size_t)(row0 + r) * DM + k0 + 4 * q);
#pragma unroll
            for (int i = 0; i < 4; ++i) {
#pragma unroll
                for (int j = 0; j < 5; ++j) { const float bv = wr[(size_t)(k0 + 4 * q + i) * 80 + 16 * j + r];
                    acc[j] = __builtin_amdgcn_mfma_f32_16x16x4f32(a[i], bv, acc[j], 0, 0, 0); } }
        }
#pragma unroll
        for (int j = 0; j < 5; ++j)
#pragma unroll
            for (int i = 0; i < 4; ++i) lg[(size_t)(row0 + 4 * q + i) * 80 + 16 * j + r] = acc[j][i];
    }
}

__device__ __forceinline__ void stage8(const Params& p) {
    const float* lg = (const float*)(p.ws + WS_LOG);
    int* cnt = (int*)(p.ws + WS_CTL); int* toke = (int*)(p.ws + WS_TOKE); int* tokp = (int*)(p.ws + WS_TOKP); float* tokw = (float*)(p.ws + WS_TOKW);
    for (int t = blockIdx.x * NT + threadIdx.x; t < M; t += gridDim.x * NT) {
        float best = -3e38f; int grp = 0; float l8[8];
#pragma unroll
        for (int i = 0; i < 8; ++i) { l8[i] = lg[(size_t)t * 80 + 64 + i] + p.in[22][i]; if (l8[i] > best) { best = l8[i]; grp = i; } }
        float den = 0.f;
#pragma unroll
        for (int i = 0; i < 8; ++i) den += __expf(l8[i] - best);
        const float pg = 1.f / den;
        float v1 = -3e38f, v2 = -3e38f; int i1 = 0, i2 = 0;
#pragma unroll
        for (int i = 0; i < 8; ++i) { const float v = lg[(size_t)t * 80 + grp * 8 + i] + p.in[24][grp * 8 + i];
            if (v > v1) { v2 = v1; i2 = i1; v1 = v; i1 = i; } else if (v > v2) { v2 = v; i2 = i; } }
        const float e2 = __expf(v2 - v1), w1 = pg / (1.f + e2), w2 = pg * e2 / (1.f + e2);
        const int ea = grp * 8 + i1, eb = grp * 8 + i2;
        const int pa = atomicAdd(&cnt[ea], 1), pb = atomicAdd(&cnt[eb], 1);
        toke[t * 2] = ea; toke[t * 2 + 1] = eb; tokp[t * 2] = pa; tokp[t * 2 + 1] = pb; tokw[t * 2] = w1; tokw[t * 2 + 1] = w2;
    }
}

__device__ __forceinline__ void expert_bases(const Params& p, int* lb) {
    const int* cnt = (const int*)(p.ws + WS_CTL);
    __syncthreads();
    if (threadIdx.x < 65) { int s = 0; for (int e = 0; e < (int)threadIdx.x; ++e) s += (cnt[e] + 127) / 128 * 128; lb[threadIdx.x] = threadIdx.x < 64 ? s : s / 128; }
    __syncthreads();
}

__device__ __forceinline__ void stage9(const Params& p, unsigned char* smem) {
    int* lb = (int*)smem; expert_bases(p, lb);
    const int* toke = (const int*)(p.ws + WS_TOKE); const int* tokp = (const int*)(p.ws + WS_TOKP); int* tokr = (int*)(p.ws + WS_TOKR); int* rowt = (int*)(p.ws + WS_ROWT);
    for (int i = blockIdx.x * NT + threadIdx.x; i < M * 2; i += gridDim.x * NT) { const int row = lb[toke[i]] + tokp[i]; tokr[i] = row; rowt[row] = i >> 1; }
}

__device__ __forceinline__ void stage10(const Params& p, unsigned char* smem) {
    int* lb = (int*)smem; expert_bases(p, lb);
    const int* cnt = (const int*)(p.ws + WS_CTL);
    const int ntiles = lb[64];
    const bf16_t* h2 = (const bf16_t*)(p.ws + WS_H2); const int* rowt = (const int*)(p.ws + WS_ROWT); bf16_t* hid = (bf16_t*)(p.ws + WS_HID);
    for (int vb = blockIdx.x; vb < ntiles * 8; vb += gridDim.x) {
        const int tile = vb / 8, tn = vb % 8;
        int e = 0;
        for (int i = 0; i < 64; ++i) if (lb[i] <= tile * 128 && cnt[i] > 0) e = i;
        const bf16_t* wt = (const bf16_t*)(p.ws + WS_WTGU) + (size_t)e * 1024 * 1024 + (size_t)tn * 128 * 1024;
        auto arow = [&](int r) { const int tk = rowt[tile * 128 + r]; return h2 + (size_t)(tk < 0 ? 0 : tk) * DM; };
        auto epi = [&](int r, int c, f32x4 v) { *(unsigned*)(hid + (size_t)(tile * 128 + r) * 512 + (tn * 128 + c) / 2) = pk2(silu_f(v[0]) * v[1], silu_f(v[2]) * v[3]); };
        gemm128(arow, wt, 1024, epi);
    }
}

__device__ __forceinline__ void stage11(const Params& p, unsigned char* smem) {
    int* lb = (int*)smem; expert_bases(p, lb);
    const int* cnt = (const int*)(p.ws + WS_CTL);
    const int ntiles = lb[64];
    const bf16_t* hid = (const bf16_t*)(p.ws + WS_HID); float* Y = (float*)(p.ws + WS_Y);
    for (int vb = blockIdx.x; vb < ntiles * 8; vb += gridDim.x) {
        const int tile = vb / 8, tn = vb % 8;
        int e = 0;
        for (int i = 0; i < 64; ++i) if (lb[i] <= tile * 128 && cnt[i] > 0) e = i;
        const bf16_t* wt = (const bf16_t*)(p.ws + WS_WTDN) + (size_t)e * 1024 * 512 + (size_t)tn * 128 * 512;
        auto arow = [&](int r) { return hid + (size_t)(tile * 128 + r) * 512; };
        auto epi = [&](int r, int c, f32x4 v) { *(f32x4*)(Y + (size_t)(tile * 128 + r) * DM + tn * 128 + c) = v; };
        gemm128(arow, wt, 512, epi);
    }
}

__device__ __forceinline__ void stage12(const Params& p) {
    const int tid = threadIdx.x, wid = tid >> 6, lane = tid & 63;
    const float* mod = (const float*)(p.ws + WS_MOD); const float* Y = (const float*)(p.ws + WS_Y);
    const int* tokr = (const int*)(p.ws + WS_TOKR); const float* tokw = (const float*)(p.ws + WS_TOKW);
    for (int row = blockIdx.x * NW + wid; row < M; row += gridDim.x * NW) {
        const int b = row / SEQ; const int r0 = tokr[row * 2], r1 = tokr[row * 2 + 1]; const float w0 = tokw[row * 2], w1 = tokw[row * 2 + 1];
        f32x4 f[4]; float ss = 0.f;
#pragma unroll
        for (int j = 0; j < 4; ++j) { const int col = lane * 4 + 256 * j;
            f[j] = *(const f32x4*)(Y + (size_t)r0 * DM + col) * w0 + *(const f32x4*)(Y + (size_t)r1 * DM + col) * w1;
            ss += f[j].x * f[j].x + f[j].y * f[j].y + f[j].z * f[j].z + f[j].w * f[j].w; }
        const float rstd = rsqrtf(wave_sum(ss) * (1.f / DM) + 1e-6f);
#pragma unroll
        for (int j = 0; j < 4; ++j) { const int col = lane * 4 + 256 * j;
            const f32x4 g = *(const f32x4*)(p.in[7] + col), gt = *(const f32x4*)(mod + b * 6144 + 5120 + col);
            f32x4* op = (f32x4*)(p.out + (size_t)row * DM + col);
            *op = *op + gt * (f[j] * rstd * g); }
    }
}

constexpr int NSTAGE = 13;
template <int S> __device__ __forceinline__ void run_stage(const Params& p, unsigned char* smem) {
    if constexpr (S == 0) stage0(p, smem);
    else if constexpr (S == 1) stage1(p);
    else if constexpr (S == 2) stage2(p);
    else if constexpr (S == 3) stage3(p, smem);
    else if constexpr (S == 4) stage4(p, smem);
    else if constexpr (S == 5) stage5(p);
    else if constexpr (S == 6) stage6(p);
    else if constexpr (S == 7) stage7(p);
    else if constexpr (S == 8) stage8(p);
    else if constexpr (S == 9) stage9(p, smem);
    else if constexpr (S == 10) stage10(p, smem);
    else if constexpr (S == 11) stage11(p, smem);
    else if constexpr (S == 12) stage12(p);
}
#if MK_FUSED
__global__ void __launch_bounds__(NT, 2) mk(Params p) {
    extern __shared__ __attribute__((aligned(16))) unsigned char smem[];
    cg::grid_group grid = cg::this_grid();
    run_stage<0>(p, smem); grid.sync();
    run_stage<1>(p, smem); grid.sync();
    run_stage<2>(p, smem); grid.sync();
    run_stage<3>(p, smem); grid.sync();
    run_stage<4>(p, smem); grid.sync();
    run_stage<5>(p, smem); grid.sync();
    run_stage<6>(p, smem); grid.sync();
    run_stage<7>(p, smem); grid.sync();
    run_stage<8>(p, smem); grid.sync();
    run_stage<9>(p, smem); grid.sync();
    run_stage<10>(p, smem); grid.sync();
    run_stage<11>(p, smem); grid.sync();
    run_stage<12>(p, smem);
}
#else
template <int S> __global__ void __launch_bounds__(NT, 2) mk1(Params p) {
    extern __shared__ __attribute__((aligned(16))) unsigned char smem[];
    run_stage<S>(p, smem);
}
template <int S> static void launch_stage(const Params& p, int cus, hipStream_t stream) {
    static int grid = 0;
    if (grid == 0) { int per_cu = 0;
        (void)hipFuncSetAttribute((const void*)mk1<S>, hipFuncAttributeMaxDynamicSharedMemorySize, LDS_BYTES);
        (void)hipOccupancyMaxActiveBlocksPerMultiprocessor(&per_cu, (const void*)mk1<S>, NT, LDS_BYTES);
        if (per_cu < 1) per_cu = 1;
        grid = cus * per_cu; (void)hipGetLastError(); }
    hipLaunchKernelGGL(mk1<S>, dim3(grid), dim3(NT), LDS_BYTES, stream, p);
}
#endif

extern "C" void kernel_launch(void* const* d_in, const int* in_sizes, int n_in, void* d_out, int out_size, void* d_ws, size_t ws_size, hipStream_t stream) {
    static int grid = 0, cus = 0;
    if (grid == 0) {
        if (n_in != 28 || out_size != M * DM || ws_size < WS_END) { fprintf(stderr, "kernel_launch: unexpected shapes (n_in %d out %d ws %zu)\n", n_in, out_size, ws_size); grid = -1; return; }
        int dev = 0;
        (void)hipGetDevice(&dev); (void)hipDeviceGetAttribute(&cus, hipDeviceAttributeMultiprocessorCount, dev);
        grid = cus;
#if MK_FUSED
        int per_cu = 0;
        (void)hipFuncSetAttribute((const void*)mk, hipFuncAttributeMaxDynamicSharedMemorySize, LDS_BYTES);
        (void)hipOccupancyMaxActiveBlocksPerMultiprocessor(&per_cu, (const void*)mk, NT, LDS_BYTES);
        if (per_cu < 1) per_cu = 1;
        grid = cus * per_cu;
#endif
        (void)hipGetLastError();
    }
    if (grid < 0) return;
    (void)hipMemsetAsync((char*)d_ws + WS_CTL, 0, 4096, stream);
    Params p{};
    for (int i = 0; i < 28; ++i) p.in[i] = (const float*)d_in[i];
    p.out = (float*)d_out; p.ws = (unsigned char*)d_ws;
#if MK_FUSED
    void* args[] = {&p};
    hipError_t e = hipLaunchCooperativeKernel((const void*)mk, dim3(grid), dim3(NT), args, LDS_BYTES, stream);
    if (e != hipSuccess) fprintf(stderr, "cooperative launch failed: %s (grid %d)\n", hipGetErrorString(e), grid);
#else
    launch_stage<0>(p, cus, stream); launch_stage<1>(p, cus, stream); launch_stage<2>(p, cus, stream); launch_stage<3>(p, cus, stream);
    launch_stage<4>(p, cus, stream); launch_stage<5>(p, cus, stream); launch_stage<6>(p, cus, stream); launch_stage<7>(p, cus, stream);
    launch_stage<8>(p, cus, stream); launch_stage<9>(p, cus, stream); launch_stage<10>(p, cus, stream); launch_stage<11>(p, cus, stream);
    launch_stage<12>(p, cus, stream);
#endif
}
```

```cpp
#include <hip/hip_runtime.h>
#include <hip/hip_cooperative_groups.h>
#include <cstdio>
#include <cstdint>
namespace cg = cooperative_groups;

#ifndef MK_FUSED
#define MK_FUSED 1
#endif

typedef unsigned short bf16_t;
typedef short bf16x8 __attribute__((ext_vector_type(8)));
typedef float f32x4 __attribute__((ext_vector_type(4)));
typedef unsigned u32x4 __attribute__((ext_vector_type(4)));
typedef unsigned u32x2 __attribute__((ext_vector_type(2)));

constexpr int NT = 512, NW = 8;
constexpr int BATCH = 2, SEQ = 8192, DM = 1024, M = BATCH * SEQ;
constexpr int UC = 3072, IN_COLS = 2840;
constexpr int C_DQ = 0, C_DK = 512, C_DV = 1024, C_NQ = 1536, C_CK = 2048, C_CV = 2176, C_SK = 2304, C_SV = 2432, C_WK = 2560, C_WV = 2688, C_NG = 2816;
constexpr int NEXP = 64, RMAX = 49152, NCMP = 511;
constexpr int LDS_BYTES = 147456;

constexpr size_t MiB = 1u << 20;
constexpr size_t WS_CTL = 0;
constexpr size_t WS_MOD = 65536;
constexpr size_t WS_KC = 2 * MiB;
constexpr size_t WS_VC = 3 * MiB;
constexpr size_t WS_ELIST = 4 * MiB;
constexpr size_t WS_TOKE = 10 * MiB;
constexpr size_t WS_TOKP = WS_TOKE + 128 * 1024;
constexpr size_t WS_TOKW = WS_TOKP + 128 * 1024;
constexpr size_t WS_TOKR = WS_TOKW + 128 * 1024;
constexpr size_t WS_ROWT = 11 * MiB;
constexpr size_t WS_WR = 14 * MiB;
constexpr size_t WS_W1T = 14 * MiB + 512 * 1024;
constexpr size_t WS_W2T = 15 * MiB + 512 * 1024;
constexpr int CTL_NORM = 384;
constexpr int CTL_CNT = 8192;
constexpr int CTL_TREADY = 1024;
constexpr int CTL_TQ = 320;
constexpr int CTL_QHEAD = 448;
constexpr size_t WS_B1P = 15 * MiB + 768 * 1024;
constexpr size_t WS_WTIN = 16 * MiB;
constexpr size_t WS_WTOUT = 22 * MiB;
constexpr size_t WS_WTGU = 24 * MiB;
constexpr size_t WS_WTDN = 152 * MiB;
constexpr size_t WS_XN = 216 * MiB;
constexpr size_t WS_U = 248 * MiB;
constexpr size_t WS_OC = 344 * MiB;
constexpr size_t WS_AO = 408 * MiB;
constexpr size_t WS_MIX = 440 * MiB;
constexpr size_t WS_KFS = 440 * MiB, WS_KFW = 444 * MiB, WS_VFS = 448 * MiB, WS_VFW = 452 * MiB;
constexpr size_t WS_AOF = 456 * MiB;
constexpr size_t WS_H2 = WS_XN;
constexpr size_t WS_H2F = WS_OC;
constexpr size_t WS_HID = WS_U;
constexpr size_t WS_Y = 296 * MiB;
constexpr size_t WS_END = 504 * MiB;

struct Params { const float* in[28]; float* out; unsigned char* ws; };

__device__ __forceinline__ int opaque_tid() { int t = threadIdx.x; asm volatile("" : "+v"(t)); return t; }
__device__ __forceinline__ float bf2f(bf16_t v) { return __uint_as_float(((unsigned)v) << 16); }
__device__ __forceinline__ bf16_t f2bf(float f) { unsigned u = __float_as_uint(f); return (bf16_t)((u + 0x7fffu + ((u >> 16) & 1u)) >> 16); }
__device__ __forceinline__ unsigned pk2(float lo, float hi) { return (unsigned)f2bf(lo) | ((unsigned)f2bf(hi) << 16); }
__device__ __forceinline__ float wave_sum(float v) {
    v += __int_as_float(__builtin_amdgcn_update_dpp(0, __float_as_int(v), 0xB1, 0xF, 0xF, true));
    v += __int_as_float(__builtin_amdgcn_update_dpp(0, __float_as_int(v), 0x4E, 0xF, 0xF, true));
    v += __int_as_float(__builtin_amdgcn_update_dpp(0, __float_as_int(v), 0x141, 0xF, 0xF, true));
    v += __int_as_float(__builtin_amdgcn_update_dpp(0, __float_as_int(v), 0x140, 0xF, 0xF, true));
    const float r0 = __int_as_float(__builtin_amdgcn_readlane(__float_as_int(v), 0)), r1 = __int_as_float(__builtin_amdgcn_readlane(__float_as_int(v), 16));
    const float r2 = __int_as_float(__builtin_amdgcn_readlane(__float_as_int(v), 32)), r3 = __int_as_float(__builtin_amdgcn_readlane(__float_as_int(v), 48));
    return (r0 + r1) + (r2 + r3);
}
__device__ __forceinline__ float wave_max(float v) {
#pragma unroll
    for (int o = 32; o > 0; o >>= 1) v = fmaxf(v, __shfl_xor(v, o));
    return v;
}
__device__ __forceinline__ void lds_fence() { asm volatile("s_waitcnt lgkmcnt(0)" ::: "memory"); }
__device__ __forceinline__ float silu_f(float x) { return x / (1.f + __expf(-x)); }
__device__ __forceinline__ float gelu_tanh(float x) { return 0.5f * x * (1.f + tanhf(0.7978845608028654f * (x + 0.044715f * x * x * x))); }
__device__ __forceinline__ void unpack8(const u32x4 w, float* v) {
    v[0] = __uint_as_float(w.x << 16); v[1] = __uint_as_float(w.x & 0xffff0000u);
    v[2] = __uint_as_float(w.y << 16); v[3] = __uint_as_float(w.y & 0xffff0000u);
    v[4] = __uint_as_float(w.z << 16); v[5] = __uint_as_float(w.z & 0xffff0000u);
    v[6] = __uint_as_float(w.w << 16); v[7] = __uint_as_float(w.w & 0xffff0000u);
}

template <class AF, class Epi>
__device__ __forceinline__ void gemm128(const AF& arow, const bf16_t* Bt, int K, const Epi& epi) {
    const int tid = threadIdx.x, wid = tid >> 6, lane = tid & 63, fr = lane & 15, fq = lane >> 4, wr = wid >> 2, wc = wid & 3;
    const bf16_t* ap[4]; const bf16_t* bp[2];
#pragma unroll
    for (int m = 0; m < 4; ++m) ap[m] = arow(wr * 64 + m * 16 + fr) + fq * 8;
#pragma unroll
    for (int n = 0; n < 2; ++n) bp[n] = Bt + (size_t)(wc * 32 + n * 16 + fr) * K + fq * 8;
    f32x4 acc[4][2];
#pragma unroll
    for (int m = 0; m < 4; ++m)
#pragma unroll
        for (int n = 0; n < 2; ++n) acc[m][n] = (f32x4){0.f, 0.f, 0.f, 0.f};
#pragma unroll 2
    for (int k0 = 0; k0 < K; k0 += 32) {
        bf16x8 a[4], b[2];
#pragma unroll
        for (int m = 0; m < 4; ++m) a[m] = *(const bf16x8*)(ap[m] + k0);
#pragma unroll
        for (int n = 0; n < 2; ++n) b[n] = *(const bf16x8*)(bp[n] + k0);
#pragma unroll
        for (int m = 0; m < 4; ++m)
#pragma unroll
            for (int n = 0; n < 2; ++n) acc[m][n] = __builtin_amdgcn_mfma_f32_16x16x32_bf16(b[n], a[m], acc[m][n], 0, 0, 0);
    }
#pragma unroll
    for (int m = 0; m < 4; ++m)
#pragma unroll
        for (int n = 0; n < 2; ++n) epi(wr * 64 + m * 16 + fr, wc * 32 + n * 16 + fq * 4, acc[m][n]);
}


namespace pg8 {
#define PG8_LAS __attribute__((address_space(3)))
constexpr int BM = 256, BK = 64, HALF = 128, HTB = HALF * BK * 2, STAGE_BYTES = 8 * HTB, NXCD = 8, WGM = 8;
__host__ __device__ __forceinline__ int lds_byte(int r, int c) { const int st = (r >> 4) * 2 + (c >> 5), rr = r & 15, cc = c & 31, ob = rr * 64 + cc * 2; return st * 1024 + (ob ^ (((ob >> 9) & 1) << 5)); }
__host__ __device__ __forceinline__ void stage_rc(int b, int& R, int& C) { const int st = b / 1024, sb = b % 1024, swz = sb ^ (((sb >> 9) & 1) << 5); R = (st >> 1) * 16 + swz / 64; C = (st & 1) * 32 + (swz % 64) / 2; }
__host__ __device__ __forceinline__ int perm32(int rho) { const int n = rho >> 4, i = rho & 15; return 8 * (i >> 2) + 4 * n + (i & 3); }

struct Unit { int pm, pn; const char* bbase; int half; };
struct Gemm { const bf16_t* A; int K; };

struct StaticOrder {
    int nM, nN, nwg, G, c; const char* bt;
    __device__ void init(int Mr, int N, int G_, int c_, const bf16_t* Bt) { nM = Mr / BM; nN = N / BM; nwg = nM * nN; G = G_; c = c_; bt = (const char*)Bt; }
    __device__ bool next(int i, Unit& u) const {
        const long L = (long)i * G + c; if (L >= nwg) return false;
        int wgid = (int)L; { const int q = nwg / NXCD, r = nwg % NXCD, xcd = wgid % NXCD, off = wgid / NXCD; wgid = (xcd < r ? xcd * (q + 1) : r * (q + 1) + (xcd - r) * q) + off; }
        const int nig = WGM * nN, gid = wgid / nig, fm = gid * WGM, gsz = (nM - fm) < WGM ? (nM - fm) : WGM;
        u.pm = fm + ((wgid % nig) % gsz); u.pn = (wgid % nig) / gsz; u.bbase = bt; u.half = 0; return true;
    }
    __device__ __forceinline__ unsigned arow(const Unit& u, int r) const { return (unsigned)(u.pm * BM + r); }
    __device__ __forceinline__ void a_ready(const Unit&) const {}
    __device__ __forceinline__ void done(const Unit&) const {}
};

__device__ __forceinline__ unsigned cvt_pk_bf16(float lo, float hi) { unsigned r; asm volatile("v_cvt_pk_bf16_f32 %0, %1, %2" : "=v"(r) : "v"(lo), "v"(hi)); return r; }

template <class Epi, class Sched>
__device__ __forceinline__ void gemm_phase(PG8_LAS unsigned char* lds, const Gemm g, const Sched& S, const Epi& E) {
    int tid_ = threadIdx.x; asm volatile("" : "+v"(tid_));
    const int tid = tid_, wid = __builtin_amdgcn_readfirstlane(tid >> 6), lane = tid & 63, wr = wid >> 2, wc = wid & 3, fr = lane & 15, fq = lane >> 4;
    const int K = g.K, nt = K / BK;
    int RA[2], CA[2]; unsigned voffB[2];
#pragma unroll
    for (int i = 0; i < 2; ++i) { int R, C; stage_rc(tid * 16 + i * 8192, R, C); const int Rb = Epi::PERM ? ((R & ~31) + perm32(R & 31)) : R;
        RA[i] = R; CA[i] = C; voffB[i] = (unsigned)(Rb * K + C) * 2u; }
    const size_t kstep = (size_t)(BK * 2);
    const size_t hstep = (size_t)HALF * K * 2;
    const size_t tstep = 2 * hstep;
    const unsigned ldsw = (unsigned)wid * 1024u;
    const int aoff = lds_byte(wr * 64 + fr, fq * 8), boff = lds_byte(wc * 32 + fr, fq * 8);
    const char* Abase = (const char*)g.A;
#define PG8_SA(b, h) (((b) * 2 + (h)) * HTB)
#define PG8_SB(b, h) ((4 + (b) * 2 + (h)) * HTB)
#define PG8_STAGE(bufoff, gbase, voff) do { _Pragma("unroll") for (int _i = 0; _i < 2; ++_i) \
        __builtin_amdgcn_global_load_lds((const unsigned*)((const char*)(gbase) + (voff)[_i]), (PG8_LAS unsigned*)(lds + (bufoff) + ldsw + _i * 8192), 16, 0, 0); } while (0)
#define PG8_LDA(dst, b, h) do { _Pragma("unroll") for (int m = 0; m < 4; ++m) _Pragma("unroll") for (int k = 0; k < 2; ++k) dst[m][k] = *(const PG8_LAS bf16x8*)(lds + PG8_SA(b, h) + aoff + m * 2048 + k * 1024); } while (0)
#define PG8_LDB(dst, b, h) do { _Pragma("unroll") for (int n = 0; n < 2; ++n) _Pragma("unroll") for (int k = 0; k < 2; ++k) dst[n][k] = *(const PG8_LAS bf16x8*)(lds + PG8_SB(b, h) + boff + n * 2048 + k * 1024); } while (0)
#define PG8_MMA(ai, bj, At, Bt) do { __builtin_amdgcn_s_setprio(1); _Pragma("unroll") for (int m = 0; m < 4; ++m) _Pragma("unroll") for (int n = 0; n < 2; ++n) _Pragma("unroll") for (int k = 0; k < 2; ++k) \
        acc[ai][bj][m][n] = __builtin_amdgcn_mfma_f32_16x16x32_bf16(Bt[n][k], At[m][k], acc[ai][bj][m][n], 0, 0, 0); __builtin_amdgcn_s_setprio(0); } while (0)
#define PG8_WAIT_V(n) asm volatile("s_waitcnt vmcnt(" #n ")" ::: "memory")
#define PG8_WAIT_L(n) asm volatile("s_waitcnt lgkmcnt(" #n ")" ::: "memory")
#define PG8_BAR __builtin_amdgcn_s_barrier()
#define PG8_SCHED __builtin_amdgcn_sched_barrier(0)
#define PG8_AOFFS(dst, u) do { _Pragma("unroll") for (int _h = 0; _h < 2; ++_h) _Pragma("unroll") for (int _i = 0; _i < 2; ++_i) \
        dst[_h][_i] = (S.arow(u, _h * HALF + RA[_i]) * (unsigned)K + (unsigned)CA[_i]) * 2u; } while (0)
    Unit cur, nxt; int ui = 0;
    if (!S.next(0, cur)) return;
    f32x4 acc[2][2][4][2];
#pragma unroll
    for (int a = 0; a < 2; ++a)
#pragma unroll
        for (int b = 0; b < 2; ++b)
#pragma unroll
            for (int m = 0; m < 4; ++m)
#pragma unroll
                for (int n = 0; n < 2; ++n) acc[a][b][m][n] = (f32x4){0.f, 0.f, 0.f, 0.f};
    bf16x8 At[4][2], B0[2][2], B1[2][2];
    unsigned ca[2][2], na[2][2];
    S.a_ready(cur);
    PG8_AOFFS(ca, cur);
    const char* cB = cur.bbase + (size_t)cur.pn * tstep;
    PG8_STAGE(PG8_SB(0, 0), cB, voffB); PG8_STAGE(PG8_SB(0, 1), cB + hstep, voffB); PG8_STAGE(PG8_SA(0, 0), Abase, ca[0]); PG8_STAGE(PG8_SA(0, 1), Abase, ca[1]);
    if (wr == 1) PG8_BAR;
    PG8_WAIT_V(2); PG8_BAR;
    PG8_STAGE(PG8_SB(1, 0), cB + kstep, voffB); PG8_STAGE(PG8_SA(1, 0), Abase + kstep, ca[0]); PG8_STAGE(PG8_SB(1, 1), cB + hstep + kstep, voffB);
    PG8_WAIT_V(6); PG8_BAR;
    for (;;) {
        const bool has_next = S.next(ui + 1, nxt);
        if (has_next) { PG8_AOFFS(na, nxt); } else {
#pragma unroll
            for (int _h = 0; _h < 2; ++_h)
#pragma unroll
                for (int _i = 0; _i < 2; ++_i) na[_h][_i] = ca[_h][_i]; }
        const char* nB = has_next ? nxt.bbase + (size_t)nxt.pn * tstep : cB;
        const bool full = cur.half == 0;
        for (int t = 0; t < nt; t += 2) {
            const bool last = (t == nt - 2);
            if (last && has_next) S.a_ready(nxt);
            const char* a1 = Abase + (size_t)(t + 1) * kstep;
            const char* a2 = last ? Abase : Abase + (size_t)(t + 2) * kstep; const char* b2 = last ? nB : cB + (size_t)(t + 2) * kstep;
            const char* a3 = a2 + kstep; const char* b3 = b2 + kstep;
            unsigned o2[2][2];
#pragma unroll
            for (int _h = 0; _h < 2; ++_h)
#pragma unroll
                for (int _i = 0; _i < 2; ++_i) o2[_h][_i] = last ? na[_h][_i] : ca[_h][_i];
            PG8_LDB(B0, 0, 0); PG8_LDB(B1, 0, 1); PG8_SCHED; PG8_LDA(At, 0, 0); PG8_STAGE(PG8_SA(1, 1), a1, ca[1]);
            PG8_WAIT_V(8); PG8_WAIT_L(0); PG8_BAR; PG8_MMA(0, 0, At, B0); PG8_MMA(0, 1, At, B1); PG8_BAR; PG8_SCHED;
            PG8_LDA(At, 0, 1); PG8_STAGE(PG8_SB(0, 0), b2, voffB); PG8_STAGE(PG8_SB(0, 1), b2 + hstep, voffB); PG8_STAGE(PG8_SA(0, 0), a2, o2[0]);
            PG8_WAIT_V(8); PG8_WAIT_L(0); PG8_BAR; if (full) { PG8_MMA(1, 0, At, B0); PG8_MMA(1, 1, At, B1); } PG8_BAR; PG8_SCHED;
            PG8_LDB(B0, 1, 0); PG8_LDB(B1, 1, 1); PG8_SCHED; PG8_LDA(At, 1, 0); PG8_STAGE(PG8_SA(0, 1), a2, o2[1]);
            PG8_WAIT_V(8); PG8_WAIT_L(0); PG8_BAR; PG8_MMA(0, 0, At, B0); PG8_MMA(0, 1, At, B1); PG8_BAR; PG8_SCHED;
            PG8_LDA(At, 1, 1); PG8_STAGE(PG8_SB(1, 0), b3, voffB); PG8_STAGE(PG8_SB(1, 1), b3 + hstep, voffB); PG8_STAGE(PG8_SA(1, 0), a3, o2[0]);
            PG8_WAIT_V(8); PG8_WAIT_L(0); PG8_BAR; if (full) { PG8_MMA(1, 0, At, B0); PG8_MMA(1, 1, At, B1); } PG8_BAR; PG8_SCHED;
        }
        if (wr == 0) PG8_BAR;
        E(acc, cur, wr, wc, fr, fq);
        S.done(cur);
        if (!has_next) break;
#pragma unroll
        for (int a = 0; a < 2; ++a)
#pragma unroll
            for (int b = 0; b < 2; ++b)
#pragma unroll
                for (int m = 0; m < 4; ++m)
#pragma unroll
                    for (int n = 0; n < 2; ++n) acc[a][b][m][n] = (f32x4){0.f, 0.f, 0.f, 0.f};
        cur = nxt; cB = nB; ++ui;
#pragma unroll
        for (int _h = 0; _h < 2; ++_h)
#pragma unroll
            for (int _i = 0; _i < 2; ++_i) ca[_h][_i] = na[_h][_i];
        if (wr == 1) PG8_BAR;
    }
    PG8_WAIT_V(0);
    PG8_BAR;
#undef PG8_SA
#undef PG8_SB
#undef PG8_STAGE
#undef PG8_LDA
#undef PG8_LDB
#undef PG8_MMA
#undef PG8_WAIT_V
#undef PG8_WAIT_L
#undef PG8_BAR
#undef PG8_SCHED
#undef PG8_AOFFS
}
}


namespace attn_body {
using bf16x8=__attribute__((ext_vector_type(8)))short;
using s16x4=__attribute__((ext_vector_type(4)))short;
using f32x16=__attribute__((ext_vector_type(16)))float;
constexpr int D=64;
constexpr int QBLK=32,QB=256,KVBLK=64;
constexpr int KP=UC, OP=DM;
__device__ __forceinline__ int crow(int r,int hi){return (r&3)+8*(r>>2)+4*hi;}
#define SBAR() __builtin_amdgcn_sched_barrier(0)
__device__ __forceinline__ void cmask(f32x16&p0,f32x16&p1,int jb,int qrel,int hi){
  const float NEG=-INFINITY; int kb=64*jb+4*hi;
  #pragma unroll
  for(int r=0;r<16;++r){int kv=kb+(r&3)+8*(r>>2); if(kv>qrel)p0[r]=NEG; if(kv+32>qrel)p1[r]=NEG;}
}
constexpr int NSLOT=3, SLOTB=8192;
constexpr int LDS_K=0, LDS_V=NSLOT*SLOTB, LDS_WS=2*NSLOT*SLOTB, LDS_OST=LDS_WS+NW*64*4, LDS_BYTES_A=LDS_OST+NW*4096;
constexpr float C2=0.125f*1.4426950408889634f;
__device__ __forceinline__ void glds16(const void*gsrc,unsigned lds_dst){unsigned keep;
  asm volatile("s_mov_b32 %0, m0\n\ts_mov_b32 m0, %2\n\ts_nop 0\n\tglobal_load_lds_dwordx4 %1, off\n\ts_mov_b32 m0, %0":"=&s"(keep):"v"(gsrc),"s"(lds_dst):"memory");}
__device__ __forceinline__ float max3f(float a,float b,float c){float r;asm("v_max3_f32 %0, %1, %2, %3":"=v"(r):"v"(a),"v"(b),"v"(c));return r;}
__device__ __forceinline__ float max2f(float a,float b){float r;asm("v_max_f32_e32 %0, %1, %2":"=v"(r):"v"(a),"v"(b));return r;}
__device__ __forceinline__ float fsub_s(float a,float b){float r;asm("v_sub_f32_e32 %0, %1, %2":"=v"(r):"v"(a),"v"(b));return r;}
typedef float f32x2_t __attribute__((ext_vector_type(2))); typedef __bf16 bf16x2_t __attribute__((ext_vector_type(2)));
__device__ __forceinline__ unsigned cvtpk_s(float lo,float hi){f32x2_t v={lo,hi};bf16x2_t b=__builtin_convertvector(v,bf16x2_t);return __builtin_bit_cast(unsigned,b);}
#define WAIT_BAR(N) asm volatile("s_waitcnt vmcnt(" #N ") lgkmcnt(0)\n\ts_barrier":::"memory")

__device__ __forceinline__ void qkt(f32x16&p0,f32x16&p1,const char*Kslot,const bf16x8*qr,const f32x16&negm,int r32,int hi){
  const char*kb=Kslot+hi*1024+r32*16;
  #pragma unroll
  for(int d0=0;d0<4;++d0){
    const bf16x8 b0=*reinterpret_cast<const bf16x8*>(kb+d0*2048);
    const bf16x8 b1=*reinterpret_cast<const bf16x8*>(kb+d0*2048+512);
    if(d0==0){p0=__builtin_amdgcn_mfma_f32_32x32x16_bf16(b0,qr[0],negm,0,0,0);p1=__builtin_amdgcn_mfma_f32_32x32x16_bf16(b1,qr[0],negm,0,0,0);}
    else{p0=__builtin_amdgcn_mfma_f32_32x32x16_bf16(b0,qr[d0],p0,0,0,0);p1=__builtin_amdgcn_mfma_f32_32x32x16_bf16(b1,qr[d0],p1,0,0,0);}}
}
typedef __attribute__((address_space(3))) const char* lds_cptr;
typedef short v4i16_t __attribute__((ext_vector_type(4)));
__device__ __forceinline__ void kload8(bf16x8*kf,lds_cptr kp){
  kf[0]=*(const __attribute__((address_space(3))) bf16x8*)(kp);      kf[1]=*(const __attribute__((address_space(3))) bf16x8*)(kp+512);
  kf[2]=*(const __attribute__((address_space(3))) bf16x8*)(kp+2048); kf[3]=*(const __attribute__((address_space(3))) bf16x8*)(kp+2560);
  kf[4]=*(const __attribute__((address_space(3))) bf16x8*)(kp+4096); kf[5]=*(const __attribute__((address_space(3))) bf16x8*)(kp+4608);
  kf[6]=*(const __attribute__((address_space(3))) bf16x8*)(kp+6144); kf[7]=*(const __attribute__((address_space(3))) bf16x8*)(kp+6656);
}
__device__ __forceinline__ void kload2(bf16x8*kf,lds_cptr kp,int j){ kf[2*j]=*(const __attribute__((address_space(3))) bf16x8*)(kp+j*2048); kf[2*j+1]=*(const __attribute__((address_space(3))) bf16x8*)(kp+j*2048+512); }
__device__ __forceinline__ s16x4 vtr(lds_cptr p){ return __builtin_bit_cast(s16x4,__builtin_amdgcn_ds_read_tr16_b64_v4i16((__attribute__((address_space(3))) v4i16_t*)p)); }
__device__ __forceinline__ float rowmax(const f32x16&p0,const f32x16&p1){
  float a=max3f(p0[0],p0[1],p1[0]),b=max3f(p0[2],p0[3],p1[1]);a=max3f(a,p1[2],p1[3]);
  #pragma unroll
  for(int r=4;r<16;r+=4){a=max3f(a,p0[r],p0[r+1]);b=max3f(b,p0[r+2],p0[r+3]);a=max3f(a,p1[r],p1[r+1]);b=max3f(b,p1[r+2],p1[r+3]);}
  const float m=max2f(a,b);
  auto rr=__builtin_amdgcn_permlane32_swap(__float_as_uint(m),__float_as_uint(m),false,false);
  return max2f(__uint_as_float(rr[0]),__uint_as_float(rr[1]));
}
__device__ __forceinline__ void pv(f32x16*o,int vb,bf16x8 pa0,bf16x8 pa1,bf16x8 pa2,bf16x8 pa3){
  #pragma unroll
  for(int d0=0;d0<2;++d0){s16x4 lo[4],hi[4];
    #pragma unroll
    for(int ks=0;ks<4;++ks){
      asm volatile("ds_read_b64_tr_b16 %0,%1 offset:%c2":"=&v"(lo[ks]):"v"(vb),"i"(d0*4096+ks*1024):"memory");
      asm volatile("ds_read_b64_tr_b16 %0,%1 offset:%c2":"=&v"(hi[ks]):"v"(vb),"i"(d0*4096+ks*1024+512):"memory");}
    asm volatile("s_waitcnt lgkmcnt(0)":::"memory");SBAR();
    #define PK(k) (bf16x8){lo[k][0],lo[k][1],lo[k][2],lo[k][3],hi[k][0],hi[k][1],hi[k][2],hi[k][3]}
    o[d0]=__builtin_amdgcn_mfma_f32_32x32x16_bf16(pa0,PK(0),o[d0],0,0,0);
    o[d0]=__builtin_amdgcn_mfma_f32_32x32x16_bf16(pa1,PK(1),o[d0],0,0,0);
    o[d0]=__builtin_amdgcn_mfma_f32_32x32x16_bf16(pa2,PK(2),o[d0],0,0,0);
    o[d0]=__builtin_amdgcn_mfma_f32_32x32x16_bf16(pa3,PK(3),o[d0],0,0,0);
    #undef PK
  }
}

template<int THRL> __device__ __forceinline__ void attn_unit(int b,int vh,int qb,const bf16_t*U,bf16_t*O,char*shm,int ncap){
  int tid_=threadIdx.x; asm volatile("":"+v"(tid_));
  const int tid=tid_,lane=tid&63,r32=lane&31,hi=lane>>5; const int wid=__builtin_amdgcn_readfirstlane(tid>>6);
  const int hh=vh>>2, cc=(vh>>1)&1, vhalf=vh&1;
  const long rowbase=(long)b*SEQ; const int q0=qb*QB;
  const bf16_t*Qw=U+(rowbase+q0+wid*QBLK)*KP+C_DQ+hh*128+cc*64;
  const bf16_t*Kh=U+rowbase*KP+C_DK+hh*128+cc*64,*Vh=U+rowbase*KP+C_DV+hh*128+vhalf*64;
  const float slope2=__uint_as_float(__builtin_amdgcn_readfirstlane(__float_as_uint(exp2f(-2.f*(float)(hh+1))*1.4426950408889634f)));
  const float s64=__uint_as_float(__builtin_amdgcn_readfirstlane(__float_as_uint(64.f*slope2))), s32=__uint_as_float(__builtin_amdgcn_readfirstlane(__float_as_uint(32.f*slope2)));
  const unsigned lds0=(unsigned)(uintptr_t)shm;
  float*wsf=(float*)(shm+LDS_WS)+wid*64;
  const bf16_t*ksrc=Kh+(long)lane*KP+wid*8;
  const bf16_t*vsrc=Vh+(long)(16*(wid&3)+(lane>>2))*KP+(wid>>2)*32+(lane&3)*8;
  const unsigned kdst=lds0+LDS_K+wid*1024, vdst=lds0+LDS_V+wid*1024;
  const int NTT=(q0+QB)/KVBLK;
  const int NT=NTT<ncap?NTT:ncap;
  #define DMA_K(s,slot) glds16(ksrc+(long)(NTT-1-(s))*KVBLK*KP,(unsigned)__builtin_amdgcn_readfirstlane(kdst+(slot)))
  #define DMA_V(s,slot) glds16(vsrc+(long)(NTT-1-(s))*KVBLK*KP,(unsigned)__builtin_amdgcn_readfirstlane(vdst+(slot)))
  const int vb0=(int)(lds0+LDS_V)+((lane>>4)&1)*32+(lane&3)*8+(4*hi+((lane&15)>>2))*64;
  const char*Kbase=shm+LDS_K; bf16x8 kf[8];
  const lds_cptr shm3=(lds_cptr)shm; const lds_cptr kp0=shm3+LDS_K+hi*1024+r32*16; const lds_cptr vp0=shm3+LDS_V+((lane>>4)&1)*32+(lane&3)*8+(4*hi+((lane&15)>>2))*64;
  DMA_K(0,0);DMA_V(0,0);DMA_K(1,SLOTB);
  bf16x8 qr[4];
  #pragma unroll
  for(int d0=0;d0<4;++d0)qr[d0]=*reinterpret_cast<const bf16x8*>(&Qw[(long)r32*KP+d0*16+hi*8]);
  float l_reg=0.f;f32x16 o[2];o[0]=f32x16{};o[1]=f32x16{};
  f32x16 negm;
  #pragma unroll
  for(int r=0;r<16;++r)negm[r]=slope2*(float)(crow(r,hi)-63);
  asm volatile("":"+v"(negm));
  const int qrel=wid*QBLK+r32;
  #define CMASK(P0,P1,s) do{ if((s)<4)cmask(P0,P1,3-(s),qrel,hi);}while(0)
  #define BIAS1(P1) do{ _Pragma("unroll") for(int r=0;r<16;++r)P1[r]+=s32; }while(0)
  #define NEXTTILE() do{ _Pragma("unroll") for(int r=0;r<16;++r)negm[r]-=s64; asm volatile("":"+v"(negm)); }while(0)
  bool resc=false;
  #define START(P0,P1) do{ const float rm=rowmax(P0,P1); resc=false; \
    { const float dl=__builtin_fmaxf(rm,-8192.f); \
      _Pragma("unroll") for(int r=0;r<16;++r){P0[r]=fsub_s(P0[r],dl);P1[r]=fsub_s(P1[r],dl);} \
      _Pragma("unroll") for(int r=0;r<16;++r)negm[r]-=dl; asm volatile("":"+v"(negm)); } \
    _Pragma("unroll") for(int r=0;r<16;++r)P0[r]=__builtin_amdgcn_exp2f(P0[r]); }while(0)
  #define RESC() do{ if(resc){ asm volatile("s_waitcnt lgkmcnt(0)":::"memory"); \
      _Pragma("unroll") for(int d_=0;d_<2;++d_) _Pragma("unroll") for(int r=0;r<16;++r)o[d_][r]*=wsf[crow(r,hi)]; } }while(0)
  f32x16 pA0,pA1,pB0,pB1;
  int sl_prev=0,sl_cur=0,sl_next=SLOTB;
  #define ROT() do{sl_prev=sl_cur;sl_cur=sl_next;sl_next=(sl_next==(NSLOT-1)*SLOTB)?0:sl_next+SLOTB;}while(0)
  DMA_K(2,2*SLOTB);
  WAIT_BAR(3);
  qkt(pA0,pA1,Kbase,qr,negm,r32,hi);asm volatile("s_nop 15\n\ts_nop 7":"+v"(pA0),"+v"(pA1));BIAS1(pA1);CMASK(pA0,pA1,0);
  START(pA0,pA1);
  NEXTTILE();
  _Pragma("unroll") for(int r=0;r<16;++r)pA1[r]=__builtin_amdgcn_exp2f(pA1[r]);
  WAIT_BAR(0);
  DMA_K(3,0);DMA_V(1,SLOTB);
  ROT();
  kload8(kf,kp0+sl_cur);
  WAIT_BAR(2);
  s16x4 vlo[8],vhi[8]; u32x4 pw0,pw1,pw2,pw3;
  #define PKW(P,B) cvtpk_s(P[B],P[B+1])
  #define PAF(k) __builtin_bit_cast(bf16x8,pw##k)
  #define VFR(i) (bf16x8){vlo[i][0],vlo[i][1],vlo[i][2],vlo[i][3],vhi[i][0],vhi[i][1],vhi[i][2],vhi[i][3]}
  #define PIN(x) asm volatile("":"+v"(x))
  #define MX3(a,b,c) __builtin_fmaxf(__builtin_fmaxf((a),(b)),(c))
  #define GAPA(MF,A0,A1,A2,A3,W0,W1,PW) do{ MF; sacc+=A0; sacc+=A1; sacc+=A2; sacc+=A3; PIN(sacc); W0; W1; PIN(PW); SBAR(); }while(0)
  #define EX(v) __builtin_amdgcn_exp2f(v)
  #define GAPB(MF,X,B) do{ MF; X[B]=EX(X[B]); X[B+1]=EX(X[B+1]); X[B+2]=EX(X[B+2]); X[B+3]=EX(X[B+3]); PIN(X); SBAR(); }while(0)
  #define VRD(i) do{ vlo[i]=vtr(vp_+(((i)>>2)*4096+((i)&3)*1024)); vhi[i]=vtr(vp_+(((i)>>2)*4096+((i)&3)*1024+512)); }while(0)
  #define KRD(G,j) do{ if(G){ kload2(kf,kp0+sl_next,j); SBAR(); } }while(0)
  #define STEP(C0,C1,P0,P1,t,GK,GV,GL) do{ SBAR(); \
    const lds_cptr vp_=vp0+sl_prev; \
    VRD(0); SBAR(); float sacc=(P0[0]+P0[1]); \
    GAPA(C0=__builtin_amdgcn_mfma_f32_32x32x16_bf16(kf[0],qr[0],negm,0,0,0), P0[2],P0[3],P0[4],P0[5],     pw0[0]=PKW(P0,0), pw0[1]=PKW(P0,2), pw0); \
    VRD(4); SBAR(); GAPA(C1=__builtin_amdgcn_mfma_f32_32x32x16_bf16(kf[1],qr[0],negm,0,0,0), P0[6],P0[7],P0[8],P0[9],     pw0[2]=PKW(P0,4), pw0[3]=PKW(P0,6), pw0); \
    VRD(1); SBAR(); GAPA(C0=__builtin_amdgcn_mfma_f32_32x32x16_bf16(kf[2],qr[1],C0,0,0,0),   P0[10],P0[11],P0[12],P0[13], pw1[0]=PKW(P0,8), pw1[1]=PKW(P0,10), pw1); \
    VRD(5); SBAR(); GAPA(C1=__builtin_amdgcn_mfma_f32_32x32x16_bf16(kf[3],qr[1],C1,0,0,0),   P0[14],P0[15],P1[0],P1[1],   pw1[2]=PKW(P0,12),pw1[3]=PKW(P0,14), pw1); \
    VRD(2); SBAR(); GAPA(C0=__builtin_amdgcn_mfma_f32_32x32x16_bf16(kf[4],qr[2],C0,0,0,0),   P1[2],P1[3],P1[4],P1[5],     pw2[0]=PKW(P1,0), pw2[1]=PKW(P1,2), pw2); \
    VRD(6); SBAR(); GAPA(C1=__builtin_amdgcn_mfma_f32_32x32x16_bf16(kf[5],qr[2],C1,0,0,0),   P1[6],P1[7],P1[8],P1[9],     pw2[2]=PKW(P1,4), pw2[3]=PKW(P1,6), pw2); \
    VRD(3); SBAR(); GAPA(C0=__builtin_amdgcn_mfma_f32_32x32x16_bf16(kf[6],qr[3],C0,0,0,0),   P1[10],P1[11],P1[12],P1[13], pw3[0]=PKW(P1,8), pw3[1]=PKW(P1,10), pw3); \
    VRD(7); SBAR(); GAPA(C1=__builtin_amdgcn_mfma_f32_32x32x16_bf16(kf[7],qr[3],C1,0,0,0),   P1[14],P1[15],0.f,0.f,       pw3[2]=PKW(P1,12),pw3[3]=PKW(P1,14), pw3); \
    l_reg+=sacc; \
    if(GK){DMA_K((t)+3,sl_cur);} if(GV){DMA_V((t)+1,sl_next);} \
    BIAS1(C1); CMASK(C0,C1,t); \
    { float a=MX3(C0[0],C0[1],C1[0]),b=MX3(C0[2],C0[3],C1[1]); a=MX3(a,C1[2],C1[3]); \
      _Pragma("unroll") for(int r=4;r<16;r+=4){a=MX3(a,C0[r],C0[r+1]);b=MX3(b,C0[r+2],C0[r+3]);a=MX3(a,C1[r],C1[r+1]);b=MX3(b,C1[r+2],C1[r+3]);} \
      float rm=__builtin_fmaxf(a,b); { auto rr=__builtin_amdgcn_permlane32_swap(__float_as_uint(rm),__float_as_uint(rm),false,false); rm=__builtin_fmaxf(__uint_as_float(rr[0]),__uint_as_float(rr[1])); } \
      resc=false; \
      if(__builtin_expect(__any(rm>(float)THRL),0)){ const float dl=__builtin_fmaxf(rm,0.f); \
        _Pragma("unroll") for(int r=0;r<16;++r){C0[r]-=dl;C1[r]-=dl;} \
        _Pragma("unroll") for(int r=0;r<16;++r)negm[r]-=dl; asm volatile("":"+v"(negm)); \
        const float f=__builtin_amdgcn_exp2f(-dl); l_reg*=f; if(hi==0)wsf[r32]=f; resc=true; } } \
    NEXTTILE(); \
    SBAR(); \
    GAPB(o[0]=__builtin_amdgcn_mfma_f32_32x32x16_bf16(PAF(0),VFR(0),o[0],0,0,0), C0,0); \
    GAPB(o[1]=__builtin_amdgcn_mfma_f32_32x32x16_bf16(PAF(0),VFR(4),o[1],0,0,0), C0,4); \
    KRD(GL,0); GAPB(o[0]=__builtin_amdgcn_mfma_f32_32x32x16_bf16(PAF(1),VFR(1),o[0],0,0,0), C0,8); \
    KRD(GL,1); GAPB(o[1]=__builtin_amdgcn_mfma_f32_32x32x16_bf16(PAF(1),VFR(5),o[1],0,0,0), C0,12); \
    KRD(GL,2); GAPB(o[0]=__builtin_amdgcn_mfma_f32_32x32x16_bf16(PAF(2),VFR(2),o[0],0,0,0), C1,0); \
    KRD(GL,3); GAPB(o[1]=__builtin_amdgcn_mfma_f32_32x32x16_bf16(PAF(2),VFR(6),o[1],0,0,0), C1,4); \
    GAPB(o[0]=__builtin_amdgcn_mfma_f32_32x32x16_bf16(PAF(3),VFR(3),o[0],0,0,0), C1,8); \
    GAPB(o[1]=__builtin_amdgcn_mfma_f32_32x32x16_bf16(PAF(3),VFR(7),o[1],0,0,0), C1,12); \
    }while(0)
  int t=1;
  for(;t+5<NT;t+=2){
    STEP(pB0,pB1,pA0,pA1,t,true,true,true);     WAIT_BAR(2); RESC(); ROT();
    STEP(pA0,pA1,pB0,pB1,t+1,true,true,true);   WAIT_BAR(2); RESC(); ROT();
  }
  #define ENDW(tt) do{ if((tt)+3<NT){WAIT_BAR(2);} else if((tt)+2<NT){WAIT_BAR(1);} else {WAIT_BAR(0);} }while(0)
  for(;t+1<NT;t+=2){
    STEP(pB0,pB1,pA0,pA1,t,(t+3<NT),(t+1<NT),(t+1<NT));       ENDW(t);   RESC(); ROT();
    STEP(pA0,pA1,pB0,pB1,t+1,(t+4<NT),(t+2<NT),(t+2<NT));     ENDW(t+1); RESC(); ROT();
  }
  STEP(pB0,pB1,pA0,pA1,NT-1,false,false,false); RESC();
  { float sacc=pB0[0]+pB0[1]; _Pragma("unroll") for(int r=2;r<16;++r)sacc+=pB0[r]; _Pragma("unroll") for(int r=0;r<16;++r)sacc+=pB1[r]; l_reg+=sacc;
    pw0=(u32x4){PKW(pB0,0),PKW(pB0,2),PKW(pB0,4),PKW(pB0,6)};pw1=(u32x4){PKW(pB0,8),PKW(pB0,10),PKW(pB0,12),PKW(pB0,14)};pw2=(u32x4){PKW(pB1,0),PKW(pB1,2),PKW(pB1,4),PKW(pB1,6)};pw3=(u32x4){PKW(pB1,8),PKW(pB1,10),PKW(pB1,12),PKW(pB1,14)};
    SBAR(); pv(o,vb0+sl_cur,PAF(0),PAF(1),PAF(2),PAF(3)); }
  #undef PKW
  #undef PAF
  #undef VFR
  #undef PIN
  #undef MX3
  #undef GAPA
  #undef GAPB
  #undef EX
  #undef VRD
  #undef KRD
  #undef STEP
  #undef ENDW
  {auto rr=__builtin_amdgcn_permlane32_swap(__float_as_uint(l_reg),__float_as_uint(l_reg),false,false);l_reg=__uint_as_float(rr[0])+__uint_as_float(rr[1]);}
  if(hi==0)wsf[32+r32]=l_reg;asm volatile("s_waitcnt lgkmcnt(0)":::"memory");
  float rli[16];
  #pragma unroll
  for(int r=0;r<16;++r)rli[r]=__builtin_amdgcn_rcpf(wsf[32+crow(r,hi)]);
  bf16_t*Ow=O+(rowbase+q0+wid*QBLK)*OP+vh*D;
  { bf16_t*stg=(bf16_t*)(shm+LDS_OST)+wid*2048;
    #pragma unroll
    for(int r=0;r<16;++r){const int orow=crow(r,hi);
      #pragma unroll
      for(int d0=0;d0<2;++d0)stg[orow*64+d0*32+r32]=f2bf(o[d0][r]*rli[r]);}
    asm volatile("s_waitcnt lgkmcnt(0)":::"memory");
    #pragma unroll
    for(int i=0;i<4;++i){const int row=i*8+(lane>>3),ch=lane&7; const u32x4 v=*(const u32x4*)(stg+row*64+ch*8); *(u32x4*)(Ow+(long)row*OP+ch*8)=v;} }
  asm volatile("s_waitcnt lgkmcnt(0)\n\ts_barrier":::"memory");
  #undef DMA_K
  #undef DMA_V
  #undef CMASK
  #undef BIAS1
  #undef NEXTTILE
  #undef START
  #undef RESC
  #undef ROT
}

constexpr int PC_K=0, PC_V0=24576, PC_V1=49152, PC_PX=73728, PC_WS=106496, PC_OST=108544, PC_BYTES=PC_OST+8*4096;
template<int THRL> __device__ __forceinline__ void attn_unit_pc(int b,int hh,int cc,int qb,const bf16_t*U,bf16_t*O,char*shm,int ncap){
  int tid_=threadIdx.x; asm volatile("":"+v"(tid_));
  const int tid=tid_,lane=tid&63,r32=lane&31,hi=lane>>5; const int wid=__builtin_amdgcn_readfirstlane(tid>>6);
  const bool prod=wid<4; const int pw=wid&3;
  const long rowbase=(long)b*SEQ; const int q0=qb*128;
  const float slope2=__uint_as_float(__builtin_amdgcn_readfirstlane(__float_as_uint(exp2f(-2.f*(float)(hh+1))*1.4426950408889634f)));
  const float s64=__uint_as_float(__builtin_amdgcn_readfirstlane(__float_as_uint(64.f*slope2))), s32=__uint_as_float(__builtin_amdgcn_readfirstlane(__float_as_uint(32.f*slope2)));
  const unsigned lds0=(unsigned)(uintptr_t)shm;
  const int NTT=(q0+128)/KVBLK;
  int NT=NTT<ncap?NTT:ncap; if(NT<4)NT=4;
  float*wsf=(float*)(shm+PC_WS)+pw*128;
  char*px=shm+PC_PX+pw*8192;
  bf16_t*Ow=O+(rowbase+q0+pw*QBLK)*OP+(hh*4+cc*2+(prod?0:1))*D;
  #define TILE_OF(s) ((NTT-1-(s))>0?(NTT-1-(s)):0)
  if(prod){
    const bf16_t*Qw=U+(rowbase+q0+pw*QBLK)*KP+C_DQ+hh*128+cc*64;
    const bf16_t*Kh=U+rowbase*KP+C_DK+hh*128+cc*64,*Vh=U+rowbase*KP+C_DV+hh*128;
    const bf16_t*ksrc=Kh+(long)lane*KP+(2*pw)*8;
    const bf16_t*vsrc0=Vh+(long)(16*((2*pw)&3)+(lane>>2))*KP+((2*pw)>>2)*32+(lane&3)*8;
    const bf16_t*vsrc1=Vh+(long)(16*((2*pw+1)&3)+(lane>>2))*KP+((2*pw+1)>>2)*32+(lane&3)*8;
    const unsigned kdst=lds0+PC_K+(2*pw)*1024, vdst=lds0+PC_V0+(2*pw)*1024;
    #define DMA_K(s,slot) do{ const long to_=(long)TILE_OF(s)*KVBLK*KP; const unsigned d_=(unsigned)__builtin_amdgcn_readfirstlane(kdst+(slot)); glds16(ksrc+to_,d_); glds16(ksrc+to_+8,d_+1024); }while(0)
    #define DMA_V(s,slot) do{ const long to_=(long)TILE_OF(s)*KVBLK*KP; const unsigned d_=(unsigned)__builtin_amdgcn_readfirstlane(vdst+(slot)); glds16(vsrc0+to_,d_); glds16(vsrc1+to_,d_+1024); }while(0)
    const int vb0=(int)(lds0+PC_V0)+((lane>>4)&1)*32+(lane&3)*8+(4*hi+((lane&15)>>2))*64;
    const char*Kbase=shm+PC_K; bf16x8 kf[8];
    const lds_cptr shm3=(lds_cptr)shm; const lds_cptr kp0=shm3+PC_K+hi*1024+r32*16; const lds_cptr vp0=shm3+PC_V0+((lane>>4)&1)*32+(lane&3)*8+(4*hi+((lane&15)>>2))*64;
    DMA_K(0,0);DMA_V(0,0);DMA_K(1,SLOTB);
    bf16x8 qr[4];
    #pragma unroll
    for(int d0=0;d0<4;++d0)qr[d0]=*reinterpret_cast<const bf16x8*>(&Qw[(long)r32*KP+d0*16+hi*8]);
    float l_reg=0.f;f32x16 o[2];o[0]=f32x16{};o[1]=f32x16{};
    f32x16 negm;
    #pragma unroll
    for(int r=0;r<16;++r)negm[r]=slope2*(float)(crow(r,hi)-63);
    asm volatile("":"+v"(negm));
    const int qrel=pw*QBLK+r32;
    #define CMASK(P0,P1,s) do{ if((s)<2)cmask(P0,P1,1-(s),qrel,hi); else if(NTT-1-(s)<0){ _Pragma("unroll") for(int r=0;r<16;++r){P0[r]=-INFINITY;P1[r]=-INFINITY;} } }while(0)
    #define BIAS1(P1) do{ _Pragma("unroll") for(int r=0;r<16;++r)P1[r]+=s32; }while(0)
    #define NEXTTILE() do{ _Pragma("unroll") for(int r=0;r<16;++r)negm[r]-=s64; asm volatile("":"+v"(negm)); }while(0)
    bool resc=false;
    #define START(P0,P1) do{ const float rm=rowmax(P0,P1); resc=false; \
      { const float dl=__builtin_fmaxf(rm,-8192.f); \
        _Pragma("unroll") for(int r=0;r<16;++r){P0[r]=fsub_s(P0[r],dl);P1[r]=fsub_s(P1[r],dl);} \
        _Pragma("unroll") for(int r=0;r<16;++r)negm[r]-=dl; asm volatile("":"+v"(negm)); } \
      _Pragma("unroll") for(int r=0;r<16;++r)P0[r]=__builtin_amdgcn_exp2f(P0[r]); }while(0)
    #define RESC(t) do{ if(resc){ asm volatile("s_waitcnt lgkmcnt(0)":::"memory"); \
        _Pragma("unroll") for(int d_=0;d_<2;++d_) _Pragma("unroll") for(int r=0;r<16;++r)o[d_][r]*=wsf[32*((t)&1)+crow(r,hi)]; } }while(0)
    f32x16 pA0,pA1,pB0,pB1;
    int sl_prev=0,sl_cur=0,sl_next=SLOTB;
    #define ROT() do{sl_prev=sl_cur;sl_cur=sl_next;sl_next=(sl_next==(NSLOT-1)*SLOTB)?0:sl_next+SLOTB;}while(0)
    DMA_K(2,2*SLOTB);
    WAIT_BAR(6);
    qkt(pA0,pA1,Kbase,qr,negm,r32,hi);asm volatile("s_nop 15\n\ts_nop 7":"+v"(pA0),"+v"(pA1));BIAS1(pA1);CMASK(pA0,pA1,0);
    START(pA0,pA1);
    NEXTTILE();
    _Pragma("unroll") for(int r=0;r<16;++r)pA1[r]=__builtin_amdgcn_exp2f(pA1[r]);
    WAIT_BAR(0);
    DMA_K(3,0);DMA_V(1,SLOTB);
    ROT();
    kload8(kf,kp0+sl_cur);
    WAIT_BAR(4);
    s16x4 vlo[8],vhi[8]; u32x4 pw0,pw1,pw2,pw3;
    #define PKW(P,B) cvtpk_s(P[B],P[B+1])
    #define PAF(k) __builtin_bit_cast(bf16x8,pw##k)
    #define VFR(i) (bf16x8){vlo[i][0],vlo[i][1],vlo[i][2],vlo[i][3],vhi[i][0],vhi[i][1],vhi[i][2],vhi[i][3]}
    #define PIN(x) asm volatile("":"+v"(x))
    #define MX3(a,b,c) __builtin_fmaxf(__builtin_fmaxf((a),(b)),(c))
    #define GAPA(MF,A0,A1,A2,A3,W0,W1,PW) do{ MF; sacc+=A0; sacc+=A1; sacc+=A2; sacc+=A3; PIN(sacc); W0; W1; PIN(PW); SBAR(); }while(0)
    #define EX(v) __builtin_amdgcn_exp2f(v)
    #define GAPB(MF,X,B) do{ MF; X[B]=EX(X[B]); X[B+1]=EX(X[B+1]); X[B+2]=EX(X[B+2]); X[B+3]=EX(X[B+3]); PIN(X); SBAR(); }while(0)
    #define VRD(i) do{ vlo[i]=vtr(vp_+(((i)>>2)*4096+((i)&3)*1024)); vhi[i]=vtr(vp_+(((i)>>2)*4096+((i)&3)*1024+512)); }while(0)
    #define KRD(G,j) do{ if(G){ kload2(kf,kp0+sl_next,j); SBAR(); } }while(0)
    #define PXW(tt) do{ char*pb_=px+4096*((tt)&1)+16*lane; *(u32x4*)(pb_)=pw0; *(u32x4*)(pb_+1024)=pw1; *(u32x4*)(pb_+2048)=pw2; *(u32x4*)(pb_+3072)=pw3; }while(0)
    #define STEP(C0,C1,P0,P1,t,GK,GV,GL) do{ SBAR(); \
      const lds_cptr vp_=vp0+sl_prev; \
      VRD(0); SBAR(); float sacc=(P0[0]+P0[1]); \
      GAPA(C0=__builtin_amdgcn_mfma_f32_32x32x16_bf16(kf[0],qr[0],negm,0,0,0), P0[2],P0[3],P0[4],P0[5],     pw0[0]=PKW(P0,0), pw0[1]=PKW(P0,2), pw0); \
      VRD(4); SBAR(); GAPA(C1=__builtin_amdgcn_mfma_f32_32x32x16_bf16(kf[1],qr[0],negm,0,0,0), P0[6],P0[7],P0[8],P0[9],     pw0[2]=PKW(P0,4), pw0[3]=PKW(P0,6), pw0); \
      VRD(1); SBAR(); GAPA(C0=__builtin_amdgcn_mfma_f32_32x32x16_bf16(kf[2],qr[1],C0,0,0,0),   P0[10],P0[11],P0[12],P0[13], pw1[0]=PKW(P0,8), pw1[1]=PKW(P0,10), pw1); \
      VRD(5); SBAR(); GAPA(C1=__builtin_amdgcn_mfma_f32_32x32x16_bf16(kf[3],qr[1],C1,0,0,0),   P0[14],P0[15],P1[0],P1[1],   pw1[2]=PKW(P0,12),pw1[3]=PKW(P0,14), pw1); \
      VRD(2); SBAR(); GAPA(C0=__builtin_amdgcn_mfma_f32_32x32x16_bf16(kf[4],qr[2],C0,0,0,0),   P1[2],P1[3],P1[4],P1[5],     pw2[0]=PKW(P1,0), pw2[1]=PKW(P1,2), pw2); \
      VRD(6); SBAR(); GAPA(C1=__builtin_amdgcn_mfma_f32_32x32x16_bf16(kf[5],qr[2],C1,0,0,0),   P1[6],P1[7],P1[8],P1[9],     pw2[2]=PKW(P1,4), pw2[3]=PKW(P1,6), pw2); \
      VRD(3); SBAR(); GAPA(C0=__builtin_amdgcn_mfma_f32_32x32x16_bf16(kf[6],qr[3],C0,0,0,0),   P1[10],P1[11],P1[12],P1[13], pw3[0]=PKW(P1,8), pw3[1]=PKW(P1,10), pw3); \
      VRD(7); SBAR(); GAPA(C1=__builtin_amdgcn_mfma_f32_32x32x16_bf16(kf[7],qr[3],C1,0,0,0),   P1[14],P1[15],0.f,0.f,       pw3[2]=PKW(P1,12),pw3[3]=PKW(P1,14), pw3); \
      l_reg+=sacc; PXW((t)-1); \
      if(GK){DMA_K((t)+3,sl_cur);} if(GV){DMA_V((t)+1,sl_next);} \
      BIAS1(C1); CMASK(C0,C1,t); \
      { float a=MX3(C0[0],C0[1],C1[0]),b=MX3(C0[2],C0[3],C1[1]); a=MX3(a,C1[2],C1[3]); \
        _Pragma("unroll") for(int r=4;r<16;r+=4){a=MX3(a,C0[r],C0[r+1]);b=MX3(b,C0[r+2],C0[r+3]);a=MX3(a,C1[r],C1[r+1]);b=MX3(b,C1[r+2],C1[r+3]);} \
        float rm=__builtin_fmaxf(a,b); { auto rr=__builtin_amdgcn_permlane32_swap(__float_as_uint(rm),__float_as_uint(rm),false,false); rm=__builtin_fmaxf(__uint_as_float(rr[0]),__uint_as_float(rr[1])); } \
        resc=false; \
        if(__builtin_expect(__any(rm>(float)THRL),0)){ const float dl=__builtin_fmaxf(rm,0.f); \
          _Pragma("unroll") for(int r=0;r<16;++r){C0[r]-=dl;C1[r]-=dl;} \
          _Pragma("unroll") for(int r=0;r<16;++r)negm[r]-=dl; asm volatile("":"+v"(negm)); \
          const float f=__builtin_amdgcn_exp2f(-dl); l_reg*=f; if(hi==0)wsf[32*((t)&1)+r32]=f; resc=true; } \
        if(lane==0)wsf[64+((t)&1)]=resc?1.f:0.f; } \
      NEXTTILE(); \
      SBAR(); \
      GAPB(o[0]=__builtin_amdgcn_mfma_f32_32x32x16_bf16(PAF(0),VFR(0),o[0],0,0,0), C0,0); \
      GAPB(o[1]=__builtin_amdgcn_mfma_f32_32x32x16_bf16(PAF(0),VFR(4),o[1],0,0,0), C0,4); \
      KRD(GL,0); GAPB(o[0]=__builtin_amdgcn_mfma_f32_32x32x16_bf16(PAF(1),VFR(1),o[0],0,0,0), C0,8); \
      KRD(GL,1); GAPB(o[1]=__builtin_amdgcn_mfma_f32_32x32x16_bf16(PAF(1),VFR(5),o[1],0,0,0), C0,12); \
      KRD(GL,2); GAPB(o[0]=__builtin_amdgcn_mfma_f32_32x32x16_bf16(PAF(2),VFR(2),o[0],0,0,0), C1,0); \
      KRD(GL,3); GAPB(o[1]=__builtin_amdgcn_mfma_f32_32x32x16_bf16(PAF(2),VFR(6),o[1],0,0,0), C1,4); \
      GAPB(o[0]=__builtin_amdgcn_mfma_f32_32x32x16_bf16(PAF(3),VFR(3),o[0],0,0,0), C1,8); \
      GAPB(o[1]=__builtin_amdgcn_mfma_f32_32x32x16_bf16(PAF(3),VFR(7),o[1],0,0,0), C1,12); \
      }while(0)
    int t=1;
    for(;t+5<NT;t+=2){
      STEP(pB0,pB1,pA0,pA1,t,true,true,true);     WAIT_BAR(4); RESC(t);   ROT();
      STEP(pA0,pA1,pB0,pB1,t+1,true,true,true);   WAIT_BAR(4); RESC(t+1); ROT();
    }
    #define ENDW(tt) do{ if((tt)+3<NT){WAIT_BAR(4);} else if((tt)+2<NT){WAIT_BAR(2);} else {WAIT_BAR(0);} }while(0)
    for(;t+1<NT;t+=2){
      STEP(pB0,pB1,pA0,pA1,t,(t+3<NT),(t+1<NT),(t+1<NT));       ENDW(t);   RESC(t);   ROT();
      STEP(pA0,pA1,pB0,pB1,t+1,(t+4<NT),(t+2<NT),(t+2<NT));     ENDW(t+1); RESC(t+1); ROT();
    }
    STEP(pB0,pB1,pA0,pA1,NT-1,false,false,false); RESC(NT-1);
    { float sacc=pB0[0]+pB0[1]; _Pragma("unroll") for(int r=2;r<16;++r)sacc+=pB0[r]; _Pragma("unroll") for(int r=0;r<16;++r)sacc+=pB1[r]; l_reg+=sacc;
      pw0=(u32x4){PKW(pB0,0),PKW(pB0,2),PKW(pB0,4),PKW(pB0,6)};pw1=(u32x4){PKW(pB0,8),PKW(pB0,10),PKW(pB0,12),PKW(pB0,14)};pw2=(u32x4){PKW(pB1,0),PKW(pB1,2),PKW(pB1,4),PKW(pB1,6)};pw3=(u32x4){PKW(pB1,8),PKW(pB1,10),PKW(pB1,12),PKW(pB1,14)};
      { char*pb_=shm+PC_K+pw*4096+16*lane; *(u32x4*)(pb_)=pw0; *(u32x4*)(pb_+1024)=pw1; *(u32x4*)(pb_+2048)=pw2; *(u32x4*)(pb_+3072)=pw3; }
      SBAR(); pv(o,vb0+sl_cur,PAF(0),PAF(1),PAF(2),PAF(3)); }
    {auto rr=__builtin_amdgcn_permlane32_swap(__float_as_uint(l_reg),__float_as_uint(l_reg),false,false);l_reg=__uint_as_float(rr[0])+__uint_as_float(rr[1]);}
    if(hi==0)wsf[96+r32]=l_reg;
    WAIT_BAR(0);
    float rli[16];
    #pragma unroll
    for(int r=0;r<16;++r)rli[r]=__builtin_amdgcn_rcpf(wsf[96+crow(r,hi)]);
    { bf16_t*stg=(bf16_t*)(shm+PC_OST)+wid*2048;
      #pragma unroll
      for(int r=0;r<16;++r){const int orow=crow(r,hi);
        #pragma unroll
        for(int d0=0;d0<2;++d0)stg[orow*64+d0*32+r32]=f2bf(o[d0][r]*rli[r]);}
      asm volatile("s_waitcnt lgkmcnt(0)":::"memory");
      #pragma unroll
      for(int i=0;i<4;++i){const int row=i*8+(lane>>3),ch=lane&7; const u32x4 v=*(const u32x4*)(stg+row*64+ch*8); *(u32x4*)(Ow+(long)row*OP+ch*8)=v;} }
    asm volatile("s_waitcnt lgkmcnt(0)\n\ts_barrier":::"memory");
    #undef PKW
    #undef PAF
    #undef VFR
    #undef PIN
    #undef MX3
    #undef GAPA
    #undef GAPB
    #undef EX
    #undef VRD
    #undef KRD
    #undef PXW
    #undef STEP
    #undef ENDW
    #undef DMA_K
    #undef DMA_V
    #undef CMASK
    #undef BIAS1
    #undef NEXTTILE
    #undef START
    #undef RESC
    #undef ROT
  } else {
    const bf16_t*Vh=U+rowbase*KP+C_DV+hh*128+64;
    const bf16_t*vsrc0=Vh+(long)(16*((2*pw)&3)+(lane>>2))*KP+((2*pw)>>2)*32+(lane&3)*8;
    const bf16_t*vsrc1=Vh+(long)(16*((2*pw+1)&3)+(lane>>2))*KP+((2*pw+1)>>2)*32+(lane&3)*8;
    const unsigned vdst=lds0+PC_V1+(2*pw)*1024;
    #define DMA_V1(j) do{ const long to_=(long)TILE_OF(j)*KVBLK*KP; const unsigned d_=(unsigned)__builtin_amdgcn_readfirstlane(vdst+((j)%3)*SLOTB); glds16(vsrc0+to_,d_); glds16(vsrc1+to_,d_+1024); }while(0)
    const int vb1=(int)(lds0+PC_V1)+((lane>>4)&1)*32+(lane&3)*8+(4*hi+((lane&15)>>2))*64;
    f32x16 o[2];o[0]=f32x16{};o[1]=f32x16{};
    #define CPVB(j,PB) do{ const char*pb_=(PB); const u32x4 a0=*(const u32x4*)(pb_),a1=*(const u32x4*)(pb_+1024),a2=*(const u32x4*)(pb_+2048),a3=*(const u32x4*)(pb_+3072); \
        pv(o,vb1+((j)%3)*SLOTB,__builtin_bit_cast(bf16x8,a0),__builtin_bit_cast(bf16x8,a1),__builtin_bit_cast(bf16x8,a2),__builtin_bit_cast(bf16x8,a3)); \
        if((j)+1<NT && wsf[64+(((j)+1)&1)]!=0.f){ _Pragma("unroll") for(int d_=0;d_<2;++d_) _Pragma("unroll") for(int r=0;r<16;++r)o[d_][r]*=wsf[32*(((j)+1)&1)+crow(r,hi)]; } }while(0)
    #define CPV(j) CPVB(j, px+4096*((j)&1)+16*lane)
    DMA_V1(0); DMA_V1(1);
    WAIT_BAR(2);
    WAIT_BAR(2);
    WAIT_BAR(2);
    WAIT_BAR(2);
    #pragma unroll 1
    for(int j=0;j+2<NT;++j){
      if(j+2<NT) DMA_V1(j+2);
      CPV(j);
      if(j+3<NT){ WAIT_BAR(2); } else { WAIT_BAR(0); }
    }
    CPV(NT-2);
    CPVB(NT-1, shm+PC_K+pw*4096+16*lane);
    float rli[16];
    #pragma unroll
    for(int r=0;r<16;++r)rli[r]=__builtin_amdgcn_rcpf(wsf[96+crow(r,hi)]);
    { bf16_t*stg=(bf16_t*)(shm+PC_OST)+wid*2048;
      #pragma unroll
      for(int r=0;r<16;++r){const int orow=crow(r,hi);
        #pragma unroll
        for(int d0=0;d0<2;++d0)stg[orow*64+d0*32+r32]=f2bf(o[d0][r]*rli[r]);}
      asm volatile("s_waitcnt lgkmcnt(0)":::"memory");
      #pragma unroll
      for(int i=0;i<4;++i){const int row=i*8+(lane>>3),ch=lane&7; const u32x4 v=*(const u32x4*)(stg+row*64+ch*8); *(u32x4*)(Ow+(long)row*OP+ch*8)=v;} }
    asm volatile("s_waitcnt lgkmcnt(0)\n\ts_barrier":::"memory");
    #undef DMA_V1
    #undef CPV
    #undef CPVB
  }
  #undef TILE_OF
}
#undef SBAR
#undef WAIT_BAR
}

__device__ __forceinline__ void transpose_item(const float* W, int K, int Nsrc, bf16_t* WT, int roff, int rmul, float* scr, int kb, int nb, int lane) {
    const int k0 = 64 * kb, n0 = 32 * nb;
    float tv[32];
#pragma unroll
    for (int i = 0; i < 32; ++i) { const int kk = 2 * i + (lane >> 5), n = n0 + (lane & 31); tv[i] = (n < Nsrc) ? W[(size_t)(k0 + kk) * Nsrc + n] : 0.f; }
#pragma unroll
    for (int i = 0; i < 32; ++i) scr[(2 * i + (lane >> 5)) * 33 + (lane & 31)] = tv[i];
    lds_fence();
    const int c = lane & 7;
#pragma unroll
    for (int j = 0; j < 4; ++j) { const int n = (lane >> 3) + 8 * j; const float* s = scr + (8 * c) * 33 + n;
        u32x4 o; o.x = pk2(s[0 * 33], s[1 * 33]); o.y = pk2(s[2 * 33], s[3 * 33]); o.z = pk2(s[4 * 33], s[5 * 33]); o.w = pk2(s[6 * 33], s[7 * 33]);
        *(u32x4*)(WT + (size_t)(roff + (n0 + n) * rmul) * K + k0 + 8 * c) = o; }
    lds_fence();
}

__device__ __forceinline__ void stage0(const Params& p, unsigned char* smem) {
    const int tid = opaque_tid(), wid = tid >> 6, lane = tid & 63, G = gridDim.x;
    unsigned char* ws = p.ws;
    for (int it = blockIdx.x; it < 96; it += G) {
        float* ssl = (float*)(smem + 73728);
        float* mp = (float*)(smem + 73728 + 8192);
        for (int i = tid; i < 2048; i += NT) ssl[i] = silu_f(p.in[1][i]);
        __syncthreads();
        const float* wa = p.in[2]; const int j = it * 64 + lane; float a0 = 0.f, a1 = 0.f;
#pragma unroll 1
        for (int k0 = 128 * wid; k0 < 128 * wid + 128; k0 += 32) { float wv[32];
#pragma unroll
            for (int k = 0; k < 32; ++k) wv[k] = wa[(size_t)(k0 + k) * 6144 + j];
#pragma unroll
            for (int k = 0; k < 32; ++k) { a0 += ssl[k0 + k] * wv[k]; a1 += ssl[1024 + k0 + k] * wv[k]; } }
        mp[wid * 128 + lane] = a0; mp[wid * 128 + 64 + lane] = a1;
        __syncthreads();
        if (tid < 128) { float s = p.in[3][it * 64 + (tid & 63)];
#pragma unroll
            for (int w = 0; w < 8; ++w) s += mp[w * 128 + tid];
            ((float*)(ws + WS_MOD))[(tid >> 6) * 6144 + it * 64 + (tid & 63)] = s; }
        __syncthreads();
    }
    {
        float* scr = (float*)(smem + wid * 8448);
        const int gw = blockIdx.x * NW + wid, NGW = G * NW;
        constexpr int I_IN = 16 * 96, I_OUT = 16 * 32, I_E = 256;
        constexpr int NITEMS = I_IN + I_OUT + 64 * 3 * I_E, I_C = 2 * (128 + 4), I_B = 32;
        for (int it = gw; it < I_C + I_B; it += NGW) {
            if (it < I_C) { const int kv = it / 132, r = it % 132;
                if (r < 128) transpose_item(p.in[kv ? 17 : 16], 2048, 128, (bf16_t*)(ws + WS_W1T) + (size_t)kv * 128 * 2048, 0, 1, scr, r >> 2, r & 3, lane);
                else transpose_item(p.in[kv ? 19 : 18], 128, 64, (bf16_t*)(ws + WS_W2T) + (size_t)kv * 64 * 128, 0, 1, scr, (r - 128) >> 1, (r - 128) & 1, lane);
            } else { const int r = it - I_C, kv = r >> 4, kc = r & 15; const float* pos = p.in[kv ? 15 : 14]; const float* w1 = p.in[kv ? 17 : 16];
                float a0 = 0.f, a1 = 0.f;
#pragma unroll 8
                for (int k = kc * 128; k < kc * 128 + 128; ++k) { const float pv = pos[k]; a0 += pv * w1[(size_t)k * 128 + lane]; a1 += pv * w1[(size_t)k * 128 + 64 + lane]; }
                float* b1 = (float*)(ws + WS_B1P) + (kv * 16 + kc) * 128; b1[lane] = a0; b1[64 + lane] = a1; }
        }
        for (int it = gw; it < NITEMS; it += NGW) {
            int r = it;
            if (r < I_IN) { transpose_item(p.in[8], 1024, IN_COLS, (bf16_t*)(ws + WS_WTIN), 0, 1, scr, r / 96, r % 96, lane); continue; } r -= I_IN;
            if (r < I_OUT) { transpose_item(p.in[20], 1024, 1024, (bf16_t*)(ws + WS_WTOUT), 0, 1, scr, r / 32, r % 32, lane); continue; } r -= I_OUT;
            const int e = r / (3 * I_E), q = r % (3 * I_E), kind = q / I_E, ii = q % I_E;
            if (kind == 0) transpose_item(p.in[25] + (size_t)e * 1024 * 512, 1024, 512, (bf16_t*)(ws + WS_WTGU) + (size_t)e * 1024 * 1024, 0, 2, scr, ii / 16, ii % 16, lane);
            else if (kind == 1) transpose_item(p.in[26] + (size_t)e * 1024 * 512, 1024, 512, (bf16_t*)(ws + WS_WTGU) + (size_t)e * 1024 * 1024, 1, 2, scr, ii / 16, ii % 16, lane);
            else transpose_item(p.in[27] + (size_t)e * 512 * 1024, 512, 1024, (bf16_t*)(ws + WS_WTDN) + (size_t)e * 1024 * 512, 0, 1, scr, ii / 32, ii % 32, lane);
        }
    }
    {
        const int gt = blockIdx.x * NT + tid, NGT = G * NT;
        float* wr = (float*)(ws + WS_WR);
        for (int i = gt; i < 1024 * 80; i += NGT) { const int ln = (i >> 2) & 63, jj = (i >> 8) % 5, ks = (i >> 8) / 5, k = 16 * ks + 4 * (ln >> 4) + (i & 3), c = 16 * jj + (ln & 15);
            wr[i] = c < 64 ? p.in[23][k * 64 + c] : (c < 72 ? p.in[21][k * 8 + (c - 64)] : 0.f); }
    }
}

__device__ __forceinline__ void stage1(const Params& p) {
    const int tid = opaque_tid(), wid = tid >> 6, lane = tid & 63;
    const float* mod = (const float*)(p.ws + WS_MOD);
    bf16_t* xn = (bf16_t*)(p.ws + WS_XN);
    for (int row = blockIdx.x * NW + wid; row < M; row += gridDim.x * NW) {
        const int b = row / SEQ;
        const f32x4* xr = (const f32x4*)(p.in[0] + (size_t)row * DM) + lane;
        f32x4 v[4]; float ss = 0.f;
#pragma unroll
        for (int j = 0; j < 4; ++j) { v[j] = xr[64 * j]; ss += v[j].x * v[j].x + v[j].y * v[j].y + v[j].z * v[j].z + v[j].w * v[j].w; }
        const float rstd = rsqrtf(wave_sum(ss) * (1.f / DM) + 1e-6f);
#pragma unroll
        for (int j = 0; j < 4; ++j) { const int col = lane * 4 + 256 * j;
            const f32x4 g = *(const f32x4*)(p.in[4] + col), sc = *(const f32x4*)(mod + b * 6144 + 1024 + col), sh = *(const f32x4*)(mod + b * 6144 + col);
            const f32x4 h = v[j] * rstd * g * (sc + 1.f) + sh;
            u32x2 o; o.x = pk2(h.x, h.y); o.y = pk2(h.z, h.w);
            *(u32x2*)(xn + (size_t)row * DM + col) = o; }
    }
}

struct EpiBf16Out {
    static constexpr bool PERM = true;
    bf16_t* O; int ldc; int nscale; float sc; unsigned* norm;
    __device__ __forceinline__ void operator()(const f32x4 (&acc)[2][2][4][2], const pg8::Unit& u, int wr, int wc, int fr, int fq) const {
        const int row0 = u.pm * 256 + wr * 64 + fr, col0 = u.pn * 256 + wc * 32 + 8 * fq; const float s_ = ((nscale >> u.pn) & 1) ? sc : 1.f;
        if (norm && u.pn < 4) {
#pragma unroll
            for (int bj = 0; bj < 2; ++bj) { float mx = 0.f;
#pragma unroll
                for (int ai = 0; ai < 2; ++ai)
#pragma unroll
                    for (int m = 0; m < 4; ++m) { const f32x4 v0 = acc[ai][bj][m][0] * s_, v1 = acc[ai][bj][m][1] * s_;
                        float ss = (v0[0] * v0[0] + v0[1] * v0[1]) + (v0[2] * v0[2] + v0[3] * v0[3]) + (v1[0] * v1[0] + v1[1] * v1[1]) + (v1[2] * v1[2] + v1[3] * v1[3]);
                        ss += __shfl_xor(ss, 16); ss += __shfl_xor(ss, 32); mx = fmaxf(mx, ss); }
                mx = fmaxf(mx, __shfl_xor(mx, 1)); mx = fmaxf(mx, __shfl_xor(mx, 2)); mx = fmaxf(mx, __shfl_xor(mx, 4)); mx = fmaxf(mx, __shfl_xor(mx, 8));
                if (fr == 0 && fq == 0) atomicMax(norm + (u.pm >> 5) * 32 + u.pn * 8 + bj * 4 + wc, __float_as_uint(mx * 1.001f)); }
        }
#pragma unroll
        for (int ai = 0; ai < 2; ++ai) { if (ai == 1 && u.half) break;
#pragma unroll
            for (int m = 0; m < 4; ++m) { bf16_t* rowp = O + (size_t)(row0 + ai * 128 + m * 16) * ldc + col0;
#pragma unroll
                for (int bj = 0; bj < 2; ++bj) { const f32x4 v0 = acc[ai][bj][m][0] * s_, v1 = acc[ai][bj][m][1] * s_;
                    u32x4 w; w.x = pg8::cvt_pk_bf16(v0[0], v0[1]); w.y = pg8::cvt_pk_bf16(v0[2], v0[3]); w.z = pg8::cvt_pk_bf16(v1[0], v1[1]); w.w = pg8::cvt_pk_bf16(v1[2], v1[3]);
                    *(u32x4*)(rowp + bj * 128) = w; } } }
    }
};
struct EpiF32Out {
    static constexpr bool PERM = false;
    float* O; int ldc;
    __device__ __forceinline__ void operator()(const f32x4 (&acc)[2][2][4][2], const pg8::Unit& u, int wr, int wc, int fr, int fq) const {
        const int row0 = u.pm * 256 + wr * 64 + fr, col0 = u.pn * 256 + wc * 32 + 4 * fq;
#pragma unroll
        for (int ai = 0; ai < 2; ++ai)
#pragma unroll
            for (int m = 0; m < 4; ++m) { float* rowp = O + (size_t)(row0 + ai * 128 + m * 16) * ldc + col0;
#pragma unroll
                for (int bj = 0; bj < 2; ++bj)
#pragma unroll
                    for (int n = 0; n < 2; ++n) *(f32x4*)(rowp + bj * 128 + n * 16) = acc[ai][bj][m][n]; }
    }
};
__device__ __forceinline__ void stage2(const Params& p, unsigned char* smem) {
    pg8::Gemm g{(const bf16_t*)(p.ws + WS_XN), DM};
    pg8::StaticOrder S; S.init(M, UC, gridDim.x, blockIdx.x, (const bf16_t*)(p.ws + WS_WTIN));
    EpiBf16Out E{(bf16_t*)(p.ws + WS_U), UC, 0xC3, attn_body::C2, (unsigned*)(p.ws + WS_CTL) + CTL_NORM};
    pg8::gemm_phase(( PG8_LAS unsigned char*)smem, g, S, E);
}

__device__ __forceinline__ void diff_attn_block(const Params& p, unsigned char* smem, int vb) {
    const int tid = threadIdx.x;
    const int qb = 15 - vb / 32, rest = vb % 32, b = rest >> 4, h = (rest >> 2) & 3, c = (rest >> 1) & 1, vh = rest & 1;
    const bf16_t* U = (const bf16_t*)(p.ws + WS_U);
    float* Ks = (float*)smem;
    float* Vs = (float*)(smem + 16384);
    const int qrow = qb * 512 + tid; const size_t row = (size_t)b * SEQ + qrow;
    float q[64];
    {
        const u32x4* qp = (const u32x4*)(U + row * UC + C_DQ + h * 128 + c * 64);
#pragma unroll
        for (int i = 0; i < 8; ++i) unpack8(qp[i], q + 8 * i);
#pragma unroll
        for (int i = 0; i < 64; ++i) q[i] *= 0.125f;
    }
    float o[64];
#pragma unroll
    for (int i = 0; i < 64; ++i) o[i] = 0.f;
    float m = -1e30f, l = 0.f;
    const float slope = exp2f(-2.f * (float)(h + 1));
    const int ntiles = (qb * 512 + 512) / 64;
    for (int tile = ntiles - 1; tile >= 0; --tile) {
        __syncthreads();
        {
            const int key = tid >> 3, ch = tid & 7; const size_t krow = (size_t)b * SEQ + tile * 64 + key;
            float t8[8];
            unpack8(*(const u32x4*)(U + krow * UC + C_DK + h * 128 + c * 64 + ch * 8), t8);
#pragma unroll
            for (int e = 0; e < 8; ++e) Ks[key * 64 + ch * 8 + e] = t8[e];
            unpack8(*(const u32x4*)(U + krow * UC + C_DV + h * 128 + vh * 64 + ch * 8), t8);
#pragma unroll
            for (int e = 0; e < 8; ++e) Vs[key * 64 + ch * 8 + e] = t8[e];
        }
        __syncthreads();
        const int k0 = tile * 64;
        if (k0 <= qrow) {
#pragma unroll 1
            for (int j = 63; j >= 0; --j) {
                const int kpos = k0 + j;
                if (kpos <= qrow) {
                    const f32x4* kr = (const f32x4*)(Ks + j * 64);
                    float s0 = 0.f, s1 = 0.f;
#pragma unroll
                    for (int d = 0; d < 16; d += 2) { const f32x4 ka = kr[d], kb = kr[d + 1];
                        s0 += q[4 * d] * ka.x + q[4 * d + 1] * ka.y + q[4 * d + 2] * ka.z + q[4 * d + 3] * ka.w;
                        s1 += q[4 * d + 4] * kb.x + q[4 * d + 5] * kb.y + q[4 * d + 6] * kb.z + q[4 * d + 7] * kb.w; }
                    const float s = s0 + s1 - slope * (float)(qrow - kpos);
                    if (s > m) { const float corr = __expf(m - s); l *= corr;
#pragma unroll
                        for (int e = 0; e < 64; ++e) o[e] *= corr;
                        m = s; }
                    const float pr = __expf(s - m); l += pr;
                    const f32x4* vr = (const f32x4*)(Vs + j * 64);
#pragma unroll
                    for (int e = 0; e < 16; ++e) { const f32x4 vv = vr[e]; o[4 * e] += pr * vv.x; o[4 * e + 1] += pr * vv.y; o[4 * e + 2] += pr * vv.z; o[4 * e + 3] += pr * vv.w; }
                }
            }
        }
    }
    const float il = 1.f / l;
    f32x4* op = (f32x4*)((float*)(p.ws + WS_OC) + ((row * 4 + h) * 2 + c) * 128 + vh * 64);
#pragma unroll
    for (int e = 0; e < 16; ++e) op[e] = (f32x4){o[4 * e] * il, o[4 * e + 1] * il, o[4 * e + 2] * il, o[4 * e + 3] * il};
}

__device__ __forceinline__ void write_frags(const bf16_t* kt, const bf16_t* vt, int pitch, bf16_t* kf_tile, bf16_t* vf_tile, int lane) {
    const int r32 = lane & 31, hi = lane >> 5;
    if (kt) {
#pragma unroll
        for (int d0 = 0; d0 < 4; ++d0) *(u32x4*)(kf_tile + (d0 * 64 + lane) * 8) = *(const u32x4*)(kt + r32 * pitch + 16 * d0 + 8 * hi);
    }
    if (vt) {
#pragma unroll
        for (int d0 = 0; d0 < 2; ++d0)
#pragma unroll
            for (int s = 0; s < 2; ++s) { unsigned w[4];
#pragma unroll
                for (int e2 = 0; e2 < 4; ++e2) { const int j = 2 * e2, t0_ = 16 * s + 8 * (j >> 2) + 4 * hi + (j & 3);
                    w[e2] = (unsigned)vt[t0_ * pitch + 32 * d0 + r32] | ((unsigned)vt[(t0_ + 1) * pitch + 32 * d0 + r32] << 16); }
                *(u32x4*)(vf_tile + ((d0 * 2 + s) * 64 + lane) * 8) = (u32x4){w[0], w[1], w[2], w[3]}; }
    }
}
__device__ __forceinline__ void compress_item(const Params& p, unsigned char* smem, int idx) {
    typedef float f32x16 __attribute__((ext_vector_type(16)));
    int tid_ = threadIdx.x; asm volatile("" : "+v"(tid_));
    const int tid = tid_, wid = tid >> 6, lane = tid & 63, r32 = lane & 31, hi = lane >> 5;
    const int kv = idx >> 6, b = (idx >> 5) & 1, hkv = (idx >> 4) & 1, n0 = (idx & 15) * 32;
    const bf16_t* U = (const bf16_t*)(p.ws + WS_U);
    const bf16_t* w1t = (const bf16_t*)(p.ws + WS_W1T) + (size_t)kv * 128 * 2048;
    const bf16_t* w2t = (const bf16_t*)(p.ws + WS_W2T) + (size_t)kv * 64 * 128;
    const float* b1p = (const float*)(p.ws + WS_B1P) + kv * 16 * 128;
    float* hsum = (float*)smem;
    bf16_t* hb = (bf16_t*)(smem + 131072);
    bf16_t* ot = (bf16_t*)(smem + 131072 + 8704);
    const int col = (kv ? C_CV : C_CK) + hkv * 64;
    __syncthreads();
    f32x16 acc[4];
#pragma unroll
    for (int c = 0; c < 4; ++c) acc[c] = (f32x16){};
    const int n = n0 + r32;
#pragma unroll 1
    for (int ii = 0; ii < 4; ++ii) { const int i = 4 * wid + ii, tok = 16 * n + i; const bool ok = tok < SEQ;
        const bf16_t* arow = U + ((size_t)b * SEQ + (ok ? tok : 0)) * UC + col + 8 * hi;
#pragma unroll
        for (int d0 = 0; d0 < 64; d0 += 16) { bf16x8 a = *(const bf16x8*)(arow + d0); if (!ok) a = (bf16x8){};
            const int kk = i * 64 + d0 + 8 * hi;
#pragma unroll
            for (int c = 0; c < 4; ++c) acc[c] = __builtin_amdgcn_mfma_f32_32x32x16_bf16(a, *(const bf16x8*)(w1t + (size_t)(32 * c + r32) * 2048 + kk), acc[c], 0, 0, 0); } }
#pragma unroll
    for (int c = 0; c < 4; ++c)
#pragma unroll
        for (int r = 0; r < 16; ++r) hsum[wid * 4096 + ((r & 3) + 8 * (r >> 2) + 4 * hi) * 128 + 32 * c + r32] = acc[c][r];
    __syncthreads();
    for (int i = tid; i < 4096; i += NT) { const int row = i >> 7, j = i & 127; float bs = 0.f;
#pragma unroll
        for (int c = 0; c < 16; ++c) bs += b1p[c * 128 + j];
        float hs = 0.f;
#pragma unroll
        for (int w = 0; w < 8; ++w) hs += hsum[w * 4096 + i];
        hb[row * 136 + j] = f2bf(gelu_tanh(hs + bs)); }
    __syncthreads();
    if (wid < 2) {
        f32x16 o = (f32x16){};
#pragma unroll
        for (int k0 = 0; k0 < 128; k0 += 16) o = __builtin_amdgcn_mfma_f32_32x32x16_bf16(*(const bf16x8*)(hb + r32 * 136 + k0 + 8 * hi), *(const bf16x8*)(w2t + (size_t)(32 * wid + r32) * 128 + k0 + 8 * hi), o, 0, 0, 0);
        const int d = 32 * wid + r32;
#pragma unroll
        for (int r = 0; r < 16; ++r) { const int nl = (r & 3) + 8 * (r >> 2) + 4 * hi; ot[nl * 72 + d] = (n0 + nl) < NCMP ? f2bf(o[r]) : (bf16_t)0; }
    }
    __syncthreads();
    if (wid == 0) { bf16_t* dst = (bf16_t*)(p.ws + (kv ? WS_VC : WS_KC)) + ((size_t)(b * 2 + hkv) * 16 + (idx & 15)) * 2048;
        write_frags(kv ? nullptr : ot, kv ? ot : nullptr, 72, dst, dst, lane); }
}

__device__ __forceinline__ void vt_item(const Params& p, bf16_t* scr, int item, int lane) {
    const int kind = item >> 9, b = (item >> 8) & 1, hkv = (item >> 7) & 1, blk = item & 127, tok0 = blk * 64;
    const bf16_t* U = (const bf16_t*)(p.ws + WS_U);
    bf16_t* KF = (bf16_t*)(p.ws + (kind ? WS_KFW : WS_KFS)) + (size_t)(b * 2 + hkv) * 64 * SEQ;
    bf16_t* VF = (bf16_t*)(p.ws + (kind ? WS_VFW : WS_VFS)) + (size_t)(b * 2 + hkv) * 64 * SEQ;
    const int kcol = (kind ? C_WK : C_SK) + hkv * 64, vcol = (kind ? C_WV : C_SV) + hkv * 64;
    bf16_t* ks = scr; bf16_t* vs = scr + 64 * 72;
    lds_fence();
#pragma unroll
    for (int i = 0; i < 8; ++i) { const int row = 8 * i + (lane >> 3), ch = lane & 7; const bf16_t* src = U + ((size_t)b * SEQ + tok0 + row) * UC + ch * 8;
        *(u32x4*)(ks + row * 72 + ch * 8) = *(const u32x4*)(src + kcol); *(u32x4*)(vs + row * 72 + ch * 8) = *(const u32x4*)(src + vcol); }
    lds_fence();
#pragma unroll
    for (int t = 0; t < 2; ++t) write_frags(ks + 32 * t * 72, vs + 32 * t * 72, 72, KF + (size_t)(2 * blk + t) * 2048, VF + (size_t)(2 * blk + t) * 2048, lane);
    lds_fence();
}

__device__ __forceinline__ void stage3(const Params& p, unsigned char* smem) {
    for (int vb = blockIdx.x; vb < 128; vb += gridDim.x) compress_item(p, smem, vb);
    __syncthreads();
    { const int t_ = opaque_tid(), wid = t_ >> 6, lane = t_ & 63;
      const int G = gridDim.x, sh = (G >= 256) ? 128 : 0, vbk = (blockIdx.x + G - sh) % G;
      for (int it = vbk * NW + wid; it < 1024; it += G * NW) vt_item(p, (bf16_t*)(smem + wid * 18432), it, lane); }
    __syncthreads();
    __syncthreads();
    {
        const bf16_t* U = (const bf16_t*)(p.ws + WS_U); bf16_t* OB = (bf16_t*)(p.ws + WS_OC);
        unsigned* qhead = (unsigned*)(p.ws + WS_CTL) + CTL_QHEAD; const float* nrm = (const float*)(p.ws + WS_CTL) + CTL_NORM;
        volatile int* bc = (volatile int*)(smem + LDS_BYTES - 64);
        const int nq = (gridDim.x % 8 == 0) ? 8 : 1, myq = blockIdx.x % nq, qlen = 1024 / nq;
        for (;;) {
            __syncthreads();
            if (threadIdx.x == 0) *bc = (int)atomicAdd(qhead + 16 * myq, 1u);
            __syncthreads();
            const int ri = __builtin_amdgcn_readfirstlane(*bc);
            if (ri >= qlen) break;
            const int x = nq == 8 ? myq : (ri >> 7), r = ri & 127;
            const int b = x >> 2, c = (x >> 1) & 1, par = x & 1;
            int k, h;
            if (r < 64) { k = 31 - (r >> 1); h = 2 + (r & 1); } else if (r < 96) { k = 31 - (r - 64); h = 1; } else { k = 31 - (r - 96); h = 0; }
            const int qb = 2 * k + par;
            const int g = h * 4 + c * 2;
            const float qn2 = nrm[b * 32 + g] + nrm[b * 32 + g + 1], kn2 = nrm[b * 32 + 16 + g] + nrm[b * 32 + 16 + g + 1];
            const float sb_ = sqrtf(qn2) * sqrtf(kn2) * 1.001f, slope2 = exp2f(-2.f * (float)(h + 1)) * 1.4426950408889634f;
            const float sc_ = (2.f * sb_ + 127.f * slope2 + 168.f) / (64.f * slope2);
            int ncap = sc_ < 1000.f ? (int)sc_ + 2 : 1000; ncap = (ncap + 1) & ~1; if (ncap < 4) ncap = 4;
            attn_body::attn_unit_pc<8>(b, h, c, qb, U, OB, (char*)smem, __builtin_amdgcn_readfirstlane(ncap));
        }
    }
}

__device__ __forceinline__ void qk4(const bf16_t* krow, const float* qs, float* s) {
    s[0] = s[1] = s[2] = s[3] = 0.f;
#pragma unroll 2
    for (int c = 0; c < 8; ++c) { float kd[8]; unpack8(*(const u32x4*)(krow + c * 8), kd);
#pragma unroll
        for (int g = 0; g < 4; ++g) { const f32x4 qa = *(const f32x4*)(qs + g * 64 + c * 8), qb = *(const f32x4*)(qs + g * 64 + c * 8 + 4);
            s[g] += kd[0] * qa.x + kd[1] * qa.y + kd[2] * qa.z + kd[3] * qa.w + kd[4] * qb.x + kd[5] * qb.y + kd[6] * qb.z + kd[7] * qb.w; } }
}
__device__ __forceinline__ void pv_block(const float* pw, int pstride, const bf16_t* vbase, size_t vstride, int nrows, float (&os)[4][8], int lane) {
    const int jr = lane >> 3, ch = lane & 7;
#pragma unroll 2
    for (int i = 0; i < 8; ++i) { const int j = jr + 8 * i;
        if (j < nrows) { float vd[8]; unpack8(*(const u32x4*)(vbase + (size_t)j * vstride + ch * 8), vd);
#pragma unroll
            for (int g = 0; g < 4; ++g) { const float pr = pw[g * pstride + j];
#pragma unroll
                for (int e = 0; e < 8; ++e) os[g][e] += pr * vd[e]; } } }
}

__device__ __forceinline__ void nsa_item(const Params& p, float* wl, int item, int lane) {
    const int hkv = item & 1, t = (item >> 1) % SEQ, b = (item >> 1) / SEQ;
    const bf16_t* U = (const bf16_t*)(p.ws + WS_U);
    const bf16_t* KC = (const bf16_t*)(p.ws + WS_KC); const bf16_t* VC = (const bf16_t*)(p.ws + WS_VC);
    const size_t row = (size_t)b * SEQ + t;
    float* qs = wl;
    float* ps = wl + 256;
    lds_fence();
#pragma unroll
    for (int g = 0; g < 4; ++g) qs[g * 64 + lane] = bf2f(U[row * UC + C_NQ + (hkv * 4 + g) * 64 + lane]);
    lds_fence();
    float slope[4], gate[4][3];
#pragma unroll
    for (int g = 0; g < 4; ++g) { slope[g] = exp2f(-(float)(hkv * 4 + g + 1));
#pragma unroll
        for (int i = 0; i < 3; ++i) { const float x = bf2f(U[row * UC + C_NG + (hkv * 4 + g) * 3 + i]); gate[g][i] = 1.f / (1.f + __expf(-x)); } }
    float tot[4][8];
#pragma unroll
    for (int g = 0; g < 4; ++g)
#pragma unroll
        for (int e = 0; e < 8; ++e) tot[g][e] = 0.f;
    const int nvalid = t >= 31 ? min((t - 31) / 16 + 1, NCMP) : 0;
    float cinv[4];
    {
        float mx[4] = {-1e30f, -1e30f, -1e30f, -1e30f};
#pragma unroll 1
        for (int i = 0; i < 8; ++i) { const int n = lane + 64 * i;
            asm volatile("" ::: "memory");
            if (n < nvalid) { float s[4]; qk4(KC + ((size_t)(b * 512 + n) * 2 + hkv) * 64, qs, s);
#pragma unroll
                for (int g = 0; g < 4; ++g) { const float v = s[g] * 0.125f - slope[g] * (float)(t - (16 * n + 31)); ps[g * 512 + n] = v; mx[g] = fmaxf(mx[g], v); } }
            else {
#pragma unroll
                for (int g = 0; g < 4; ++g) ps[g * 512 + n] = -1e30f; } }
        lds_fence();
#pragma unroll
        for (int g = 0; g < 4; ++g) { mx[g] = wave_max(mx[g]); float sum = 0.f;
#pragma unroll 1
            for (int i = 0; i < 8; ++i) { const int n = lane + 64 * i; const float e = n < nvalid ? __expf(ps[g * 512 + n] - mx[g]) : 0.f; ps[g * 512 + n] = e; sum += e; }
            sum = wave_sum(sum); cinv[g] = 1.f / fmaxf(sum, 1e-30f); }
        lds_fence();
        float oc[4][8];
#pragma unroll
        for (int g = 0; g < 4; ++g)
#pragma unroll
            for (int e = 0; e < 8; ++e) oc[g][e] = 0.f;
#pragma unroll 1
        for (int n0 = 0; n0 < nvalid; n0 += 64) pv_block(ps + n0, 512, VC + ((size_t)(b * 512 + n0) * 2 + hkv) * 64, 128, min(64, nvalid - n0), oc, lane);
#pragma unroll
        for (int g = 0; g < 4; ++g)
#pragma unroll
            for (int e = 0; e < 8; ++e) tot[g][e] += gate[g][0] * cinv[g] * oc[g][e];
    }
    const int cur = t >> 6;
    int mysel = 0;
    {
        float sc0, sc1;
        { float i0 = 0.f, i1 = 0.f;
#pragma unroll
            for (int g = 0; g < 4; ++g)
#pragma unroll
                for (int d = -1; d <= 3; ++d) { const int n0 = 4 * lane + d, n1 = 4 * (lane + 64) + d;
                    if (n0 >= 0 && n0 < NCMP) i0 += cinv[g] * ps[g * 512 + n0];
                    if (n1 < NCMP) i1 += cinv[g] * ps[g * 512 + n1]; }
            const int j0 = lane, j1 = lane + 64;
            const bool f0 = (j0 == 0) || (j0 == cur) || (j0 == cur - 1), f1 = (j1 == cur) || (j1 == cur - 1);
            sc0 = (j0 <= cur) ? i0 + (f0 ? 1e4f : 0.f) : -1e30f;
            sc1 = (j1 <= cur) ? i1 + (f1 ? 1e4f : 0.f) : -1e30f; }
        for (int r = 0; r < 16; ++r) {
            float v; int idx;
            if (sc0 >= sc1) { v = sc0; idx = lane; } else { v = sc1; idx = lane + 64; }
#pragma unroll
            for (int o = 32; o > 0; o >>= 1) { const float ov = __shfl_xor(v, o); const int oi = __shfl_xor(idx, o); if (ov > v || (ov == v && oi < idx)) { v = ov; idx = oi; } }
            if (idx == lane) sc0 = -3e38f; else if (idx == lane + 64) sc1 = -3e38f;
            if (lane == r) mysel = idx;
        }
    }
#pragma unroll 1
    for (int br = 0; br < 2; ++br) {
        float ms[4], ls[4], os[4][8];
#pragma unroll
        for (int g = 0; g < 4; ++g) { ms[g] = -1e30f; ls[g] = 0.f;
#pragma unroll
            for (int e = 0; e < 8; ++e) os[g][e] = 0.f; }
        const int kcol = (br == 0 ? C_SK : C_WK) + hkv * 64, vcol = (br == 0 ? C_SV : C_WV) + hkv * 64;
        const int lo = br == 0 ? 0 : max(t - 511, 0);
        const int nb = br == 0 ? 16 : (cur - (lo >> 6) + 1);
#pragma unroll 1
        for (int r = 0; r < nb; ++r) {
            int blk;
            if (br == 0) { blk = __shfl(mysel, r); if (blk > cur) continue; } else blk = (lo >> 6) + r;
            const int tok = blk * 64 + lane; const bool valid = tok <= t && tok >= lo;
            float s[4]; qk4(U + ((size_t)b * SEQ + tok) * UC + kcol, qs, s);
            lds_fence();
#pragma unroll
            for (int g = 0; g < 4; ++g) {
                const float sv = valid ? s[g] * 0.125f - slope[g] * (float)(t - tok) : -1e30f;
                const float mx = wave_max(sv), mnew = fmaxf(ms[g], mx), corr = __expf(ms[g] - mnew);
                const float pr = valid ? __expf(sv - mnew) : 0.f;
                ls[g] = ls[g] * corr + wave_sum(pr); ms[g] = mnew;
#pragma unroll
                for (int e = 0; e < 8; ++e) os[g][e] *= corr;
                ps[g * 64 + lane] = pr; }
            lds_fence();
            pv_block(ps, 64, U + ((size_t)b * SEQ + blk * 64) * UC + vcol, UC, 64, os, lane);
        }
#pragma unroll
        for (int g = 0; g < 4; ++g) { const float gsel = br == 0 ? gate[g][1] : gate[g][2]; const float w = ls[g] > 0.f ? gsel / ls[g] : 0.f;
#pragma unroll
            for (int e = 0; e < 8; ++e) tot[g][e] += w * os[g][e]; }
    }
#pragma unroll
    for (int g = 0; g < 4; ++g)
#pragma unroll
        for (int e = 0; e < 8; ++e) { float v = tot[g][e]; v += __shfl_xor(v, 8); v += __shfl_xor(v, 16); v += __shfl_xor(v, 32); tot[g][e] = v; }
    if (lane < 8) { bf16_t* ao = (bf16_t*)(p.ws + WS_AO) + row * DM + 512;
#pragma unroll
        for (int g = 0; g < 4; ++g) { u32x4 o; o.x = pk2(tot[g][0], tot[g][1]); o.y = pk2(tot[g][2], tot[g][3]); o.z = pk2(tot[g][4], tot[g][5]); o.w = pk2(tot[g][6], tot[g][7]);
            *(u32x4*)(ao + (hkv * 4 + g) * 64 + lane * 8) = o; } }
}


namespace nsa {
typedef float f32x16 __attribute__((ext_vector_type(16)));
constexpr int WL_BYTES = 17408;
constexpr float LOG2E = 1.4426950408889634f;
#define NSA_CR(r) (((r) & 3) + 8 * ((r) >> 2))
__device__ __forceinline__ float quad_xor1(float v) { return __int_as_float(__builtin_amdgcn_update_dpp(0, __float_as_int(v), 0xB1, 0xF, 0xF, true)); }
__device__ __forceinline__ float quad_xor2(float v) { return __int_as_float(__builtin_amdgcn_update_dpp(0, __float_as_int(v), 0x4E, 0xF, 0xF, true)); }
__device__ __forceinline__ float hmax(float v) { auto rr = __builtin_amdgcn_permlane32_swap(__float_as_uint(v), __float_as_uint(v), false, false); return fmaxf(__uint_as_float(rr[0]), __uint_as_float(rr[1])); }
__device__ __forceinline__ float hsum(float v) { auto rr = __builtin_amdgcn_permlane32_swap(__float_as_uint(v), __float_as_uint(v), false, false); return __uint_as_float(rr[0]) + __uint_as_float(rr[1]); }
__device__ __forceinline__ unsigned cvtpk(float lo, float hi) { typedef float f2 __attribute__((ext_vector_type(2))); typedef __bf16 b2 __attribute__((ext_vector_type(2))); f2 v = {lo, hi}; b2 r = __builtin_convertvector(v, b2); return __builtin_bit_cast(unsigned, r); }

__device__ __forceinline__ void k_frags(const bf16_t* ktile, bf16x8 (&kf)[4]) {
#pragma unroll
    for (int d0 = 0; d0 < 4; ++d0) kf[d0] = *(const bf16x8*)(ktile + d0 * 512);
}
__device__ __forceinline__ f32x16 qk_ct(const bf16x8 (&kf)[4], const bf16_t* ql, const f32x16& c) {
    bf16x8 q[4];
#pragma unroll
    for (int d0 = 0; d0 < 4; ++d0) q[d0] = *(const bf16x8*)(ql + d0 * 512);
    f32x16 S = __builtin_amdgcn_mfma_f32_32x32x16_bf16(kf[0], q[0], c, 0, 0, 0);
#pragma unroll
    for (int d0 = 1; d0 < 4; ++d0) S = __builtin_amdgcn_mfma_f32_32x32x16_bf16(kf[d0], q[d0], S, 0, 0, 0);
    return S;
}
template <bool MASKED, class VF>
__device__ __forceinline__ void tile_pass1_f(const bf16x8 (&kf)[4], const bf16_t* qf, const f32x16& c1, const VF& valid, const bool (&colon)[2], float (&m)[2], float (&l)[2]) {
#pragma unroll
    for (int ct = 0; ct < 2; ++ct) {
        f32x16 S = qk_ct(kf, qf + ct * 2048, c1);
        float mx = -INFINITY;
#pragma unroll
        for (int r = 0; r < 16; ++r) { if (MASKED) S[r] = valid(ct, r) ? S[r] : -INFINITY; mx = fmaxf(mx, S[r]); }
        mx = hmax(mx);
        const float mn = fmaxf(m[ct], mx); float sum = 0.f;
#pragma unroll
        for (int r = 0; r < 16; ++r) sum += __builtin_amdgcn_exp2f(S[r] - mn);
        if (colon[ct]) { l[ct] = l[ct] * __builtin_amdgcn_exp2f(m[ct] - mn) + sum; m[ct] = mn; }
    }
}
template <bool MASKED, bool HOOK, class VF, class PH>
__device__ __forceinline__ void tile_pass2_p(const bf16x8 (&kf)[4], const bf16_t* qf, const f32x16& crv, const float (&lm)[2], const VF& valid, u32x4 (&pb)[2][2], const PH& ph) {
#pragma unroll
    for (int ct = 0; ct < 2; ++ct) {
        f32x16 c2;
#pragma unroll
        for (int r = 0; r < 16; ++r) c2[r] = crv[r] + lm[ct];
        const f32x16 S = qk_ct(kf, qf + ct * 2048, c2);
        float pr[16];
#pragma unroll
        for (int r = 0; r < 16; ++r) { pr[r] = __builtin_amdgcn_exp2f(S[r]); if (MASKED) pr[r] = valid(ct, r) ? pr[r] : 0.f; }
        if (HOOK) ph(ct, pr);
#pragma unroll
        for (int s = 0; s < 2; ++s) pb[ct][s] = (u32x4){cvtpk(pr[8 * s], pr[8 * s + 1]), cvtpk(pr[8 * s + 2], pr[8 * s + 3]), cvtpk(pr[8 * s + 4], pr[8 * s + 5]), cvtpk(pr[8 * s + 6], pr[8 * s + 7])};
    }
}
template <bool MASKED, class VF>
__device__ __forceinline__ void tile_online_p(const bf16x8 (&kf)[4], const bf16_t* qf, float slope, float base, const bool (&sb)[2], const VF& valid,
                                              float (&mref)[2], bool (&ini)[2], float (&l)[2], f32x16 (&o)[2][2], u32x4 (&pb)[2][2]) {
    f32x16 S[2];
#pragma unroll
    for (int ct = 0; ct < 2; ++ct) {
        const float lm = sb[ct] ? base - mref[ct] : -INFINITY;
        f32x16 c;
#pragma unroll
        for (int r = 0; r < 16; ++r) c[r] = fmaf(slope, (float)NSA_CR(r), lm);
        S[ct] = qk_ct(kf, qf + ct * 2048, c);
    }
    float mx[2]; bool need[2];
#pragma unroll
    for (int ct = 0; ct < 2; ++ct) {
        float m_ = -INFINITY;
#pragma unroll
        for (int r = 0; r < 16; ++r) { if (MASKED) S[ct][r] = valid(ct, r) ? S[ct][r] : -INFINITY; m_ = fmaxf(m_, S[ct][r]); }
        mx[ct] = hmax(m_);
        need[ct] = ini[ct] ? (mx[ct] > 8.f) : (mx[ct] > -INFINITY);
    }
    if (__any(need[0] || need[1])) {
#pragma unroll
        for (int ct = 0; ct < 2; ++ct) {
            const float delta = need[ct] ? mx[ct] : 0.f, f = (need[ct] && ini[ct]) ? __builtin_amdgcn_exp2f(-delta) : 1.f;
            mref[ct] += delta; l[ct] *= f; ini[ct] = ini[ct] || need[ct];
#pragma unroll
            for (int d0 = 0; d0 < 2; ++d0) o[ct][d0] *= f;
#pragma unroll
            for (int r = 0; r < 16; ++r) S[ct][r] -= delta;
        }
    }
#pragma unroll
    for (int ct = 0; ct < 2; ++ct) {
        float pr[16]; float s0 = 0.f, s1 = 0.f;
#pragma unroll
        for (int r = 0; r < 16; r += 2) { pr[r] = __builtin_amdgcn_exp2f(S[ct][r]); pr[r + 1] = __builtin_amdgcn_exp2f(S[ct][r + 1]); s0 += pr[r]; s1 += pr[r + 1]; }
        l[ct] += s0 + s1;
#pragma unroll
        for (int s = 0; s < 2; ++s) pb[ct][s] = (u32x4){cvtpk(pr[8 * s], pr[8 * s + 1]), cvtpk(pr[8 * s + 2], pr[8 * s + 3]), cvtpk(pr[8 * s + 4], pr[8 * s + 5]), cvtpk(pr[8 * s + 6], pr[8 * s + 7])};
    }
}
__device__ __forceinline__ void tile_pass2_v(const bf16x8 (&vf)[2][2], const u32x4 (&pb)[2][2], f32x16 (&o)[2][2]) {
#pragma unroll
    for (int d0 = 0; d0 < 2; ++d0)
#pragma unroll
        for (int s = 0; s < 2; ++s)
#pragma unroll
            for (int ct = 0; ct < 2; ++ct) o[ct][d0] = __builtin_amdgcn_mfma_f32_32x32x16_bf16(vf[d0][s], __builtin_bit_cast(bf16x8, pb[ct][s]), o[ct][d0], 0, 0, 0);
}
__device__ __forceinline__ void v_frags(const bf16_t* vt, bf16x8 (&vf)[2][2]) {
#pragma unroll
    for (int d0 = 0; d0 < 2; ++d0)
#pragma unroll
        for (int s = 0; s < 2; ++s) vf[d0][s] = *(const bf16x8*)(vt + (d0 * 2 + s) * 512);
}
__device__ __forceinline__ void glds16(const void* gsrc, unsigned lds_dst) { unsigned keep;
    asm volatile("s_mov_b32 %0, m0\n\ts_mov_b32 m0, %2\n\ts_nop 0\n\tglobal_load_lds_dwordx4 %1, off\n\ts_mov_b32 m0, %0" : "=&s"(keep) : "v"(gsrc), "s"(lds_dst) : "memory"); }
__device__ __forceinline__ void dma4(const bf16_t* tile, unsigned slot) {
#pragma unroll
    for (int i = 0; i < 4; ++i) glds16(tile + i * 512, slot + i * 1024);
}

struct LaneC { int c32, hi, hc, head, qi0, qi1, tc0, tc1; float slope2; };
__device__ __forceinline__ LaneC lanec(int lane_, int t0, int hkv) {
    int lane = lane_; asm volatile("" : "+v"(lane));
    LaneC L; L.c32 = lane & 31; L.hi = lane >> 5; L.hc = lane & 3; L.head = hkv * 4 + L.hc; L.qi0 = L.c32 >> 2; L.qi1 = 8 + L.qi0; L.tc0 = t0 + L.qi0; L.tc1 = t0 + L.qi1;
    L.slope2 = exp2f(-(float)(L.head + 1)) * LOG2E; return L;
}
__device__ __forceinline__ float gate_of(const bf16_t* U, size_t rowb, int tcol, int head, int which) { return 1.f / (1.f + __expf(-bf2f(U[(rowb + tcol) * UC + C_NG + head * 3 + which]))); }

__device__ __forceinline__ void item(const Params& p, unsigned char* wl, int it, int lane_) {
    const int B_ = it >> 3, w_ = it & 7, x_ = B_ & 7, k_ = (x_ & 1) * 32 + (B_ >> 3), bh = x_ >> 1, qt = (w_ >> 2) ? 511 - (k_ * 4 + (w_ & 3)) : k_ * 4 + (w_ & 3);
    const int b = bh >> 1, hkv = bh & 1, t0 = qt * 16, cur = t0 >> 6;
    const bf16_t* U = (const bf16_t*)(p.ws + WS_U);
    const size_t rowb = (size_t)b * SEQ;
    float* G = (float*)wl; unsigned* selm = (unsigned*)(wl + 16384); unsigned* uni = selm + 64;
    const bf16_t* qf;
    lds_fence();
    {
        const LaneC L = lanec(lane_, t0, hkv);
        bf16_t* ql = (bf16_t*)(wl + 8192) + (lane_ & 63) * 8; qf = ql;
#pragma unroll
        for (int ct = 0; ct < 2; ++ct) {
            const bf16_t* qrow = U + (rowb + (ct ? L.tc1 : L.tc0)) * UC;
#pragma unroll
            for (int d0 = 0; d0 < 4; ++d0) *(bf16x8*)(ql + (ct * 4 + d0) * 512) = *(const bf16x8*)(qrow + C_NQ + L.head * 64 + 16 * d0 + 8 * L.hi);
        }
    }
    f32x16 o[2][2];
#pragma unroll
    for (int ct = 0; ct < 2; ++ct)
#pragma unroll
        for (int d0 = 0; d0 < 2; ++d0) o[ct][d0] = (f32x16){};
    auto nohook = [](int, float*) {};
    lds_fence();
    for (int i = (lane_ & 63); i < 2048; i += 64) ((unsigned*)wl)[i] = 0u;
    for (int i = (lane_ & 63); i < 68; i += 64) selm[i] = 0u;
    lds_fence();
    {
        const LaneC L = lanec(lane_, t0, hkv);
        const int hi = L.hi, c32 = L.c32;
        const bf16_t* KC = (const bf16_t*)(p.ws + WS_KC) + (size_t)(b * 2 + hkv) * 16 * 2048 + (lane_ & 63) * 8;
        const bf16_t* VCt = (const bf16_t*)(p.ws + WS_VC) + (size_t)(b * 2 + hkv) * 16 * 2048 + (lane_ & 63) * 8;
        const int tc[2] = {L.tc0, L.tc1}, qi[2] = {L.qi0, L.qi1};
        int nv[2];
#pragma unroll
        for (int ct = 0; ct < 2; ++ct) nv[ct] = tc[ct] >= 31 ? min((tc[ct] - 31) / 16 + 1, NCMP) : 0;
        const int tl = t0 + 15, nvmax = tl >= 31 ? min((tl - 31) / 16 + 1, NCMP) : 0, ntl = (nvmax + 31) >> 5, nvmin = t0 >= 31 ? min((t0 - 31) / 16 + 1, NCMP) : 0;
        const float sl16 = L.slope2 * 16.f;
        float m[2] = {-30000.f, -30000.f}, l[2] = {0.f, 0.f};
        f32x16 crv;
#pragma unroll
        for (int r = 0; r < 16; ++r) crv[r] = sl16 * (float)NSA_CR(r);
        const bool on2[2] = {true, true};
        bf16x8 kfn[4];
        if (ntl > 0) k_frags(KC, kfn);
#pragma unroll 1
        for (int nt = 0; nt < ntl; ++nt) {
            const int nb = 32 * nt + 4 * hi; const float base = sl16 * (float)nb;
            auto valid = [&](int ct, int r) { return nb + NSA_CR(r) < nv[ct]; };
            bf16x8 kf[4];
#pragma unroll
            for (int d0 = 0; d0 < 4; ++d0) kf[d0] = kfn[d0];
            if (nt + 1 < ntl) k_frags(KC + (nt + 1) * 2048, kfn);
            f32x16 c1;
#pragma unroll
            for (int r = 0; r < 16; ++r) c1[r] = crv[r] + base;
            if (32 * nt + 32 <= nvmin) tile_pass1_f<false>(kf, qf, c1, valid, on2, m, l); else tile_pass1_f<true>(kf, qf, c1, valid, on2, m, l);
        }
        float lmc[2];
#pragma unroll
        for (int ct = 0; ct < 2; ++ct) { const float lt = hsum(l[ct]); lmc[ct] = lt > 0.f ? -__builtin_amdgcn_logf(lt) - m[ct] : -INFINITY; }
        if (ntl > 0) k_frags(KC, kfn);
#pragma unroll 1
        for (int nt = 0; nt < ntl; ++nt) {
            const int nb = 32 * nt + 4 * hi; const float base = sl16 * (float)nb;
            auto valid = [&](int ct, int r) { return nb + NSA_CR(r) < nv[ct]; };
            auto hook = [&](int ct, float* pr) {
#pragma unroll
                for (int k = 0; k < 4; ++k) { float g4 = (pr[4 * k] + pr[4 * k + 1]) + (pr[4 * k + 2] + pr[4 * k + 3]), e = pr[4 * k + 3];
                    g4 += quad_xor1(g4); g4 += quad_xor2(g4); e += quad_xor1(e); e += quad_xor2(e);
                    const int j = 8 * nt + 2 * k + hi;
                    if (L.hc == 0) { atomicAdd(&G[qi[ct] * 128 + j], g4); if (j + 1 < 128) atomicAdd(&G[qi[ct] * 128 + j + 1], e); } } };
            bf16x8 kf[4], vf[2][2];
#pragma unroll
            for (int d0 = 0; d0 < 4; ++d0) kf[d0] = kfn[d0];
            v_frags(VCt + nt * 2048, vf);
            if (nt + 1 < ntl) k_frags(KC + (nt + 1) * 2048, kfn);
            const float lm[2] = {lmc[0] + base, lmc[1] + base};
            u32x4 pb[2][2];
            if (32 * nt + 32 <= nvmin) tile_pass2_p<false, true>(kf, qf, crv, lm, valid, pb, hook); else tile_pass2_p<true, true>(kf, qf, crv, lm, valid, pb, hook);
            tile_pass2_v(vf, pb, o);
        }
        float* AOF = (float*)(p.ws + WS_AOF);
#pragma unroll
        for (int ct = 0; ct < 2; ++ct) { const float gcv = gate_of(U, rowb, tc[ct], L.head, 0); float* orow = AOF + (rowb + tc[ct]) * 512 + L.head * 64 + 4 * hi;
#pragma unroll
            for (int d0 = 0; d0 < 2; ++d0) {
#pragma unroll
                for (int k = 0; k < 4; ++k) *(f32x4*)(orow + 32 * d0 + 8 * k) = (f32x4){o[ct][d0][4 * k] * gcv, o[ct][d0][4 * k + 1] * gcv, o[ct][d0][4 * k + 2] * gcv, o[ct][d0][4 * k + 3] * gcv};
                o[ct][d0] = (f32x16){}; } }
    }
    lds_fence();
    {
        int lane = lane_; asm volatile("" : "+v"(lane));
        unsigned u0 = 0u, u1 = 0u, u2 = 0u, u3 = 0u;
        const int j0 = lane, j1 = lane + 64;
        const bool f0 = (j0 == 0) || (j0 == cur) || (j0 == cur - 1), f1 = (j1 == cur) || (j1 == cur - 1);
        const bool ok0 = j0 <= cur, ok1 = j1 <= cur;
#pragma unroll 1
        for (int q = 0; q < 16; q += 2) {
            unsigned ka0, ka1, kb0, kb1;
            { const float i0 = G[q * 128 + lane], i1 = G[q * 128 + 64 + lane], i2 = G[(q + 1) * 128 + lane], i3 = G[(q + 1) * 128 + 64 + lane];
              ka0 = ok0 ? ((__float_as_uint(i0 + (f0 ? 1e4f : 0.f)) & ~127u) | (unsigned)(127 - j0)) : 0u;
              ka1 = ok1 ? ((__float_as_uint(i1 + (f1 ? 1e4f : 0.f)) & ~127u) | (unsigned)(127 - j1)) : 0u;
              kb0 = ok0 ? ((__float_as_uint(i2 + (f0 ? 1e4f : 0.f)) & ~127u) | (unsigned)(127 - j0)) : 0u;
              kb1 = ok1 ? ((__float_as_uint(i3 + (f1 ? 1e4f : 0.f)) & ~127u) | (unsigned)(127 - j1)) : 0u; }
            unsigned pa = 0u, pb = 0u;
#pragma unroll
            for (int bit = 30; bit >= 0; --bit) {
                const unsigned ca = pa | (1u << bit), cb = pb | (1u << bit);
                const int na = __popcll(__ballot(ka0 >= ca)) + __popcll(__ballot(ka1 >= ca));
                const int nb = __popcll(__ballot(kb0 >= cb)) + __popcll(__ballot(kb1 >= cb));
                pa = na >= 16 ? ca : pa; pb = nb >= 16 ? cb : pb;
            }
            const unsigned long long a0 = __ballot(ok0 && ka0 >= pa), a1 = __ballot(ok1 && ka1 >= pa), b0 = __ballot(ok0 && kb0 >= pb), b1 = __ballot(ok1 && kb1 >= pb);
            if (lane == 0) { selm[q * 4 + 0] = (unsigned)a0; selm[q * 4 + 1] = (unsigned)(a0 >> 32); selm[q * 4 + 2] = (unsigned)a1; selm[q * 4 + 3] = (unsigned)(a1 >> 32);
                selm[q * 4 + 4] = (unsigned)b0; selm[q * 4 + 5] = (unsigned)(b0 >> 32); selm[q * 4 + 6] = (unsigned)b1; selm[q * 4 + 7] = (unsigned)(b1 >> 32); }
            u0 |= (unsigned)a0 | (unsigned)b0; u1 |= (unsigned)(a0 >> 32) | (unsigned)(b0 >> 32); u2 |= (unsigned)a1 | (unsigned)b1; u3 |= (unsigned)(a1 >> 32) | (unsigned)(b1 >> 32);
        }
        if (lane == 0) { uni[0] = u0; uni[1] = u1; uni[2] = u2; uni[3] = u3; }
    }
    lds_fence();
#pragma unroll 1
    for (int br = 0; br < 2; ++br) {
        const LaneC L = lanec(lane_, t0, hkv);
        const int hi = L.hi; const float slope2 = L.slope2;
        const int tc[2] = {L.tc0, L.tc1}, qi[2] = {L.qi0, L.qi1};
        unsigned short* tl = (unsigned short*)(wl + 16896);
        int ntile = 0;
        if (br == 0) {
            const unsigned um0 = __builtin_amdgcn_readfirstlane(uni[0]), um1 = __builtin_amdgcn_readfirstlane(uni[1]), um2 = __builtin_amdgcn_readfirstlane(uni[2]), um3 = __builtin_amdgcn_readfirstlane(uni[3]);
#pragma unroll 1
            for (int j = cur; j >= 0; --j) { const int ws_ = j >> 5; const unsigned uw = ws_ == 0 ? um0 : ws_ == 1 ? um1 : ws_ == 2 ? um2 : um3;
                if ((uw >> (j & 31)) & 1u) { tl[ntile] = (unsigned short)(2 * j); tl[ntile + 1] = (unsigned short)(2 * j + 1); ntile += 2; } }
        } else {
            const int lo_t = (t0 - 511 > 0 ? t0 - 511 : 0) >> 5, hi_t = (t0 + 15) >> 5;
#pragma unroll 1
            for (int kt = hi_t; kt >= lo_t; --kt) { tl[ntile] = (unsigned short)kt; ++ntile; }
        }
        lds_fence();
        const bf16_t* Kb = (const bf16_t*)(p.ws + (br ? WS_KFW : WS_KFS)) + (size_t)(b * 2 + hkv) * 64 * SEQ + (lane_ & 63) * 8;
        static_assert(WS_VFS - WS_KFS == WS_VFW - WS_KFW, "V images sit at one constant distance behind the K images");
        constexpr size_t VOFF = (WS_VFS - WS_KFS) / 2;
        const unsigned slot = (unsigned)__builtin_amdgcn_readfirstlane((unsigned)(uintptr_t)wl);
        const bf16_t* kl = (const bf16_t*)wl + (lane_ & 63) * 8; const bf16_t* vl = (const bf16_t*)(wl + 4096) + (lane_ & 63) * 8;
        float mref[2] = {0.f, 0.f}, l[2] = {0.f, 0.f}; bool ini[2] = {false, false};
        if (ntile > 0) { const int t_ = __builtin_amdgcn_readfirstlane((int)tl[0]); dma4(Kb + (size_t)t_ * 2048, slot); dma4(Kb + (size_t)t_ * 2048 + VOFF, slot + 4096); }
#pragma unroll 1
        for (int idx = 0; idx < ntile; ++idx) {
            const int tile = __builtin_amdgcn_readfirstlane((int)tl[idx]);
            const bool more = idx + 1 < ntile; const int tnext = more ? __builtin_amdgcn_readfirstlane((int)tl[idx + 1]) : 0;
            asm volatile("s_waitcnt vmcnt(4)" ::: "memory");
            bf16x8 kf[4]; k_frags(kl, kf);
            asm volatile("s_waitcnt lgkmcnt(0)" ::: "memory");
            if (more) dma4(Kb + (size_t)tnext * 2048, slot);
            const int tokb = 32 * tile, tb = tokb + 4 * hi; const float base = slope2 * (float)(tb - t0);
            bool sb[2] = {true, true}; bool interior;
            if (br == 0) { const int j = tile >> 1, ws_ = j >> 5, bp = j & 31;
#pragma unroll
                for (int ct = 0; ct < 2; ++ct) sb[ct] = (selm[qi[ct] * 4 + ws_] >> bp) & 1u;
                interior = (j < cur);
            } else interior = (tokb + 31 <= t0 && tokb >= t0 + 15 - 511);
            const int wlo = br ? 511 : (1 << 30);
            auto valid = [&](int ct, int r) { const int tok = tb + NSA_CR(r); return tok <= tc[ct] && tok >= tc[ct] - wlo; };
            u32x4 pb[2][2];
            if (interior) tile_online_p<false>(kf, qf, slope2, base, sb, valid, mref, ini, l, o, pb); else tile_online_p<true>(kf, qf, slope2, base, sb, valid, mref, ini, l, o, pb);
            if (more) asm volatile("s_waitcnt vmcnt(4)" ::: "memory"); else asm volatile("s_waitcnt vmcnt(0)" ::: "memory");
            bf16x8 vf[2][2]; v_frags(vl, vf);
            asm volatile("s_waitcnt lgkmcnt(0)" ::: "memory");
            if (more) dma4(Kb + (size_t)tnext * 2048 + VOFF, slot + 4096);
            tile_pass2_v(vf, pb, o);
        }
        {
            float* AOF = (float*)(p.ws + WS_AOF); bf16_t* AO = (bf16_t*)(p.ws + WS_AO);
#pragma unroll
            for (int ct = 0; ct < 2; ++ct) { const float lt = hsum(l[ct]); const float cw = lt > 0.f ? gate_of(U, rowb, tc[ct], L.head, 1 + br) / lt : 0.f;
                float* frow = AOF + (rowb + tc[ct]) * 512 + L.head * 64 + 4 * hi; bf16_t* orow = AO + (rowb + tc[ct]) * DM + 512 + L.head * 64 + 4 * hi;
#pragma unroll
                for (int d0 = 0; d0 < 2; ++d0) {
#pragma unroll
                    for (int k = 0; k < 4; ++k) { const f32x4 a = *(const f32x4*)(frow + 32 * d0 + 8 * k);
                        const f32x4 v = {a[0] + cw * o[ct][d0][4 * k], a[1] + cw * o[ct][d0][4 * k + 1], a[2] + cw * o[ct][d0][4 * k + 2], a[3] + cw * o[ct][d0][4 * k + 3]};
                        if (br == 0) *(f32x4*)(frow + 32 * d0 + 8 * k) = v;
                        else { u32x2 w2; w2.x = cvtpk(v[0], v[1]); w2.y = cvtpk(v[2], v[3]); *(u32x2*)(orow + 32 * d0 + 8 * k) = w2; } }
                    o[ct][d0] = (f32x16){}; } }
        }
        lds_fence();
    }
}
#undef NSA_CR
}

__device__ __forceinline__ float diff_lambda(const Params& p, int lane) {
    const float a = p.in[9][lane] * p.in[10][lane], c = p.in[11][lane] * p.in[12][lane];
    return __expf(wave_sum(a)) - __expf(wave_sum(c)) + 0.2f;
}
__device__ __forceinline__ void diffc_rows8(const Params& p, int row0, int lane, float lam) {
    const int h = lane >> 4, l16 = lane & 15;
    const bf16_t* oc = (const bf16_t*)(p.ws + WS_OC) + ((size_t)row0 * 4 + h) * 256 + 8 * l16;
    bf16_t* ao = (bf16_t*)(p.ws + WS_AO) + (size_t)row0 * DM + h * 128 + 8 * l16;
    const f32x4 g0 = *(const f32x4*)(p.in[13] + 8 * l16), g1 = *(const f32x4*)(p.in[13] + 8 * l16 + 4);
    const float g[8] = {g0.x * 0.8f, g0.y * 0.8f, g0.z * 0.8f, g0.w * 0.8f, g1.x * 0.8f, g1.y * 0.8f, g1.z * 0.8f, g1.w * 0.8f};
    u32x4 a[8], c[8];
#pragma unroll
    for (int i = 0; i < 8; ++i) { a[i] = *(const u32x4*)(oc + (size_t)i * 1024); c[i] = *(const u32x4*)(oc + (size_t)i * 1024 + 128); }
#pragma unroll
    for (int i = 0; i < 8; ++i) { float x[8], y[8]; unpack8(a[i], x); unpack8(c[i], y); float ss = 0.f;
#pragma unroll
        for (int e = 0; e < 8; ++e) { x[e] -= lam * y[e]; ss += x[e] * x[e]; }
        ss += nsa::quad_xor1(ss); ss += nsa::quad_xor2(ss);
        ss += __int_as_float(__builtin_amdgcn_update_dpp(0, __float_as_int(ss), 0x141, 0xf, 0xf, true));
        ss += __int_as_float(__builtin_amdgcn_update_dpp(0, __float_as_int(ss), 0x140, 0xf, 0xf, true));
        const float rstd = rsqrtf(ss * (1.f / 128.f) + 1e-6f);
        u32x4 o; o.x = pk2(x[0] * rstd * g[0], x[1] * rstd * g[1]); o.y = pk2(x[2] * rstd * g[2], x[3] * rstd * g[3]); o.z = pk2(x[4] * rstd * g[4], x[5] * rstd * g[5]); o.w = pk2(x[6] * rstd * g[6], x[7] * rstd * g[7]);
        *(u32x4*)(ao + (size_t)i * DM) = o; }
}

__device__ __forceinline__ void stage4(const Params& p, unsigned char* smem) {
    const int tid = opaque_tid(), wid = tid >> 6, lane = tid & 63;
    const int gw = blockIdx.x * NW + wid, NGW = gridDim.x * NW;
    for (int it = gw; it < 2048; it += NGW) nsa::item(p, smem + wid * nsa::WL_BYTES, it, lane);
    const float lam = diff_lambda(p, lane);
    for (int it = gw; it < M / 8; it += NGW) diffc_rows8(p, it * 8, lane, lam);
}

__device__ __forceinline__ void stage5(const Params& p, unsigned char* smem) {
    pg8::Gemm g{(const bf16_t*)(p.ws + WS_AO), DM};
    pg8::StaticOrder S; S.init(M, DM, gridDim.x, blockIdx.x, (const bf16_t*)(p.ws + WS_WTOUT));
    EpiBf16Out E{(bf16_t*)(p.ws + WS_MIX), DM, 0, 1.f, nullptr};
    pg8::gemm_phase((PG8_LAS unsigned char*)smem, g, S, E);
}

__device__ __forceinline__ void stage6(const Params& p, unsigned char* smem) {
    int tid_ = threadIdx.x; asm volatile("" : "+v"(tid_));
    const int tid = tid_, wid = tid >> 6, lane = tid & 63;
    const float* mod = (const float*)(p.ws + WS_MOD); const bf16_t* mix = (const bf16_t*)(p.ws + WS_MIX); const f32x4* wrf = (const f32x4*)(p.ws + WS_WR);
    bf16_t* h2 = (bf16_t*)(p.ws + WS_H2); bf16_t* x1b = (bf16_t*)(p.ws + WS_MIX);
    int* cnt = (int*)(p.ws + WS_CTL) + CTL_CNT; int* toke = (int*)(p.ws + WS_TOKE); int* tokp = (int*)(p.ws + WS_TOKP); float* tokw = (float*)(p.ws + WS_TOKW);
    float* hq = (float*)smem;
    float* part = (float*)(smem + 65792);
    float* lgs = (float*)(smem + 65792 + 40960);
    for (int chunk = blockIdx.x; chunk < M / 64; chunk += gridDim.x) {
        const int row0 = chunk * 64, b = row0 / SEQ; const float* mb = mod + b * 6144;
        f32x4 ggt[4], gsc[4], shv[4];
#pragma unroll
        for (int j = 0; j < 4; ++j) { const int col = lane * 4 + 256 * j;
            ggt[j] = *(const f32x4*)(p.in[5] + col) * *(const f32x4*)(mb + 2048 + col);
            gsc[j] = *(const f32x4*)(p.in[6] + col) * (*(const f32x4*)(mb + 4096 + col) + 1.f);
            shv[j] = *(const f32x4*)(mb + 3072 + col); }
        u32x2 pm[2][4]; f32x4 px[2][4];
#define S6_LOAD(T) { _Pragma("unroll") for (int rr = 0; rr < 2; ++rr) { const size_t ro = (size_t)(row0 + 16 * (T) + 2 * wid + rr) * DM + lane * 4; \
            _Pragma("unroll") for (int j = 0; j < 4; ++j) { pm[rr][j] = *(const u32x2*)(mix + ro + 256 * j); px[rr][j] = *(const f32x4*)(p.in[0] + ro + 256 * j); } } }
        S6_LOAD(0)
#pragma unroll 1
        for (int t = 0; t < 4; ++t) {
#pragma unroll
            for (int rr = 0; rr < 2; ++rr) {
                const int lr = 2 * wid + rr, row = row0 + 16 * t + lr;
                f32x4 v[4], x1[4]; float ss = 0.f;
#pragma unroll
                for (int j = 0; j < 4; ++j) { const u32x2 mw = pm[rr][j];
                    v[j] = (f32x4){__uint_as_float(mw.x << 16), __uint_as_float(mw.x & 0xffff0000u), __uint_as_float(mw.y << 16), __uint_as_float(mw.y & 0xffff0000u)};
                    ss += v[j].x * v[j].x + v[j].y * v[j].y + v[j].z * v[j].z + v[j].w * v[j].w; }
                const float rstd = rsqrtf(wave_sum(ss) * (1.f / DM) + 1e-6f); float s2 = 0.f;
#pragma unroll
                for (int j = 0; j < 4; ++j) { const int col = lane * 4 + 256 * j;
                    x1[j] = px[rr][j] + ggt[j] * (v[j] * rstd);
                    { u32x2 xo; xo.x = pk2(x1[j].x, x1[j].y); xo.y = pk2(x1[j].z, x1[j].w); *(u32x2*)(x1b + (size_t)row * DM + col) = xo; }
                    s2 += x1[j].x * x1[j].x + x1[j].y * x1[j].y + x1[j].z * x1[j].z + x1[j].w * x1[j].w; }
                const float rstd2 = rsqrtf(wave_sum(s2) * (1.f / DM) + 1e-6f);
#pragma unroll
                for (int j = 0; j < 4; ++j) { const int col = lane * 4 + 256 * j;
                    const f32x4 h = x1[j] * rstd2 * gsc[j] + shv[j];
                    *(f32x4*)(hq + lr * 1028 + col) = h;
                    u32x2 o; o.x = pk2(h.x, h.y); o.y = pk2(h.z, h.w); *(u32x2*)(h2 + (size_t)row * DM + col) = o; }
            }
            if (t < 3) S6_LOAD(t + 1)
            __syncthreads();
            {
                const int r = lane & 15, q = lane >> 4;
                f32x4 acc[5];
#pragma unroll
                for (int j = 0; j < 5; ++j) acc[j] = (f32x4){0.f, 0.f, 0.f, 0.f};
#pragma unroll 4
                for (int s = 0; s < 8; ++s) {
                    const f32x4 a = *(const f32x4*)(hq + r * 1028 + 128 * wid + 16 * s + 4 * q);
                    f32x4 bv[5];
#pragma unroll
                    for (int j = 0; j < 5; ++j) bv[j] = wrf[((wid * 8 + s) * 5 + j) * 64 + lane];
#pragma unroll
                    for (int i = 0; i < 4; ++i)
#pragma unroll
                        for (int j = 0; j < 5; ++j) acc[j] = __builtin_amdgcn_mfma_f32_16x16x4f32(a[i], bv[j][i], acc[j], 0, 0, 0);
                }
#pragma unroll
                for (int j = 0; j < 5; ++j)
#pragma unroll
                    for (int i = 0; i < 4; ++i) part[(wid * 16 + 4 * q + i) * 80 + 16 * j + r] = acc[j][i];
            }
            __syncthreads();
            for (int idx = tid; idx < 1280; idx += NT) { float s = 0.f;
#pragma unroll
                for (int w = 0; w < 8; ++w) s += part[w * 1280 + idx];
                lgs[t * 1280 + idx] = s; }
        }
#undef S6_LOAD
        __syncthreads();
        if (tid < 64) { const int t = row0 + tid; const float* lg = lgs + tid * 80;
            float best = -3e38f; int grp = 0; float l8[8];
#pragma unroll
            for (int i = 0; i < 8; ++i) { l8[i] = lg[64 + i] + p.in[22][i]; if (l8[i] > best) { best = l8[i]; grp = i; } }
            float den = 0.f;
#pragma unroll
            for (int i = 0; i < 8; ++i) den += __expf(l8[i] - best);
            const float pg = 1.f / den;
            float v1 = -3e38f, v2 = -3e38f; int i1 = 0, i2 = 0;
#pragma unroll
            for (int i = 0; i < 8; ++i) { const float v = lg[grp * 8 + i] + p.in[24][grp * 8 + i];
                if (v > v1) { v2 = v1; i2 = i1; v1 = v; i1 = i; } else if (v > v2) { v2 = v; i2 = i; } }
            const float e2 = __expf(v2 - v1), w1 = pg / (1.f + e2), w2 = pg * e2 / (1.f + e2);
            const int ea = grp * 8 + i1, eb = grp * 8 + i2;
            const int xg = chunk & 7;
            const int pa = atomicAdd(&cnt[(xg * 64 + ea) * 16], 1), pb = atomicAdd(&cnt[(xg * 64 + eb) * 16], 1);
            toke[t * 2] = ea; toke[t * 2 + 1] = eb; tokp[t * 2] = pa; tokp[t * 2 + 1] = pb; tokw[t * 2] = w1; tokw[t * 2 + 1] = w2;
            int* elist = (int*)(p.ws + WS_ELIST); elist[ea * 16384 + xg * 2048 + pa] = t; elist[eb * 16384 + xg * 2048 + pb] = t; }
        __syncthreads();
    }
}

__device__ __forceinline__ void expert_bases(const Params& p, int* lb) {
    const int* cntg = (const int*)(p.ws + WS_CTL) + CTL_CNT; int* cnt = lb + 768;
    __syncthreads();
    if (threadIdx.x < 64) { int s = 0;
        for (int x = 0; x < 8; ++x) { lb[832 + threadIdx.x * 8 + x] = s; s += cntg[(x * 64 + threadIdx.x) * 16]; }
        cnt[threadIdx.x] = s; }
    __syncthreads();
    if (threadIdx.x < 65) { int s = 0; for (int e = 0; e < (int)threadIdx.x; ++e) s += (cnt[e] + 255) / 256 * 256; lb[threadIdx.x] = threadIdx.x < 64 ? s : s / 256; }
    __syncthreads();
    if (threadIdx.x < 192) { const int tile = threadIdx.x; int e = 0;
        for (int i = 0; i < 64; ++i) if (lb[i] <= tile * 256 && cnt[i] > 0) e = i;
        lb[128 + tile] = e; lb[320 + tile] = (tile < lb[64] && (cnt[e] - (tile * 256 - lb[e])) <= 128) ? 1 : 0; }
    __syncthreads();
    if (threadIdx.x < 192) { const int tile = threadIdx.x, nt = lb[64];
        if (tile < nt) { int nfull = 0, fb = 0, hb = 0;
            for (int i = 0; i < nt; ++i) { const int h = lb[320 + i]; nfull += 1 - h; if (i < tile) { fb += 1 - h; hb += h; } }
            lb[512 + (lb[320 + tile] ? nfull + hb : fb)] = tile; } }
    __syncthreads();
}
__device__ __forceinline__ int xcd_major_id() { const int G = gridDim.x, c = blockIdx.x; return (G % 8 == 0) ? (c % 8) * (G / 8) + c / 8 : c; }
struct MoeOrder {
    int ntiles, nN, G, c; const int* lb; const char* wbase; size_t estride; const int* elist; const int* cnt;
    unsigned* sig;
    unsigned* wait;
    __device__ __forceinline__ bool next(int i, pg8::Unit& u) const {
        const int L = i * G + c; if (L >= ntiles * nN) return false;
        u.pm = lb[512 + L / nN]; u.pn = L % nN; const int e = lb[128 + u.pm]; u.bbase = wbase + (size_t)e * estride;
        u.half = lb[320 + u.pm]; return true; }
    __device__ __forceinline__ unsigned arow(const pg8::Unit& u, int r) const {
        if (elist) { const int e = lb[128 + u.pm], off = u.pm * 256 - lb[e] + r;
            if (off >= lb[768 + e]) return 0u;
            int x = 0;
#pragma unroll
            for (int i = 1; i < 8; ++i) x += (off >= lb[832 + e * 8 + i]) ? 1 : 0;
            return (unsigned)elist[e * 16384 + x * 2048 + (off - lb[832 + e * 8 + x])]; }
        return (unsigned)(u.pm * 256 + r); }
    __device__ __forceinline__ void a_ready(const pg8::Unit& u) const {
        if (!wait) return;
        unsigned sp = 0;
        while (__hip_atomic_load(wait + u.pm, __ATOMIC_RELAXED, __HIP_MEMORY_SCOPE_AGENT) < 4u) { __builtin_amdgcn_s_sleep(2); if (++sp > (1u << 22)) break; }
        __builtin_amdgcn_fence(__ATOMIC_ACQUIRE, "agent");
    }
    __device__ __forceinline__ void done(const pg8::Unit& u) const {
        if (!sig) return;
        asm volatile("s_waitcnt vmcnt(0)" ::: "memory");
        __builtin_amdgcn_s_barrier();
        if (threadIdx.x == 0) { __builtin_amdgcn_fence(__ATOMIC_RELEASE, "agent"); asm volatile("s_waitcnt vmcnt(0)" ::: "memory");
            (void)__hip_atomic_fetch_add(sig + u.pm, 1u, __ATOMIC_RELAXED, __HIP_MEMORY_SCOPE_AGENT); }
    }
};

struct EpiGateUp {
    static constexpr bool PERM = true;
    bf16_t* O;
    __device__ __forceinline__ void operator()(const f32x4 (&acc)[2][2][4][2], const pg8::Unit& u, int wr, int wc, int fr, int fq) const {
        const int row0 = u.pm * 256 + wr * 64 + fr, col0 = (u.pn * 256 + wc * 32 + 8 * fq) / 2;
#pragma unroll
        for (int ai = 0; ai < 2; ++ai) { if (ai == 1 && u.half) break;
#pragma unroll
            for (int m = 0; m < 4; ++m) { bf16_t* rowp = O + (size_t)(row0 + ai * 128 + m * 16) * 512 + col0;
#pragma unroll
                for (int bj = 0; bj < 2; ++bj) { const f32x4 v0 = acc[ai][bj][m][0], v1 = acc[ai][bj][m][1];
                    u32x2 w; w.x = pg8::cvt_pk_bf16(silu_f(v0[0]) * v0[1], silu_f(v0[2]) * v0[3]); w.y = pg8::cvt_pk_bf16(silu_f(v1[0]) * v1[1], silu_f(v1[2]) * v1[3]);
                    *(u32x2*)(rowp + bj * 64) = w; } } }
    }
};
__device__ __forceinline__ void stage10(const Params& p, unsigned char* smem) {
    int* lb = (int*)(smem + 131072); expert_bases(p, lb);
    pg8::Gemm g{(const bf16_t*)(p.ws + WS_H2), DM};
    MoeOrder S{lb[64], 4, (int)gridDim.x, xcd_major_id(), lb, (const char*)(p.ws + WS_WTGU), (size_t)1024 * 1024 * 2, (const int*)(p.ws + WS_ELIST), (const int*)(p.ws + WS_CTL), nullptr, nullptr};
    EpiGateUp E{(bf16_t*)(p.ws + WS_HID)};
    pg8::gemm_phase((PG8_LAS unsigned char*)smem, g, S, E);
}

__device__ __forceinline__ void stage11(const Params& p, unsigned char* smem) {
    int* lb = (int*)(smem + 131072); expert_bases(p, lb);
    pg8::Gemm g{(const bf16_t*)(p.ws + WS_HID), 512};
    MoeOrder S{lb[64], 4, (int)gridDim.x, xcd_major_id(), lb, (const char*)(p.ws + WS_WTDN), (size_t)1024 * 512 * 2, nullptr, (const int*)(p.ws + WS_CTL), nullptr, nullptr};
    EpiBf16Out E{(bf16_t*)(p.ws + WS_Y), DM, 0, 1.f, nullptr};
    pg8::gemm_phase((PG8_LAS unsigned char*)smem, g, S, E);
}

__device__ __forceinline__ void stage12(const Params& p, unsigned char* smem) {
    int* lb = (int*)(smem + 131072); expert_bases(p, lb);
    const int tid = opaque_tid(), wid = tid >> 6, lane = tid & 63;
    const float* mod = (const float*)(p.ws + WS_MOD); const bf16_t* Y = (const bf16_t*)(p.ws + WS_Y); const bf16_t* X1 = (const bf16_t*)(p.ws + WS_MIX);
    const int* toke = (const int*)(p.ws + WS_TOKE); const int* tokp = (const int*)(p.ws + WS_TOKP); const float* tokw = (const float*)(p.ws + WS_TOKW);
    for (int rg = blockIdx.x * NW + wid; rg < M / 8; rg += gridDim.x * NW) {
        const int rowb = rg * 8, b = rowb / SEQ, xg = (rowb >> 6) & 7;
        int yr = 0; float tw = 0.f;
        if (lane < 16) { const int te = toke[rowb * 2 + lane]; yr = lb[te] + lb[832 + te * 8 + xg] + tokp[rowb * 2 + lane]; tw = tokw[rowb * 2 + lane]; }
        f32x4 ggt[2][2];
#pragma unroll
        for (int j = 0; j < 2; ++j)
#pragma unroll
            for (int h = 0; h < 2; ++h) { const int col = lane * 8 + 512 * j + 4 * h; ggt[j][h] = *(const f32x4*)(p.in[7] + col) * *(const f32x4*)(mod + b * 6144 + 5120 + col); }
        u32x4 ya[2][2], yb[2][2], xv[2][2];
#define S12_LOAD(I, BF) { const int r0 = __builtin_amdgcn_readlane(yr, 2 * (I)), r1 = __builtin_amdgcn_readlane(yr, 2 * (I) + 1); \
            _Pragma("unroll") for (int j = 0; j < 2; ++j) { const int col = lane * 8 + 512 * j; \
                ya[BF][j] = *(const u32x4*)(Y + (size_t)r0 * DM + col); yb[BF][j] = *(const u32x4*)(Y + (size_t)r1 * DM + col); \
                xv[BF][j] = *(const u32x4*)(X1 + (size_t)(rowb + (I)) * DM + col); } }
        S12_LOAD(0, 0)
#pragma unroll
        for (int i = 0; i < 8; ++i) {
            if (i + 1 < 8) { if ((i + 1) & 1) S12_LOAD(i + 1, 1) else S12_LOAD(i + 1, 0) }
            const float w0 = __int_as_float(__builtin_amdgcn_readlane(__float_as_int(tw), 2 * i)), w1 = __int_as_float(__builtin_amdgcn_readlane(__float_as_int(tw), 2 * i + 1));
            float f[2][8], xf[2][8]; float ss = 0.f;
#pragma unroll
            for (int j = 0; j < 2; ++j) { float a[8], c[8]; unpack8(ya[i & 1][j], a); unpack8(yb[i & 1][j], c); unpack8(xv[i & 1][j], xf[j]);
#pragma unroll
                for (int e = 0; e < 8; ++e) { f[j][e] = a[e] * w0 + c[e] * w1; ss += f[j][e] * f[j][e]; } }
            const float rstd = rsqrtf(wave_sum(ss) * (1.f / DM) + 1e-6f);
#pragma unroll
            for (int j = 0; j < 2; ++j)
#pragma unroll
                for (int h = 0; h < 2; ++h) { const int col = lane * 8 + 512 * j + 4 * h;
                    const f32x4 fv = {f[j][4 * h], f[j][4 * h + 1], f[j][4 * h + 2], f[j][4 * h + 3]};
                    const f32x4 xq = {xf[j][4 * h], xf[j][4 * h + 1], xf[j][4 * h + 2], xf[j][4 * h + 3]};
                    *(f32x4*)(p.out + (size_t)(rowb + i) * DM + col) = xq + ggt[j][h] * (fv * rstd); }
        }
#undef S12_LOAD
    }
}

#define GAS __attribute__((address_space(1)))
#define LAS __attribute__((address_space(3)))
#define XB_TMO      128
#define XB_XCNT(j)  (256  + 64 * (j))
#define XB_XSUB(j)  (1280 + 64 * (j))
#define XB_XGEN(j)  (2304 + 64 * (j))
#define XB_TOP      3328
#define XB_TOPGEN   3392
#define XCD_BAR_WORDS 3456
#define XB_SPIN_CAP (1u << 18)
__device__ __forceinline__ unsigned xb_ld(unsigned* p)              { return __hip_atomic_load(p, __ATOMIC_RELAXED, __HIP_MEMORY_SCOPE_AGENT); }
__device__ __forceinline__ unsigned xb_add(unsigned* p, unsigned v) { return __hip_atomic_fetch_add(p, v, __ATOMIC_RELAXED, __HIP_MEMORY_SCOPE_AGENT); }
__device__ __forceinline__ unsigned xb_xcc_id() { return (unsigned)__builtin_amdgcn_s_getreg((3 << 11) | 20) & 0xFu; }
#define XB_SPIN(cond, bar) do { unsigned _sp = 0; while (cond) { __builtin_amdgcn_s_sleep(1); \
    if ((++_sp & 255u) == 0u) { if (xb_ld(&(bar)[XB_TMO])) break; if (_sp > XB_SPIN_CAP) { atomicAdd(&(bar)[XB_TMO], 1u); break; } } } } while (0)
struct XcdBarrier { unsigned* bar; unsigned x; volatile LAS unsigned* st; };
__device__ __forceinline__ XcdBarrier xcd_barrier_post(unsigned* bar, volatile LAS unsigned* st) {
    XcdBarrier b; b.bar = bar; b.x = xb_xcc_id(); b.st = st;
    if (threadIdx.x == 0) (void)xb_add(&bar[XB_XCNT(b.x)], 1u);
    return b;
}
__device__ __forceinline__ void xcd_barrier_complete(unsigned* bar, unsigned x, unsigned& nloc, unsigned& nx) {
    const unsigned G = gridDim.x * gridDim.y * gridDim.z;
    unsigned sum, cnt, mine, sp = 0u;
    for (;;) {
        sum = 0u; cnt = 0u; mine = 0u;
#pragma unroll
        for (unsigned j = 0; j < 16; ++j) { const unsigned c = xb_ld(&bar[XB_XCNT(j)]); sum += c; cnt += (c > 0u) ? 1u : 0u; mine = (j == x) ? c : mine; }
        if (sum == G) break;
        __builtin_amdgcn_s_sleep(1);
        if ((++sp & 255u) == 0u) { if (xb_ld(&bar[XB_TMO])) break; if (sp > XB_SPIN_CAP) { atomicAdd(&bar[XB_TMO], 1u); break; } }
    }
    nloc = mine > 0u ? mine : 1u; nx = cnt > 0u ? cnt : 1u;
}
__device__ __forceinline__ void xcd_barrier(const XcdBarrier& b) {
    asm volatile("s_waitcnt vmcnt(0)" ::: "memory");
    __syncthreads();
    if (threadIdx.x == 0) {
        unsigned* bar = b.bar;
        __builtin_amdgcn_s_waitcnt(0);
        unsigned nloc = b.st[0], nx = b.st[1];
        if (nloc == 0u) { xcd_barrier_complete(bar, b.x, nloc, nx); b.st[0] = nloc; b.st[1] = nx; }
        const unsigned old = xb_add(&bar[XB_XSUB(b.x)], 1u);
        const unsigned gen = old / nloc;
        if (old + 1u == (gen + 1u) * nloc) {
            __builtin_amdgcn_fence(__ATOMIC_RELEASE, "agent");
            asm volatile("s_waitcnt vmcnt(0)" ::: "memory");
            const unsigned og = xb_add(&bar[XB_TOP], 1u);
            const unsigned tg = og / nx;
            if (og + 1u == (tg + 1u) * nx) xb_add(&bar[XB_TOPGEN], 1u);
            else XB_SPIN(xb_ld(&bar[XB_TOPGEN]) == tg, bar);
            __builtin_amdgcn_fence(__ATOMIC_ACQUIRE, "agent");
            xb_add(&bar[XB_XGEN(b.x)], 1u);
            asm volatile("s_waitcnt vmcnt(0)" ::: "memory");
        } else {
            XB_SPIN(xb_ld(&bar[XB_XGEN(b.x)]) == gen, bar);
            __builtin_amdgcn_fence(__ATOMIC_ACQUIRE, "agent");
            asm volatile("s_waitcnt vmcnt(0)" ::: "memory");
        }
    }
    __syncthreads();
}

__device__ __forceinline__ void ctr_barrier(unsigned* base, unsigned epoch) {
    asm volatile("s_waitcnt vmcnt(0)" ::: "memory");
    __syncthreads();
    if (threadIdx.x == 0) {
        __builtin_amdgcn_fence(__ATOMIC_RELEASE, "agent");
        asm volatile("s_waitcnt vmcnt(0)" ::: "memory");
        const unsigned G = gridDim.x, ngrp = (G % 8u == 0u) ? 8u : 1u, g = blockIdx.x % ngrp, per = G / ngrp;
        unsigned* sub = base + 64u * g; unsigned* gen = base + 64u * (8u + g); unsigned* top = base + 64u * 16u;
        const unsigned old = __hip_atomic_fetch_add(sub, 1u, __ATOMIC_RELAXED, __HIP_MEMORY_SCOPE_AGENT);
        if (old + 1u == epoch * per) {
            const unsigned ot = __hip_atomic_fetch_add(top, 1u, __ATOMIC_RELAXED, __HIP_MEMORY_SCOPE_AGENT);
            if (ot + 1u == epoch * ngrp) { for (unsigned j = 0; j < ngrp; ++j) __hip_atomic_store(base + 64u * (8u + j), epoch, __ATOMIC_RELAXED, __HIP_MEMORY_SCOPE_AGENT); }
        }
        unsigned sp = 0;
        while (__hip_atomic_load(gen, __ATOMIC_RELAXED, __HIP_MEMORY_SCOPE_AGENT) < epoch) { __builtin_amdgcn_s_sleep(1); if (++sp > (1u << 22)) break; }
        __builtin_amdgcn_fence(__ATOMIC_ACQUIRE, "agent");
        asm volatile("s_waitcnt vmcnt(0)" ::: "memory");
    }
    __syncthreads();
}
constexpr int NSTAGE = 13;
template <int S> __device__ __forceinline__ void run_stage(const Params& p, unsigned char* smem) {
    if constexpr (S == 0) stage0(p, smem);
    else if constexpr (S == 1) stage1(p);
    else if constexpr (S == 2) stage2(p, smem);
    else if constexpr (S == 3) stage3(p, smem);
    else if constexpr (S == 4) stage4(p, smem);
    else if constexpr (S == 5) stage5(p, smem);
    else if constexpr (S == 6) stage6(p, smem);
    else if constexpr (S == 10) stage10(p, smem);
    else if constexpr (S == 11) stage11(p, smem);
    else if constexpr (S == 12) stage12(p, smem);
}
typedef const __attribute__((address_space(4))) Params* KParams;
template <int S> __device__ __forceinline__ void run_stage_k(unsigned char* smem) {
    KParams kp = (KParams)__builtin_amdgcn_kernarg_segment_ptr();
    asm volatile("" : "+s"(kp));
    Params lp;
#pragma unroll
    for (int i = 0; i < 28; ++i) lp.in[i] = kp->in[i];
    lp.out = kp->out; lp.ws = kp->ws;
    run_stage<S>(lp, smem);
}
#if MK_FUSED
constexpr int CTL_BAR_WORD = 4096;
constexpr int CTL_ZERO_BYTES = 65536 + 49152;
__global__ void __launch_bounds__(NT, 2) mk(Params p) {
    extern __shared__ __attribute__((aligned(16))) unsigned char smem[];
#define CTR() ((unsigned*)(((KParams)__builtin_amdgcn_kernarg_segment_ptr())->ws + WS_CTL) + CTL_BAR_WORD)
    run_stage_k<0>(smem); ctr_barrier(CTR(), 1u);
    run_stage_k<1>(smem); ctr_barrier(CTR(), 2u);
    run_stage_k<2>(smem); ctr_barrier(CTR(), 3u);
    run_stage_k<3>(smem); ctr_barrier(CTR(), 4u);
    run_stage_k<4>(smem); ctr_barrier(CTR(), 5u);
    run_stage_k<5>(smem); ctr_barrier(CTR(), 6u);
    run_stage_k<6>(smem); ctr_barrier(CTR(), 7u);
    run_stage_k<10>(smem); ctr_barrier(CTR(), 8u);
    run_stage_k<11>(smem); ctr_barrier(CTR(), 9u);
    run_stage_k<12>(smem);
#undef CTR
}
#else
template <int S> __global__ void __launch_bounds__(NT, 2) mk1(Params p) {
    extern __shared__ __attribute__((aligned(16))) unsigned char smem[];
    run_stage<S>(p, smem);
}
template <int S> static void launch_stage(const Params& p, int cus, hipStream_t stream) {
    static int grid = 0;
    if (grid == 0) { int per_cu = 0;
        (void)hipFuncSetAttribute((const void*)mk1<S>, hipFuncAttributeMaxDynamicSharedMemorySize, LDS_BYTES);
        (void)hipOccupancyMaxActiveBlocksPerMultiprocessor(&per_cu, (const void*)mk1<S>, NT, LDS_BYTES);
        if (per_cu < 1) per_cu = 1;
        grid = cus * per_cu; (void)hipGetLastError(); }
    hipLaunchKernelGGL(mk1<S>, dim3(grid), dim3(NT), LDS_BYTES, stream, p);
}
#endif

extern "C" void kernel_launch(void* const* d_in, const int* in_sizes, int n_in, void* d_out, int out_size, void* d_ws, size_t ws_size, hipStream_t stream) {
    static int grid = 0, cus = 0;
    if (grid == 0) {
        if (n_in != 28 || out_size != M * DM || ws_size < WS_END) { fprintf(stderr, "kernel_launch: unexpected shapes (n_in %d out %d ws %zu)\n", n_in, out_size, ws_size); grid = -1; return; }
        int dev = 0;
        (void)hipGetDevice(&dev); (void)hipDeviceGetAttribute(&cus, hipDeviceAttributeMultiprocessorCount, dev);
        grid = cus;
#if MK_FUSED
        int per_cu = 0;
        (void)hipFuncSetAttribute((const void*)mk, hipFuncAttributeMaxDynamicSharedMemorySize, LDS_BYTES);
        (void)hipOccupancyMaxActiveBlocksPerMultiprocessor(&per_cu, (const void*)mk, NT, LDS_BYTES);
        if (per_cu < 1) fprintf(stderr, "kernel_launch: occupancy query reports %d workgroups per CU\n", per_cu);
        grid = cus;
#endif
        (void)hipGetLastError();
    }
    if (grid < 0) return;
    Params p{};
    for (int i = 0; i < 28; ++i) p.in[i] = (const float*)d_in[i];
    p.out = (float*)d_out; p.ws = (unsigned char*)d_ws;
#if MK_FUSED
    (void)hipMemsetAsync((char*)d_ws + WS_CTL, 0, CTL_ZERO_BYTES, stream);
    hipLaunchKernelGGL(mk, dim3(grid), dim3(NT), LDS_BYTES, stream, p);
#else
    (void)hipMemsetAsync((char*)d_ws + WS_CTL, 0, 65536 + 49152, stream);
    launch_stage<0>(p, cus, stream); launch_stage<1>(p, cus, stream); launch_stage<2>(p, cus, stream); launch_stage<3>(p, cus, stream);
    launch_stage<4>(p, cus, stream); launch_stage<5>(p, cus, stream); launch_stage<6>(p, cus, stream);
    launch_stage<10>(p, cus, stream); launch_stage<11>(p, cus, stream);
    launch_stage<12>(p, cus, stream);
#endif
}
```

```cpp
#include <hip/hip_runtime.h>
#include <hip/hip_cooperative_groups.h>
#include <cstdio>
#include <cstdint>
namespace cg = cooperative_groups;

#ifndef MK_FUSED
#define MK_FUSED 1
#endif

typedef unsigned short bf16_t;
typedef short bf16x8 __attribute__((ext_vector_type(8)));
typedef float f32x4 __attribute__((ext_vector_type(4)));
typedef unsigned u32x4 __attribute__((ext_vector_type(4)));
typedef unsigned u32x2 __attribute__((ext_vector_type(2)));

constexpr int NT = 512, NW = 8;
constexpr int BATCH = 2, SEQ = 8192, DM = 1024, M = BATCH * SEQ;
constexpr int UC = 3072, IN_COLS = 2840;
constexpr int C_DQ = 0, C_DK = 512, C_DV = 1024, C_NQ = 1536, C_CK = 2048, C_CV = 2176, C_SK = 2304, C_SV = 2432, C_WK = 2560, C_WV = 2688, C_NG = 2816;
constexpr int NEXP = 64, RMAX = 49152, NCMP = 511;
constexpr int LDS_BYTES = 147456;

constexpr size_t MiB = 1u << 20;
constexpr size_t WS_CTL = 0;
constexpr size_t WS_MOD = 65536;
constexpr size_t WS_KC = 2 * MiB;
constexpr size_t WS_VC = 3 * MiB;
constexpr size_t WS_ELIST = 4 * MiB;
constexpr size_t WS_TOKE = 10 * MiB;
constexpr size_t WS_TOKP = WS_TOKE + 128 * 1024;
constexpr size_t WS_TOKW = WS_TOKP + 128 * 1024;
constexpr size_t WS_TOKR = WS_TOKW + 128 * 1024;
constexpr size_t WS_ROWT = 11 * MiB;
constexpr size_t WS_WR = 14 * MiB;
constexpr size_t WS_W1T = 14 * MiB + 512 * 1024;
constexpr size_t WS_W2T = 15 * MiB + 512 * 1024;
constexpr int CTL_NORM = 384;
constexpr int CTL_CNT = 8192;
constexpr int CTL_TREADY = 1024;
constexpr int CTL_TQ = 320;
constexpr int CTL_QHEAD = 448;
constexpr size_t WS_B1P = 15 * MiB + 768 * 1024;
constexpr size_t WS_WTIN = 16 * MiB;
constexpr size_t WS_WTOUT = 22 * MiB;
constexpr size_t WS_WTGU = 24 * MiB;
constexpr size_t WS_WTDN = 152 * MiB;
constexpr size_t WS_XN = 216 * MiB;
constexpr size_t WS_U = 248 * MiB;
constexpr size_t WS_OC = 344 * MiB;
constexpr size_t WS_AO = 408 * MiB;
constexpr size_t WS_MIX = 440 * MiB;
constexpr size_t WS_KFS = 440 * MiB, WS_KFW = 444 * MiB, WS_VFS = 448 * MiB, WS_VFW = 452 * MiB;
constexpr size_t WS_AOF = 456 * MiB;
constexpr size_t WS_H2 = WS_XN;
constexpr size_t WS_H2F = WS_OC;
constexpr size_t WS_HID = WS_U;
constexpr size_t WS_Y = 296 * MiB;
constexpr size_t WS_END = 504 * MiB;

struct Params { const float* in[28]; float* out; unsigned char* ws; };

__device__ __forceinline__ int opaque_tid() { int t = threadIdx.x; asm volatile("" : "+v"(t)); return t; }
__device__ __forceinline__ float bf2f(bf16_t v) { return __uint_as_float(((unsigned)v) << 16); }
__device__ __forceinline__ bf16_t f2bf(float f) { unsigned u = __float_as_uint(f); return (bf16_t)((u + 0x7fffu + ((u >> 16) & 1u)) >> 16); }
__device__ __forceinline__ unsigned pk2(float lo, float hi) { return (unsigned)f2bf(lo) | ((unsigned)f2bf(hi) << 16); }
__device__ __forceinline__ float wave_sum(float v) {
    v += __int_as_float(__builtin_amdgcn_update_dpp(0, __float_as_int(v), 0xB1, 0xF, 0xF, true));
    v += __int_as_float(__builtin_amdgcn_update_dpp(0, __float_as_int(v), 0x4E, 0xF, 0xF, true));
    v += __int_as_float(__builtin_amdgcn_update_dpp(0, __float_as_int(v), 0x141, 0xF, 0xF, true));
    v += __int_as_float(__builtin_amdgcn_update_dpp(0, __float_as_int(v), 0x140, 0xF, 0xF, true));
    const float r0 = __int_as_float(__builtin_amdgcn_readlane(__float_as_int(v), 0)), r1 = __int_as_float(__builtin_amdgcn_readlane(__float_as_int(v), 16));
    const float r2 = __int_as_float(__builtin_amdgcn_readlane(__float_as_int(v), 32)), r3 = __int_as_float(__builtin_amdgcn_readlane(__float_as_int(v), 48));
    return (r0 + r1) + (r2 + r3);
}
__device__ __forceinline__ float wave_max(float v) {
#pragma unroll
    for (int o = 32; o > 0; o >>= 1) v = fmaxf(v, __shfl_xor(v, o));
    return v;
}
__device__ __forceinline__ void lds_fence() { asm volatile("s_waitcnt lgkmcnt(0)" ::: "memory"); }
__device__ __forceinline__ float silu_f(float x) { return x / (1.f + __expf(-x)); }
__device__ __forceinline__ float gelu_tanh(float x) { return 0.5f * x * (1.f + tanhf(0.7978845608028654f * (x + 0.044715f * x * x * x))); }
__device__ __forceinline__ void unpack8(const u32x4 w, float* v) {
    v[0] = __uint_as_float(w.x << 16); v[1] = __uint_as_float(w.x & 0xffff0000u);
    v[2] = __uint_as_float(w.y << 16); v[3] = __uint_as_float(w.y & 0xffff0000u);
    v[4] = __uint_as_float(w.z << 16); v[5] = __uint_as_float(w.z & 0xffff0000u);
    v[6] = __uint_as_float(w.w << 16); v[7] = __uint_as_float(w.w & 0xffff0000u);
}

template <class AF, class Epi>
__device__ __forceinline__ void gemm128(const AF& arow, const bf16_t* Bt, int K, const Epi& epi) {
    const int tid = threadIdx.x, wid = tid >> 6, lane = tid & 63, fr = lane & 15, fq = lane >> 4, wr = wid >> 2, wc = wid & 3;
    const bf16_t* ap[4]; const bf16_t* bp[2];
#pragma unroll
    for (int m = 0; m < 4; ++m) ap[m] = arow(wr * 64 + m * 16 + fr) + fq * 8;
#pragma unroll
    for (int n = 0; n < 2; ++n) bp[n] = Bt + (size_t)(wc * 32 + n * 16 + fr) * K + fq * 8;
    f32x4 acc[4][2];
#pragma unroll
    for (int m = 0; m < 4; ++m)
#pragma unroll
        for (int n = 0; n < 2; ++n) acc[m][n] = (f32x4){0.f, 0.f, 0.f, 0.f};
#pragma unroll 2
    for (int k0 = 0; k0 < K; k0 += 32) {
        bf16x8 a[4], b[2];
#pragma unroll
        for (int m = 0; m < 4; ++m) a[m] = *(const bf16x8*)(ap[m] + k0);
#pragma unroll
        for (int n = 0; n < 2; ++n) b[n] = *(const bf16x8*)(bp[n] + k0);
#pragma unroll
        for (int m = 0; m < 4; ++m)
#pragma unroll
            for (int n = 0; n < 2; ++n) acc[m][n] = __builtin_amdgcn_mfma_f32_16x16x32_bf16(b[n], a[m], acc[m][n], 0, 0, 0);
    }
#pragma unroll
    for (int m = 0; m < 4; ++m)
#pragma unroll
        for (int n = 0; n < 2; ++n) epi(wr * 64 + m * 16 + fr, wc * 32 + n * 16 + fq * 4, acc[m][n]);
}


namespace pg8 {
#define PG8_LAS __attribute__((address_space(3)))
constexpr int BM = 256, BK = 64, HALF = 128, HTB = HALF * BK * 2, STAGE_BYTES = 8 * HTB, NXCD = 8, WGM = 8;
__host__ __device__ __forceinline__ int lds_byte(int r, int c) { const int st = (r >> 4) * 2 + (c >> 5), rr = r & 15, cc = c & 31, ob = rr * 64 + cc * 2; return st * 1024 + (ob ^ (((ob >> 9) & 1) << 5)); }
__host__ __device__ __forceinline__ void stage_rc(int b, int& R, int& C) { const int st = b / 1024, sb = b % 1024, swz = sb ^ (((sb >> 9) & 1) << 5); R = (st >> 1) * 16 + swz / 64; C = (st & 1) * 32 + (swz % 64) / 2; }
__host__ __device__ __forceinline__ int perm32(int rho) { const int n = rho >> 4, i = rho & 15; return 8 * (i >> 2) + 4 * n + (i & 3); }

struct Unit { int pm, pn; const char* bbase; int half; };
struct Gemm { const bf16_t* A; int K; };

struct StaticOrder {
    int nM, nN, nwg, G, c; const char* bt;
    __device__ void init(int Mr, int N, int G_, int c_, const bf16_t* Bt) { nM = Mr / BM; nN = N / BM; nwg = nM * nN; G = G_; c = c_; bt = (const char*)Bt; }
    __device__ bool next(int i, Unit& u) const {
        const long L = (long)i * G + c; if (L >= nwg) return false;
        int wgid = (int)L; { const int q = nwg / NXCD, r = nwg % NXCD, xcd = wgid % NXCD, off = wgid / NXCD; wgid = (xcd < r ? xcd * (q + 1) : r * (q + 1) + (xcd - r) * q) + off; }
        const int nig = WGM * nN, gid = wgid / nig, fm = gid * WGM, gsz = (nM - fm) < WGM ? (nM - fm) : WGM;
        u.pm = fm + ((wgid % nig) % gsz); u.pn = (wgid % nig) / gsz; u.bbase = bt; u.half = 0; return true;
    }
    __device__ __forceinline__ unsigned arow(const Unit& u, int r) const { return (unsigned)(u.pm * BM + r); }
    __device__ __forceinline__ void a_ready(const Unit&) const {}
    __device__ __forceinline__ void done(const Unit&) const {}
};

__device__ __forceinline__ unsigned cvt_pk_bf16(float lo, float hi) { unsigned r; asm volatile("v_cvt_pk_bf16_f32 %0, %1, %2" : "=v"(r) : "v"(lo), "v"(hi)); return r; }

template <class Epi, class Sched>
__device__ __forceinline__ void gemm_phase(PG8_LAS unsigned char* lds, const Gemm g, const Sched& S, const Epi& E) {
    int tid_ = threadIdx.x; asm volatile("" : "+v"(tid_));
    const int tid = tid_, wid = __builtin_amdgcn_readfirstlane(tid >> 6), lane = tid & 63, wr = wid >> 2, wc = wid & 3, fr = lane & 15, fq = lane >> 4;
    const int K = g.K, nt = K / BK;
    int RA[2], CA[2]; unsigned voffB[2];
#pragma unroll
    for (int i = 0; i < 2; ++i) { int R, C; stage_rc(tid * 16 + i * 8192, R, C); const int Rb = Epi::PERM ? ((R & ~31) + perm32(R & 31)) : R;
        RA[i] = R; CA[i] = C; voffB[i] = (unsigned)(Rb * K + C) * 2u; }
    const size_t kstep = (size_t)(BK * 2);
    const size_t hstep = (size_t)HALF * K * 2;
    const size_t tstep = 2 * hstep;
    const unsigned ldsw = (unsigned)wid * 1024u;
    const int aoff = lds_byte(wr * 64 + fr, fq * 8), boff = lds_byte(wc * 32 + fr, fq * 8);
    const char* Abase = (const char*)g.A;
#define PG8_SA(b, h) (((b) * 2 + (h)) * HTB)
#define PG8_SB(b, h) ((4 + (b) * 2 + (h)) * HTB)
#define PG8_STAGE(bufoff, gbase, voff) do { _Pragma("unroll") for (int _i = 0; _i < 2; ++_i) \
        __builtin_amdgcn_global_load_lds((const unsigned*)((const char*)(gbase) + (voff)[_i]), (PG8_LAS unsigned*)(lds + (bufoff) + ldsw + _i * 8192), 16, 0, 0); } while (0)
#define PG8_LDA(dst, b, h) do { _Pragma("unroll") for (int m = 0; m < 4; ++m) _Pragma("unroll") for (int k = 0; k < 2; ++k) dst[m][k] = *(const PG8_LAS bf16x8*)(lds + PG8_SA(b, h) + aoff + m * 2048 + k * 1024); } while (0)
#define PG8_LDB(dst, b, h) do { _Pragma("unroll") for (int n = 0; n < 2; ++n) _Pragma("unroll") for (int k = 0; k < 2; ++k) dst[n][k] = *(const PG8_LAS bf16x8*)(lds + PG8_SB(b, h) + boff + n * 2048 + k * 1024); } while (0)
#define PG8_MMA(ai, bj, At, Bt) do { __builtin_amdgcn_s_setprio(1); _Pragma("unroll") for (int m = 0; m < 4; ++m) _Pragma("unroll") for (int n = 0; n < 2; ++n) _Pragma("unroll") for (int k = 0; k < 2; ++k) \
        acc[ai][bj][m][n] = __builtin_amdgcn_mfma_f32_16x16x32_bf16(Bt[n][k], At[m][k], acc[ai][bj][m][n], 0, 0, 0); __builtin_amdgcn_s_setprio(0); } while (0)
#define PG8_WAIT_V(n) asm volatile("s_waitcnt vmcnt(" #n ")" ::: "memory")
#define PG8_WAIT_L(n) asm volatile("s_waitcnt lgkmcnt(" #n ")" ::: "memory")
#define PG8_BAR __builtin_amdgcn_s_barrier()
#define PG8_SCHED __builtin_amdgcn_sched_barrier(0)
#define PG8_AOFFS(dst, u) do { _Pragma("unroll") for (int _h = 0; _h < 2; ++_h) _Pragma("unroll") for (int _i = 0; _i < 2; ++_i) \
        dst[_h][_i] = (S.arow(u, _h * HALF + RA[_i]) * (unsigned)K + (unsigned)CA[_i]) * 2u; } while (0)
    Unit cur, nxt; int ui = 0;
    if (!S.next(0, cur)) return;
    f32x4 acc[2][2][4][2];
#pragma unroll
    for (int a = 0; a < 2; ++a)
#pragma unroll
        for (int b = 0; b < 2; ++b)
#pragma unroll
            for (int m = 0; m < 4; ++m)
#pragma unroll
                for (int n = 0; n < 2; ++n) acc[a][b][m][n] = (f32x4){0.f, 0.f, 0.f, 0.f};
    bf16x8 At[4][2], B0[2][2], B1[2][2];
    unsigned ca[2][2], na[2][2];
    S.a_ready(cur);
    PG8_AOFFS(ca, cur);
    const char* cB = cur.bbase + (size_t)cur.pn * tstep;
    PG8_STAGE(PG8_SB(0, 0), cB, voffB); PG8_STAGE(PG8_SB(0, 1), cB + hstep, voffB); PG8_STAGE(PG8_SA(0, 0), Abase, ca[0]); PG8_STAGE(PG8_SA(0, 1), Abase, ca[1]);
    if (wr == 1) PG8_BAR;
    PG8_WAIT_V(2); PG8_BAR;
    PG8_STAGE(PG8_SB(1, 0), cB + kstep, voffB); PG8_STAGE(PG8_SA(1, 0), Abase + kstep, ca[0]); PG8_STAGE(PG8_SB(1, 1), cB + hstep + kstep, voffB);
    PG8_WAIT_V(6); PG8_BAR;
    for (;;) {
        const bool has_next = S.next(ui + 1, nxt);
        if (has_next) { PG8_AOFFS(na, nxt); } else {
#pragma unroll
            for (int _h = 0; _h < 2; ++_h)
#pragma unroll
                for (int _i = 0; _i < 2; ++_i) na[_h][_i] = ca[_h][_i]; }
        const char* nB = has_next ? nxt.bbase + (size_t)nxt.pn * tstep : cB;
        const bool full = cur.half == 0;
        for (int t = 0; t < nt; t += 2) {
            const bool last = (t == nt - 2);
            if (last && has_next) S.a_ready(nxt);
            const char* a1 = Abase + (size_t)(t + 1) * kstep;
            const char* a2 = last ? Abase : Abase + (size_t)(t + 2) * kstep; const char* b2 = last ? nB : cB + (size_t)(t + 2) * kstep;
            const char* a3 = a2 + kstep; const char* b3 = b2 + kstep;
            unsigned o2[2][2];
#pragma unroll
            for (int _h = 0; _h < 2; ++_h)
#pragma unroll
                for (int _i = 0; _i < 2; ++_i) o2[_h][_i] = last ? na[_h][_i] : ca[_h][_i];
            PG8_LDB(B0, 0, 0); PG8_LDB(B1, 0, 1); PG8_SCHED; PG8_LDA(At, 0, 0); PG8_STAGE(PG8_SA(1, 1), a1, ca[1]);
            PG8_WAIT_V(8); PG8_WAIT_L(0); PG8_BAR; PG8_MMA(0, 0, At, B0); PG8_MMA(0, 1, At, B1); PG8_BAR; PG8_SCHED;
            PG8_LDA(At, 0, 1); PG8_STAGE(PG8_SB(0, 0), b2, voffB); PG8_STAGE(PG8_SB(0, 1), b2 + hstep, voffB); PG8_STAGE(PG8_SA(0, 0), a2, o2[0]);
            PG8_WAIT_V(8); PG8_WAIT_L(0); PG8_BAR; if (full) { PG8_MMA(1, 0, At, B0); PG8_MMA(1, 1, At, B1); } PG8_BAR; PG8_SCHED;
            PG8_LDB(B0, 1, 0); PG8_LDB(B1, 1, 1); PG8_SCHED; PG8_LDA(At, 1, 0); PG8_STAGE(PG8_SA(0, 1), a2, o2[1]);
            PG8_WAIT_V(8); PG8_WAIT_L(0); PG8_BAR; PG8_MMA(0, 0, At, B0); PG8_MMA(0, 1, At, B1); PG8_BAR; PG8_SCHED;
            PG8_LDA(At, 1, 1); PG8_STAGE(PG8_SB(1, 0), b3, voffB); PG8_STAGE(PG8_SB(1, 1), b3 + hstep, voffB); PG8_STAGE(PG8_SA(1, 0), a3, o2[0]);
            PG8_WAIT_V(8); PG8_WAIT_L(0); PG8_BAR; if (full) { PG8_MMA(1, 0, At, B0); PG8_MMA(1, 1, At, B1); } PG8_BAR; PG8_SCHED;
        }
        if (wr == 0) PG8_BAR;
        E(acc, cur, wr, wc, fr, fq);
        S.done(cur);
        if (!has_next) break;
#pragma unroll
        for (int a = 0; a < 2; ++a)
#pragma unroll
            for (int b = 0; b < 2; ++b)
#pragma unroll
                for (int m = 0; m < 4; ++m)
#pragma unroll
                    for (int n = 0; n < 2; ++n) acc[a][b][m][n] = (f32x4){0.f, 0.f, 0.f, 0.f};
        cur = nxt; cB = nB; ++ui;
#pragma unroll
        for (int _h = 0; _h < 2; ++_h)
#pragma unroll
            for (int _i = 0; _i < 2; ++_i) ca[_h][_i] = na[_h][_i];
        if (wr == 1) PG8_BAR;
    }
    PG8_WAIT_V(0);
    PG8_BAR;
#undef PG8_SA
#undef PG8_SB
#undef PG8_STAGE
#undef PG8_LDA
#undef PG8_LDB
#undef PG8_MMA
#undef PG8_WAIT_V
#undef PG8_WAIT_L
#undef PG8_BAR
#undef PG8_SCHED
#undef PG8_AOFFS
}
}


namespace attn_body {
using bf16x8=__attribute__((ext_vector_type(8)))short;
using s16x4=__attribute__((ext_vector_type(4)))short;
using f32x16=__attribute__((ext_vector_type(16)))float;
constexpr int D=64;
constexpr int QBLK=32,QB=256,KVBLK=64;
constexpr int KP=UC, OP=DM;
__device__ __forceinline__ int crow(int r,int hi){return (r&3)+8*(r>>2)+4*hi;}
#define SBAR() __builtin_amdgcn_sched_barrier(0)
__device__ __forceinline__ void cmask(f32x16&p0,f32x16&p1,int jb,int qrel,int hi){
  const float NEG=-INFINITY; int kb=64*jb+4*hi;
  #pragma unroll
  for(int r=0;r<16;++r){int kv=kb+(r&3)+8*(r>>2); if(kv>qrel)p0[r]=NEG; if(kv+32>qrel)p1[r]=NEG;}
}
constexpr int NSLOT=3, SLOTB=8192;
constexpr int LDS_K=0, LDS_V=NSLOT*SLOTB, LDS_WS=2*NSLOT*SLOTB, LDS_OST=LDS_WS+NW*64*4, LDS_BYTES_A=LDS_OST+NW*4096;
constexpr float C2=0.125f*1.4426950408889634f;
__device__ __forceinline__ void glds16(const void*gsrc,unsigned lds_dst){unsigned keep;
  asm volatile("s_mov_b32 %0, m0\n\ts_mov_b32 m0, %2\n\ts_nop 0\n\tglobal_load_lds_dwordx4 %1, off\n\ts_mov_b32 m0, %0":"=&s"(keep):"v"(gsrc),"s"(lds_dst):"memory");}
__device__ __forceinline__ float max3f(float a,float b,float c){float r;asm("v_max3_f32 %0, %1, %2, %3":"=v"(r):"v"(a),"v"(b),"v"(c));return r;}
__device__ __forceinline__ float max2f(float a,float b){float r;asm("v_max_f32_e32 %0, %1, %2":"=v"(r):"v"(a),"v"(b));return r;}
__device__ __forceinline__ float fsub_s(float a,float b){float r;asm("v_sub_f32_e32 %0, %1, %2":"=v"(r):"v"(a),"v"(b));return r;}
typedef float f32x2_t __attribute__((ext_vector_type(2))); typedef __bf16 bf16x2_t __attribute__((ext_vector_type(2)));
__device__ __forceinline__ unsigned cvtpk_s(float lo,float hi){f32x2_t v={lo,hi};bf16x2_t b=__builtin_convertvector(v,bf16x2_t);return __builtin_bit_cast(unsigned,b);}
#define WAIT_BAR(N) asm volatile("s_waitcnt vmcnt(" #N ") lgkmcnt(0)\n\ts_barrier":::"memory")

__device__ __forceinline__ void qkt(f32x16&p0,f32x16&p1,const char*Kslot,const bf16x8*qr,const f32x16&negm,int r32,int hi){
  const char*kb=Kslot+hi*1024+r32*16;
  #pragma unroll
  for(int d0=0;d0<4;++d0){
    const bf16x8 b0=*reinterpret_cast<const bf16x8*>(kb+d0*2048);
    const bf16x8 b1=*reinterpret_cast<const bf16x8*>(kb+d0*2048+512);
    if(d0==0){p0=__builtin_amdgcn_mfma_f32_32x32x16_bf16(b0,qr[0],negm,0,0,0);p1=__builtin_amdgcn_mfma_f32_32x32x16_bf16(b1,qr[0],negm,0,0,0);}
    else{p0=__builtin_amdgcn_mfma_f32_32x32x16_bf16(b0,qr[d0],p0,0,0,0);p1=__builtin_amdgcn_mfma_f32_32x32x16_bf16(b1,qr[d0],p1,0,0,0);}}
}
typedef __attribute__((address_space(3))) const char* lds_cptr;
typedef short v4i16_t __attribute__((ext_vector_type(4)));
__device__ __forceinline__ void kload8(bf16x8*kf,lds_cptr kp){
  kf[0]=*(const __attribute__((address_space(3))) bf16x8*)(kp);      kf[1]=*(const __attribute__((address_space(3))) bf16x8*)(kp+512);
  kf[2]=*(const __attribute__((address_space(3))) bf16x8*)(kp+2048); kf[3]=*(const __attribute__((address_space(3))) bf16x8*)(kp+2560);
  kf[4]=*(const __attribute__((address_space(3))) bf16x8*)(kp+4096); kf[5]=*(const __attribute__((address_space(3))) bf16x8*)(kp+4608);
  kf[6]=*(const __attribute__((address_space(3))) bf16x8*)(kp+6144); kf[7]=*(const __attribute__((address_space(3))) bf16x8*)(kp+6656);
}
__device__ __forceinline__ void kload2(bf16x8*kf,lds_cptr kp,int j){ kf[2*j]=*(const __attribute__((address_space(3))) bf16x8*)(kp+j*2048); kf[2*j+1]=*(const __attribute__((address_space(3))) bf16x8*)(kp+j*2048+512); }
__device__ __forceinline__ s16x4 vtr(lds_cptr p){ return __builtin_bit_cast(s16x4,__builtin_amdgcn_ds_read_tr16_b64_v4i16((__attribute__((address_space(3))) v4i16_t*)p)); }
__device__ __forceinline__ float rowmax(const f32x16&p0,const f32x16&p1){
  float a=max3f(p0[0],p0[1],p1[0]),b=max3f(p0[2],p0[3],p1[1]);a=max3f(a,p1[2],p1[3]);
  #pragma unroll
  for(int r=4;r<16;r+=4){a=max3f(a,p0[r],p0[r+1]);b=max3f(b,p0[r+2],p0[r+3]);a=max3f(a,p1[r],p1[r+1]);b=max3f(b,p1[r+2],p1[r+3]);}
  const float m=max2f(a,b);
  auto rr=__builtin_amdgcn_permlane32_swap(__float_as_uint(m),__float_as_uint(m),false,false);
  return max2f(__uint_as_float(rr[0]),__uint_as_float(rr[1]));
}
__device__ __forceinline__ void pv(f32x16*o,int vb,bf16x8 pa0,bf16x8 pa1,bf16x8 pa2,bf16x8 pa3){
  #pragma unroll
  for(int d0=0;d0<2;++d0){s16x4 lo[4],hi[4];
    #pragma unroll
    for(int ks=0;ks<4;++ks){
      asm volatile("ds_read_b64_tr_b16 %0,%1 offset:%c2":"=&v"(lo[ks]):"v"(vb),"i"(d0*4096+ks*1024):"memory");
      asm volatile("ds_read_b64_tr_b16 %0,%1 offset:%c2":"=&v"(hi[ks]):"v"(vb),"i"(d0*4096+ks*1024+512):"memory");}
    asm volatile("s_waitcnt lgkmcnt(0)":::"memory");SBAR();
    #define PK(k) (bf16x8){lo[k][0],lo[k][1],lo[k][2],lo[k][3],hi[k][0],hi[k][1],hi[k][2],hi[k][3]}
    o[d0]=__builtin_amdgcn_mfma_f32_32x32x16_bf16(pa0,PK(0),o[d0],0,0,0);
    o[d0]=__builtin_amdgcn_mfma_f32_32x32x16_bf16(pa1,PK(1),o[d0],0,0,0);
    o[d0]=__builtin_amdgcn_mfma_f32_32x32x16_bf16(pa2,PK(2),o[d0],0,0,0);
    o[d0]=__builtin_amdgcn_mfma_f32_32x32x16_bf16(pa3,PK(3),o[d0],0,0,0);
    #undef PK
  }
}

template<int THRL> __device__ __forceinline__ void attn_unit(int b,int vh,int qb,const bf16_t*U,bf16_t*O,char*shm,int ncap){
  int tid_=threadIdx.x; asm volatile("":"+v"(tid_));
  const int tid=tid_,lane=tid&63,r32=lane&31,hi=lane>>5; const int wid=__builtin_amdgcn_readfirstlane(tid>>6);
  const int hh=vh>>2, cc=(vh>>1)&1, vhalf=vh&1;
  const long rowbase=(long)b*SEQ; const int q0=qb*QB;
  const bf16_t*Qw=U+(rowbase+q0+wid*QBLK)*KP+C_DQ+hh*128+cc*64;
  const bf16_t*Kh=U+rowbase*KP+C_DK+hh*128+cc*64,*Vh=U+rowbase*KP+C_DV+hh*128+vhalf*64;
  const float slope2=__uint_as_float(__builtin_amdgcn_readfirstlane(__float_as_uint(exp2f(-2.f*(float)(hh+1))*1.4426950408889634f)));
  const float s64=__uint_as_float(__builtin_amdgcn_readfirstlane(__float_as_uint(64.f*slope2))), s32=__uint_as_float(__builtin_amdgcn_readfirstlane(__float_as_uint(32.f*slope2)));
  const unsigned lds0=(unsigned)(uintptr_t)shm;
  float*wsf=(float*)(shm+LDS_WS)+wid*64;
  const bf16_t*ksrc=Kh+(long)lane*KP+wid*8;
  const bf16_t*vsrc=Vh+(long)(16*(wid&3)+(lane>>2))*KP+(wid>>2)*32+(lane&3)*8;
  const unsigned kdst=lds0+LDS_K+wid*1024, vdst=lds0+LDS_V+wid*1024;
  const int NTT=(q0+QB)/KVBLK;
  const int NT=NTT<ncap?NTT:ncap;
  #define DMA_K(s,slot) glds16(ksrc+(long)(NTT-1-(s))*KVBLK*KP,(unsigned)__builtin_amdgcn_readfirstlane(kdst+(slot)))
  #define DMA_V(s,slot) glds16(vsrc+(long)(NTT-1-(s))*KVBLK*KP,(unsigned)__builtin_amdgcn_readfirstlane(vdst+(slot)))
  const int vb0=(int)(lds0+LDS_V)+((lane>>4)&1)*32+(lane&3)*8+(4*hi+((lane&15)>>2))*64;
  const char*Kbase=shm+LDS_K; bf16x8 kf[8];
  const lds_cptr shm3=(lds_cptr)shm; const lds_cptr kp0=shm3+LDS_K+hi*1024+r32*16; const lds_cptr vp0=shm3+LDS_V+((lane>>4)&1)*32+(lane&3)*8+(4*hi+((lane&15)>>2))*64;
  DMA_K(0,0);DMA_V(0,0);DMA_K(1,SLOTB);
  bf16x8 qr[4];
  #pragma unroll
  for(int d0=0;d0<4;++d0)qr[d0]=*reinterpret_cast<const bf16x8*>(&Qw[(long)r32*KP+d0*16+hi*8]);
  float l_reg=0.f;f32x16 o[2];o[0]=f32x16{};o[1]=f32x16{};
  f32x16 negm;
  #pragma unroll
  for(int r=0;r<16;++r)negm[r]=slope2*(float)(crow(r,hi)-63);
  asm volatile("":"+v"(negm));
  const int qrel=wid*QBLK+r32;
  #define CMASK(P0,P1,s) do{ if((s)<4)cmask(P0,P1,3-(s),qrel,hi);}while(0)
  #define BIAS1(P1) do{ _Pragma("unroll") for(int r=0;r<16;++r)P1[r]+=s32; }while(0)
  #define NEXTTILE() do{ _Pragma("unroll") for(int r=0;r<16;++r)negm[r]-=s64; asm volatile("":"+v"(negm)); }while(0)
  bool resc=false;
  #define START(P0,P1) do{ const float rm=rowmax(P0,P1); resc=false; \
    { const float dl=__builtin_fmaxf(rm,-8192.f); \
      _Pragma("unroll") for(int r=0;r<16;++r){P0[r]=fsub_s(P0[r],dl);P1[r]=fsub_s(P1[r],dl);} \
      _Pragma("unroll") for(int r=0;r<16;++r)negm[r]-=dl; asm volatile("":"+v"(negm)); } \
    _Pragma("unroll") for(int r=0;r<16;++r)P0[r]=__builtin_amdgcn_exp2f(P0[r]); }while(0)
  #define RESC() do{ if(resc){ asm volatile("s_waitcnt lgkmcnt(0)":::"memory"); \
      _Pragma("unroll") for(int d_=0;d_<2;++d_) _Pragma("unroll") for(int r=0;r<16;++r)o[d_][r]*=wsf[crow(r,hi)]; } }while(0)
  f32x16 pA0,pA1,pB0,pB1;
  int sl_prev=0,sl_cur=0,sl_next=SLOTB;
  #define ROT() do{sl_prev=sl_cur;sl_cur=sl_next;sl_next=(sl_next==(NSLOT-1)*SLOTB)?0:sl_next+SLOTB;}while(0)
  DMA_K(2,2*SLOTB);
  WAIT_BAR(3);
  qkt(pA0,pA1,Kbase,qr,negm,r32,hi);asm volatile("s_nop 15\n\ts_nop 7":"+v"(pA0),"+v"(pA1));BIAS1(pA1);CMASK(pA0,pA1,0);
  START(pA0,pA1);
  NEXTTILE();
  _Pragma("unroll") for(int r=0;r<16;++r)pA1[r]=__builtin_amdgcn_exp2f(pA1[r]);
  WAIT_BAR(0);
  DMA_K(3,0);DMA_V(1,SLOTB);
  ROT();
  kload8(kf,kp0+sl_cur);
  WAIT_BAR(2);
  s16x4 vlo[8],vhi[8]; u32x4 pw0,pw1,pw2,pw3;
  #define PKW(P,B) cvtpk_s(P[B],P[B+1])
  #define PAF(k) __builtin_bit_cast(bf16x8,pw##k)
  #define VFR(i) (bf16x8){vlo[i][0],vlo[i][1],vlo[i][2],vlo[i][3],vhi[i][0],vhi[i][1],vhi[i][2],vhi[i][3]}
  #define PIN(x) asm volatile("":"+v"(x))
  #define MX3(a,b,c) __builtin_fmaxf(__builtin_fmaxf((a),(b)),(c))
  #define GAPA(MF,A0,A1,A2,A3,W0,W1,PW) do{ MF; sacc+=A0; sacc+=A1; sacc+=A2; sacc+=A3; PIN(sacc); W0; W1; PIN(PW); SBAR(); }while(0)
  #define EX(v) __builtin_amdgcn_exp2f(v)
  #define GAPB(MF,X,B) do{ MF; X[B]=EX(X[B]); X[B+1]=EX(X[B+1]); X[B+2]=EX(X[B+2]); X[B+3]=EX(X[B+3]); PIN(X); SBAR(); }while(0)
  #define VRD(i) do{ vlo[i]=vtr(vp_+(((i)>>2)*4096+((i)&3)*1024)); vhi[i]=vtr(vp_+(((i)>>2)*4096+((i)&3)*1024+512)); }while(0)
  #define KRD(G,j) do{ if(G){ kload2(kf,kp0+sl_next,j); SBAR(); } }while(0)
  #define STEP(C0,C1,P0,P1,t,GK,GV,GL) do{ SBAR(); \
    const lds_cptr vp_=vp0+sl_prev; \
    VRD(0); SBAR(); float sacc=(P0[0]+P0[1]); \
    GAPA(C0=__builtin_amdgcn_mfma_f32_32x32x16_bf16(kf[0],qr[0],negm,0,0,0), P0[2],P0[3],P0[4],P0[5],     pw0[0]=PKW(P0,0), pw0[1]=PKW(P0,2), pw0); \
    VRD(4); SBAR(); GAPA(C1=__builtin_amdgcn_mfma_f32_32x32x16_bf16(kf[1],qr[0],negm,0,0,0), P0[6],P0[7],P0[8],P0[9],     pw0[2]=PKW(P0,4), pw0[3]=PKW(P0,6), pw0); \
    VRD(1); SBAR(); GAPA(C0=__builtin_amdgcn_mfma_f32_32x32x16_bf16(kf[2],qr[1],C0,0,0,0),   P0[10],P0[11],P0[12],P0[13], pw1[0]=PKW(P0,8), pw1[1]=PKW(P0,10), pw1); \
    VRD(5); SBAR(); GAPA(C1=__builtin_amdgcn_mfma_f32_32x32x16_bf16(kf[3],qr[1],C1,0,0,0),   P0[14],P0[15],P1[0],P1[1],   pw1[2]=PKW(P0,12),pw1[3]=PKW(P0,14), pw1); \
    VRD(2); SBAR(); GAPA(C0=__builtin_amdgcn_mfma_f32_32x32x16_bf16(kf[4],qr[2],C0,0,0,0),   P1[2],P1[3],P1[4],P1[5],     pw2[0]=PKW(P1,0), pw2[1]=PKW(P1,2), pw2); \
    VRD(6); SBAR(); GAPA(C1=__builtin_amdgcn_mfma_f32_32x32x16_bf16(kf[5],qr[2],C1,0,0,0),   P1[6],P1[7],P1[8],P1[9],     pw2[2]=PKW(P1,4), pw2[3]=PKW(P1,6), pw2); \
    VRD(3); SBAR(); GAPA(C0=__builtin_amdgcn_mfma_f32_32x32x16_bf16(kf[6],qr[3],C0,0,0,0),   P1[10],P1[11],P1[12],P1[13], pw3[0]=PKW(P1,8), pw3[1]=PKW(P1,10), pw3); \
    VRD(7); SBAR(); GAPA(C1=__builtin_amdgcn_mfma_f32_32x32x16_bf16(kf[7],qr[3],C1,0,0,0),   P1[14],P1[15],0.f,0.f,       pw3[2]=PKW(P1,12),pw3[3]=PKW(P1,14), pw3); \
    l_reg+=sacc; \
    if(GK){DMA_K((t)+3,sl_cur);} if(GV){DMA_V((t)+1,sl_next);} \
    BIAS1(C1); CMASK(C0,C1,t); \
    { float a=MX3(C0[0],C0[1],C1[0]),b=MX3(C0[2],C0[3],C1[1]); a=MX3(a,C1[2],C1[3]); \
      _Pragma("unroll") for(int r=4;r<16;r+=4){a=MX3(a,C0[r],C0[r+1]);b=MX3(b,C0[r+2],C0[r+3]);a=MX3(a,C1[r],C1[r+1]);b=MX3(b,C1[r+2],C1[r+3]);} \
      float rm=__builtin_fmaxf(a,b); { auto rr=__builtin_amdgcn_permlane32_swap(__float_as_uint(rm),__float_as_uint(rm),false,false); rm=__builtin_fmaxf(__uint_as_float(rr[0]),__uint_as_float(rr[1])); } \
      resc=false; \
      if(__builtin_expect(__any(rm>(float)THRL),0)){ const float dl=__builtin_fmaxf(rm,0.f); \
        _Pragma("unroll") for(int r=0;r<16;++r){C0[r]-=dl;C1[r]-=dl;} \
        _Pragma("unroll") for(int r=0;r<16;++r)negm[r]-=dl; asm volatile("":"+v"(negm)); \
        const float f=__builtin_amdgcn_exp2f(-dl); l_reg*=f; if(hi==0)wsf[r32]=f; resc=true; } } \
    NEXTTILE(); \
    SBAR(); \
    GAPB(o[0]=__builtin_amdgcn_mfma_f32_32x32x16_bf16(PAF(0),VFR(0),o[0],0,0,0), C0,0); \
    GAPB(o[1]=__builtin_amdgcn_mfma_f32_32x32x16_bf16(PAF(0),VFR(4),o[1],0,0,0), C0,4); \
    KRD(GL,0); GAPB(o[0]=__builtin_amdgcn_mfma_f32_32x32x16_bf16(PAF(1),VFR(1),o[0],0,0,0), C0,8); \
    KRD(GL,1); GAPB(o[1]=__builtin_amdgcn_mfma_f32_32x32x16_bf16(PAF(1),VFR(5),o[1],0,0,0), C0,12); \
    KRD(GL,2); GAPB(o[0]=__builtin_amdgcn_mfma_f32_32x32x16_bf16(PAF(2),VFR(2),o[0],0,0,0), C1,0); \
    KRD(GL,3); GAPB(o[1]=__builtin_amdgcn_mfma_f32_32x32x16_bf16(PAF(2),VFR(6),o[1],0,0,0), C1,4); \
    GAPB(o[0]=__builtin_amdgcn_mfma_f32_32x32x16_bf16(PAF(3),VFR(3),o[0],0,0,0), C1,8); \
    GAPB(o[1]=__builtin_amdgcn_mfma_f32_32x32x16_bf16(PAF(3),VFR(7),o[1],0,0,0), C1,12); \
    }while(0)
  int t=1;
  for(;t+5<NT;t+=2){
    STEP(pB0,pB1,pA0,pA1,t,true,true,true);     WAIT_BAR(2); RESC(); ROT();
    STEP(pA0,pA1,pB0,pB1,t+1,true,true,true);   WAIT_BAR(2); RESC(); ROT();
  }
  #define ENDW(tt) do{ if((tt)+3<NT){WAIT_BAR(2);} else if((tt)+2<NT){WAIT_BAR(1);} else {WAIT_BAR(0);} }while(0)
  for(;t+1<NT;t+=2){
    STEP(pB0,pB1,pA0,pA1,t,(t+3<NT),(t+1<NT),(t+1<NT));       ENDW(t);   RESC(); ROT();
    STEP(pA0,pA1,pB0,pB1,t+1,(t+4<NT),(t+2<NT),(t+2<NT));     ENDW(t+1); RESC(); ROT();
  }
  STEP(pB0,pB1,pA0,pA1,NT-1,false,false,false); RESC();
  { float sacc=pB0[0]+pB0[1]; _Pragma("unroll") for(int r=2;r<16;++r)sacc+=pB0[r]; _Pragma("unroll") for(int r=0;r<16;++r)sacc+=pB1[r]; l_reg+=sacc;
    pw0=(u32x4){PKW(pB0,0),PKW(pB0,2),PKW(pB0,4),PKW(pB0,6)};pw1=(u32x4){PKW(pB0,8),PKW(pB0,10),PKW(pB0,12),PKW(pB0,14)};pw2=(u32x4){PKW(pB1,0),PKW(pB1,2),PKW(pB1,4),PKW(pB1,6)};pw3=(u32x4){PKW(pB1,8),PKW(pB1,10),PKW(pB1,12),PKW(pB1,14)};
    SBAR(); pv(o,vb0+sl_cur,PAF(0),PAF(1),PAF(2),PAF(3)); }
  #undef PKW
  #undef PAF
  #undef VFR
  #undef PIN
  #undef MX3
  #undef GAPA
  #undef GAPB
  #undef EX
  #undef VRD
  #undef KRD
  #undef STEP
  #undef ENDW
  {auto rr=__builtin_amdgcn_permlane32_swap(__float_as_uint(l_reg),__float_as_uint(l_reg),false,false);l_reg=__uint_as_float(rr[0])+__uint_as_float(rr[1]);}
  if(hi==0)wsf[32+r32]=l_reg;asm volatile("s_waitcnt lgkmcnt(0)":::"memory");
  float rli[16];
  #pragma unroll
  for(int r=0;r<16;++r)rli[r]=__builtin_amdgcn_rcpf(wsf[32+crow(r,hi)]);
  bf16_t*Ow=O+(rowbase+q0+wid*QBLK)*OP+vh*D;
  { bf16_t*stg=(bf16_t*)(shm+LDS_OST)+wid*2048;
    #pragma unroll
    for(int r=0;r<16;++r){const int orow=crow(r,hi);
      #pragma unroll
      for(int d0=0;d0<2;++d0)stg[orow*64+d0*32+r32]=f2bf(o[d0][r]*rli[r]);}
    asm volatile("s_waitcnt lgkmcnt(0)":::"memory");
    #pragma unroll
    for(int i=0;i<4;++i){const int row=i*8+(lane>>3),ch=lane&7; const u32x4 v=*(const u32x4*)(stg+row*64+ch*8); *(u32x4*)(Ow+(long)row*OP+ch*8)=v;} }
  asm volatile("s_waitcnt lgkmcnt(0)\n\ts_barrier":::"memory");
  #undef DMA_K
  #undef DMA_V
  #undef CMASK
  #undef BIAS1
  #undef NEXTTILE
  #undef START
  #undef RESC
  #undef ROT
}

constexpr int PC_K=0, PC_V0=24576, PC_V1=49152, PC_PX=73728, PC_WS=106496, PC_OST=108544, PC_BYTES=PC_OST+8*4096;
template<int THRL> __device__ __forceinline__ void attn_unit_pc(int b,int hh,int cc,int qb,const bf16_t*U,bf16_t*O,char*shm,int ncap){
  int tid_=threadIdx.x; asm volatile("":"+v"(tid_));
  const int tid=tid_,lane=tid&63,r32=lane&31,hi=lane>>5; const int wid=__builtin_amdgcn_readfirstlane(tid>>6);
  const bool prod=wid<4; const int pw=wid&3;
  const long rowbase=(long)b*SEQ; const int q0=qb*128;
  const float slope2=__uint_as_float(__builtin_amdgcn_readfirstlane(__float_as_uint(exp2f(-2.f*(float)(hh+1))*1.4426950408889634f)));
  const float s64=__uint_as_float(__builtin_amdgcn_readfirstlane(__float_as_uint(64.f*slope2))), s32=__uint_as_float(__builtin_amdgcn_readfirstlane(__float_as_uint(32.f*slope2)));
  const unsigned lds0=(unsigned)(uintptr_t)shm;
  const int NTT=(q0+128)/KVBLK;
  int NT=NTT<ncap?NTT:ncap; if(NT<4)NT=4;
  float*wsf=(float*)(shm+PC_WS)+pw*128;
  char*px=shm+PC_PX+pw*8192;
  bf16_t*Ow=O+(rowbase+q0+pw*QBLK)*OP+(hh*4+cc*2+(prod?0:1))*D;
  #define TILE_OF(s) ((NTT-1-(s))>0?(NTT-1-(s)):0)
  if(prod){
    const bf16_t*Qw=U+(rowbase+q0+pw*QBLK)*KP+C_DQ+hh*128+cc*64;
    const bf16_t*Kh=U+rowbase*KP+C_DK+hh*128+cc*64,*Vh=U+rowbase*KP+C_DV+hh*128;
    const bf16_t*ksrc=Kh+(long)lane*KP+(2*pw)*8;
    const bf16_t*vsrc0=Vh+(long)(16*((2*pw)&3)+(lane>>2))*KP+((2*pw)>>2)*32+(lane&3)*8;
    const bf16_t*vsrc1=Vh+(long)(16*((2*pw+1)&3)+(lane>>2))*KP+((2*pw+1)>>2)*32+(lane&3)*8;
    const unsigned kdst=lds0+PC_K+(2*pw)*1024, vdst=lds0+PC_V0+(2*pw)*1024;
    #define DMA_K(s,slot) do{ const long to_=(long)TILE_OF(s)*KVBLK*KP; const unsigned d_=(unsigned)__builtin_amdgcn_readfirstlane(kdst+(slot)); glds16(ksrc+to_,d_); glds16(ksrc+to_+8,d_+1024); }while(0)
    #define DMA_V(s,slot) do{ const long to_=(long)TILE_OF(s)*KVBLK*KP; const unsigned d_=(unsigned)__builtin_amdgcn_readfirstlane(vdst+(slot)); glds16(vsrc0+to_,d_); glds16(vsrc1+to_,d_+1024); }while(0)
    const int vb0=(int)(lds0+PC_V0)+((lane>>4)&1)*32+(lane&3)*8+(4*hi+((lane&15)>>2))*64;
    const char*Kbase=shm+PC_K; bf16x8 kf[8];
    const lds_cptr shm3=(lds_cptr)shm; const lds_cptr kp0=shm3+PC_K+hi*1024+r32*16; const lds_cptr vp0=shm3+PC_V0+((lane>>4)&1)*32+(lane&3)*8+(4*hi+((lane&15)>>2))*64;
    DMA_K(0,0);DMA_V(0,0);DMA_K(1,SLOTB);
    bf16x8 qr[4];
    #pragma unroll
    for(int d0=0;d0<4;++d0)qr[d0]=*reinterpret_cast<const bf16x8*>(&Qw[(long)r32*KP+d0*16+hi*8]);
    float l_reg=0.f;f32x16 o[2];o[0]=f32x16{};o[1]=f32x16{};
    f32x16 negm;
    #pragma unroll
    for(int r=0;r<16;++r)negm[r]=slope2*(float)(crow(r,hi)-63);
    asm volatile("":"+v"(negm));
    const int qrel=pw*QBLK+r32;
    #define CMASK(P0,P1,s) do{ if((s)<2)cmask(P0,P1,1-(s),qrel,hi); else if(NTT-1-(s)<0){ _Pragma("unroll") for(int r=0;r<16;++r){P0[r]=-INFINITY;P1[r]=-INFINITY;} } }while(0)
    #define BIAS1(P1) do{ _Pragma("unroll") for(int r=0;r<16;++r)P1[r]+=s32; }while(0)
    #define NEXTTILE() do{ _Pragma("unroll") for(int r=0;r<16;++r)negm[r]-=s64; asm volatile("":"+v"(negm)); }while(0)
    bool resc=false;
    #define START(P0,P1) do{ const float rm=rowmax(P0,P1); resc=false; \
      { const float dl=__builtin_fmaxf(rm,-8192.f); \
        _Pragma("unroll") for(int r=0;r<16;++r){P0[r]=fsub_s(P0[r],dl);P1[r]=fsub_s(P1[r],dl);} \
        _Pragma("unroll") for(int r=0;r<16;++r)negm[r]-=dl; asm volatile("":"+v"(negm)); } \
      _Pragma("unroll") for(int r=0;r<16;++r)P0[r]=__builtin_amdgcn_exp2f(P0[r]); }while(0)
    #define RESC(t) do{ if(resc){ asm volatile("s_waitcnt lgkmcnt(0)":::"memory"); \
        _Pragma("unroll") for(int d_=0;d_<2;++d_) _Pragma("unroll") for(int r=0;r<16;++r)o[d_][r]*=wsf[32*((t)&1)+crow(r,hi)]; } }while(0)
    f32x16 pA0,pA1,pB0,pB1;
    int sl_prev=0,sl_cur=0,sl_next=SLOTB;
    #define ROT() do{sl_prev=sl_cur;sl_cur=sl_next;sl_next=(sl_next==(NSLOT-1)*SLOTB)?0:sl_next+SLOTB;}while(0)
    DMA_K(2,2*SLOTB);
    WAIT_BAR(6);
    qkt(pA0,pA1,Kbase,qr,negm,r32,hi);asm volatile("s_nop 15\n\ts_nop 7":"+v"(pA0),"+v"(pA1));BIAS1(pA1);CMASK(pA0,pA1,0);
    START(pA0,pA1);
    NEXTTILE();
    _Pragma("unroll") for(int r=0;r<16;++r)pA1[r]=__builtin_amdgcn_exp2f(pA1[r]);
    WAIT_BAR(0);
    DMA_K(3,0);DMA_V(1,SLOTB);
    ROT();
    kload8(kf,kp0+sl_cur);
    WAIT_BAR(4);
    s16x4 vlo[8],vhi[8]; u32x4 pw0,pw1,pw2,pw3;
    #define PKW(P,B) cvtpk_s(P[B],P[B+1])
    #define PAF(k) __builtin_bit_cast(bf16x8,pw##k)
    #define VFR(i) (bf16x8){vlo[i][0],vlo[i][1],vlo[i][2],vlo[i][3],vhi[i][0],vhi[i][1],vhi[i][2],vhi[i][3]}
    #define PIN(x) asm volatile("":"+v"(x))
    #define MX3(a,b,c) __builtin_fmaxf(__builtin_fmaxf((a),(b)),(c))
    #define GAPA(MF,A0,A1,A2,A3,W0,W1,PW) do{ MF; sacc+=A0; sacc+=A1; sacc+=A2; sacc+=A3; PIN(sacc); W0; W1; PIN(PW); SBAR(); }while(0)
    #define EX(v) __builtin_amdgcn_exp2f(v)
    #define GAPB(MF,X,B) do{ MF; X[B]=EX(X[B]); X[B+1]=EX(X[B+1]); X[B+2]=EX(X[B+2]); X[B+3]=EX(X[B+3]); PIN(X); SBAR(); }while(0)
    #define VRD(i) do{ vlo[i]=vtr(vp_+(((i)>>2)*4096+((i)&3)*1024)); vhi[i]=vtr(vp_+(((i)>>2)*4096+((i)&3)*1024+512)); }while(0)
    #define KRD(G,j) do{ if(G){ kload2(kf,kp0+sl_next,j); SBAR(); } }while(0)
    #define PXW(tt) do{ char*pb_=px+4096*((tt)&1)+16*lane; *(u32x4*)(pb_)=pw0; *(u32x4*)(pb_+1024)=pw1; *(u32x4*)(pb_+2048)=pw2; *(u32x4*)(pb_+3072)=pw3; }while(0)
    #define STEP(C0,C1,P0,P1,t,GK,GV,GL) do{ SBAR(); \
      const lds_cptr vp_=vp0+sl_prev; \
      VRD(0); SBAR(); float sacc=(P0[0]+P0[1]); \
      GAPA(C0=__builtin_amdgcn_mfma_f32_32x32x16_bf16(kf[0],qr[0],negm,0,0,0), P0[2],P0[3],P0[4],P0[5],     pw0[0]=PKW(P0,0), pw0[1]=PKW(P0,2), pw0); \
      VRD(4); SBAR(); GAPA(C1=__builtin_amdgcn_mfma_f32_32x32x16_bf16(kf[1],qr[0],negm,0,0,0), P0[6],P0[7],P0[8],P0[9],     pw0[2]=PKW(P0,4), pw0[3]=PKW(P0,6), pw0); \
      VRD(1); SBAR(); GAPA(C0=__builtin_amdgcn_mfma_f32_32x32x16_bf16(kf[2],qr[1],C0,0,0,0),   P0[10],P0[11],P0[12],P0[13], pw1[0]=PKW(P0,8), pw1[1]=PKW(P0,10), pw1); \
      VRD(5); SBAR(); GAPA(C1=__builtin_amdgcn_mfma_f32_32x32x16_bf16(kf[3],qr[1],C1,0,0,0),   P0[14],P0[15],P1[0],P1[1],   pw1[2]=PKW(P0,12),pw1[3]=PKW(P0,14), pw1); \
      VRD(2); SBAR(); GAPA(C0=__builtin_amdgcn_mfma_f32_32x32x16_bf16(kf[4],qr[2],C0,0,0,0),   P1[2],P1[3],P1[4],P1[5],     pw2[0]=PKW(P1,0), pw2[1]=PKW(P1,2), pw2); \
      VRD(6); SBAR(); GAPA(C1=__builtin_amdgcn_mfma_f32_32x32x16_bf16(kf[5],qr[2],C1,0,0,0),   P1[6],P1[7],P1[8],P1[9],     pw2[2]=PKW(P1,4), pw2[3]=PKW(P1,6), pw2); \
      VRD(3); SBAR(); GAPA(C0=__builtin_amdgcn_mfma_f32_32x32x16_bf16(kf[6],qr[3],C0,0,0,0),   P1[10],P1[11],P1[12],P1[13], pw3[0]=PKW(P1,8), pw3[1]=PKW(P1,10), pw3); \
      VRD(7); SBAR(); GAPA(C1=__builtin_amdgcn_mfma_f32_32x32x16_bf16(kf[7],qr[3],C1,0,0,0),   P1[14],P1[15],0.f,0.f,       pw3[2]=PKW(P1,12),pw3[3]=PKW(P1,14), pw3); \
      l_reg+=sacc; PXW((t)-1); \
      if(GK){DMA_K((t)+3,sl_cur);} if(GV){DMA_V((t)+1,sl_next);} \
      BIAS1(C1); CMASK(C0,C1,t); \
      { float a=MX3(C0[0],C0[1],C1[0]),b=MX3(C0[2],C0[3],C1[1]); a=MX3(a,C1[2],C1[3]); \
        _Pragma("unroll") for(int r=4;r<16;r+=4){a=MX3(a,C0[r],C0[r+1]);b=MX3(b,C0[r+2],C0[r+3]);a=MX3(a,C1[r],C1[r+1]);b=MX3(b,C1[r+2],C1[r+3]);} \
        float rm=__builtin_fmaxf(a,b); { auto rr=__builtin_amdgcn_permlane32_swap(__float_as_uint(rm),__float_as_uint(rm),false,false); rm=__builtin_fmaxf(__uint_as_float(rr[0]),__uint_as_float(rr[1])); } \
        resc=false; \
        if(__builtin_expect(__any(rm>(float)THRL),0)){ const float dl=__builtin_fmaxf(rm,0.f); \
          _Pragma("unroll") for(int r=0;r<16;++r){C0[r]-=dl;C1[r]-=dl;} \
          _Pragma("unroll") for(int r=0;r<16;++r)negm[r]-=dl; asm volatile("":"+v"(negm)); \
          const float f=__builtin_amdgcn_exp2f(-dl); l_reg*=f; if(hi==0)wsf[32*((t)&1)+r32]=f; resc=true; } \
        if(lane==0)wsf[64+((t)&1)]=resc?1.f:0.f; } \
      NEXTTILE(); \
      SBAR(); \
      GAPB(o[0]=__builtin_amdgcn_mfma_f32_32x32x16_bf16(PAF(0),VFR(0),o[0],0,0,0), C0,0); \
      GAPB(o[1]=__builtin_amdgcn_mfma_f32_32x32x16_bf16(PAF(0),VFR(4),o[1],0,0,0), C0,4); \
      KRD(GL,0); GAPB(o[0]=__builtin_amdgcn_mfma_f32_32x32x16_bf16(PAF(1),VFR(1),o[0],0,0,0), C0,8); \
      KRD(GL,1); GAPB(o[1]=__builtin_amdgcn_mfma_f32_32x32x16_bf16(PAF(1),VFR(5),o[1],0,0,0), C0,12); \
      KRD(GL,2); GAPB(o[0]=__builtin_amdgcn_mfma_f32_32x32x16_bf16(PAF(2),VFR(2),o[0],0,0,0), C1,0); \
      KRD(GL,3); GAPB(o[1]=__builtin_amdgcn_mfma_f32_32x32x16_bf16(PAF(2),VFR(6),o[1],0,0,0), C1,4); \
      GAPB(o[0]=__builtin_amdgcn_mfma_f32_32x32x16_bf16(PAF(3),VFR(3),o[0],0,0,0), C1,8); \
      GAPB(o[1]=__builtin_amdgcn_mfma_f32_32x32x16_bf16(PAF(3),VFR(7),o[1],0,0,0), C1,12); \
      }while(0)
    int t=1;
    for(;t+5<NT;t+=2){
      STEP(pB0,pB1,pA0,pA1,t,true,true,true);     WAIT_BAR(4); RESC(t);   ROT();
      STEP(pA0,pA1,pB0,pB1,t+1,true,true,true);   WAIT_BAR(4); RESC(t+1); ROT();
    }
    #define ENDW(tt) do{ if((tt)+3<NT){WAIT_BAR(4);} else if((tt)+2<NT){WAIT_BAR(2);} else {WAIT_BAR(0);} }while(0)
    for(;t+1<NT;t+=2){
      STEP(pB0,pB1,pA0,pA1,t,(t+3<NT),(t+1<NT),(t+1<NT));       ENDW(t);   RESC(t);   ROT();
      STEP(pA0,pA1,pB0,pB1,t+1,(t+4<NT),(t+2<NT),(t+2<NT));     ENDW(t+1); RESC(t+1); ROT();
    }
    STEP(pB0,pB1,pA0,pA1,NT-1,false,false,false); RESC(NT-1);
    { float sacc=pB0[0]+pB0[1]; _Pragma("unroll") for(int r=2;r<16;++r)sacc+=pB0[r]; _Pragma("unroll") for(int r=0;r<16;++r)sacc+=pB1[r]; l_reg+=sacc;
      pw0=(u32x4){PKW(pB0,0),PKW(pB0,2),PKW(pB0,4),PKW(pB0,6)};pw1=(u32x4){PKW(pB0,8),PKW(pB0,10),PKW(pB0,12),PKW(pB0,14)};pw2=(u32x4){PKW(pB1,0),PKW(pB1,2),PKW(pB1,4),PKW(pB1,6)};pw3=(u32x4){PKW(pB1,8),PKW(pB1,10),PKW(pB1,12),PKW(pB1,14)};
      { char*pb_=shm+PC_K+pw*4096+16*lane; *(u32x4*)(pb_)=pw0; *(u32x4*)(pb_+1024)=pw1; *(u32x4*)(pb_+2048)=pw2; *(u32x4*)(pb_+3072)=pw3; }
      SBAR(); pv(o,vb0+sl_cur,PAF(0),PAF(1),PAF(2),PAF(3)); }
    {auto rr=__builtin_amdgcn_permlane32_swap(__float_as_uint(l_reg),__float_as_uint(l_reg),false,false);l_reg=__uint_as_float(rr[0])+__uint_as_float(rr[1]);}
    if(hi==0)wsf[96+r32]=l_reg;
    WAIT_BAR(0);
    float rli[16];
    #pragma unroll
    for(int r=0;r<16;++r)rli[r]=__builtin_amdgcn_rcpf(wsf[96+crow(r,hi)]);
    { bf16_t*stg=(bf16_t*)(shm+PC_OST)+wid*2048;
      #pragma unroll
      for(int r=0;r<16;++r){const int orow=crow(r,hi);
        #pragma unroll
        for(int d0=0;d0<2;++d0)stg[orow*64+d0*32+r32]=f2bf(o[d0][r]*rli[r]);}
      asm volatile("s_waitcnt lgkmcnt(0)":::"memory");
      #pragma unroll
      for(int i=0;i<4;++i){const int row=i*8+(lane>>3),ch=lane&7; const u32x4 v=*(const u32x4*)(stg+row*64+ch*8); *(u32x4*)(Ow+(long)row*OP+ch*8)=v;} }
    asm volatile("s_waitcnt lgkmcnt(0)\n\ts_barrier":::"memory");
    #undef PKW
    #undef PAF
    #undef VFR
    #undef PIN
    #undef MX3
    #undef GAPA
    #undef GAPB
    #undef EX
    #undef VRD
    #undef KRD
    #undef PXW
    #undef STEP
    #undef ENDW
    #undef DMA_K
    #undef DMA_V
    #undef CMASK
    #undef BIAS1
    #undef NEXTTILE
    #undef START
    #undef RESC
    #undef ROT
  } else {
    const bf16_t*Vh=U+rowbase*KP+C_DV+hh*128+64;
    const bf16_t*vsrc0=Vh+(long)(16*((2*pw)&3)+(lane>>2))*KP+((2*pw)>>2)*32+(lane&3)*8;
    const bf16_t*vsrc1=Vh+(long)(16*((2*pw+1)&3)+(lane>>2))*KP+((2*pw+1)>>2)*32+(lane&3)*8;
    const unsigned vdst=lds0+PC_V1+(2*pw)*1024;
    #define DMA_V1(j) do{ const long to_=(long)TILE_OF(j)*KVBLK*KP; const unsigned d_=(unsigned)__builtin_amdgcn_readfirstlane(vdst+((j)%3)*SLOTB); glds16(vsrc0+to_,d_); glds16(vsrc1+to_,d_+1024); }while(0)
    const int vb1=(int)(lds0+PC_V1)+((lane>>4)&1)*32+(lane&3)*8+(4*hi+((lane&15)>>2))*64;
    f32x16 o[2];o[0]=f32x16{};o[1]=f32x16{};
    #define CPVB(j,PB) do{ const char*pb_=(PB); const u32x4 a0=*(const u32x4*)(pb_),a1=*(const u32x4*)(pb_+1024),a2=*(const u32x4*)(pb_+2048),a3=*(const u32x4*)(pb_+3072); \
        pv(o,vb1+((j)%3)*SLOTB,__builtin_bit_cast(bf16x8,a0),__builtin_bit_cast(bf16x8,a1),__builtin_bit_cast(bf16x8,a2),__builtin_bit_cast(bf16x8,a3)); \
        if((j)+1<NT && wsf[64+(((j)+1)&1)]!=0.f){ _Pragma("unroll") for(int d_=0;d_<2;++d_) _Pragma("unroll") for(int r=0;r<16;++r)o[d_][r]*=wsf[32*(((j)+1)&1)+crow(r,hi)]; } }while(0)
    #define CPV(j) CPVB(j, px+4096*((j)&1)+16*lane)
    DMA_V1(0); DMA_V1(1);
    WAIT_BAR(2);
    WAIT_BAR(2);
    WAIT_BAR(2);
    WAIT_BAR(2);
    #pragma unroll 1
    for(int j=0;j+2<NT;++j){
      if(j+2<NT) DMA_V1(j+2);
      CPV(j);
      if(j+3<NT){ WAIT_BAR(2); } else { WAIT_BAR(0); }
    }
    CPV(NT-2);
    CPVB(NT-1, shm+PC_K+pw*4096+16*lane);
    float rli[16];
    #pragma unroll
    for(int r=0;r<16;++r)rli[r]=__builtin_amdgcn_rcpf(wsf[96+crow(r,hi)]);
    { bf16_t*stg=(bf16_t*)(shm+PC_OST)+wid*2048;
      #pragma unroll
      for(int r=0;r<16;++r){const int orow=crow(r,hi);
        #pragma unroll
        for(int d0=0;d0<2;++d0)stg[orow*64+d0*32+r32]=f2bf(o[d0][r]*rli[r]);}
      asm volatile("s_waitcnt lgkmcnt(0)":::"memory");
      #pragma unroll
      for(int i=0;i<4;++i){const int row=i*8+(lane>>3),ch=lane&7; const u32x4 v=*(const u32x4*)(stg+row*64+ch*8); *(u32x4*)(Ow+(long)row*OP+ch*8)=v;} }
    asm volatile("s_waitcnt lgkmcnt(0)\n\ts_barrier":::"memory");
    #undef DMA_V1
    #undef CPV
    #undef CPVB
  }
  #undef TILE_OF
}
#undef SBAR
#undef WAIT_BAR
}

__device__ __forceinline__ void transpose_item(const float* W, int K, int Nsrc, bf16_t* WT, int roff, int rmul, float* scr, int kb, int nb, int lane) {
    const int k0 = 64 * kb, n0 = 32 * nb;
    float tv[32];
#pragma unroll
    for (int i = 0; i < 32; ++i) { const int kk = 2 * i + (lane >> 5), n = n0 + (lane & 31); tv[i] = (n < Nsrc) ? W[(size_t)(k0 + kk) * Nsrc + n] : 0.f; }
#pragma unroll
    for (int i = 0; i < 32; ++i) scr[(2 * i + (lane >> 5)) * 33 + (lane & 31)] = tv[i];
    lds_fence();
    const int c = lane & 7;
#pragma unroll
    for (int j = 0; j < 4; ++j) { const int n = (lane >> 3) + 8 * j; const float* s = scr + (8 * c) * 33 + n;
        u32x4 o; o.x = pk2(s[0 * 33], s[1 * 33]); o.y = pk2(s[2 * 33], s[3 * 33]); o.z = pk2(s[4 * 33], s[5 * 33]); o.w = pk2(s[6 * 33], s[7 * 33]);
        *(u32x4*)(WT + (size_t)(roff + (n0 + n) * rmul) * K + k0 + 8 * c) = o; }
    lds_fence();
}

__device__ __forceinline__ void stage0(const Params& p, unsigned char* smem) {
    const int tid = opaque_tid(), wid = tid >> 6, lane = tid & 63, G = gridDim.x;
    unsigned char* ws = p.ws;
    for (int it = blockIdx.x; it < 96; it += G) {
        float* ssl = (float*)(smem + 73728);
        float* mp = (float*)(smem + 73728 + 8192);
        for (int i = tid; i < 2048; i += NT) ssl[i] = silu_f(p.in[1][i]);
        __syncthreads();
        const float* wa = p.in[2]; const int j = it * 64 + lane; float a0 = 0.f, a1 = 0.f;
#pragma unroll 1
        for (int k0 = 128 * wid; k0 < 128 * wid + 128; k0 += 32) { float wv[32];
#pragma unroll
            for (int k = 0; k < 32; ++k) wv[k] = wa[(size_t)(k0 + k) * 6144 + j];
#pragma unroll
            for (int k = 0; k < 32; ++k) { a0 += ssl[k0 + k] * wv[k]; a1 += ssl[1024 + k0 + k] * wv[k]; } }
        mp[wid * 128 + lane] = a0; mp[wid * 128 + 64 + lane] = a1;
        __syncthreads();
        if (tid < 128) { float s = p.in[3][it * 64 + (tid & 63)];
#pragma unroll
            for (int w = 0; w < 8; ++w) s += mp[w * 128 + tid];
            ((float*)(ws + WS_MOD))[(tid >> 6) * 6144 + it * 64 + (tid & 63)] = s; }
        __syncthreads();
    }
    {
        float* scr = (float*)(smem + wid * 8448);
        const int gw = blockIdx.x * NW + wid, NGW = G * NW;
        constexpr int I_IN = 16 * 96, I_OUT = 16 * 32, I_E = 256;
        constexpr int NITEMS = I_IN + I_OUT + 64 * 3 * I_E, I_C = 2 * (128 + 4), I_B = 32;
        for (int it = gw; it < I_C + I_B; it += NGW) {
            if (it < I_C) { const int kv = it / 132, r = it % 132;
                if (r < 128) transpose_item(p.in[kv ? 17 : 16], 2048, 128, (bf16_t*)(ws + WS_W1T) + (size_t)kv * 128 * 2048, 0, 1, scr, r >> 2, r & 3, lane);
                else transpose_item(p.in[kv ? 19 : 18], 128, 64, (bf16_t*)(ws + WS_W2T) + (size_t)kv * 64 * 128, 0, 1, scr, (r - 128) >> 1, (r - 128) & 1, lane);
            } else { const int r = it - I_C, kv = r >> 4, kc = r & 15; const float* pos = p.in[kv ? 15 : 14]; const float* w1 = p.in[kv ? 17 : 16];
                float a0 = 0.f, a1 = 0.f;
#pragma unroll 8
                for (int k = kc * 128; k < kc * 128 + 128; ++k) { const float pv = pos[k]; a0 += pv * w1[(size_t)k * 128 + lane]; a1 += pv * w1[(size_t)k * 128 + 64 + lane]; }
                float* b1 = (float*)(ws + WS_B1P) + (kv * 16 + kc) * 128; b1[lane] = a0; b1[64 + lane] = a1; }
        }
        for (int it = gw; it < NITEMS; it += NGW) {
            int r = it;
            if (r < I_IN) { transpose_item(p.in[8], 1024, IN_COLS, (bf16_t*)(ws + WS_WTIN), 0, 1, scr, r / 96, r % 96, lane); continue; } r -= I_IN;
            if (r < I_OUT) { transpose_item(p.in[20], 1024, 1024, (bf16_t*)(ws + WS_WTOUT), 0, 1, scr, r / 32, r % 32, lane); continue; } r -= I_OUT;
            const int e = r / (3 * I_E), q = r % (3 * I_E), kind = q / I_E, ii = q % I_E;
            if (kind == 0) transpose_item(p.in[25] + (size_t)e * 1024 * 512, 1024, 512, (bf16_t*)(ws + WS_WTGU) + (size_t)e * 1024 * 1024, 0, 2, scr, ii / 16, ii % 16, lane);
            else if (kind == 1) transpose_item(p.in[26] + (size_t)e * 1024 * 512, 1024, 512, (bf16_t*)(ws + WS_WTGU) + (size_t)e * 1024 * 1024, 1, 2, scr, ii / 16, ii % 16, lane);
            else transpose_item(p.in[27] + (size_t)e * 512 * 1024, 512, 1024, (bf16_t*)(ws + WS_WTDN) + (size_t)e * 1024 * 512, 0, 1, scr, ii / 32, ii % 32, lane);
        }
    }
    {
        const int gt = blockIdx.x * NT + tid, NGT = G * NT;
        float* wr = (float*)(ws + WS_WR);
        bf16_t* wrh = (bf16_t*)wr; bf16_t* wrl = wrh + 1024 * 80;
        for (int i = gt; i < 1024 * 80; i += NGT) { const int ln = (i >> 3) & 63, jj = (i >> 9) % 5, ks = (i >> 9) / 5, k = 32 * ks + 8 * (ln >> 4) + (i & 7), c = 16 * jj + (ln & 15);
            const float w = c < 64 ? p.in[23][k * 64 + c] : (c < 72 ? p.in[21][k * 8 + (c - 64)] : 0.f);
            const bf16_t hi = f2bf(w); wrh[i] = hi; wrl[i] = f2bf(w - bf2f(hi)); }
    }
}

__device__ __forceinline__ void stage1(const Params& p) {
    const int tid = opaque_tid(), wid = tid >> 6, lane = tid & 63;
    const float* mod = (const float*)(p.ws + WS_MOD);
    bf16_t* xn = (bf16_t*)(p.ws + WS_XN);
    for (int row = blockIdx.x * NW + wid; row < M; row += gridDim.x * NW) {
        const int b = row / SEQ;
        const f32x4* xr = (const f32x4*)(p.in[0] + (size_t)row * DM) + lane;
        f32x4 v[4]; float ss = 0.f;
#pragma unroll
        for (int j = 0; j < 4; ++j) { v[j] = xr[64 * j]; ss += v[j].x * v[j].x + v[j].y * v[j].y + v[j].z * v[j].z + v[j].w * v[j].w; }
        const float rstd = rsqrtf(wave_sum(ss) * (1.f / DM) + 1e-6f);
#pragma unroll
        for (int j = 0; j < 4; ++j) { const int col = lane * 4 + 256 * j;
            const f32x4 g = *(const f32x4*)(p.in[4] + col), sc = *(const f32x4*)(mod + b * 6144 + 1024 + col), sh = *(const f32x4*)(mod + b * 6144 + col);
            const f32x4 h = v[j] * rstd * g * (sc + 1.f) + sh;
            u32x2 o; o.x = pk2(h.x, h.y); o.y = pk2(h.z, h.w);
            *(u32x2*)(xn + (size_t)row * DM + col) = o; }
    }
}

struct EpiBf16Out {
    static constexpr bool PERM = true;
    bf16_t* O; int ldc; int nscale; float sc; unsigned* norm;
    __device__ __forceinline__ void operator()(const f32x4 (&acc)[2][2][4][2], const pg8::Unit& u, int wr, int wc, int fr, int fq) const {
        const int row0 = u.pm * 256 + wr * 64 + fr, col0 = u.pn * 256 + wc * 32 + 8 * fq; const float s_ = ((nscale >> u.pn) & 1) ? sc : 1.f;
        if (norm && u.pn < 4) {
#pragma unroll
            for (int bj = 0; bj < 2; ++bj) { float mx = 0.f;
#pragma unroll
                for (int ai = 0; ai < 2; ++ai)
#pragma unroll
                    for (int m = 0; m < 4; ++m) { const f32x4 v0 = acc[ai][bj][m][0] * s_, v1 = acc[ai][bj][m][1] * s_;
                        float ss = (v0[0] * v0[0] + v0[1] * v0[1]) + (v0[2] * v0[2] + v0[3] * v0[3]) + (v1[0] * v1[0] + v1[1] * v1[1]) + (v1[2] * v1[2] + v1[3] * v1[3]);
                        ss += __shfl_xor(ss, 16); ss += __shfl_xor(ss, 32); mx = fmaxf(mx, ss); }
                mx = fmaxf(mx, __shfl_xor(mx, 1)); mx = fmaxf(mx, __shfl_xor(mx, 2)); mx = fmaxf(mx, __shfl_xor(mx, 4)); mx = fmaxf(mx, __shfl_xor(mx, 8));
                if (fr == 0 && fq == 0) atomicMax(norm + (u.pm >> 5) * 32 + u.pn * 8 + bj * 4 + wc, __float_as_uint(mx * 1.001f)); }
        }
#pragma unroll
        for (int ai = 0; ai < 2; ++ai) { if (ai == 1 && u.half) break;
#pragma unroll
            for (int m = 0; m < 4; ++m) { bf16_t* rowp = O + (size_t)(row0 + ai * 128 + m * 16) * ldc + col0;
#pragma unroll
                for (int bj = 0; bj < 2; ++bj) { const f32x4 v0 = acc[ai][bj][m][0] * s_, v1 = acc[ai][bj][m][1] * s_;
                    u32x4 w; w.x = pg8::cvt_pk_bf16(v0[0], v0[1]); w.y = pg8::cvt_pk_bf16(v0[2], v0[3]); w.z = pg8::cvt_pk_bf16(v1[0], v1[1]); w.w = pg8::cvt_pk_bf16(v1[2], v1[3]);
                    *(u32x4*)(rowp + bj * 128) = w; } } }
    }
};
struct EpiF32Out {
    static constexpr bool PERM = false;
    float* O; int ldc;
    __device__ __forceinline__ void operator()(const f32x4 (&acc)[2][2][4][2], const pg8::Unit& u, int wr, int wc, int fr, int fq) const {
        const int row0 = u.pm * 256 + wr * 64 + fr, col0 = u.pn * 256 + wc * 32 + 4 * fq;
#pragma unroll
        for (int ai = 0; ai < 2; ++ai)
#pragma unroll
            for (int m = 0; m < 4; ++m) { float* rowp = O + (size_t)(row0 + ai * 128 + m * 16) * ldc + col0;
#pragma unroll
                for (int bj = 0; bj < 2; ++bj)
#pragma unroll
                    for (int n = 0; n < 2; ++n) *(f32x4*)(rowp + bj * 128 + n * 16) = acc[ai][bj][m][n]; }
    }
};
__device__ __forceinline__ void stage2(const Params& p, unsigned char* smem) {
    pg8::Gemm g{(const bf16_t*)(p.ws + WS_XN), DM};
    pg8::StaticOrder S; S.init(M, UC, gridDim.x, blockIdx.x, (const bf16_t*)(p.ws + WS_WTIN));
    EpiBf16Out E{(bf16_t*)(p.ws + WS_U), UC, 0xC3, attn_body::C2, (unsigned*)(p.ws + WS_CTL) + CTL_NORM};
    pg8::gemm_phase(( PG8_LAS unsigned char*)smem, g, S, E);
}

__device__ __forceinline__ void diff_attn_block(const Params& p, unsigned char* smem, int vb) {
    const int tid = threadIdx.x;
    const int qb = 15 - vb / 32, rest = vb % 32, b = rest >> 4, h = (rest >> 2) & 3, c = (rest >> 1) & 1, vh = rest & 1;
    const bf16_t* U = (const bf16_t*)(p.ws + WS_U);
    float* Ks = (float*)smem;
    float* Vs = (float*)(smem + 16384);
    const int qrow = qb * 512 + tid; const size_t row = (size_t)b * SEQ + qrow;
    float q[64];
    {
        const u32x4* qp = (const u32x4*)(U + row * UC + C_DQ + h * 128 + c * 64);
#pragma unroll
        for (int i = 0; i < 8; ++i) unpack8(qp[i], q + 8 * i);
#pragma unroll
        for (int i = 0; i < 64; ++i) q[i] *= 0.125f;
    }
    float o[64];
#pragma unroll
    for (int i = 0; i < 64; ++i) o[i] = 0.f;
    float m = -1e30f, l = 0.f;
    const float slope = exp2f(-2.f * (float)(h + 1));
    const int ntiles = (qb * 512 + 512) / 64;
    for (int tile = ntiles - 1; tile >= 0; --tile) {
        __syncthreads();
        {
            const int key = tid >> 3, ch = tid & 7; const size_t krow = (size_t)b * SEQ + tile * 64 + key;
            float t8[8];
            unpack8(*(const u32x4*)(U + krow * UC + C_DK + h * 128 + c * 64 + ch * 8), t8);
#pragma unroll
            for (int e = 0; e < 8; ++e) Ks[key * 64 + ch * 8 + e] = t8[e];
            unpack8(*(const u32x4*)(U + krow * UC + C_DV + h * 128 + vh * 64 + ch * 8), t8);
#pragma unroll
            for (int e = 0; e < 8; ++e) Vs[key * 64 + ch * 8 + e] = t8[e];
        }
        __syncthreads();
        const int k0 = tile * 64;
        if (k0 <= qrow) {
#pragma unroll 1
            for (int j = 63; j >= 0; --j) {
                const int kpos = k0 + j;
                if (kpos <= qrow) {
                    const f32x4* kr = (const f32x4*)(Ks + j * 64);
                    float s0 = 0.f, s1 = 0.f;
#pragma unroll
                    for (int d = 0; d < 16; d += 2) { const f32x4 ka = kr[d], kb = kr[d + 1];
                        s0 += q[4 * d] * ka.x + q[4 * d + 1] * ka.y + q[4 * d + 2] * ka.z + q[4 * d + 3] * ka.w;
                        s1 += q[4 * d + 4] * kb.x + q[4 * d + 5] * kb.y + q[4 * d + 6] * kb.z + q[4 * d + 7] * kb.w; }
                    const float s = s0 + s1 - slope * (float)(qrow - kpos);
                    if (s > m) { const float corr = __expf(m - s); l *= corr;
#pragma unroll
                        for (int e = 0; e < 64; ++e) o[e] *= corr;
                        m = s; }
                    const float pr = __expf(s - m); l += pr;
                    const f32x4* vr = (const f32x4*)(Vs + j * 64);
#pragma unroll
                    for (int e = 0; e < 16; ++e) { const f32x4 vv = vr[e]; o[4 * e] += pr * vv.x; o[4 * e + 1] += pr * vv.y; o[4 * e + 2] += pr * vv.z; o[4 * e + 3] += pr * vv.w; }
                }
            }
        }
    }
    const float il = 1.f / l;
    f32x4* op = (f32x4*)((float*)(p.ws + WS_OC) + ((row * 4 + h) * 2 + c) * 128 + vh * 64);
#pragma unroll
    for (int e = 0; e < 16; ++e) op[e] = (f32x4){o[4 * e] * il, o[4 * e + 1] * il, o[4 * e + 2] * il, o[4 * e + 3] * il};
}

__device__ __forceinline__ void write_frags(const bf16_t* kt, const bf16_t* vt, int pitch, bf16_t* kf_tile, bf16_t* vf_tile, int lane) {
    const int r32 = lane & 31, hi = lane >> 5;
    if (kt) {
#pragma unroll
        for (int d0 = 0; d0 < 4; ++d0) *(u32x4*)(kf_tile + (d0 * 64 + lane) * 8) = *(const u32x4*)(kt + r32 * pitch + 16 * d0 + 8 * hi);
    }
    if (vt) {
#pragma unroll
        for (int d0 = 0; d0 < 2; ++d0)
#pragma unroll
            for (int s = 0; s < 2; ++s) { unsigned w[4];
#pragma unroll
                for (int e2 = 0; e2 < 4; ++e2) { const int j = 2 * e2, t0_ = 16 * s + 8 * (j >> 2) + 4 * hi + (j & 3);
                    w[e2] = (unsigned)vt[t0_ * pitch + 32 * d0 + r32] | ((unsigned)vt[(t0_ + 1) * pitch + 32 * d0 + r32] << 16); }
                *(u32x4*)(vf_tile + ((d0 * 2 + s) * 64 + lane) * 8) = (u32x4){w[0], w[1], w[2], w[3]}; }
    }
}
__device__ __forceinline__ void compress_item(const Params& p, unsigned char* smem, int idx) {
    typedef float f32x16 __attribute__((ext_vector_type(16)));
    int tid_ = threadIdx.x; asm volatile("" : "+v"(tid_));
    const int tid = tid_, wid = tid >> 6, lane = tid & 63, r32 = lane & 31, hi = lane >> 5;
    const int kv = idx >> 6, b = (idx >> 5) & 1, hkv = (idx >> 4) & 1, n0 = (idx & 15) * 32;
    const bf16_t* U = (const bf16_t*)(p.ws + WS_U);
    const bf16_t* w1t = (const bf16_t*)(p.ws + WS_W1T) + (size_t)kv * 128 * 2048;
    const bf16_t* w2t = (const bf16_t*)(p.ws + WS_W2T) + (size_t)kv * 64 * 128;
    const float* b1p = (const float*)(p.ws + WS_B1P) + kv * 16 * 128;
    float* hsum = (float*)smem;
    bf16_t* hb = (bf16_t*)(smem + 131072);
    bf16_t* ot = (bf16_t*)(smem + 131072 + 8704);
    const int col = (kv ? C_CV : C_CK) + hkv * 64;
    __syncthreads();
    f32x16 acc[4];
#pragma unroll
    for (int c = 0; c < 4; ++c) acc[c] = (f32x16){};
    const int n = n0 + r32;
#pragma unroll 1
    for (int ii = 0; ii < 4; ++ii) { const int i = 4 * wid + ii, tok = 16 * n + i; const bool ok = tok < SEQ;
        const bf16_t* arow = U + ((size_t)b * SEQ + (ok ? tok : 0)) * UC + col + 8 * hi;
#pragma unroll
        for (int d0 = 0; d0 < 64; d0 += 16) { bf16x8 a = *(const bf16x8*)(arow + d0); if (!ok) a = (bf16x8){};
            const int kk = i * 64 + d0 + 8 * hi;
#pragma unroll
            for (int c = 0; c < 4; ++c) acc[c] = __builtin_amdgcn_mfma_f32_32x32x16_bf16(a, *(const bf16x8*)(w1t + (size_t)(32 * c + r32) * 2048 + kk), acc[c], 0, 0, 0); } }
#pragma unroll
    for (int c = 0; c < 4; ++c)
#pragma unroll
        for (int r = 0; r < 16; ++r) hsum[wid * 4096 + ((r & 3) + 8 * (r >> 2) + 4 * hi) * 128 + 32 * c + r32] = acc[c][r];
    __syncthreads();
    for (int i = tid; i < 4096; i += NT) { const int row = i >> 7, j = i & 127; float bs = 0.f;
#pragma unroll
        for (int c = 0; c < 16; ++c) bs += b1p[c * 128 + j];
        float hs = 0.f;
#pragma unroll
        for (int w = 0; w < 8; ++w) hs += hsum[w * 4096 + i];
        hb[row * 136 + j] = f2bf(gelu_tanh(hs + bs)); }
    __syncthreads();
    if (wid < 2) {
        f32x16 o = (f32x16){};
#pragma unroll
        for (int k0 = 0; k0 < 128; k0 += 16) o = __builtin_amdgcn_mfma_f32_32x32x16_bf16(*(const bf16x8*)(hb + r32 * 136 + k0 + 8 * hi), *(const bf16x8*)(w2t + (size_t)(32 * wid + r32) * 128 + k0 + 8 * hi), o, 0, 0, 0);
        const int d = 32 * wid + r32;
#pragma unroll
        for (int r = 0; r < 16; ++r) { const int nl = (r & 3) + 8 * (r >> 2) + 4 * hi; ot[nl * 72 + d] = (n0 + nl) < NCMP ? f2bf(o[r]) : (bf16_t)0; }
    }
    __syncthreads();
    if (wid == 0) { bf16_t* dst = (bf16_t*)(p.ws + (kv ? WS_VC : WS_KC)) + ((size_t)(b * 2 + hkv) * 16 + (idx & 15)) * 2048;
        write_frags(kv ? nullptr : ot, kv ? ot : nullptr, 72, dst, dst, lane); }
}

__device__ __forceinline__ void vt_item(const Params& p, bf16_t* scr, int item, int lane) {
    const int kind = item >> 9, b = (item >> 8) & 1, hkv = (item >> 7) & 1, blk = item & 127, tok0 = blk * 64;
    const bf16_t* U = (const bf16_t*)(p.ws + WS_U);
    bf16_t* KF = (bf16_t*)(p.ws + (kind ? WS_KFW : WS_KFS)) + (size_t)(b * 2 + hkv) * 64 * SEQ;
    bf16_t* VF = (bf16_t*)(p.ws + (kind ? WS_VFW : WS_VFS)) + (size_t)(b * 2 + hkv) * 64 * SEQ;
    const int kcol = (kind ? C_WK : C_SK) + hkv * 64, vcol = (kind ? C_WV : C_SV) + hkv * 64;
    bf16_t* ks = scr; bf16_t* vs = scr + 64 * 72;
    lds_fence();
#pragma unroll
    for (int i = 0; i < 8; ++i) { const int row = 8 * i + (lane >> 3), ch = lane & 7; const bf16_t* src = U + ((size_t)b * SEQ + tok0 + row) * UC + ch * 8;
        *(u32x4*)(ks + row * 72 + ch * 8) = *(const u32x4*)(src + kcol); *(u32x4*)(vs + row * 72 + ch * 8) = *(const u32x4*)(src + vcol); }
    lds_fence();
#pragma unroll
    for (int t = 0; t < 2; ++t) write_frags(ks + 32 * t * 72, vs + 32 * t * 72, 72, KF + (size_t)(2 * blk + t) * 2048, VF + (size_t)(2 * blk + t) * 2048, lane);
    lds_fence();
}

__device__ __forceinline__ void stage3(const Params& p, unsigned char* smem) {
    for (int vb = blockIdx.x; vb < 128; vb += gridDim.x) compress_item(p, smem, vb);
    __syncthreads();
    { const int t_ = opaque_tid(), wid = t_ >> 6, lane = t_ & 63;
      const int G = gridDim.x, sh = (G >= 256) ? 128 : 0, vbk = (blockIdx.x + G - sh) % G;
      for (int it = vbk * NW + wid; it < 1024; it += G * NW) vt_item(p, (bf16_t*)(smem + wid * 18432), it, lane); }
    __syncthreads();
    __syncthreads();
    {
        const bf16_t* U = (const bf16_t*)(p.ws + WS_U); bf16_t* OB = (bf16_t*)(p.ws + WS_OC);
        unsigned* qhead = (unsigned*)(p.ws + WS_CTL) + CTL_QHEAD; const float* nrm = (const float*)(p.ws + WS_CTL) + CTL_NORM;
        volatile int* bc = (volatile int*)(smem + LDS_BYTES - 64);
        const int nq = (gridDim.x % 8 == 0) ? 8 : 1, myq = blockIdx.x % nq, qlen = 1024 / nq;
        for (;;) {
            __syncthreads();
            if (threadIdx.x == 0) *bc = (int)atomicAdd(qhead + 16 * myq, 1u);
            __syncthreads();
            const int ri = __builtin_amdgcn_readfirstlane(*bc);
            if (ri >= qlen) break;
            const int x = nq == 8 ? myq : (ri >> 7), r = ri & 127;
            const int b = x >> 2, c = (x >> 1) & 1, par = x & 1;
            int k, h;
            if (r < 64) { k = 31 - (r >> 1); h = 2 + (r & 1); } else if (r < 96) { k = 31 - (r - 64); h = 1; } else { k = 31 - (r - 96); h = 0; }
            const int qb = 2 * k + par;
            const int g = h * 4 + c * 2;
            const float qn2 = nrm[b * 32 + g] + nrm[b * 32 + g + 1], kn2 = nrm[b * 32 + 16 + g] + nrm[b * 32 + 16 + g + 1];
            const float sb_ = sqrtf(qn2) * sqrtf(kn2) * 1.001f, slope2 = exp2f(-2.f * (float)(h + 1)) * 1.4426950408889634f;
            const float sc_ = (2.f * sb_ + 127.f * slope2 + 168.f) / (64.f * slope2);
            int ncap = sc_ < 1000.f ? (int)sc_ + 2 : 1000; ncap = (ncap + 1) & ~1; if (ncap < 4) ncap = 4;
            attn_body::attn_unit_pc<8>(b, h, c, qb, U, OB, (char*)smem, __builtin_amdgcn_readfirstlane(ncap));
        }
    }
}

__device__ __forceinline__ void qk4(const bf16_t* krow, const float* qs, float* s) {
    s[0] = s[1] = s[2] = s[3] = 0.f;
#pragma unroll 2
    for (int c = 0; c < 8; ++c) { float kd[8]; unpack8(*(const u32x4*)(krow + c * 8), kd);
#pragma unroll
        for (int g = 0; g < 4; ++g) { const f32x4 qa = *(const f32x4*)(qs + g * 64 + c * 8), qb = *(const f32x4*)(qs + g * 64 + c * 8 + 4);
            s[g] += kd[0] * qa.x + kd[1] * qa.y + kd[2] * qa.z + kd[3] * qa.w + kd[4] * qb.x + kd[5] * qb.y + kd[6] * qb.z + kd[7] * qb.w; } }
}
__device__ __forceinline__ void pv_block(const float* pw, int pstride, const bf16_t* vbase, size_t vstride, int nrows, float (&os)[4][8], int lane) {
    const int jr = lane >> 3, ch = lane & 7;
#pragma unroll 2
    for (int i = 0; i < 8; ++i) { const int j = jr + 8 * i;
        if (j < nrows) { float vd[8]; unpack8(*(const u32x4*)(vbase + (size_t)j * vstride + ch * 8), vd);
#pragma unroll
            for (int g = 0; g < 4; ++g) { const float pr = pw[g * pstride + j];
#pragma unroll
                for (int e = 0; e < 8; ++e) os[g][e] += pr * vd[e]; } } }
}

__device__ __forceinline__ void nsa_item(const Params& p, float* wl, int item, int lane) {
    const int hkv = item & 1, t = (item >> 1) % SEQ, b = (item >> 1) / SEQ;
    const bf16_t* U = (const bf16_t*)(p.ws + WS_U);
    const bf16_t* KC = (const bf16_t*)(p.ws + WS_KC); const bf16_t* VC = (const bf16_t*)(p.ws + WS_VC);
    const size_t row = (size_t)b * SEQ + t;
    float* qs = wl;
    float* ps = wl + 256;
    lds_fence();
#pragma unroll
    for (int g = 0; g < 4; ++g) qs[g * 64 + lane] = bf2f(U[row * UC + C_NQ + (hkv * 4 + g) * 64 + lane]);
    lds_fence();
    float slope[4], gate[4][3];
#pragma unroll
    for (int g = 0; g < 4; ++g) { slope[g] = exp2f(-(float)(hkv * 4 + g + 1));
#pragma unroll
        for (int i = 0; i < 3; ++i) { const float x = bf2f(U[row * UC + C_NG + (hkv * 4 + g) * 3 + i]); gate[g][i] = 1.f / (1.f + __expf(-x)); } }
    float tot[4][8];
#pragma unroll
    for (int g = 0; g < 4; ++g)
#pragma unroll
        for (int e = 0; e < 8; ++e) tot[g][e] = 0.f;
    const int nvalid = t >= 31 ? min((t - 31) / 16 + 1, NCMP) : 0;
    float cinv[4];
    {
        float mx[4] = {-1e30f, -1e30f, -1e30f, -1e30f};
#pragma unroll 1
        for (int i = 0; i < 8; ++i) { const int n = lane + 64 * i;
            asm volatile("" ::: "memory");
            if (n < nvalid) { float s[4]; qk4(KC + ((size_t)(b * 512 + n) * 2 + hkv) * 64, qs, s);
#pragma unroll
                for (int g = 0; g < 4; ++g) { const float v = s[g] * 0.125f - slope[g] * (float)(t - (16 * n + 31)); ps[g * 512 + n] = v; mx[g] = fmaxf(mx[g], v); } }
            else {
#pragma unroll
                for (int g = 0; g < 4; ++g) ps[g * 512 + n] = -1e30f; } }
        lds_fence();
#pragma unroll
        for (int g = 0; g < 4; ++g) { mx[g] = wave_max(mx[g]); float sum = 0.f;
#pragma unroll 1
            for (int i = 0; i < 8; ++i) { const int n = lane + 64 * i; const float e = n < nvalid ? __expf(ps[g * 512 + n] - mx[g]) : 0.f; ps[g * 512 + n] = e; sum += e; }
            sum = wave_sum(sum); cinv[g] = 1.f / fmaxf(sum, 1e-30f); }
        lds_fence();
        float oc[4][8];
#pragma unroll
        for (int g = 0; g < 4; ++g)
#pragma unroll
            for (int e = 0; e < 8; ++e) oc[g][e] = 0.f;
#pragma unroll 1
        for (int n0 = 0; n0 < nvalid; n0 += 64) pv_block(ps + n0, 512, VC + ((size_t)(b * 512 + n0) * 2 + hkv) * 64, 128, min(64, nvalid - n0), oc, lane);
#pragma unroll
        for (int g = 0; g < 4; ++g)
#pragma unroll
            for (int e = 0; e < 8; ++e) tot[g][e] += gate[g][0] * cinv[g] * oc[g][e];
    }
    const int cur = t >> 6;
    int mysel = 0;
    {
        float sc0, sc1;
        { float i0 = 0.f, i1 = 0.f;
#pragma unroll
            for (int g = 0; g < 4; ++g)
#pragma unroll
                for (int d = -1; d <= 3; ++d) { const int n0 = 4 * lane + d, n1 = 4 * (lane + 64) + d;
                    if (n0 >= 0 && n0 < NCMP) i0 += cinv[g] * ps[g * 512 + n0];
                    if (n1 < NCMP) i1 += cinv[g] * ps[g * 512 + n1]; }
            const int j0 = lane, j1 = lane + 64;
            const bool f0 = (j0 == 0) || (j0 == cur) || (j0 == cur - 1), f1 = (j1 == cur) || (j1 == cur - 1);
            sc0 = (j0 <= cur) ? i0 + (f0 ? 1e4f : 0.f) : -1e30f;
            sc1 = (j1 <= cur) ? i1 + (f1 ? 1e4f : 0.f) : -1e30f; }
        for (int r = 0; r < 16; ++r) {
            float v; int idx;
            if (sc0 >= sc1) { v = sc0; idx = lane; } else { v = sc1; idx = lane + 64; }
#pragma unroll
            for (int o = 32; o > 0; o >>= 1) { const float ov = __shfl_xor(v, o); const int oi = __shfl_xor(idx, o); if (ov > v || (ov == v && oi < idx)) { v = ov; idx = oi; } }
            if (idx == lane) sc0 = -3e38f; else if (idx == lane + 64) sc1 = -3e38f;
            if (lane == r) mysel = idx;
        }
    }
#pragma unroll 1
    for (int br = 0; br < 2; ++br) {
        float ms[4], ls[4], os[4][8];
#pragma unroll
        for (int g = 0; g < 4; ++g) { ms[g] = -1e30f; ls[g] = 0.f;
#pragma unroll
            for (int e = 0; e < 8; ++e) os[g][e] = 0.f; }
        const int kcol = (br == 0 ? C_SK : C_WK) + hkv * 64, vcol = (br == 0 ? C_SV : C_WV) + hkv * 64;
        const int lo = br == 0 ? 0 : max(t - 511, 0);
        const int nb = br == 0 ? 16 : (cur - (lo >> 6) + 1);
#pragma unroll 1
        for (int r = 0; r < nb; ++r) {
            int blk;
            if (br == 0) { blk = __shfl(mysel, r); if (blk > cur) continue; } else blk = (lo >> 6) + r;
            const int tok = blk * 64 + lane; const bool valid = tok <= t && tok >= lo;
            float s[4]; qk4(U + ((size_t)b * SEQ + tok) * UC + kcol, qs, s);
            lds_fence();
#pragma unroll
            for (int g = 0; g < 4; ++g) {
                const float sv = valid ? s[g] * 0.125f - slope[g] * (float)(t - tok) : -1e30f;
                const float mx = wave_max(sv), mnew = fmaxf(ms[g], mx), corr = __expf(ms[g] - mnew);
                const float pr = valid ? __expf(sv - mnew) : 0.f;
                ls[g] = ls[g] * corr + wave_sum(pr); ms[g] = mnew;
#pragma unroll
                for (int e = 0; e < 8; ++e) os[g][e] *= corr;
                ps[g * 64 + lane] = pr; }
            lds_fence();
            pv_block(ps, 64, U + ((size_t)b * SEQ + blk * 64) * UC + vcol, UC, 64, os, lane);
        }
#pragma unroll
        for (int g = 0; g < 4; ++g) { const float gsel = br == 0 ? gate[g][1] : gate[g][2]; const float w = ls[g] > 0.f ? gsel / ls[g] : 0.f;
#pragma unroll
            for (int e = 0; e < 8; ++e) tot[g][e] += w * os[g][e]; }
    }
#pragma unroll
    for (int g = 0; g < 4; ++g)
#pragma unroll
        for (int e = 0; e < 8; ++e) { float v = tot[g][e]; v += __shfl_xor(v, 8); v += __shfl_xor(v, 16); v += __shfl_xor(v, 32); tot[g][e] = v; }
    if (lane < 8) { bf16_t* ao = (bf16_t*)(p.ws + WS_AO) + row * DM + 512;
#pragma unroll
        for (int g = 0; g < 4; ++g) { u32x4 o; o.x = pk2(tot[g][0], tot[g][1]); o.y = pk2(tot[g][2], tot[g][3]); o.z = pk2(tot[g][4], tot[g][5]); o.w = pk2(tot[g][6], tot[g][7]);
            *(u32x4*)(ao + (hkv * 4 + g) * 64 + lane * 8) = o; } }
}


namespace nsa {
typedef float f32x16 __attribute__((ext_vector_type(16)));
constexpr int WL_BYTES = 17408;
constexpr float LOG2E = 1.4426950408889634f;
#define NSA_CR(r) (((r) & 3) + 8 * ((r) >> 2))
__device__ __forceinline__ float quad_xor1(float v) { return __int_as_float(__builtin_amdgcn_update_dpp(0, __float_as_int(v), 0xB1, 0xF, 0xF, true)); }
__device__ __forceinline__ float quad_xor2(float v) { return __int_as_float(__builtin_amdgcn_update_dpp(0, __float_as_int(v), 0x4E, 0xF, 0xF, true)); }
__device__ __forceinline__ float hmax(float v) { auto rr = __builtin_amdgcn_permlane32_swap(__float_as_uint(v), __float_as_uint(v), false, false); return fmaxf(__uint_as_float(rr[0]), __uint_as_float(rr[1])); }
__device__ __forceinline__ float hsum(float v) { auto rr = __builtin_amdgcn_permlane32_swap(__float_as_uint(v), __float_as_uint(v), false, false); return __uint_as_float(rr[0]) + __uint_as_float(rr[1]); }
__device__ __forceinline__ unsigned cvtpk(float lo, float hi) { typedef float f2 __attribute__((ext_vector_type(2))); typedef __bf16 b2 __attribute__((ext_vector_type(2))); f2 v = {lo, hi}; b2 r = __builtin_convertvector(v, b2); return __builtin_bit_cast(unsigned, r); }

__device__ __forceinline__ void k_frags(const bf16_t* ktile, bf16x8 (&kf)[4]) {
#pragma unroll
    for (int d0 = 0; d0 < 4; ++d0) kf[d0] = *(const bf16x8*)(ktile + d0 * 512);
}
__device__ __forceinline__ f32x16 qk_ct(const bf16x8 (&kf)[4], const bf16_t* ql, const f32x16& c) {
    bf16x8 q[4];
#pragma unroll
    for (int d0 = 0; d0 < 4; ++d0) q[d0] = *(const bf16x8*)(ql + d0 * 512);
    f32x16 S = __builtin_amdgcn_mfma_f32_32x32x16_bf16(kf[0], q[0], c, 0, 0, 0);
#pragma unroll
    for (int d0 = 1; d0 < 4; ++d0) S = __builtin_amdgcn_mfma_f32_32x32x16_bf16(kf[d0], q[d0], S, 0, 0, 0);
    return S;
}
template <bool MASKED, class VF>
__device__ __forceinline__ void tile_pass1_f(const bf16x8 (&kf)[4], const bf16_t* qf, const f32x16& c1, const VF& valid, const bool (&colon)[2], float (&m)[2], float (&l)[2]) {
#pragma unroll
    for (int ct = 0; ct < 2; ++ct) {
        f32x16 S = qk_ct(kf, qf + ct * 2048, c1);
        float mx = -INFINITY;
#pragma unroll
        for (int r = 0; r < 16; ++r) { if (MASKED) S[r] = valid(ct, r) ? S[r] : -INFINITY; mx = fmaxf(mx, S[r]); }
        mx = hmax(mx);
        const float mn = fmaxf(m[ct], mx); float sum = 0.f;
#pragma unroll
        for (int r = 0; r < 16; ++r) sum += __builtin_amdgcn_exp2f(S[r] - mn);
        if (colon[ct]) { l[ct] = l[ct] * __builtin_amdgcn_exp2f(m[ct] - mn) + sum; m[ct] = mn; }
    }
}
template <bool MASKED, bool HOOK, class VF, class PH>
__device__ __forceinline__ void tile_pass2_p(const bf16x8 (&kf)[4], const bf16_t* qf, const f32x16& crv, const float (&lm)[2], const VF& valid, u32x4 (&pb)[2][2], const PH& ph) {
#pragma unroll
    for (int ct = 0; ct < 2; ++ct) {
        f32x16 c2;
#pragma unroll
        for (int r = 0; r < 16; ++r) c2[r] = crv[r] + lm[ct];
        const f32x16 S = qk_ct(kf, qf + ct * 2048, c2);
        float pr[16];
#pragma unroll
        for (int r = 0; r < 16; ++r) { pr[r] = __builtin_amdgcn_exp2f(S[r]); if (MASKED) pr[r] = valid(ct, r) ? pr[r] : 0.f; }
        if (HOOK) ph(ct, pr);
#pragma unroll
        for (int s = 0; s < 2; ++s) pb[ct][s] = (u32x4){cvtpk(pr[8 * s], pr[8 * s + 1]), cvtpk(pr[8 * s + 2], pr[8 * s + 3]), cvtpk(pr[8 * s + 4], pr[8 * s + 5]), cvtpk(pr[8 * s + 6], pr[8 * s + 7])};
    }
}
template <bool MASKED, class VF>
__device__ __forceinline__ void tile_online_p(const bf16x8 (&kf)[4], const bf16_t* qf, float slope, float base, const bool (&sb)[2], const VF& valid,
                                              float (&mref)[2], bool (&ini)[2], float (&l)[2], f32x16 (&o)[2][2], u32x4 (&pb)[2][2]) {
    f32x16 S[2];
#pragma unroll
    for (int ct = 0; ct < 2; ++ct) {
        const float lm = sb[ct] ? base - mref[ct] : -INFINITY;
        f32x16 c;
#pragma unroll
        for (int r = 0; r < 16; ++r) c[r] = fmaf(slope, (float)NSA_CR(r), lm);
        S[ct] = qk_ct(kf, qf + ct * 2048, c);
    }
    float mx[2]; bool need[2];
#pragma unroll
    for (int ct = 0; ct < 2; ++ct) {
        float m_ = -INFINITY;
#pragma unroll
        for (int r = 0; r < 16; ++r) { if (MASKED) S[ct][r] = valid(ct, r) ? S[ct][r] : -INFINITY; m_ = fmaxf(m_, S[ct][r]); }
        mx[ct] = hmax(m_);
        need[ct] = ini[ct] ? (mx[ct] > 8.f) : (mx[ct] > -INFINITY);
    }
    if (__any(need[0] || need[1])) {
#pragma unroll
        for (int ct = 0; ct < 2; ++ct) {
            const float delta = need[ct] ? mx[ct] : 0.f, f = (need[ct] && ini[ct]) ? __builtin_amdgcn_exp2f(-delta) : 1.f;
            mref[ct] += delta; l[ct] *= f; ini[ct] = ini[ct] || need[ct];
#pragma unroll
            for (int d0 = 0; d0 < 2; ++d0) o[ct][d0] *= f;
#pragma unroll
            for (int r = 0; r < 16; ++r) S[ct][r] -= delta;
        }
    }
#pragma unroll
    for (int ct = 0; ct < 2; ++ct) {
        float pr[16]; float s0 = 0.f, s1 = 0.f;
#pragma unroll
        for (int r = 0; r < 16; r += 2) { pr[r] = __builtin_amdgcn_exp2f(S[ct][r]); pr[r + 1] = __builtin_amdgcn_exp2f(S[ct][r + 1]); s0 += pr[r]; s1 += pr[r + 1]; }
        l[ct] += s0 + s1;
#pragma unroll
        for (int s = 0; s < 2; ++s) pb[ct][s] = (u32x4){cvtpk(pr[8 * s], pr[8 * s + 1]), cvtpk(pr[8 * s + 2], pr[8 * s + 3]), cvtpk(pr[8 * s + 4], pr[8 * s + 5]), cvtpk(pr[8 * s + 6], pr[8 * s + 7])};
    }
}
__device__ __forceinline__ void tile_pass2_v(const bf16x8 (&vf)[2][2], const u32x4 (&pb)[2][2], f32x16 (&o)[2][2]) {
#pragma unroll
    for (int d0 = 0; d0 < 2; ++d0)
#pragma unroll
        for (int s = 0; s < 2; ++s)
#pragma unroll
            for (int ct = 0; ct < 2; ++ct) o[ct][d0] = __builtin_amdgcn_mfma_f32_32x32x16_bf16(vf[d0][s], __builtin_bit_cast(bf16x8, pb[ct][s]), o[ct][d0], 0, 0, 0);
}
__device__ __forceinline__ void v_frags(const bf16_t* vt, bf16x8 (&vf)[2][2]) {
#pragma unroll
    for (int d0 = 0; d0 < 2; ++d0)
#pragma unroll
        for (int s = 0; s < 2; ++s) vf[d0][s] = *(const bf16x8*)(vt + (d0 * 2 + s) * 512);
}
__device__ __forceinline__ void glds16(const void* gsrc, unsigned lds_dst) { unsigned keep;
    asm volatile("s_mov_b32 %0, m0\n\ts_mov_b32 m0, %2\n\ts_nop 0\n\tglobal_load_lds_dwordx4 %1, off\n\ts_mov_b32 m0, %0" : "=&s"(keep) : "v"(gsrc), "s"(lds_dst) : "memory"); }
__device__ __forceinline__ void dma4(const bf16_t* tile, unsigned slot) {
#pragma unroll
    for (int i = 0; i < 4; ++i) glds16(tile + i * 512, slot + i * 1024);
}

struct LaneC { int c32, hi, hc, head, qi0, qi1, tc0, tc1; float slope2; };
__device__ __forceinline__ LaneC lanec(int lane_, int t0, int hkv) {
    int lane = lane_; asm volatile("" : "+v"(lane));
    LaneC L; L.c32 = lane & 31; L.hi = lane >> 5; L.hc = lane & 3; L.head = hkv * 4 + L.hc; L.qi0 = L.c32 >> 2; L.qi1 = 8 + L.qi0; L.tc0 = t0 + L.qi0; L.tc1 = t0 + L.qi1;
    L.slope2 = exp2f(-(float)(L.head + 1)) * LOG2E; return L;
}
__device__ __forceinline__ float gate_of(const bf16_t* U, size_t rowb, int tcol, int head, int which) { return 1.f / (1.f + __expf(-bf2f(U[(rowb + tcol) * UC + C_NG + head * 3 + which]))); }

__device__ __forceinline__ void item(const Params& p, unsigned char* wl, int it, int lane_) {
    const int B_ = it >> 3, w_ = it & 7, x_ = B_ & 7, k_ = (x_ & 1) * 32 + (B_ >> 3), bh = x_ >> 1, qt = (w_ >> 2) ? 511 - (k_ * 4 + (w_ & 3)) : k_ * 4 + (w_ & 3);
    const int b = bh >> 1, hkv = bh & 1, t0 = qt * 16, cur = t0 >> 6;
    const bf16_t* U = (const bf16_t*)(p.ws + WS_U);
    const size_t rowb = (size_t)b * SEQ;
    float* G = (float*)wl; unsigned* selm = (unsigned*)(wl + 16384); unsigned* uni = selm + 64;
    const bf16_t* qf;
    lds_fence();
    {
        const LaneC L = lanec(lane_, t0, hkv);
        bf16_t* ql = (bf16_t*)(wl + 8192) + (lane_ & 63) * 8; qf = ql;
#pragma unroll
        for (int ct = 0; ct < 2; ++ct) {
            const bf16_t* qrow = U + (rowb + (ct ? L.tc1 : L.tc0)) * UC;
#pragma unroll
            for (int d0 = 0; d0 < 4; ++d0) *(bf16x8*)(ql + (ct * 4 + d0) * 512) = *(const bf16x8*)(qrow + C_NQ + L.head * 64 + 16 * d0 + 8 * L.hi);
        }
    }
    f32x16 o[2][2];
#pragma unroll
    for (int ct = 0; ct < 2; ++ct)
#pragma unroll
        for (int d0 = 0; d0 < 2; ++d0) o[ct][d0] = (f32x16){};
    auto nohook = [](int, float*) {};
    lds_fence();
    for (int i = (lane_ & 63); i < 2048; i += 64) ((unsigned*)wl)[i] = 0u;
    for (int i = (lane_ & 63); i < 68; i += 64) selm[i] = 0u;
    lds_fence();
    {
        const LaneC L = lanec(lane_, t0, hkv);
        const int hi = L.hi, c32 = L.c32;
        const bf16_t* KC = (const bf16_t*)(p.ws + WS_KC) + (size_t)(b * 2 + hkv) * 16 * 2048 + (lane_ & 63) * 8;
        const bf16_t* VCt = (const bf16_t*)(p.ws + WS_VC) + (size_t)(b * 2 + hkv) * 16 * 2048 + (lane_ & 63) * 8;
        const int tc[2] = {L.tc0, L.tc1}, qi[2] = {L.qi0, L.qi1};
        int nv[2];
#pragma unroll
        for (int ct = 0; ct < 2; ++ct) nv[ct] = tc[ct] >= 31 ? min((tc[ct] - 31) / 16 + 1, NCMP) : 0;
        const int tl = t0 + 15, nvmax = tl >= 31 ? min((tl - 31) / 16 + 1, NCMP) : 0, ntl = (nvmax + 31) >> 5, nvmin = t0 >= 31 ? min((t0 - 31) / 16 + 1, NCMP) : 0;
        const float sl16 = L.slope2 * 16.f;
        float m[2] = {-30000.f, -30000.f}, l[2] = {0.f, 0.f};
        f32x16 crv;
#pragma unroll
        for (int r = 0; r < 16; ++r) crv[r] = sl16 * (float)NSA_CR(r);
        const bool on2[2] = {true, true};
        bf16x8 kfn[4];
        if (ntl > 0) k_frags(KC, kfn);
#pragma unroll 1
        for (int nt = 0; nt < ntl; ++nt) {
            const int nb = 32 * nt + 4 * hi; const float base = sl16 * (float)nb;
            auto valid = [&](int ct, int r) { return nb + NSA_CR(r) < nv[ct]; };
            bf16x8 kf[4];
#pragma unroll
            for (int d0 = 0; d0 < 4; ++d0) kf[d0] = kfn[d0];
            if (nt + 1 < ntl) k_frags(KC + (nt + 1) * 2048, kfn);
            f32x16 c1;
#pragma unroll
            for (int r = 0; r < 16; ++r) c1[r] = crv[r] + base;
            if (32 * nt + 32 <= nvmin) tile_pass1_f<false>(kf, qf, c1, valid, on2, m, l); else tile_pass1_f<true>(kf, qf, c1, valid, on2, m, l);
        }
        float lmc[2];
#pragma unroll
        for (int ct = 0; ct < 2; ++ct) { const float lt = hsum(l[ct]); lmc[ct] = lt > 0.f ? -__builtin_amdgcn_logf(lt) - m[ct] : -INFINITY; }
        if (ntl > 0) k_frags(KC, kfn);
#pragma unroll 1
        for (int nt = 0; nt < ntl; ++nt) {
            const int nb = 32 * nt + 4 * hi; const float base = sl16 * (float)nb;
            auto valid = [&](int ct, int r) { return nb + NSA_CR(r) < nv[ct]; };
            auto hook = [&](int ct, float* pr) {
#pragma unroll
                for (int k = 0; k < 4; ++k) { float g4 = (pr[4 * k] + pr[4 * k + 1]) + (pr[4 * k + 2] + pr[4 * k + 3]), e = pr[4 * k + 3];
                    g4 += quad_xor1(g4); g4 += quad_xor2(g4); e += quad_xor1(e); e += quad_xor2(e);
                    const int j = 8 * nt + 2 * k + hi;
                    if (L.hc == 0) { atomicAdd(&G[qi[ct] * 128 + j], g4); if (j + 1 < 128) atomicAdd(&G[qi[ct] * 128 + j + 1], e); } } };
            bf16x8 kf[4], vf[2][2];
#pragma unroll
            for (int d0 = 0; d0 < 4; ++d0) kf[d0] = kfn[d0];
            v_frags(VCt + nt * 2048, vf);
            if (nt + 1 < ntl) k_frags(KC + (nt + 1) * 2048, kfn);
            const float lm[2] = {lmc[0] + base, lmc[1] + base};
            u32x4 pb[2][2];
            if (32 * nt + 32 <= nvmin) tile_pass2_p<false, true>(kf, qf, crv, lm, valid, pb, hook); else tile_pass2_p<true, true>(kf, qf, crv, lm, valid, pb, hook);
            tile_pass2_v(vf, pb, o);
        }
        float* AOF = (float*)(p.ws + WS_AOF);
#pragma unroll
        for (int ct = 0; ct < 2; ++ct) { const float gcv = gate_of(U, rowb, tc[ct], L.head, 0); float* orow = AOF + (rowb + tc[ct]) * 512 + L.head * 64 + 4 * hi;
#pragma unroll
            for (int d0 = 0; d0 < 2; ++d0) {
#pragma unroll
                for (int k = 0; k < 4; ++k) *(f32x4*)(orow + 32 * d0 + 8 * k) = (f32x4){o[ct][d0][4 * k] * gcv, o[ct][d0][4 * k + 1] * gcv, o[ct][d0][4 * k + 2] * gcv, o[ct][d0][4 * k + 3] * gcv};
                o[ct][d0] = (f32x16){}; } }
    }
    lds_fence();
    {
        int lane = lane_; asm volatile("" : "+v"(lane));
        unsigned u0 = 0u, u1 = 0u, u2 = 0u, u3 = 0u;
        const int j0 = lane, j1 = lane + 64;
        const bool f0 = (j0 == 0) || (j0 == cur) || (j0 == cur - 1), f1 = (j1 == cur) || (j1 == cur - 1);
        const bool ok0 = j0 <= cur, ok1 = j1 <= cur;
#pragma unroll 1
        for (int q = 0; q < 16; q += 2) {
            unsigned ka0, ka1, kb0, kb1;
            { const float i0 = G[q * 128 + lane], i1 = G[q * 128 + 64 + lane], i2 = G[(q + 1) * 128 + lane], i3 = G[(q + 1) * 128 + 64 + lane];
              ka0 = ok0 ? ((__float_as_uint(i0 + (f0 ? 1e4f : 0.f)) & ~127u) | (unsigned)(127 - j0)) : 0u;
              ka1 = ok1 ? ((__float_as_uint(i1 + (f1 ? 1e4f : 0.f)) & ~127u) | (unsigned)(127 - j1)) : 0u;
              kb0 = ok0 ? ((__float_as_uint(i2 + (f0 ? 1e4f : 0.f)) & ~127u) | (unsigned)(127 - j0)) : 0u;
              kb1 = ok1 ? ((__float_as_uint(i3 + (f1 ? 1e4f : 0.f)) & ~127u) | (unsigned)(127 - j1)) : 0u; }
            unsigned pa = 0u, pb = 0u;
#pragma unroll
            for (int bit = 30; bit >= 0; --bit) {
                const unsigned ca = pa | (1u << bit), cb = pb | (1u << bit);
                const int na = __popcll(__ballot(ka0 >= ca)) + __popcll(__ballot(ka1 >= ca));
                const int nb = __popcll(__ballot(kb0 >= cb)) + __popcll(__ballot(kb1 >= cb));
                pa = na >= 16 ? ca : pa; pb = nb >= 16 ? cb : pb;
            }
            const unsigned long long a0 = __ballot(ok0 && ka0 >= pa), a1 = __ballot(ok1 && ka1 >= pa), b0 = __ballot(ok0 && kb0 >= pb), b1 = __ballot(ok1 && kb1 >= pb);
            if (lane == 0) { selm[q * 4 + 0] = (unsigned)a0; selm[q * 4 + 1] = (unsigned)(a0 >> 32); selm[q * 4 + 2] = (unsigned)a1; selm[q * 4 + 3] = (unsigned)(a1 >> 32);
                selm[q * 4 + 4] = (unsigned)b0; selm[q * 4 + 5] = (unsigned)(b0 >> 32); selm[q * 4 + 6] = (unsigned)b1; selm[q * 4 + 7] = (unsigned)(b1 >> 32); }
            u0 |= (unsigned)a0 | (unsigned)b0; u1 |= (unsigned)(a0 >> 32) | (unsigned)(b0 >> 32); u2 |= (unsigned)a1 | (unsigned)b1; u3 |= (unsigned)(a1 >> 32) | (unsigned)(b1 >> 32);
        }
        if (lane == 0) { uni[0] = u0; uni[1] = u1; uni[2] = u2; uni[3] = u3; }
    }
    lds_fence();
#pragma unroll 1
    for (int br = 0; br < 2; ++br) {
        const LaneC L = lanec(lane_, t0, hkv);
        const int hi = L.hi; const float slope2 = L.slope2;
        const int tc[2] = {L.tc0, L.tc1}, qi[2] = {L.qi0, L.qi1};
        unsigned short* tl = (unsigned short*)(wl + 16896);
        int ntile = 0;
        if (br == 0) {
            const unsigned um0 = __builtin_amdgcn_readfirstlane(uni[0]), um1 = __builtin_amdgcn_readfirstlane(uni[1]), um2 = __builtin_amdgcn_readfirstlane(uni[2]), um3 = __builtin_amdgcn_readfirstlane(uni[3]);
#pragma unroll 1
            for (int j = cur; j >= 0; --j) { const int ws_ = j >> 5; const unsigned uw = ws_ == 0 ? um0 : ws_ == 1 ? um1 : ws_ == 2 ? um2 : um3;
                if ((uw >> (j & 31)) & 1u) { tl[ntile] = (unsigned short)(2 * j); tl[ntile + 1] = (unsigned short)(2 * j + 1); ntile += 2; } }
        } else {
            const int lo_t = (t0 - 511 > 0 ? t0 - 511 : 0) >> 5, hi_t = (t0 + 15) >> 5;
#pragma unroll 1
            for (int kt = hi_t; kt >= lo_t; --kt) { tl[ntile] = (unsigned short)kt; ++ntile; }
        }
        lds_fence();
        const bf16_t* Kb = (const bf16_t*)(p.ws + (br ? WS_KFW : WS_KFS)) + (size_t)(b * 2 + hkv) * 64 * SEQ + (lane_ & 63) * 8;
        static_assert(WS_VFS - WS_KFS == WS_VFW - WS_KFW, "V images sit at one constant distance behind the K images");
        constexpr size_t VOFF = (WS_VFS - WS_KFS) / 2;
        const unsigned slot = (unsigned)__builtin_amdgcn_readfirstlane((unsigned)(uintptr_t)wl);
        const bf16_t* kl = (const bf16_t*)wl + (lane_ & 63) * 8; const bf16_t* vl = (const bf16_t*)(wl + 4096) + (lane_ & 63) * 8;
        float mref[2] = {0.f, 0.f}, l[2] = {0.f, 0.f}; bool ini[2] = {false, false};
        if (ntile > 0) { const int t_ = __builtin_amdgcn_readfirstlane((int)tl[0]); dma4(Kb + (size_t)t_ * 2048, slot); dma4(Kb + (size_t)t_ * 2048 + VOFF, slot + 4096); }
#pragma unroll 1
        for (int idx = 0; idx < ntile; ++idx) {
            const int tile = __builtin_amdgcn_readfirstlane((int)tl[idx]);
            const bool more = idx + 1 < ntile; const int tnext = more ? __builtin_amdgcn_readfirstlane((int)tl[idx + 1]) : 0;
            asm volatile("s_waitcnt vmcnt(4)" ::: "memory");
            bf16x8 kf[4]; k_frags(kl, kf);
            asm volatile("s_waitcnt lgkmcnt(0)" ::: "memory");
            if (more) dma4(Kb + (size_t)tnext * 2048, slot);
            const int tokb = 32 * tile, tb = tokb + 4 * hi; const float base = slope2 * (float)(tb - t0);
            bool sb[2] = {true, true}; bool interior;
            if (br == 0) { const int j = tile >> 1, ws_ = j >> 5, bp = j & 31;
#pragma unroll
                for (int ct = 0; ct < 2; ++ct) sb[ct] = (selm[qi[ct] * 4 + ws_] >> bp) & 1u;
                interior = (j < cur);
            } else interior = (tokb + 31 <= t0 && tokb >= t0 + 15 - 511);
            const int wlo = br ? 511 : (1 << 30);
            auto valid = [&](int ct, int r) { const int tok = tb + NSA_CR(r); return tok <= tc[ct] && tok >= tc[ct] - wlo; };
            u32x4 pb[2][2];
            if (interior) tile_online_p<false>(kf, qf, slope2, base, sb, valid, mref, ini, l, o, pb); else tile_online_p<true>(kf, qf, slope2, base, sb, valid, mref, ini, l, o, pb);
            if (more) asm volatile("s_waitcnt vmcnt(4)" ::: "memory"); else asm volatile("s_waitcnt vmcnt(0)" ::: "memory");
            bf16x8 vf[2][2]; v_frags(vl, vf);
            asm volatile("s_waitcnt lgkmcnt(0)" ::: "memory");
            if (more) dma4(Kb + (size_t)tnext * 2048 + VOFF, slot + 4096);
            tile_pass2_v(vf, pb, o);
        }
        {
            float* AOF = (float*)(p.ws + WS_AOF); bf16_t* AO = (bf16_t*)(p.ws + WS_AO);
#pragma unroll
            for (int ct = 0; ct < 2; ++ct) { const float lt = hsum(l[ct]); const float cw = lt > 0.f ? gate_of(U, rowb, tc[ct], L.head, 1 + br) / lt : 0.f;
                float* frow = AOF + (rowb + tc[ct]) * 512 + L.head * 64 + 4 * hi; bf16_t* orow = AO + (rowb + tc[ct]) * DM + 512 + L.head * 64 + 4 * hi;
#pragma unroll
                for (int d0 = 0; d0 < 2; ++d0) {
#pragma unroll
                    for (int k = 0; k < 4; ++k) { const f32x4 a = *(const f32x4*)(frow + 32 * d0 + 8 * k);
                        const f32x4 v = {a[0] + cw * o[ct][d0][4 * k], a[1] + cw * o[ct][d0][4 * k + 1], a[2] + cw * o[ct][d0][4 * k + 2], a[3] + cw * o[ct][d0][4 * k + 3]};
                        if (br == 0) *(f32x4*)(frow + 32 * d0 + 8 * k) = v;
                        else { u32x2 w2; w2.x = cvtpk(v[0], v[1]); w2.y = cvtpk(v[2], v[3]); *(u32x2*)(orow + 32 * d0 + 8 * k) = w2; } }
                    o[ct][d0] = (f32x16){}; } }
        }
        lds_fence();
    }
}
#undef NSA_CR
}

__device__ __forceinline__ float diff_lambda(const Params& p, int lane) {
    const float a = p.in[9][lane] * p.in[10][lane], c = p.in[11][lane] * p.in[12][lane];
    return __expf(wave_sum(a)) - __expf(wave_sum(c)) + 0.2f;
}
__device__ __forceinline__ void diffc_rows8(const Params& p, int row0, int lane, float lam) {
    const int h = lane >> 4, l16 = lane & 15;
    const bf16_t* oc = (const bf16_t*)(p.ws + WS_OC) + ((size_t)row0 * 4 + h) * 256 + 8 * l16;
    bf16_t* ao = (bf16_t*)(p.ws + WS_AO) + (size_t)row0 * DM + h * 128 + 8 * l16;
    const f32x4 g0 = *(const f32x4*)(p.in[13] + 8 * l16), g1 = *(const f32x4*)(p.in[13] + 8 * l16 + 4);
    const float g[8] = {g0.x * 0.8f, g0.y * 0.8f, g0.z * 0.8f, g0.w * 0.8f, g1.x * 0.8f, g1.y * 0.8f, g1.z * 0.8f, g1.w * 0.8f};
    u32x4 a[8], c[8];
#pragma unroll
    for (int i = 0; i < 8; ++i) { a[i] = *(const u32x4*)(oc + (size_t)i * 1024); c[i] = *(const u32x4*)(oc + (size_t)i * 1024 + 128); }
#pragma unroll
    for (int i = 0; i < 8; ++i) { float x[8], y[8]; unpack8(a[i], x); unpack8(c[i], y); float ss = 0.f;
#pragma unroll
        for (int e = 0; e < 8; ++e) { x[e] -= lam * y[e]; ss += x[e] * x[e]; }
        ss += nsa::quad_xor1(ss); ss += nsa::quad_xor2(ss);
        ss += __int_as_float(__builtin_amdgcn_update_dpp(0, __float_as_int(ss), 0x141, 0xf, 0xf, true));
        ss += __int_as_float(__builtin_amdgcn_update_dpp(0, __float_as_int(ss), 0x140, 0xf, 0xf, true));
        const float rstd = rsqrtf(ss * (1.f / 128.f) + 1e-6f);
        u32x4 o; o.x = pk2(x[0] * rstd * g[0], x[1] * rstd * g[1]); o.y = pk2(x[2] * rstd * g[2], x[3] * rstd * g[3]); o.z = pk2(x[4] * rstd * g[4], x[5] * rstd * g[5]); o.w = pk2(x[6] * rstd * g[6], x[7] * rstd * g[7]);
        *(u32x4*)(ao + (size_t)i * DM) = o; }
}

__device__ __forceinline__ void stage4(const Params& p, unsigned char* smem) {
    const int tid = opaque_tid(), wid = tid >> 6, lane = tid & 63;
    const int gw = blockIdx.x * NW + wid, NGW = gridDim.x * NW;
    for (int it = gw; it < 2048; it += NGW) nsa::item(p, smem + wid * nsa::WL_BYTES, it, lane);
    const float lam = diff_lambda(p, lane);
    for (int it = gw; it < M / 8; it += NGW) diffc_rows8(p, it * 8, lane, lam);
}

__device__ __forceinline__ void stage5(const Params& p, unsigned char* smem) {
    pg8::Gemm g{(const bf16_t*)(p.ws + WS_AO), DM};
    pg8::StaticOrder S; S.init(M, DM, gridDim.x, blockIdx.x, (const bf16_t*)(p.ws + WS_WTOUT));
    EpiBf16Out E{(bf16_t*)(p.ws + WS_MIX), DM, 0, 1.f, nullptr};
    pg8::gemm_phase((PG8_LAS unsigned char*)smem, g, S, E);
}

__device__ __forceinline__ void stage6(const Params& p, unsigned char* smem) {
    int tid_ = threadIdx.x; asm volatile("" : "+v"(tid_));
    const int tid = tid_, wid = tid >> 6, lane = tid & 63;
    const float* mod = (const float*)(p.ws + WS_MOD); const bf16_t* mix = (const bf16_t*)(p.ws + WS_MIX); const bf16x8* wrh = (const bf16x8*)(p.ws + WS_WR); const bf16x8* wrl = wrh + 1024 * 80 / 8;
    bf16_t* h2 = (bf16_t*)(p.ws + WS_H2); bf16_t* x1b = (bf16_t*)(p.ws + WS_MIX);
    int* cnt = (int*)(p.ws + WS_CTL) + CTL_CNT; int* toke = (int*)(p.ws + WS_TOKE); int* tokp = (int*)(p.ws + WS_TOKP); float* tokw = (float*)(p.ws + WS_TOKW);
    float* hq = (float*)smem;
    float* part = (float*)(smem + 65792);
    float* lgs = (float*)(smem + 65792 + 40960);
    for (int chunk = blockIdx.x; chunk < M / 64; chunk += gridDim.x) {
        const int row0 = chunk * 64, b = row0 / SEQ; const float* mb = mod + b * 6144;
        f32x4 ggt[4], gsc[4], shv[4];
#pragma unroll
        for (int j = 0; j < 4; ++j) { const int col = lane * 4 + 256 * j;
            ggt[j] = *(const f32x4*)(p.in[5] + col) * *(const f32x4*)(mb + 2048 + col);
            gsc[j] = *(const f32x4*)(p.in[6] + col) * (*(const f32x4*)(mb + 4096 + col) + 1.f);
            shv[j] = *(const f32x4*)(mb + 3072 + col); }
        u32x2 pm[2][4]; f32x4 px[2][4];
#define S6_LOAD(T) { _Pragma("unroll") for (int rr = 0; rr < 2; ++rr) { const size_t ro = (size_t)(row0 + 16 * (T) + 2 * wid + rr) * DM + lane * 4; \
            _Pragma("unroll") for (int j = 0; j < 4; ++j) { pm[rr][j] = *(const u32x2*)(mix + ro + 256 * j); px[rr][j] = *(const f32x4*)(p.in[0] + ro + 256 * j); } } }
        S6_LOAD(0)
#pragma unroll 1
        for (int t = 0; t < 4; ++t) {
#pragma unroll
            for (int rr = 0; rr < 2; ++rr) {
                const int lr = 2 * wid + rr, row = row0 + 16 * t + lr;
                f32x4 v[4], x1[4]; float ss = 0.f;
#pragma unroll
                for (int j = 0; j < 4; ++j) { const u32x2 mw = pm[rr][j];
                    v[j] = (f32x4){__uint_as_float(mw.x << 16), __uint_as_float(mw.x & 0xffff0000u), __uint_as_float(mw.y << 16), __uint_as_float(mw.y & 0xffff0000u)};
                    ss += v[j].x * v[j].x + v[j].y * v[j].y + v[j].z * v[j].z + v[j].w * v[j].w; }
                const float rstd = rsqrtf(wave_sum(ss) * (1.f / DM) + 1e-6f); float s2 = 0.f;
#pragma unroll
                for (int j = 0; j < 4; ++j) { const int col = lane * 4 + 256 * j;
                    x1[j] = px[rr][j] + ggt[j] * (v[j] * rstd);
                    { u32x2 xo; xo.x = pk2(x1[j].x, x1[j].y); xo.y = pk2(x1[j].z, x1[j].w); *(u32x2*)(x1b + (size_t)row * DM + col) = xo; }
                    s2 += x1[j].x * x1[j].x + x1[j].y * x1[j].y + x1[j].z * x1[j].z + x1[j].w * x1[j].w; }
                const float rstd2 = rsqrtf(wave_sum(s2) * (1.f / DM) + 1e-6f);
#pragma unroll
                for (int j = 0; j < 4; ++j) { const int col = lane * 4 + 256 * j;
                    const f32x4 h = x1[j] * rstd2 * gsc[j] + shv[j];
                    *(f32x4*)(hq + lr * 1028 + col) = h;
                    u32x2 o; o.x = pk2(h.x, h.y); o.y = pk2(h.z, h.w); *(u32x2*)(h2 + (size_t)row * DM + col) = o; }
            }
            if (t < 3) S6_LOAD(t + 1)
            __syncthreads();
            {
                const int r = lane & 15, q = lane >> 4;
                f32x4 acc[5];
#pragma unroll
                for (int j = 0; j < 5; ++j) acc[j] = (f32x4){0.f, 0.f, 0.f, 0.f};
#pragma unroll 2
                for (int s = 0; s < 4; ++s) {
                    const f32x4 a0 = *(const f32x4*)(hq + r * 1028 + 128 * wid + 32 * s + 8 * q), a1 = *(const f32x4*)(hq + r * 1028 + 128 * wid + 32 * s + 8 * q + 4);
                    u32x4 ahw, alw;
                    { const unsigned h0 = pk2(a0.x, a0.y), h1 = pk2(a0.z, a0.w), h2_ = pk2(a1.x, a1.y), h3 = pk2(a1.z, a1.w);
                      ahw = (u32x4){h0, h1, h2_, h3};
                      alw.x = pk2(a0.x - __uint_as_float(h0 << 16), a0.y - __uint_as_float(h0 & 0xffff0000u)); alw.y = pk2(a0.z - __uint_as_float(h1 << 16), a0.w - __uint_as_float(h1 & 0xffff0000u));
                      alw.z = pk2(a1.x - __uint_as_float(h2_ << 16), a1.y - __uint_as_float(h2_ & 0xffff0000u)); alw.w = pk2(a1.z - __uint_as_float(h3 << 16), a1.w - __uint_as_float(h3 & 0xffff0000u)); }
                    const bf16x8 ah = __builtin_bit_cast(bf16x8, ahw), al = __builtin_bit_cast(bf16x8, alw);
                    bf16x8 bh[5], bl[5];
#pragma unroll
                    for (int j = 0; j < 5; ++j) { bh[j] = wrh[((wid * 4 + s) * 5 + j) * 64 + lane]; bl[j] = wrl[((wid * 4 + s) * 5 + j) * 64 + lane]; }
#pragma unroll
                    for (int j = 0; j < 5; ++j) { acc[j] = __builtin_amdgcn_mfma_f32_16x16x32_bf16(ah, bh[j], acc[j], 0, 0, 0);
                        acc[j] = __builtin_amdgcn_mfma_f32_16x16x32_bf16(ah, bl[j], acc[j], 0, 0, 0); acc[j] = __builtin_amdgcn_mfma_f32_16x16x32_bf16(al, bh[j], acc[j], 0, 0, 0); }
                }
#pragma unroll
                for (int j = 0; j < 5; ++j)
#pragma unroll
                    for (int i = 0; i < 4; ++i) part[(wid * 16 + 4 * q + i) * 80 + 16 * j + r] = acc[j][i];
            }
            __syncthreads();
            for (int idx = tid; idx < 1280; idx += NT) { float s = 0.f;
#pragma unroll
                for (int w = 0; w < 8; ++w) s += part[w * 1280 + idx];
                lgs[t * 1280 + idx] = s; }
        }
#undef S6_LOAD
        __syncthreads();
        if (tid < 64) { const int t = row0 + tid; const float* lg = lgs + tid * 80;
            float best = -3e38f; int grp = 0; float l8[8];
#pragma unroll
            for (int i = 0; i < 8; ++i) { l8[i] = lg[64 + i] + p.in[22][i]; if (l8[i] > best) { best = l8[i]; grp = i; } }
            float den = 0.f;
#pragma unroll
            for (int i = 0; i < 8; ++i) den += __expf(l8[i] - best);
            const float pg = 1.f / den;
            float v1 = -3e38f, v2 = -3e38f; int i1 = 0, i2 = 0;
#pragma unroll
            for (int i = 0; i < 8; ++i) { const float v = lg[grp * 8 + i] + p.in[24][grp * 8 + i];
                if (v > v1) { v2 = v1; i2 = i1; v1 = v; i1 = i; } else if (v > v2) { v2 = v; i2 = i; } }
            const float e2 = __expf(v2 - v1), w1 = pg / (1.f + e2), w2 = pg * e2 / (1.f + e2);
            const int ea = grp * 8 + i1, eb = grp * 8 + i2;
            const int xg = chunk & 7;
            const int pa = atomicAdd(&cnt[(xg * 64 + ea) * 16], 1), pb = atomicAdd(&cnt[(xg * 64 + eb) * 16], 1);
            toke[t * 2] = ea; toke[t * 2 + 1] = eb; tokp[t * 2] = pa; tokp[t * 2 + 1] = pb; tokw[t * 2] = w1; tokw[t * 2 + 1] = w2;
            int* elist = (int*)(p.ws + WS_ELIST); elist[ea * 16384 + xg * 2048 + pa] = t; elist[eb * 16384 + xg * 2048 + pb] = t; }
        __syncthreads();
    }
}

__device__ __forceinline__ void expert_bases(const Params& p, int* lb) {
    const int* cntg = (const int*)(p.ws + WS_CTL) + CTL_CNT; int* cnt = lb + 768;
    __syncthreads();
    if (threadIdx.x < 64) { int s = 0;
        for (int x = 0; x < 8; ++x) { lb[832 + threadIdx.x * 8 + x] = s; s += cntg[(x * 64 + threadIdx.x) * 16]; }
        cnt[threadIdx.x] = s; }
    __syncthreads();
    if (threadIdx.x < 65) { int s = 0; for (int e = 0; e < (int)threadIdx.x; ++e) s += (cnt[e] + 255) / 256 * 256; lb[threadIdx.x] = threadIdx.x < 64 ? s : s / 256; }
    __syncthreads();
    if (threadIdx.x < 192) { const int tile = threadIdx.x; int e = 0;
        for (int i = 0; i < 64; ++i) if (lb[i] <= tile * 256 && cnt[i] > 0) e = i;
        lb[128 + tile] = e; lb[320 + tile] = (tile < lb[64] && (cnt[e] - (tile * 256 - lb[e])) <= 128) ? 1 : 0; }
    __syncthreads();
    if (threadIdx.x < 192) { const int tile = threadIdx.x, nt = lb[64];
        if (tile < nt) { int nfull = 0, fb = 0, hb = 0;
            for (int i = 0; i < nt; ++i) { const int h = lb[320 + i]; nfull += 1 - h; if (i < tile) { fb += 1 - h; hb += h; } }
            lb[512 + (lb[320 + tile] ? nfull + hb : fb)] = tile; } }
    __syncthreads();
}
__device__ __forceinline__ int xcd_major_id() { const int G = gridDim.x, c = blockIdx.x; return (G % 8 == 0) ? (c % 8) * (G / 8) + c / 8 : c; }
struct MoeOrder {
    int ntiles, nN, G, c; const int* lb; const char* wbase; size_t estride; const int* elist; const int* cnt;
    unsigned* sig;
    unsigned* wait;
    __device__ __forceinline__ bool next(int i, pg8::Unit& u) const {
        const int L = i * G + c; if (L >= ntiles * nN) return false;
        u.pm = lb[512 + L / nN]; u.pn = L % nN; const int e = lb[128 + u.pm]; u.bbase = wbase + (size_t)e * estride;
        u.half = lb[320 + u.pm]; return true; }
    __device__ __forceinline__ unsigned arow(const pg8::Unit& u, int r) const {
        if (elist) { const int e = lb[128 + u.pm], off = u.pm * 256 - lb[e] + r;
            if (off >= lb[768 + e]) return 0u;
            int x = 0;
#pragma unroll
            for (int i = 1; i < 8; ++i) x += (off >= lb[832 + e * 8 + i]) ? 1 : 0;
            return (unsigned)elist[e * 16384 + x * 2048 + (off - lb[832 + e * 8 + x])]; }
        return (unsigned)(u.pm * 256 + r); }
    __device__ __forceinline__ void a_ready(const pg8::Unit& u) const {
        if (!wait) return;
        unsigned sp = 0;
        while (__hip_atomic_load(wait + u.pm, __ATOMIC_RELAXED, __HIP_MEMORY_SCOPE_AGENT) < 4u) { __builtin_amdgcn_s_sleep(2); if (++sp > (1u << 22)) break; }
        __builtin_amdgcn_fence(__ATOMIC_ACQUIRE, "agent");
    }
    __device__ __forceinline__ void done(const pg8::Unit& u) const {
        if (!sig) return;
        asm volatile("s_waitcnt vmcnt(0)" ::: "memory");
        __builtin_amdgcn_s_barrier();
        if (threadIdx.x == 0) { __builtin_amdgcn_fence(__ATOMIC_RELEASE, "agent"); asm volatile("s_waitcnt vmcnt(0)" ::: "memory");
            (void)__hip_atomic_fetch_add(sig + u.pm, 1u, __ATOMIC_RELAXED, __HIP_MEMORY_SCOPE_AGENT); }
    }
};

struct EpiGateUp {
    static constexpr bool PERM = true;
    bf16_t* O;
    __device__ __forceinline__ void operator()(const f32x4 (&acc)[2][2][4][2], const pg8::Unit& u, int wr, int wc, int fr, int fq) const {
        const int row0 = u.pm * 256 + wr * 64 + fr, col0 = (u.pn * 256 + wc * 32 + 8 * fq) / 2;
#pragma unroll
        for (int ai = 0; ai < 2; ++ai) { if (ai == 1 && u.half) break;
#pragma unroll
            for (int m = 0; m < 4; ++m) { bf16_t* rowp = O + (size_t)(row0 + ai * 128 + m * 16) * 512 + col0;
#pragma unroll
                for (int bj = 0; bj < 2; ++bj) { const f32x4 v0 = acc[ai][bj][m][0], v1 = acc[ai][bj][m][1];
                    u32x2 w; w.x = pg8::cvt_pk_bf16(silu_f(v0[0]) * v0[1], silu_f(v0[2]) * v0[3]); w.y = pg8::cvt_pk_bf16(silu_f(v1[0]) * v1[1], silu_f(v1[2]) * v1[3]);
                    *(u32x2*)(rowp + bj * 64) = w; } } }
    }
};
__device__ __forceinline__ void stage10(const Params& p, unsigned char* smem) {
    int* lb = (int*)(smem + 131072); expert_bases(p, lb);
    pg8::Gemm g{(const bf16_t*)(p.ws + WS_H2), DM};
    MoeOrder S{lb[64], 4, (int)gridDim.x, xcd_major_id(), lb, (const char*)(p.ws + WS_WTGU), (size_t)1024 * 1024 * 2, (const int*)(p.ws + WS_ELIST), (const int*)(p.ws + WS_CTL), nullptr, nullptr};
    EpiGateUp E{(bf16_t*)(p.ws + WS_HID)};
    pg8::gemm_phase((PG8_LAS unsigned char*)smem, g, S, E);
}

__device__ __forceinline__ void stage11(const Params& p, unsigned char* smem) {
    int* lb = (int*)(smem + 131072); expert_bases(p, lb);
    pg8::Gemm g{(const bf16_t*)(p.ws + WS_HID), 512};
    MoeOrder S{lb[64], 4, (int)gridDim.x, xcd_major_id(), lb, (const char*)(p.ws + WS_WTDN), (size_t)1024 * 512 * 2, nullptr, (const int*)(p.ws + WS_CTL), nullptr, nullptr};
    EpiBf16Out E{(bf16_t*)(p.ws + WS_Y), DM, 0, 1.f, nullptr};
    pg8::gemm_phase((PG8_LAS unsigned char*)smem, g, S, E);
}

__device__ __forceinline__ void stage12(const Params& p, unsigned char* smem) {
    int* lb = (int*)(smem + 131072); expert_bases(p, lb);
    const int tid = opaque_tid(), wid = tid >> 6, lane = tid & 63;
    const float* mod = (const float*)(p.ws + WS_MOD); const bf16_t* Y = (const bf16_t*)(p.ws + WS_Y); const bf16_t* X1 = (const bf16_t*)(p.ws + WS_MIX);
    const int* toke = (const int*)(p.ws + WS_TOKE); const int* tokp = (const int*)(p.ws + WS_TOKP); const float* tokw = (const float*)(p.ws + WS_TOKW);
    for (int rg = blockIdx.x * NW + wid; rg < M / 8; rg += gridDim.x * NW) {
        const int rowb = rg * 8, b = rowb / SEQ, xg = (rowb >> 6) & 7;
        int yr = 0; float tw = 0.f;
        if (lane < 16) { const int te = toke[rowb * 2 + lane]; yr = lb[te] + lb[832 + te * 8 + xg] + tokp[rowb * 2 + lane]; tw = tokw[rowb * 2 + lane]; }
        f32x4 ggt[2][2];
#pragma unroll
        for (int j = 0; j < 2; ++j)
#pragma unroll
            for (int h = 0; h < 2; ++h) { const int col = lane * 8 + 512 * j + 4 * h; ggt[j][h] = *(const f32x4*)(p.in[7] + col) * *(const f32x4*)(mod + b * 6144 + 5120 + col); }
        u32x4 ya[2][2], yb[2][2], xv[2][2];
#define S12_LOAD(I, BF) { const int r0 = __builtin_amdgcn_readlane(yr, 2 * (I)), r1 = __builtin_amdgcn_readlane(yr, 2 * (I) + 1); \
            _Pragma("unroll") for (int j = 0; j < 2; ++j) { const int col = lane * 8 + 512 * j; \
                ya[BF][j] = *(const u32x4*)(Y + (size_t)r0 * DM + col); yb[BF][j] = *(const u32x4*)(Y + (size_t)r1 * DM + col); \
                xv[BF][j] = *(const u32x4*)(X1 + (size_t)(rowb + (I)) * DM + col); } }
        S12_LOAD(0, 0)
#pragma unroll
        for (int i = 0; i < 8; ++i) {
            if (i + 1 < 8) { if ((i + 1) & 1) S12_LOAD(i + 1, 1) else S12_LOAD(i + 1, 0) }
            const float w0 = __int_as_float(__builtin_amdgcn_readlane(__float_as_int(tw), 2 * i)), w1 = __int_as_float(__builtin_amdgcn_readlane(__float_as_int(tw), 2 * i + 1));
            float f[2][8], xf[2][8]; float ss = 0.f;
#pragma unroll
            for (int j = 0; j < 2; ++j) { float a[8], c[8]; unpack8(ya[i & 1][j], a); unpack8(yb[i & 1][j], c); unpack8(xv[i & 1][j], xf[j]);
#pragma unroll
                for (int e = 0; e < 8; ++e) { f[j][e] = a[e] * w0 + c[e] * w1; ss += f[j][e] * f[j][e]; } }
            const float rstd = rsqrtf(wave_sum(ss) * (1.f / DM) + 1e-6f);
#pragma unroll
            for (int j = 0; j < 2; ++j)
#pragma unroll
                for (int h = 0; h < 2; ++h) { const int col = lane * 8 + 512 * j + 4 * h;
                    const f32x4 fv = {f[j][4 * h], f[j][4 * h + 1], f[j][4 * h + 2], f[j][4 * h + 3]};
                    const f32x4 xq = {xf[j][4 * h], xf[j][4 * h + 1], xf[j][4 * h + 2], xf[j][4 * h + 3]};
                    *(f32x4*)(p.out + (size_t)(rowb + i) * DM + col) = xq + ggt[j][h] * (fv * rstd); }
        }
#undef S12_LOAD
    }
}

#define GAS __attribute__((address_space(1)))
#define LAS __attribute__((address_space(3)))
#define XB_TMO      128
#define XB_XCNT(j)  (256  + 64 * (j))
#define XB_XSUB(j)  (1280 + 64 * (j))
#define XB_XGEN(j)  (2304 + 64 * (j))
#define XB_TOP      3328
#define XB_TOPGEN   3392
#define XCD_BAR_WORDS 3456
#define XB_SPIN_CAP (1u << 18)
__device__ __forceinline__ unsigned xb_ld(unsigned* p)              { return __hip_atomic_load(p, __ATOMIC_RELAXED, __HIP_MEMORY_SCOPE_AGENT); }
__device__ __forceinline__ unsigned xb_add(unsigned* p, unsigned v) { return __hip_atomic_fetch_add(p, v, __ATOMIC_RELAXED, __HIP_MEMORY_SCOPE_AGENT); }
__device__ __forceinline__ unsigned xb_xcc_id() { return (unsigned)__builtin_amdgcn_s_getreg((3 << 11) | 20) & 0xFu; }
#define XB_SPIN(cond, bar) do { unsigned _sp = 0; while (cond) { __builtin_amdgcn_s_sleep(1); \
    if ((++_sp & 255u) == 0u) { if (xb_ld(&(bar)[XB_TMO])) break; if (_sp > XB_SPIN_CAP) { atomicAdd(&(bar)[XB_TMO], 1u); break; } } } } while (0)
struct XcdBarrier { unsigned* bar; unsigned x; volatile LAS unsigned* st; };
__device__ __forceinline__ XcdBarrier xcd_barrier_post(unsigned* bar, volatile LAS unsigned* st) {
    XcdBarrier b; b.bar = bar; b.x = xb_xcc_id(); b.st = st;
    if (threadIdx.x == 0) (void)xb_add(&bar[XB_XCNT(b.x)], 1u);
    return b;
}
__device__ __forceinline__ void xcd_barrier_complete(unsigned* bar, unsigned x, unsigned& nloc, unsigned& nx) {
    const unsigned G = gridDim.x * gridDim.y * gridDim.z;
    unsigned sum, cnt, mine, sp = 0u;
    for (;;) {
        sum = 0u; cnt = 0u; mine = 0u;
#pragma unroll
        for (unsigned j = 0; j < 16; ++j) { const unsigned c = xb_ld(&bar[XB_XCNT(j)]); sum += c; cnt += (c > 0u) ? 1u : 0u; mine = (j == x) ? c : mine; }
        if (sum == G) break;
        __builtin_amdgcn_s_sleep(1);
        if ((++sp & 255u) == 0u) { if (xb_ld(&bar[XB_TMO])) break; if (sp > XB_SPIN_CAP) { atomicAdd(&bar[XB_TMO], 1u); break; } }
    }
    nloc = mine > 0u ? mine : 1u; nx = cnt > 0u ? cnt : 1u;
}
__device__ __forceinline__ void xcd_barrier(const XcdBarrier& b) {
    asm volatile("s_waitcnt vmcnt(0)" ::: "memory");
    __syncthreads();
    if (threadIdx.x == 0) {
        unsigned* bar = b.bar;
        __builtin_amdgcn_s_waitcnt(0);
        unsigned nloc = b.st[0], nx = b.st[1];
        if (nloc == 0u) { xcd_barrier_complete(bar, b.x, nloc, nx); b.st[0] = nloc; b.st[1] = nx; }
        const unsigned old = xb_add(&bar[XB_XSUB(b.x)], 1u);
        const unsigned gen = old / nloc;
        if (old + 1u == (gen + 1u) * nloc) {
            __builtin_amdgcn_fence(__ATOMIC_RELEASE, "agent");
            asm volatile("s_waitcnt vmcnt(0)" ::: "memory");
            const unsigned og = xb_add(&bar[XB_TOP], 1u);
            const unsigned tg = og / nx;
            if (og + 1u == (tg + 1u) * nx) xb_add(&bar[XB_TOPGEN], 1u);
            else XB_SPIN(xb_ld(&bar[XB_TOPGEN]) == tg, bar);
            __builtin_amdgcn_fence(__ATOMIC_ACQUIRE, "agent");
            xb_add(&bar[XB_XGEN(b.x)], 1u);
            asm volatile("s_waitcnt vmcnt(0)" ::: "memory");
        } else {
            XB_SPIN(xb_ld(&bar[XB_XGEN(b.x)]) == gen, bar);
            __builtin_amdgcn_fence(__ATOMIC_ACQUIRE, "agent");
            asm volatile("s_waitcnt vmcnt(0)" ::: "memory");
        }
    }
    __syncthreads();
}

__device__ __forceinline__ void ctr_barrier(unsigned* base, unsigned epoch) {
    asm volatile("s_waitcnt vmcnt(0)" ::: "memory");
    __syncthreads();
    if (threadIdx.x == 0) {
        __builtin_amdgcn_fence(__ATOMIC_RELEASE, "agent");
        asm volatile("s_waitcnt vmcnt(0)" ::: "memory");
        const unsigned G = gridDim.x, ngrp = (G % 8u == 0u) ? 8u : 1u, g = blockIdx.x % ngrp, per = G / ngrp;
        unsigned* sub = base + 64u * g; unsigned* gen = base + 64u * (8u + g); unsigned* top = base + 64u * 16u;
        const unsigned old = __hip_atomic_fetch_add(sub, 1u, __ATOMIC_RELAXED, __HIP_MEMORY_SCOPE_AGENT);
        if (old + 1u == epoch * per) {
            const unsigned ot = __hip_atomic_fetch_add(top, 1u, __ATOMIC_RELAXED, __HIP_MEMORY_SCOPE_AGENT);
            if (ot + 1u == epoch * ngrp) { for (unsigned j = 0; j < ngrp; ++j) __hip_atomic_store(base + 64u * (8u + j), epoch, __ATOMIC_RELAXED, __HIP_MEMORY_SCOPE_AGENT); }
        }
        unsigned sp = 0;
        while (__hip_atomic_load(gen, __ATOMIC_RELAXED, __HIP_MEMORY_SCOPE_AGENT) < epoch) { __builtin_amdgcn_s_sleep(1); if (++sp > (1u << 22)) break; }
        __builtin_amdgcn_fence(__ATOMIC_ACQUIRE, "agent");
        asm volatile("s_waitcnt vmcnt(0)" ::: "memory");
    }
    __syncthreads();
}
constexpr int NSTAGE = 13;
template <int S> __device__ __forceinline__ void run_stage(const Params& p, unsigned char* smem) {
    if constexpr (S == 0) stage0(p, smem);
    else if constexpr (S == 1) stage1(p);
    else if constexpr (S == 2) stage2(p, smem);
    else if constexpr (S == 3) stage3(p, smem);
    else if constexpr (S == 4) stage4(p, smem);
    else if constexpr (S == 5) stage5(p, smem);
    else if constexpr (S == 6) stage6(p, smem);
    else if constexpr (S == 10) stage10(p, smem);
    else if constexpr (S == 11) stage11(p, smem);
    else if constexpr (S == 12) stage12(p, smem);
}
typedef const __attribute__((address_space(4))) Params* KParams;
template <int S> __device__ __forceinline__ void run_stage_k(unsigned char* smem) {
    KParams kp = (KParams)__builtin_amdgcn_kernarg_segment_ptr();
    asm volatile("" : "+s"(kp));
    Params lp;
#pragma unroll
    for (int i = 0; i < 28; ++i) lp.in[i] = kp->in[i];
    lp.out = kp->out; lp.ws = kp->ws;
    run_stage<S>(lp, smem);
}
#if MK_FUSED
constexpr int CTL_BAR_WORD = 4096;
constexpr int CTL_ZERO_BYTES = 65536 + 49152;
__global__ void __launch_bounds__(NT, 2) mk(Params p) {
    extern __shared__ __attribute__((aligned(16))) unsigned char smem[];
#define CTR() ((unsigned*)(((KParams)__builtin_amdgcn_kernarg_segment_ptr())->ws + WS_CTL) + CTL_BAR_WORD)
    run_stage_k<0>(smem); ctr_barrier(CTR(), 1u);
    run_stage_k<1>(smem); ctr_barrier(CTR(), 2u);
    run_stage_k<2>(smem); ctr_barrier(CTR(), 3u);
    run_stage_k<3>(smem); ctr_barrier(CTR(), 4u);
    run_stage_k<4>(smem); ctr_barrier(CTR(), 5u);
    run_stage_k<5>(smem); ctr_barrier(CTR(), 6u);
    run_stage_k<6>(smem); ctr_barrier(CTR(), 7u);
    run_stage_k<10>(smem); ctr_barrier(CTR(), 8u);
    run_stage_k<11>(smem); ctr_barrier(CTR(), 9u);
    run_stage_k<12>(smem);
#undef CTR
}
#else
template <int S> __global__ void __launch_bounds__(NT, 2) mk1(Params p) {
    extern __shared__ __attribute__((aligned(16))) unsigned char smem[];
    run_stage<S>(p, smem);
}
template <int S> static void launch_stage(const Params& p, int cus, hipStream_t stream) {
    static int grid = 0;
    if (grid == 0) { int per_cu = 0;
        (void)hipFuncSetAttribute((const void*)mk1<S>, hipFuncAttributeMaxDynamicSharedMemorySize, LDS_BYTES);
        (void)hipOccupancyMaxActiveBlocksPerMultiprocessor(&per_cu, (const void*)mk1<S>, NT, LDS_BYTES);
        if (per_cu < 1) per_cu = 1;
        grid = cus * per_cu; (void)hipGetLastError(); }
    hipLaunchKernelGGL(mk1<S>, dim3(grid), dim3(NT), LDS_BYTES, stream, p);
}
#endif

extern "C" void kernel_launch(void* const* d_in, const int* in_sizes, int n_in, void* d_out, int out_size, void* d_ws, size_t ws_size, hipStream_t stream) {
    static int grid = 0, cus = 0;
    if (grid == 0) {
        if (n_in != 28 || out_size != M * DM || ws_size < WS_END) { fprintf(stderr, "kernel_launch: unexpected shapes (n_in %d out %d ws %zu)\n", n_in, out_size, ws_size); grid = -1; return; }
        int dev = 0;
        (void)hipGetDevice(&dev); (void)hipDeviceGetAttribute(&cus, hipDeviceAttributeMultiprocessorCount, dev);
        grid = cus;
#if MK_FUSED
        int per_cu = 0;
        (void)hipFuncSetAttribute((const void*)mk, hipFuncAttributeMaxDynamicSharedMemorySize, LDS_BYTES);
        (void)hipOccupancyMaxActiveBlocksPerMultiprocessor(&per_cu, (const void*)mk, NT, LDS_BYTES);
        if (per_cu < 1) fprintf(stderr, "kernel_launch: occupancy query reports %d workgroups per CU\n", per_cu);
        grid = cus;
#endif
        (void)hipGetLastError();
    }
    if (grid < 0) return;
    Params p{};
    for (int i = 0; i < 28; ++i) p.in[i] = (const float*)d_in[i];
    p.out = (float*)d_out; p.ws = (unsigned char*)d_ws;
#if MK_FUSED
    (void)hipMemsetAsync((char*)d_ws + WS_CTL, 0, CTL_ZERO_BYTES, stream);
    hipLaunchKernelGGL(mk, dim3(grid), dim3(NT), LDS_BYTES, stream, p);
#else
    (void)hipMemsetAsync((char*)d_ws + WS_CTL, 0, 65536 + 49152, stream);
    launch_stage<0>(p, cus, stream); launch_stage<1>(p, cus, stream); launch_stage<2>(p, cus, stream); launch_stage<3>(p, cus, stream);
    launch_stage<4>(p, cus, stream); launch_stage<5>(p, cus, stream); launch_stage<6>(p, cus, stream);
    launch_stage<10>(p, cus, stream); launch_stage<11>(p, cus, stream);
    launch_stage<12>(p, cus, stream);
#endif
}
```

```cpp
#include <hip/hip_runtime.h>
#include <hip/hip_cooperative_groups.h>
#include <cstdio>
#include <cstdint>
namespace cg = cooperative_groups;

#ifndef MK_FUSED
#define MK_FUSED 1
#endif

typedef unsigned short bf16_t;
typedef short bf16x8 __attribute__((ext_vector_type(8)));
typedef float f32x4 __attribute__((ext_vector_type(4)));
typedef unsigned u32x4 __attribute__((ext_vector_type(4)));
typedef unsigned u32x2 __attribute__((ext_vector_type(2)));

constexpr int NT = 512, NW = 8;
constexpr int BATCH = 2, SEQ = 8192, DM = 1024, M = BATCH * SEQ;
constexpr int UC = 3072, IN_COLS = 2840;
constexpr int C_DQ = 0, C_DK = 512, C_DV = 1024, C_NQ = 1536, C_CK = 2048, C_CV = 2176, C_SK = 2304, C_SV = 2432, C_WK = 2560, C_WV = 2688, C_NG = 2816;
constexpr int NEXP = 64, RMAX = 49152, NCMP = 511;
constexpr int LDS_BYTES = 147456;

constexpr size_t MiB = 1u << 20;
constexpr size_t WS_CTL = 0;
constexpr size_t WS_MOD = 65536;
constexpr size_t WS_KC = 2 * MiB;
constexpr size_t WS_VC = 3 * MiB;
constexpr size_t WS_ELIST = 4 * MiB;
constexpr size_t WS_TOKE = 10 * MiB;
constexpr size_t WS_TOKP = WS_TOKE + 128 * 1024;
constexpr size_t WS_TOKW = WS_TOKP + 128 * 1024;
constexpr size_t WS_TOKR = WS_TOKW + 128 * 1024;
constexpr size_t WS_ROWT = 11 * MiB;
constexpr size_t WS_WR = 14 * MiB;
constexpr size_t WS_W1T = 14 * MiB + 512 * 1024;
constexpr size_t WS_W2T = 15 * MiB + 512 * 1024;
constexpr int CTL_NORM = 384;
constexpr int CTL_CNT = 8192;
constexpr int CTL_TREADY = 1024;
constexpr int CTL_TQ = 320;
constexpr int CTL_QHEAD = 448;
constexpr size_t WS_B1P = 15 * MiB + 768 * 1024;
constexpr size_t WS_WTIN = 16 * MiB;
constexpr size_t WS_WTOUT = 22 * MiB;
constexpr size_t WS_WTGU = 24 * MiB;
constexpr size_t WS_WTDN = 152 * MiB;
constexpr size_t WS_XN = 216 * MiB;
constexpr size_t WS_U = 248 * MiB;
constexpr size_t WS_OC = 344 * MiB;
constexpr size_t WS_AO = 408 * MiB;
constexpr size_t WS_MIX = 440 * MiB;
constexpr size_t WS_KFS = 440 * MiB, WS_KFW = 444 * MiB, WS_VFS = 448 * MiB, WS_VFW = 452 * MiB;
constexpr size_t WS_AOF = 456 * MiB;
constexpr size_t WS_H2 = WS_XN;
constexpr size_t WS_H2F = WS_OC;
constexpr size_t WS_HID = WS_U;
constexpr size_t WS_Y = 296 * MiB;
constexpr size_t WS_END = 504 * MiB;

struct Params { const float* in[28]; float* out; unsigned char* ws; };

__device__ __forceinline__ int opaque_tid() { int t = threadIdx.x; asm volatile("" : "+v"(t)); return t; }
__device__ __forceinline__ float bf2f(bf16_t v) { return __uint_as_float(((unsigned)v) << 16); }
__device__ __forceinline__ bf16_t f2bf(float f) { unsigned u = __float_as_uint(f); return (bf16_t)((u + 0x7fffu + ((u >> 16) & 1u)) >> 16); }
__device__ __forceinline__ unsigned pk2(float lo, float hi) { return (unsigned)f2bf(lo) | ((unsigned)f2bf(hi) << 16); }
__device__ __forceinline__ float wave_sum(float v) {
    v += __int_as_float(__builtin_amdgcn_update_dpp(0, __float_as_int(v), 0xB1, 0xF, 0xF, true));
    v += __int_as_float(__builtin_amdgcn_update_dpp(0, __float_as_int(v), 0x4E, 0xF, 0xF, true));
    v += __int_as_float(__builtin_amdgcn_update_dpp(0, __float_as_int(v), 0x141, 0xF, 0xF, true));
    v += __int_as_float(__builtin_amdgcn_update_dpp(0, __float_as_int(v), 0x140, 0xF, 0xF, true));
    const float r0 = __int_as_float(__builtin_amdgcn_readlane(__float_as_int(v), 0)), r1 = __int_as_float(__builtin_amdgcn_readlane(__float_as_int(v), 16));
    const float r2 = __int_as_float(__builtin_amdgcn_readlane(__float_as_int(v), 32)), r3 = __int_as_float(__builtin_amdgcn_readlane(__float_as_int(v), 48));
    return (r0 + r1) + (r2 + r3);
}
__device__ __forceinline__ float wave_max(float v) {
#pragma unroll
    for (int o = 32; o > 0; o >>= 1) v = fmaxf(v, __shfl_xor(v, o));
    return v;
}
__device__ __forceinline__ void lds_fence() { asm volatile("s_waitcnt lgkmcnt(0)" ::: "memory"); }
__device__ __forceinline__ float silu_f(float x) { return x / (1.f + __expf(-x)); }
__device__ __forceinline__ float gelu_tanh(float x) { return 0.5f * x * (1.f + tanhf(0.7978845608028654f * (x + 0.044715f * x * x * x))); }
__device__ __forceinline__ void unpack8(const u32x4 w, float* v) {
    v[0] = __uint_as_float(w.x << 16); v[1] = __uint_as_float(w.x & 0xffff0000u);
    v[2] = __uint_as_float(w.y << 16); v[3] = __uint_as_float(w.y & 0xffff0000u);
    v[4] = __uint_as_float(w.z << 16); v[5] = __uint_as_float(w.z & 0xffff0000u);
    v[6] = __uint_as_float(w.w << 16); v[7] = __uint_as_float(w.w & 0xffff0000u);
}

template <class AF, class Epi>
__device__ __forceinline__ void gemm128(const AF& arow, const bf16_t* Bt, int K, const Epi& epi) {
    const int tid = threadIdx.x, wid = tid >> 6, lane = tid & 63, fr = lane & 15, fq = lane >> 4, wr = wid >> 2, wc = wid & 3;
    const bf16_t* ap[4]; const bf16_t* bp[2];
#pragma unroll
    for (int m = 0; m < 4; ++m) ap[m] = arow(wr * 64 + m * 16 + fr) + fq * 8;
#pragma unroll
    for (int n = 0; n < 2; ++n) bp[n] = Bt + (size_t)(wc * 32 + n * 16 + fr) * K + fq * 8;
    f32x4 acc[4][2];
#pragma unroll
    for (int m = 0; m < 4; ++m)
#pragma unroll
        for (int n = 0; n < 2; ++n) acc[m][n] = (f32x4){0.f, 0.f, 0.f, 0.f};
#pragma unroll 2
    for (int k0 = 0; k0 < K; k0 += 32) {
        bf16x8 a[4], b[2];
#pragma unroll
        for (int m = 0; m < 4; ++m) a[m] = *(const bf16x8*)(ap[m] + k0);
#pragma unroll
        for (int n = 0; n < 2; ++n) b[n] = *(const bf16x8*)(bp[n] + k0);
#pragma unroll
        for (int m = 0; m < 4; ++m)
#pragma unroll
            for (int n = 0; n < 2; ++n) acc[m][n] = __builtin_amdgcn_mfma_f32_16x16x32_bf16(b[n], a[m], acc[m][n], 0, 0, 0);
    }
#pragma unroll
    for (int m = 0; m < 4; ++m)
#pragma unroll
        for (int n = 0; n < 2; ++n) epi(wr * 64 + m * 16 + fr, wc * 32 + n * 16 + fq * 4, acc[m][n]);
}


namespace pg8 {
#define PG8_LAS __attribute__((address_space(3)))
constexpr int BM = 256, BK = 64, HALF = 128, HTB = HALF * BK * 2, STAGE_BYTES = 8 * HTB, NXCD = 8, WGM = 8;
__host__ __device__ __forceinline__ int lds_byte(int r, int c) { const int st = (r >> 4) * 2 + (c >> 5), rr = r & 15, cc = c & 31, ob = rr * 64 + cc * 2; return st * 1024 + (ob ^ (((ob >> 9) & 1) << 5)); }
__host__ __device__ __forceinline__ void stage_rc(int b, int& R, int& C) { const int st = b / 1024, sb = b % 1024, swz = sb ^ (((sb >> 9) & 1) << 5); R = (st >> 1) * 16 + swz / 64; C = (st & 1) * 32 + (swz % 64) / 2; }
__host__ __device__ __forceinline__ int perm32(int rho) { const int n = rho >> 4, i = rho & 15; return 8 * (i >> 2) + 4 * n + (i & 3); }

struct Unit { int pm, pn; const char* bbase; int half; };
struct Gemm { const bf16_t* A; int K; };

struct StaticOrder {
    int nM, nN, nwg, G, c; const char* bt;
    __device__ void init(int Mr, int N, int G_, int c_, const bf16_t* Bt) { nM = Mr / BM; nN = N / BM; nwg = nM * nN; G = G_; c = c_; bt = (const char*)Bt; }
    __device__ bool next(int i, Unit& u) const {
        const long L = (long)i * G + c; if (L >= nwg) return false;
        int wgid = (int)L; { const int q = nwg / NXCD, r = nwg % NXCD, xcd = wgid % NXCD, off = wgid / NXCD; wgid = (xcd < r ? xcd * (q + 1) : r * (q + 1) + (xcd - r) * q) + off; }
        const int nig = WGM * nN, gid = wgid / nig, fm = gid * WGM, gsz = (nM - fm) < WGM ? (nM - fm) : WGM;
        u.pm = fm + ((wgid % nig) % gsz); u.pn = (wgid % nig) / gsz; u.bbase = bt; u.half = 0; return true;
    }
    __device__ __forceinline__ unsigned arow(const Unit& u, int r) const { return (unsigned)(u.pm * BM + r); }
    __device__ __forceinline__ void a_ready(const Unit&) const {}
    __device__ __forceinline__ void done(const Unit&) const {}
};

__device__ __forceinline__ unsigned cvt_pk_bf16(float lo, float hi) { unsigned r; asm volatile("v_cvt_pk_bf16_f32 %0, %1, %2" : "=v"(r) : "v"(lo), "v"(hi)); return r; }

template <class Epi, class Sched>
__device__ __forceinline__ void gemm_phase(PG8_LAS unsigned char* lds, const Gemm g, const Sched& S, const Epi& E) {
    int tid_ = threadIdx.x; asm volatile("" : "+v"(tid_));
    const int tid = tid_, wid = __builtin_amdgcn_readfirstlane(tid >> 6), lane = tid & 63, wr = wid >> 2, wc = wid & 3, fr = lane & 15, fq = lane >> 4;
    const int K = g.K, nt = K / BK;
    int RA[2], CA[2]; unsigned voffB[2];
#pragma unroll
    for (int i = 0; i < 2; ++i) { int R, C; stage_rc(tid * 16 + i * 8192, R, C); const int Rb = Epi::PERM ? ((R & ~31) + perm32(R & 31)) : R;
        RA[i] = R; CA[i] = C; voffB[i] = (unsigned)(Rb * K + C) * 2u; }
    const size_t kstep = (size_t)(BK * 2);
    const size_t hstep = (size_t)HALF * K * 2;
    const size_t tstep = 2 * hstep;
    const unsigned ldsw = (unsigned)wid * 1024u;
    const int aoff = lds_byte(wr * 64 + fr, fq * 8), boff = lds_byte(wc * 32 + fr, fq * 8);
    const char* Abase = (const char*)g.A;
#define PG8_SA(b, h) (((b) * 2 + (h)) * HTB)
#define PG8_SB(b, h) ((4 + (b) * 2 + (h)) * HTB)
#define PG8_STAGE(bufoff, gbase, voff) do { _Pragma("unroll") for (int _i = 0; _i < 2; ++_i) \
        __builtin_amdgcn_global_load_lds((const unsigned*)((const char*)(gbase) + (voff)[_i]), (PG8_LAS unsigned*)(lds + (bufoff) + ldsw + _i * 8192), 16, 0, 0); } while (0)
#define PG8_LDA(dst, b, h) do { _Pragma("unroll") for (int m = 0; m < 4; ++m) _Pragma("unroll") for (int k = 0; k < 2; ++k) dst[m][k] = *(const PG8_LAS bf16x8*)(lds + PG8_SA(b, h) + aoff + m * 2048 + k * 1024); } while (0)
#define PG8_LDB(dst, b, h) do { _Pragma("unroll") for (int n = 0; n < 2; ++n) _Pragma("unroll") for (int k = 0; k < 2; ++k) dst[n][k] = *(const PG8_LAS bf16x8*)(lds + PG8_SB(b, h) + boff + n * 2048 + k * 1024); } while (0)
#define PG8_MMA(ai, bj, At, Bt) do { __builtin_amdgcn_s_setprio(1); _Pragma("unroll") for (int m = 0; m < 4; ++m) _Pragma("unroll") for (int n = 0; n < 2; ++n) _Pragma("unroll") for (int k = 0; k < 2; ++k) \
        acc[ai][bj][m][n] = __builtin_amdgcn_mfma_f32_16x16x32_bf16(Bt[n][k], At[m][k], acc[ai][bj][m][n], 0, 0, 0); __builtin_amdgcn_s_setprio(0); } while (0)
#define PG8_WAIT_V(n) asm volatile("s_waitcnt vmcnt(" #n ")" ::: "memory")
#define PG8_WAIT_L(n) asm volatile("s_waitcnt lgkmcnt(" #n ")" ::: "memory")
#define PG8_BAR __builtin_amdgcn_s_barrier()
#define PG8_SCHED __builtin_amdgcn_sched_barrier(0)
#define PG8_AOFFS(dst, u) do { _Pragma("unroll") for (int _h = 0; _h < 2; ++_h) _Pragma("unroll") for (int _i = 0; _i < 2; ++_i) \
        dst[_h][_i] = (S.arow(u, _h * HALF + RA[_i]) * (unsigned)K + (unsigned)CA[_i]) * 2u; } while (0)
    Unit cur, nxt; int ui = 0;
    if (!S.next(0, cur)) return;
    f32x4 acc[2][2][4][2];
#pragma unroll
    for (int a = 0; a < 2; ++a)
#pragma unroll
        for (int b = 0; b < 2; ++b)
#pragma unroll
            for (int m = 0; m < 4; ++m)
#pragma unroll
                for (int n = 0; n < 2; ++n) acc[a][b][m][n] = (f32x4){0.f, 0.f, 0.f, 0.f};
    bf16x8 At[4][2], B0[2][2], B1[2][2];
    unsigned ca[2][2], na[2][2];
    S.a_ready(cur);
    PG8_AOFFS(ca, cur);
    const char* cB = cur.bbase + (size_t)cur.pn * tstep;
    PG8_STAGE(PG8_SB(0, 0), cB, voffB); PG8_STAGE(PG8_SB(0, 1), cB + hstep, voffB); PG8_STAGE(PG8_SA(0, 0), Abase, ca[0]); PG8_STAGE(PG8_SA(0, 1), Abase, ca[1]);
    if (wr == 1) PG8_BAR;
    PG8_WAIT_V(2); PG8_BAR;
    PG8_STAGE(PG8_SB(1, 0), cB + kstep, voffB); PG8_STAGE(PG8_SA(1, 0), Abase + kstep, ca[0]); PG8_STAGE(PG8_SB(1, 1), cB + hstep + kstep, voffB);
    PG8_WAIT_V(6); PG8_BAR;
    for (;;) {
        const bool has_next = S.next(ui + 1, nxt);
        if (has_next) { PG8_AOFFS(na, nxt); } else {
#pragma unroll
            for (int _h = 0; _h < 2; ++_h)
#pragma unroll
                for (int _i = 0; _i < 2; ++_i) na[_h][_i] = ca[_h][_i]; }
        const char* nB = has_next ? nxt.bbase + (size_t)nxt.pn * tstep : cB;
        const bool full = cur.half == 0;
        for (int t = 0; t < nt; t += 2) {
            const bool last = (t == nt - 2);
            if (last && has_next) S.a_ready(nxt);
            const char* a1 = Abase + (size_t)(t + 1) * kstep;
            const char* a2 = last ? Abase : Abase + (size_t)(t + 2) * kstep; const char* b2 = last ? nB : cB + (size_t)(t + 2) * kstep;
            const char* a3 = a2 + kstep; const char* b3 = b2 + kstep;
            unsigned o2[2][2];
#pragma unroll
            for (int _h = 0; _h < 2; ++_h)
#pragma unroll
                for (int _i = 0; _i < 2; ++_i) o2[_h][_i] = last ? na[_h][_i] : ca[_h][_i];
            PG8_LDB(B0, 0, 0); PG8_LDB(B1, 0, 1); PG8_SCHED; PG8_LDA(At, 0, 0); PG8_STAGE(PG8_SA(1, 1), a1, ca[1]);
            PG8_WAIT_V(8); PG8_WAIT_L(0); PG8_BAR; PG8_MMA(0, 0, At, B0); PG8_MMA(0, 1, At, B1); PG8_BAR; PG8_SCHED;
            PG8_LDA(At, 0, 1); PG8_STAGE(PG8_SB(0, 0), b2, voffB); PG8_STAGE(PG8_SB(0, 1), b2 + hstep, voffB); PG8_STAGE(PG8_SA(0, 0), a2, o2[0]);
            PG8_WAIT_V(8); PG8_WAIT_L(0); PG8_BAR; if (full) { PG8_MMA(1, 0, At, B0); PG8_MMA(1, 1, At, B1); } PG8_BAR; PG8_SCHED;
            PG8_LDB(B0, 1, 0); PG8_LDB(B1, 1, 1); PG8_SCHED; PG8_LDA(At, 1, 0); PG8_STAGE(PG8_SA(0, 1), a2, o2[1]);
            PG8_WAIT_V(8); PG8_WAIT_L(0); PG8_BAR; PG8_MMA(0, 0, At, B0); PG8_MMA(0, 1, At, B1); PG8_BAR; PG8_SCHED;
            PG8_LDA(At, 1, 1); PG8_STAGE(PG8_SB(1, 0), b3, voffB); PG8_STAGE(PG8_SB(1, 1), b3 + hstep, voffB); PG8_STAGE(PG8_SA(1, 0), a3, o2[0]);
            PG8_WAIT_V(8); PG8_WAIT_L(0); PG8_BAR; if (full) { PG8_MMA(1, 0, At, B0); PG8_MMA(1, 1, At, B1); } PG8_BAR; PG8_SCHED;
        }
        if (wr == 0) PG8_BAR;
        E(acc, cur, wr, wc, fr, fq);
        S.done(cur);
        if (!has_next) break;
#pragma unroll
        for (int a = 0; a < 2; ++a)
#pragma unroll
            for (int b = 0; b < 2; ++b)
#pragma unroll
                for (int m = 0; m < 4; ++m)
#pragma unroll
                    for (int n = 0; n < 2; ++n) acc[a][b][m][n] = (f32x4){0.f, 0.f, 0.f, 0.f};
        cur = nxt; cB = nB; ++ui;
#pragma unroll
        for (int _h = 0; _h < 2; ++_h)
#pragma unroll
            for (int _i = 0; _i < 2; ++_i) ca[_h][_i] = na[_h][_i];
        if (wr == 1) PG8_BAR;
    }
    PG8_WAIT_V(0);
    PG8_BAR;
#undef PG8_SA
#undef PG8_SB
#undef PG8_STAGE
#undef PG8_LDA
#undef PG8_LDB
#undef PG8_MMA
#undef PG8_WAIT_V
#undef PG8_WAIT_L
#undef PG8_BAR
#undef PG8_SCHED
#undef PG8_AOFFS
}
}


namespace attn_body {
using bf16x8=__attribute__((ext_vector_type(8)))short;
using s16x4=__attribute__((ext_vector_type(4)))short;
using f32x16=__attribute__((ext_vector_type(16)))float;
constexpr int D=64;
constexpr int QBLK=32,QB=256,KVBLK=64;
constexpr int KP=UC, OP=DM;
__device__ __forceinline__ int crow(int r,int hi){return (r&3)+8*(r>>2)+4*hi;}
#define SBAR() __builtin_amdgcn_sched_barrier(0)
__device__ __forceinline__ void cmask(f32x16&p0,f32x16&p1,int jb,int qrel,int hi){
  const float NEG=-INFINITY; int kb=64*jb+4*hi;
  #pragma unroll
  for(int r=0;r<16;++r){int kv=kb+(r&3)+8*(r>>2); if(kv>qrel)p0[r]=NEG; if(kv+32>qrel)p1[r]=NEG;}
}
constexpr int NSLOT=3, SLOTB=8192;
constexpr int LDS_K=0, LDS_V=NSLOT*SLOTB, LDS_WS=2*NSLOT*SLOTB, LDS_OST=LDS_WS+NW*64*4, LDS_BYTES_A=LDS_OST+NW*4096;
constexpr float C2=0.125f*1.4426950408889634f;
__device__ __forceinline__ void glds16(const void*gsrc,unsigned lds_dst){unsigned keep;
  asm volatile("s_mov_b32 %0, m0\n\ts_mov_b32 m0, %2\n\ts_nop 0\n\tglobal_load_lds_dwordx4 %1, off\n\ts_mov_b32 m0, %0":"=&s"(keep):"v"(gsrc),"s"(lds_dst):"memory");}
__device__ __forceinline__ float max3f(float a,float b,float c){float r;asm("v_max3_f32 %0, %1, %2, %3":"=v"(r):"v"(a),"v"(b),"v"(c));return r;}
__device__ __forceinline__ float max2f(float a,float b){float r;asm("v_max_f32_e32 %0, %1, %2":"=v"(r):"v"(a),"v"(b));return r;}
__device__ __forceinline__ float fsub_s(float a,float b){float r;asm("v_sub_f32_e32 %0, %1, %2":"=v"(r):"v"(a),"v"(b));return r;}
typedef float f32x2_t __attribute__((ext_vector_type(2))); typedef __bf16 bf16x2_t __attribute__((ext_vector_type(2)));
__device__ __forceinline__ unsigned cvtpk_s(float lo,float hi){f32x2_t v={lo,hi};bf16x2_t b=__builtin_convertvector(v,bf16x2_t);return __builtin_bit_cast(unsigned,b);}
#define WAIT_BAR(N) asm volatile("s_waitcnt vmcnt(" #N ") lgkmcnt(0)\n\ts_barrier":::"memory")

__device__ __forceinline__ void qkt(f32x16&p0,f32x16&p1,const char*Kslot,const bf16x8*qr,const f32x16&negm,int r32,int hi){
  const char*kb=Kslot+hi*1024+r32*16;
  #pragma unroll
  for(int d0=0;d0<4;++d0){
    const bf16x8 b0=*reinterpret_cast<const bf16x8*>(kb+d0*2048);
    const bf16x8 b1=*reinterpret_cast<const bf16x8*>(kb+d0*2048+512);
    if(d0==0){p0=__builtin_amdgcn_mfma_f32_32x32x16_bf16(b0,qr[0],negm,0,0,0);p1=__builtin_amdgcn_mfma_f32_32x32x16_bf16(b1,qr[0],negm,0,0,0);}
    else{p0=__builtin_amdgcn_mfma_f32_32x32x16_bf16(b0,qr[d0],p0,0,0,0);p1=__builtin_amdgcn_mfma_f32_32x32x16_bf16(b1,qr[d0],p1,0,0,0);}}
}
typedef __attribute__((address_space(3))) const char* lds_cptr;
typedef short v4i16_t __attribute__((ext_vector_type(4)));
__device__ __forceinline__ void kload8(bf16x8*kf,lds_cptr kp){
  kf[0]=*(const __attribute__((address_space(3))) bf16x8*)(kp);      kf[1]=*(const __attribute__((address_space(3))) bf16x8*)(kp+512);
  kf[2]=*(const __attribute__((address_space(3))) bf16x8*)(kp+2048); kf[3]=*(const __attribute__((address_space(3))) bf16x8*)(kp+2560);
  kf[4]=*(const __attribute__((address_space(3))) bf16x8*)(kp+4096); kf[5]=*(const __attribute__((address_space(3))) bf16x8*)(kp+4608);
  kf[6]=*(const __attribute__((address_space(3))) bf16x8*)(kp+6144); kf[7]=*(const __attribute__((address_space(3))) bf16x8*)(kp+6656);
}
__device__ __forceinline__ void kload2(bf16x8*kf,lds_cptr kp,int j){ kf[2*j]=*(const __attribute__((address_space(3))) bf16x8*)(kp+j*2048); kf[2*j+1]=*(const __attribute__((address_space(3))) bf16x8*)(kp+j*2048+512); }
__device__ __forceinline__ s16x4 vtr(lds_cptr p){ return __builtin_bit_cast(s16x4,__builtin_amdgcn_ds_read_tr16_b64_v4i16((__attribute__((address_space(3))) v4i16_t*)p)); }
__device__ __forceinline__ float rowmax(const f32x16&p0,const f32x16&p1){
  float a=max3f(p0[0],p0[1],p1[0]),b=max3f(p0[2],p0[3],p1[1]);a=max3f(a,p1[2],p1[3]);
  #pragma unroll
  for(int r=4;r<16;r+=4){a=max3f(a,p0[r],p0[r+1]);b=max3f(b,p0[r+2],p0[r+3]);a=max3f(a,p1[r],p1[r+1]);b=max3f(b,p1[r+2],p1[r+3]);}
  const float m=max2f(a,b);
  auto rr=__builtin_amdgcn_permlane32_swap(__float_as_uint(m),__float_as_uint(m),false,false);
  return max2f(__uint_as_float(rr[0]),__uint_as_float(rr[1]));
}
__device__ __forceinline__ void pv(f32x16*o,int vb,bf16x8 pa0,bf16x8 pa1,bf16x8 pa2,bf16x8 pa3){
  #pragma unroll
  for(int d0=0;d0<2;++d0){s16x4 lo[4],hi[4];
    #pragma unroll
    for(int ks=0;ks<4;++ks){
      asm volatile("ds_read_b64_tr_b16 %0,%1 offset:%c2":"=&v"(lo[ks]):"v"(vb),"i"(d0*4096+ks*1024):"memory");
      asm volatile("ds_read_b64_tr_b16 %0,%1 offset:%c2":"=&v"(hi[ks]):"v"(vb),"i"(d0*4096+ks*1024+512):"memory");}
    asm volatile("s_waitcnt lgkmcnt(0)":::"memory");SBAR();
    #define PK(k) (bf16x8){lo[k][0],lo[k][1],lo[k][2],lo[k][3],hi[k][0],hi[k][1],hi[k][2],hi[k][3]}
    o[d0]=__builtin_amdgcn_mfma_f32_32x32x16_bf16(pa0,PK(0),o[d0],0,0,0);
    o[d0]=__builtin_amdgcn_mfma_f32_32x32x16_bf16(pa1,PK(1),o[d0],0,0,0);
    o[d0]=__builtin_amdgcn_mfma_f32_32x32x16_bf16(pa2,PK(2),o[d0],0,0,0);
    o[d0]=__builtin_amdgcn_mfma_f32_32x32x16_bf16(pa3,PK(3),o[d0],0,0,0);
    #undef PK
  }
}

template<int THRL> __device__ __forceinline__ void attn_unit(int b,int vh,int qb,const bf16_t*U,bf16_t*O,char*shm,int ncap){
  int tid_=threadIdx.x; asm volatile("":"+v"(tid_));
  const int tid=tid_,lane=tid&63,r32=lane&31,hi=lane>>5; const int wid=__builtin_amdgcn_readfirstlane(tid>>6);
  const int hh=vh>>2, cc=(vh>>1)&1, vhalf=vh&1;
  const long rowbase=(long)b*SEQ; const int q0=qb*QB;
  const bf16_t*Qw=U+(rowbase+q0+wid*QBLK)*KP+C_DQ+hh*128+cc*64;
  const bf16_t*Kh=U+rowbase*KP+C_DK+hh*128+cc*64,*Vh=U+rowbase*KP+C_DV+hh*128+vhalf*64;
  const float slope2=__uint_as_float(__builtin_amdgcn_readfirstlane(__float_as_uint(exp2f(-2.f*(float)(hh+1))*1.4426950408889634f)));
  const float s64=__uint_as_float(__builtin_amdgcn_readfirstlane(__float_as_uint(64.f*slope2))), s32=__uint_as_float(__builtin_amdgcn_readfirstlane(__float_as_uint(32.f*slope2)));
  const unsigned lds0=(unsigned)(uintptr_t)shm;
  float*wsf=(float*)(shm+LDS_WS)+wid*64;
  const bf16_t*ksrc=Kh+(long)lane*KP+wid*8;
  const bf16_t*vsrc=Vh+(long)(16*(wid&3)+(lane>>2))*KP+(wid>>2)*32+(lane&3)*8;
  const unsigned kdst=lds0+LDS_K+wid*1024, vdst=lds0+LDS_V+wid*1024;
  const int NTT=(q0+QB)/KVBLK;
  const int NT=NTT<ncap?NTT:ncap;
  #define DMA_K(s,slot) glds16(ksrc+(long)(NTT-1-(s))*KVBLK*KP,(unsigned)__builtin_amdgcn_readfirstlane(kdst+(slot)))
  #define DMA_V(s,slot) glds16(vsrc+(long)(NTT-1-(s))*KVBLK*KP,(unsigned)__builtin_amdgcn_readfirstlane(vdst+(slot)))
  const int vb0=(int)(lds0+LDS_V)+((lane>>4)&1)*32+(lane&3)*8+(4*hi+((lane&15)>>2))*64;
  const char*Kbase=shm+LDS_K; bf16x8 kf[8];
  const lds_cptr shm3=(lds_cptr)shm; const lds_cptr kp0=shm3+LDS_K+hi*1024+r32*16; const lds_cptr vp0=shm3+LDS_V+((lane>>4)&1)*32+(lane&3)*8+(4*hi+((lane&15)>>2))*64;
  DMA_K(0,0);DMA_V(0,0);DMA_K(1,SLOTB);
  bf16x8 qr[4];
  #pragma unroll
  for(int d0=0;d0<4;++d0)qr[d0]=*reinterpret_cast<const bf16x8*>(&Qw[(long)r32*KP+d0*16+hi*8]);
  float l_reg=0.f;f32x16 o[2];o[0]=f32x16{};o[1]=f32x16{};
  f32x16 negm;
  #pragma unroll
  for(int r=0;r<16;++r)negm[r]=slope2*(float)(crow(r,hi)-63);
  asm volatile("":"+v"(negm));
  const int qrel=wid*QBLK+r32;
  #define CMASK(P0,P1,s) do{ if((s)<4)cmask(P0,P1,3-(s),qrel,hi);}while(0)
  #define BIAS1(P1) do{ _Pragma("unroll") for(int r=0;r<16;++r)P1[r]+=s32; }while(0)
  #define NEXTTILE() do{ _Pragma("unroll") for(int r=0;r<16;++r)negm[r]-=s64; asm volatile("":"+v"(negm)); }while(0)
  bool resc=false;
  #define START(P0,P1) do{ const float rm=rowmax(P0,P1); resc=false; \
    { const float dl=__builtin_fmaxf(rm,-8192.f); \
      _Pragma("unroll") for(int r=0;r<16;++r){P0[r]=fsub_s(P0[r],dl);P1[r]=fsub_s(P1[r],dl);} \
      _Pragma("unroll") for(int r=0;r<16;++r)negm[r]-=dl; asm volatile("":"+v"(negm)); } \
    _Pragma("unroll") for(int r=0;r<16;++r)P0[r]=__builtin_amdgcn_exp2f(P0[r]); }while(0)
  #define RESC() do{ if(resc){ asm volatile("s_waitcnt lgkmcnt(0)":::"memory"); \
      _Pragma("unroll") for(int d_=0;d_<2;++d_) _Pragma("unroll") for(int r=0;r<16;++r)o[d_][r]*=wsf[crow(r,hi)]; } }while(0)
  f32x16 pA0,pA1,pB0,pB1;
  int sl_prev=0,sl_cur=0,sl_next=SLOTB;
  #define ROT() do{sl_prev=sl_cur;sl_cur=sl_next;sl_next=(sl_next==(NSLOT-1)*SLOTB)?0:sl_next+SLOTB;}while(0)
  DMA_K(2,2*SLOTB);
  WAIT_BAR(3);
  qkt(pA0,pA1,Kbase,qr,negm,r32,hi);asm volatile("s_nop 15\n\ts_nop 7":"+v"(pA0),"+v"(pA1));BIAS1(pA1);CMASK(pA0,pA1,0);
  START(pA0,pA1);
  NEXTTILE();
  _Pragma("unroll") for(int r=0;r<16;++r)pA1[r]=__builtin_amdgcn_exp2f(pA1[r]);
  WAIT_BAR(0);
  DMA_K(3,0);DMA_V(1,SLOTB);
  ROT();
  kload8(kf,kp0+sl_cur);
  WAIT_BAR(2);
  s16x4 vlo[8],vhi[8]; u32x4 pw0,pw1,pw2,pw3;
  #define PKW(P,B) cvtpk_s(P[B],P[B+1])
  #define PAF(k) __builtin_bit_cast(bf16x8,pw##k)
  #define VFR(i) (bf16x8){vlo[i][0],vlo[i][1],vlo[i][2],vlo[i][3],vhi[i][0],vhi[i][1],vhi[i][2],vhi[i][3]}
  #define PIN(x) asm volatile("":"+v"(x))
  #define MX3(a,b,c) __builtin_fmaxf(__builtin_fmaxf((a),(b)),(c))
  #define GAPA(MF,A0,A1,A2,A3,W0,W1,PW) do{ MF; sacc+=A0; sacc+=A1; sacc+=A2; sacc+=A3; PIN(sacc); W0; W1; PIN(PW); SBAR(); }while(0)
  #define EX(v) __builtin_amdgcn_exp2f(v)
  #define GAPB(MF,X,B) do{ MF; X[B]=EX(X[B]); X[B+1]=EX(X[B+1]); X[B+2]=EX(X[B+2]); X[B+3]=EX(X[B+3]); PIN(X); SBAR(); }while(0)
  #define VRD(i) do{ vlo[i]=vtr(vp_+(((i)>>2)*4096+((i)&3)*1024)); vhi[i]=vtr(vp_+(((i)>>2)*4096+((i)&3)*1024+512)); }while(0)
  #define KRD(G,j) do{ if(G){ kload2(kf,kp0+sl_next,j); SBAR(); } }while(0)
  #define STEP(C0,C1,P0,P1,t,GK,GV,GL) do{ SBAR(); \
    const lds_cptr vp_=vp0+sl_prev; \
    VRD(0); SBAR(); float sacc=(P0[0]+P0[1]); \
    GAPA(C0=__builtin_amdgcn_mfma_f32_32x32x16_bf16(kf[0],qr[0],negm,0,0,0), P0[2],P0[3],P0[4],P0[5],     pw0[0]=PKW(P0,0), pw0[1]=PKW(P0,2), pw0); \
    VRD(4); SBAR(); GAPA(C1=__builtin_amdgcn_mfma_f32_32x32x16_bf16(kf[1],qr[0],negm,0,0,0), P0[6],P0[7],P0[8],P0[9],     pw0[2]=PKW(P0,4), pw0[3]=PKW(P0,6), pw0); \
    VRD(1); SBAR(); GAPA(C0=__builtin_amdgcn_mfma_f32_32x32x16_bf16(kf[2],qr[1],C0,0,0,0),   P0[10],P0[11],P0[12],P0[13], pw1[0]=PKW(P0,8), pw1[1]=PKW(P0,10), pw1); \
    VRD(5); SBAR(); GAPA(C1=__builtin_amdgcn_mfma_f32_32x32x16_bf16(kf[3],qr[1],C1,0,0,0),   P0[14],P0[15],P1[0],P1[1],   pw1[2]=PKW(P0,12),pw1[3]=PKW(P0,14), pw1); \
    VRD(2); SBAR(); GAPA(C0=__builtin_amdgcn_mfma_f32_32x32x16_bf16(kf[4],qr[2],C0,0,0,0),   P1[2],P1[3],P1[4],P1[5],     pw2[0]=PKW(P1,0), pw2[1]=PKW(P1,2), pw2); \
    VRD(6); SBAR(); GAPA(C1=__builtin_amdgcn_mfma_f32_32x32x16_bf16(kf[5],qr[2],C1,0,0,0),   P1[6],P1[7],P1[8],P1[9],     pw2[2]=PKW(P1,4), pw2[3]=PKW(P1,6), pw2); \
    VRD(3); SBAR(); GAPA(C0=__builtin_amdgcn_mfma_f32_32x32x16_bf16(kf[6],qr[3],C0,0,0,0),   P1[10],P1[11],P1[12],P1[13], pw3[0]=PKW(P1,8), pw3[1]=PKW(P1,10), pw3); \
    VRD(7); SBAR(); GAPA(C1=__builtin_amdgcn_mfma_f32_32x32x16_bf16(kf[7],qr[3],C1,0,0,0),   P1[14],P1[15],0.f,0.f,       pw3[2]=PKW(P1,12),pw3[3]=PKW(P1,14), pw3); \
    l_reg+=sacc; \
    if(GK){DMA_K((t)+3,sl_cur);} if(GV){DMA_V((t)+1,sl_next);} \
    BIAS1(C1); CMASK(C0,C1,t); \
    { float a=MX3(C0[0],C0[1],C1[0]),b=MX3(C0[2],C0[3],C1[1]); a=MX3(a,C1[2],C1[3]); \
      _Pragma("unroll") for(int r=4;r<16;r+=4){a=MX3(a,C0[r],C0[r+1]);b=MX3(b,C0[r+2],C0[r+3]);a=MX3(a,C1[r],C1[r+1]);b=MX3(b,C1[r+2],C1[r+3]);} \
      float rm=__builtin_fmaxf(a,b); { auto rr=__builtin_amdgcn_permlane32_swap(__float_as_uint(rm),__float_as_uint(rm),false,false); rm=__builtin_fmaxf(__uint_as_float(rr[0]),__uint_as_float(rr[1])); } \
      resc=false; \
      if(__builtin_expect(__any(rm>(float)THRL),0)){ const float dl=__builtin_fmaxf(rm,0.f); \
        _Pragma("unroll") for(int r=0;r<16;++r){C0[r]-=dl;C1[r]-=dl;} \
        _Pragma("unroll") for(int r=0;r<16;++r)negm[r]-=dl; asm volatile("":"+v"(negm)); \
        const float f=__builtin_amdgcn_exp2f(-dl); l_reg*=f; if(hi==0)wsf[r32]=f; resc=true; } } \
    NEXTTILE(); \
    SBAR(); \
    GAPB(o[0]=__builtin_amdgcn_mfma_f32_32x32x16_bf16(PAF(0),VFR(0),o[0],0,0,0), C0,0); \
    GAPB(o[1]=__builtin_amdgcn_mfma_f32_32x32x16_bf16(PAF(0),VFR(4),o[1],0,0,0), C0,4); \
    KRD(GL,0); GAPB(o[0]=__builtin_amdgcn_mfma_f32_32x32x16_bf16(PAF(1),VFR(1),o[0],0,0,0), C0,8); \
    KRD(GL,1); GAPB(o[1]=__builtin_amdgcn_mfma_f32_32x32x16_bf16(PAF(1),VFR(5),o[1],0,0,0), C0,12); \
    KRD(GL,2); GAPB(o[0]=__builtin_amdgcn_mfma_f32_32x32x16_bf16(PAF(2),VFR(2),o[0],0,0,0), C1,0); \
    KRD(GL,3); GAPB(o[1]=__builtin_amdgcn_mfma_f32_32x32x16_bf16(PAF(2),VFR(6),o[1],0,0,0), C1,4); \
    GAPB(o[0]=__builtin_amdgcn_mfma_f32_32x32x16_bf16(PAF(3),VFR(3),o[0],0,0,0), C1,8); \
    GAPB(o[1]=__builtin_amdgcn_mfma_f32_32x32x16_bf16(PAF(3),VFR(7),o[1],0,0,0), C1,12); \
    }while(0)
  int t=1;
  for(;t+5<NT;t+=2){
    STEP(pB0,pB1,pA0,pA1,t,true,true,true);     WAIT_BAR(2); RESC(); ROT();
    STEP(pA0,pA1,pB0,pB1,t+1,true,true,true);   WAIT_BAR(2); RESC(); ROT();
  }
  #define ENDW(tt) do{ if((tt)+3<NT){WAIT_BAR(2);} else if((tt)+2<NT){WAIT_BAR(1);} else {WAIT_BAR(0);} }while(0)
  for(;t+1<NT;t+=2){
    STEP(pB0,pB1,pA0,pA1,t,(t+3<NT),(t+1<NT),(t+1<NT));       ENDW(t);   RESC(); ROT();
    STEP(pA0,pA1,pB0,pB1,t+1,(t+4<NT),(t+2<NT),(t+2<NT));     ENDW(t+1); RESC(); ROT();
  }
  STEP(pB0,pB1,pA0,pA1,NT-1,false,false,false); RESC();
  { float sacc=pB0[0]+pB0[1]; _Pragma("unroll") for(int r=2;r<16;++r)sacc+=pB0[r]; _Pragma("unroll") for(int r=0;r<16;++r)sacc+=pB1[r]; l_reg+=sacc;
    pw0=(u32x4){PKW(pB0,0),PKW(pB0,2),PKW(pB0,4),PKW(pB0,6)};pw1=(u32x4){PKW(pB0,8),PKW(pB0,10),PKW(pB0,12),PKW(pB0,14)};pw2=(u32x4){PKW(pB1,0),PKW(pB1,2),PKW(pB1,4),PKW(pB1,6)};pw3=(u32x4){PKW(pB1,8),PKW(pB1,10),PKW(pB1,12),PKW(pB1,14)};
    SBAR(); pv(o,vb0+sl_cur,PAF(0),PAF(1),PAF(2),PAF(3)); }
  #undef PKW
  #undef PAF
  #undef VFR
  #undef PIN
  #undef MX3
  #undef GAPA
  #undef GAPB
  #undef EX
  #undef VRD
  #undef KRD
  #undef STEP
  #undef ENDW
  {auto rr=__builtin_amdgcn_permlane32_swap(__float_as_uint(l_reg),__float_as_uint(l_reg),false,false);l_reg=__uint_as_float(rr[0])+__uint_as_float(rr[1]);}
  if(hi==0)wsf[32+r32]=l_reg;asm volatile("s_waitcnt lgkmcnt(0)":::"memory");
  float rli[16];
  #pragma unroll
  for(int r=0;r<16;++r)rli[r]=__builtin_amdgcn_rcpf(wsf[32+crow(r,hi)]);
  bf16_t*Ow=O+(rowbase+q0+wid*QBLK)*OP+vh*D;
  { bf16_t*stg=(bf16_t*)(shm+LDS_OST)+wid*2048;
    #pragma unroll
    for(int r=0;r<16;++r){const int orow=crow(r,hi);
      #pragma unroll
      for(int d0=0;d0<2;++d0)stg[orow*64+d0*32+r32]=f2bf(o[d0][r]*rli[r]);}
    asm volatile("s_waitcnt lgkmcnt(0)":::"memory");
    #pragma unroll
    for(int i=0;i<4;++i){const int row=i*8+(lane>>3),ch=lane&7; const u32x4 v=*(const u32x4*)(stg+row*64+ch*8); *(u32x4*)(Ow+(long)row*OP+ch*8)=v;} }
  asm volatile("s_waitcnt lgkmcnt(0)\n\ts_barrier":::"memory");
  #undef DMA_K
  #undef DMA_V
  #undef CMASK
  #undef BIAS1
  #undef NEXTTILE
  #undef START
  #undef RESC
  #undef ROT
}

constexpr int PC_K=0, PC_V0=24576, PC_V1=49152, PC_PX=73728, PC_WS=106496, PC_OST=108544, PC_BYTES=PC_OST+8*4096;
template<int THRL> __device__ __forceinline__ void attn_unit_pc(int b,int hh,int cc,int qb,const bf16_t*U,bf16_t*O,char*shm,int ncap){
  int tid_=threadIdx.x; asm volatile("":"+v"(tid_));
  const int tid=tid_,lane=tid&63,r32=lane&31,hi=lane>>5; const int wid=__builtin_amdgcn_readfirstlane(tid>>6);
  const bool prod=wid<4; const int pw=wid&3;
  const long rowbase=(long)b*SEQ; const int q0=qb*128;
  const float slope2=__uint_as_float(__builtin_amdgcn_readfirstlane(__float_as_uint(exp2f(-2.f*(float)(hh+1))*1.4426950408889634f)));
  const float s64=__uint_as_float(__builtin_amdgcn_readfirstlane(__float_as_uint(64.f*slope2))), s32=__uint_as_float(__builtin_amdgcn_readfirstlane(__float_as_uint(32.f*slope2)));
  const unsigned lds0=(unsigned)(uintptr_t)shm;
  const int NTT=(q0+128)/KVBLK;
  int NT=NTT<ncap?NTT:ncap; if(NT<4)NT=4;
  float*wsf=(float*)(shm+PC_WS)+pw*128;
  char*px=shm+PC_PX+pw*8192;
  bf16_t*Ow=O+(rowbase+q0+pw*QBLK)*OP+(hh*4+cc*2+(prod?0:1))*D;
  #define TILE_OF(s) ((NTT-1-(s))>0?(NTT-1-(s)):0)
  if(prod){
    const bf16_t*Qw=U+(rowbase+q0+pw*QBLK)*KP+C_DQ+hh*128+cc*64;
    const bf16_t*Kh=U+rowbase*KP+C_DK+hh*128+cc*64,*Vh=U+rowbase*KP+C_DV+hh*128;
    const bf16_t*ksrc=Kh+(long)lane*KP+(2*pw)*8;
    const bf16_t*vsrc0=Vh+(long)(16*((2*pw)&3)+(lane>>2))*KP+((2*pw)>>2)*32+(lane&3)*8;
    const bf16_t*vsrc1=Vh+(long)(16*((2*pw+1)&3)+(lane>>2))*KP+((2*pw+1)>>2)*32+(lane&3)*8;
    const unsigned kdst=lds0+PC_K+(2*pw)*1024, vdst=lds0+PC_V0+(2*pw)*1024;
    #define DMA_K(s,slot) do{ const long to_=(long)TILE_OF(s)*KVBLK*KP; const unsigned d_=(unsigned)__builtin_amdgcn_readfirstlane(kdst+(slot)); glds16(ksrc+to_,d_); glds16(ksrc+to_+8,d_+1024); }while(0)
    #define DMA_V(s,slot) do{ const long to_=(long)TILE_OF(s)*KVBLK*KP; const unsigned d_=(unsigned)__builtin_amdgcn_readfirstlane(vdst+(slot)); glds16(vsrc0+to_,d_); glds16(vsrc1+to_,d_+1024); }while(0)
    const int vb0=(int)(lds0+PC_V0)+((lane>>4)&1)*32+(lane&3)*8+(4*hi+((lane&15)>>2))*64;
    const char*Kbase=shm+PC_K; bf16x8 kf[8];
    const lds_cptr shm3=(lds_cptr)shm; const lds_cptr kp0=shm3+PC_K+hi*1024+r32*16; const lds_cptr vp0=shm3+PC_V0+((lane>>4)&1)*32+(lane&3)*8+(4*hi+((lane&15)>>2))*64;
    DMA_K(0,0);DMA_V(0,0);DMA_K(1,SLOTB);
    bf16x8 qr[4];
    #pragma unroll
    for(int d0=0;d0<4;++d0)qr[d0]=*reinterpret_cast<const bf16x8*>(&Qw[(long)r32*KP+d0*16+hi*8]);
    float l_reg=0.f;f32x16 o[2];o[0]=f32x16{};o[1]=f32x16{};
    f32x16 negm;
    #pragma unroll
    for(int r=0;r<16;++r)negm[r]=slope2*(float)(crow(r,hi)-63);
    asm volatile("":"+v"(negm));
    const int qrel=pw*QBLK+r32;
    #define CMASK(P0,P1,s) do{ if((s)<2)cmask(P0,P1,1-(s),qrel,hi); else if(NTT-1-(s)<0){ _Pragma("unroll") for(int r=0;r<16;++r){P0[r]=-INFINITY;P1[r]=-INFINITY;} } }while(0)
    #define BIAS1(P1) do{ _Pragma("unroll") for(int r=0;r<16;++r)P1[r]+=s32; }while(0)
    #define NEXTTILE() do{ _Pragma("unroll") for(int r=0;r<16;++r)negm[r]-=s64; asm volatile("":"+v"(negm)); }while(0)
    bool resc=false;
    #define START(P0,P1) do{ const float rm=rowmax(P0,P1); resc=false; \
      { const float dl=__builtin_fmaxf(rm,-8192.f); \
        _Pragma("unroll") for(int r=0;r<16;++r){P0[r]=fsub_s(P0[r],dl);P1[r]=fsub_s(P1[r],dl);} \
        _Pragma("unroll") for(int r=0;r<16;++r)negm[r]-=dl; asm volatile("":"+v"(negm)); } \
      _Pragma("unroll") for(int r=0;r<16;++r)P0[r]=__builtin_amdgcn_exp2f(P0[r]); }while(0)
    #define RESC(t) do{ if(resc){ asm volatile("s_waitcnt lgkmcnt(0)":::"memory"); \
        _Pragma("unroll") for(int d_=0;d_<2;++d_) _Pragma("unroll") for(int r=0;r<16;++r)o[d_][r]*=wsf[32*((t)&1)+crow(r,hi)]; } }while(0)
    f32x16 pA0,pA1,pB0,pB1;
    int sl_prev=0,sl_cur=0,sl_next=SLOTB;
    #define ROT() do{sl_prev=sl_cur;sl_cur=sl_next;sl_next=(sl_next==(NSLOT-1)*SLOTB)?0:sl_next+SLOTB;}while(0)
    DMA_K(2,2*SLOTB);
    WAIT_BAR(6);
    qkt(pA0,pA1,Kbase,qr,negm,r32,hi);asm volatile("s_nop 15\n\ts_nop 7":"+v"(pA0),"+v"(pA1));BIAS1(pA1);CMASK(pA0,pA1,0);
    START(pA0,pA1);
    NEXTTILE();
    _Pragma("unroll") for(int r=0;r<16;++r)pA1[r]=__builtin_amdgcn_exp2f(pA1[r]);
    WAIT_BAR(0);
    DMA_K(3,0);DMA_V(1,SLOTB);
    ROT();
    kload8(kf,kp0+sl_cur);
    WAIT_BAR(4);
    s16x4 vlo[8],vhi[8]; u32x4 pw0,pw1,pw2,pw3;
    #define PKW(P,B) cvtpk_s(P[B],P[B+1])
    #define PAF(k) __builtin_bit_cast(bf16x8,pw##k)
    #define VFR(i) (bf16x8){vlo[i][0],vlo[i][1],vlo[i][2],vlo[i][3],vhi[i][0],vhi[i][1],vhi[i][2],vhi[i][3]}
    #define PIN(x) asm volatile("":"+v"(x))
    #define MX3(a,b,c) __builtin_fmaxf(__builtin_fmaxf((a),(b)),(c))
    #define GAPA(MF,A0,A1,A2,A3,W0,W1,PW) do{ MF; sacc+=A0; sacc+=A1; sacc+=A2; sacc+=A3; PIN(sacc); W0; W1; PIN(PW); SBAR(); }while(0)
    #define EX(v) __builtin_amdgcn_exp2f(v)
    #define GAPB(MF,X,B) do{ MF; X[B]=EX(X[B]); X[B+1]=EX(X[B+1]); X[B+2]=EX(X[B+2]); X[B+3]=EX(X[B+3]); PIN(X); SBAR(); }while(0)
    #define VRD(i) do{ vlo[i]=vtr(vp_+(((i)>>2)*4096+((i)&3)*1024)); vhi[i]=vtr(vp_+(((i)>>2)*4096+((i)&3)*1024+512)); }while(0)
    #define KRD(G,j) do{ if(G){ kload2(kf,kp0+sl_next,j); SBAR(); } }while(0)
    #define PXW(tt) do{ char*pb_=px+4096*((tt)&1)+16*lane; *(u32x4*)(pb_)=pw0; *(u32x4*)(pb_+1024)=pw1; *(u32x4*)(pb_+2048)=pw2; *(u32x4*)(pb_+3072)=pw3; }while(0)
    #define STEP(C0,C1,P0,P1,t,GK,GV,GL) do{ SBAR(); \
      const lds_cptr vp_=vp0+sl_prev; \
      VRD(0); SBAR(); float sacc=(P0[0]+P0[1]); \
      GAPA(C0=__builtin_amdgcn_mfma_f32_32x32x16_bf16(kf[0],qr[0],negm,0,0,0), P0[2],P0[3],P0[4],P0[5],     pw0[0]=PKW(P0,0), pw0[1]=PKW(P0,2), pw0); \
      VRD(4); SBAR(); GAPA(C1=__builtin_amdgcn_mfma_f32_32x32x16_bf16(kf[1],qr[0],negm,0,0,0), P0[6],P0[7],P0[8],P0[9],     pw0[2]=PKW(P0,4), pw0[3]=PKW(P0,6), pw0); \
      VRD(1); SBAR(); GAPA(C0=__builtin_amdgcn_mfma_f32_32x32x16_bf16(kf[2],qr[1],C0,0,0,0),   P0[10],P0[11],P0[12],P0[13], pw1[0]=PKW(P0,8), pw1[1]=PKW(P0,10), pw1); \
      VRD(5); SBAR(); GAPA(C1=__builtin_amdgcn_mfma_f32_32x32x16_bf16(kf[3],qr[1],C1,0,0,0),   P0[14],P0[15],P1[0],P1[1],   pw1[2]=PKW(P0,12),pw1[3]=PKW(P0,14), pw1); \
      VRD(2); SBAR(); GAPA(C0=__builtin_amdgcn_mfma_f32_32x32x16_bf16(kf[4],qr[2],C0,0,0,0),   P1[2],P1[3],P1[4],P1[5],     pw2[0]=PKW(P1,0), pw2[1]=PKW(P1,2), pw2); \
      VRD(6); SBAR(); GAPA(C1=__builtin_amdgcn_mfma_f32_32x32x16_bf16(kf[5],qr[2],C1,0,0,0),   P1[6],P1[7],P1[8],P1[9],     pw2[2]=PKW(P1,4), pw2[3]=PKW(P1,6), pw2); \
      VRD(3); SBAR(); GAPA(C0=__builtin_amdgcn_mfma_f32_32x32x16_bf16(kf[6],qr[3],C0,0,0,0),   P1[10],P1[11],P1[12],P1[13], pw3[0]=PKW(P1,8), pw3[1]=PKW(P1,10), pw3); \
      VRD(7); SBAR(); GAPA(C1=__builtin_amdgcn_mfma_f32_32x32x16_bf16(kf[7],qr[3],C1,0,0,0),   P1[14],P1[15],0.f,0.f,       pw3[2]=PKW(P1,12),pw3[3]=PKW(P1,14), pw3); \
      l_reg+=sacc; PXW((t)-1); \
      if(GK){DMA_K((t)+3,sl_cur);} if(GV){DMA_V((t)+1,sl_next);} \
      BIAS1(C1); CMASK(C0,C1,t); \
      { float a=MX3(C0[0],C0[1],C1[0]),b=MX3(C0[2],C0[3],C1[1]); a=MX3(a,C1[2],C1[3]); \
        _Pragma("unroll") for(int r=4;r<16;r+=4){a=MX3(a,C0[r],C0[r+1]);b=MX3(b,C0[r+2],C0[r+3]);a=MX3(a,C1[r],C1[r+1]);b=MX3(b,C1[r+2],C1[r+3]);} \
        float rm=__builtin_fmaxf(a,b); { auto rr=__builtin_amdgcn_permlane32_swap(__float_as_uint(rm),__float_as_uint(rm),false,false); rm=__builtin_fmaxf(__uint_as_float(rr[0]),__uint_as_float(rr[1])); } \
        resc=false; \
        if(__builtin_expect(__any(rm>(float)THRL),0)){ const float dl=__builtin_fmaxf(rm,0.f); \
          _Pragma("unroll") for(int r=0;r<16;++r){C0[r]-=dl;C1[r]-=dl;} \
          _Pragma("unroll") for(int r=0;r<16;++r)negm[r]-=dl; asm volatile("":"+v"(negm)); \
          const float f=__builtin_amdgcn_exp2f(-dl); l_reg*=f; if(hi==0)wsf[32*((t)&1)+r32]=f; resc=true; } \
        if(lane==0)wsf[64+((t)&1)]=resc?1.f:0.f; } \
      NEXTTILE(); \
      SBAR(); \
      GAPB(o[0]=__builtin_amdgcn_mfma_f32_32x32x16_bf16(PAF(0),VFR(0),o[0],0,0,0), C0,0); \
      GAPB(o[1]=__builtin_amdgcn_mfma_f32_32x32x16_bf16(PAF(0),VFR(4),o[1],0,0,0), C0,4); \
      KRD(GL,0); GAPB(o[0]=__builtin_amdgcn_mfma_f32_32x32x16_bf16(PAF(1),VFR(1),o[0],0,0,0), C0,8); \
      KRD(GL,1); GAPB(o[1]=__builtin_amdgcn_mfma_f32_32x32x16_bf16(PAF(1),VFR(5),o[1],0,0,0), C0,12); \
      KRD(GL,2); GAPB(o[0]=__builtin_amdgcn_mfma_f32_32x32x16_bf16(PAF(2),VFR(2),o[0],0,0,0), C1,0); \
      KRD(GL,3); GAPB(o[1]=__builtin_amdgcn_mfma_f32_32x32x16_bf16(PAF(2),VFR(6),o[1],0,0,0), C1,4); \
      GAPB(o[0]=__builtin_amdgcn_mfma_f32_32x32x16_bf16(PAF(3),VFR(3),o[0],0,0,0), C1,8); \
      GAPB(o[1]=__builtin_amdgcn_mfma_f32_32x32x16_bf16(PAF(3),VFR(7),o[1],0,0,0), C1,12); \
      }while(0)
    int t=1;
    for(;t+5<NT;t+=2){
      STEP(pB0,pB1,pA0,pA1,t,true,true,true);     WAIT_BAR(4); RESC(t);   ROT();
      STEP(pA0,pA1,pB0,pB1,t+1,true,true,true);   WAIT_BAR(4); RESC(t+1); ROT();
    }
    #define ENDW(tt) do{ if((tt)+3<NT){WAIT_BAR(4);} else if((tt)+2<NT){WAIT_BAR(2);} else {WAIT_BAR(0);} }while(0)
    for(;t+1<NT;t+=2){
      STEP(pB0,pB1,pA0,pA1,t,(t+3<NT),(t+1<NT),(t+1<NT));       ENDW(t);   RESC(t);   ROT();
      STEP(pA0,pA1,pB0,pB1,t+1,(t+4<NT),(t+2<NT),(t+2<NT));     ENDW(t+1); RESC(t+1); ROT();
    }
    STEP(pB0,pB1,pA0,pA1,NT-1,false,false,false); RESC(NT-1);
    { float sacc=pB0[0]+pB0[1]; _Pragma("unroll") for(int r=2;r<16;++r)sacc+=pB0[r]; _Pragma("unroll") for(int r=0;r<16;++r)sacc+=pB1[r]; l_reg+=sacc;
      pw0=(u32x4){PKW(pB0,0),PKW(pB0,2),PKW(pB0,4),PKW(pB0,6)};pw1=(u32x4){PKW(pB0,8),PKW(pB0,10),PKW(pB0,12),PKW(pB0,14)};pw2=(u32x4){PKW(pB1,0),PKW(pB1,2),PKW(pB1,4),PKW(pB1,6)};pw3=(u32x4){PKW(pB1,8),PKW(pB1,10),PKW(pB1,12),PKW(pB1,14)};
      { char*pb_=shm+PC_K+pw*4096+16*lane; *(u32x4*)(pb_)=pw0; *(u32x4*)(pb_+1024)=pw1; *(u32x4*)(pb_+2048)=pw2; *(u32x4*)(pb_+3072)=pw3; }
      SBAR(); pv(o,vb0+sl_cur,PAF(0),PAF(1),PAF(2),PAF(3)); }
    {auto rr=__builtin_amdgcn_permlane32_swap(__float_as_uint(l_reg),__float_as_uint(l_reg),false,false);l_reg=__uint_as_float(rr[0])+__uint_as_float(rr[1]);}
    if(hi==0)wsf[96+r32]=l_reg;
    WAIT_BAR(0);
    float rli[16];
    #pragma unroll
    for(int r=0;r<16;++r)rli[r]=__builtin_amdgcn_rcpf(wsf[96+crow(r,hi)]);
    { bf16_t*stg=(bf16_t*)(shm+PC_OST)+wid*2048;
      #pragma unroll
      for(int r=0;r<16;++r){const int orow=crow(r,hi);
        #pragma unroll
        for(int d0=0;d0<2;++d0)stg[orow*64+d0*32+r32]=f2bf(o[d0][r]*rli[r]);}
      asm volatile("s_waitcnt lgkmcnt(0)":::"memory");
      #pragma unroll
      for(int i=0;i<4;++i){const int row=i*8+(lane>>3),ch=lane&7; const u32x4 v=*(const u32x4*)(stg+row*64+ch*8); *(u32x4*)(Ow+(long)row*OP+ch*8)=v;} }
    asm volatile("s_waitcnt lgkmcnt(0)\n\ts_barrier":::"memory");
    #undef PKW
    #undef PAF
    #undef VFR
    #undef PIN
    #undef MX3
    #undef GAPA
    #undef GAPB
    #undef EX
    #undef VRD
    #undef KRD
    #undef PXW
    #undef STEP
    #undef ENDW
    #undef DMA_K
    #undef DMA_V
    #undef CMASK
    #undef BIAS1
    #undef NEXTTILE
    #undef START
    #undef RESC
    #undef ROT
  } else {
    const bf16_t*Vh=U+rowbase*KP+C_DV+hh*128+64;
    const bf16_t*vsrc0=Vh+(long)(16*((2*pw)&3)+(lane>>2))*KP+((2*pw)>>2)*32+(lane&3)*8;
    const bf16_t*vsrc1=Vh+(long)(16*((2*pw+1)&3)+(lane>>2))*KP+((2*pw+1)>>2)*32+(lane&3)*8;
    const unsigned vdst=lds0+PC_V1+(2*pw)*1024;
    #define DMA_V1(j) do{ const long to_=(long)TILE_OF(j)*KVBLK*KP; const unsigned d_=(unsigned)__builtin_amdgcn_readfirstlane(vdst+((j)%3)*SLOTB); glds16(vsrc0+to_,d_); glds16(vsrc1+to_,d_+1024); }while(0)
    const int vb1=(int)(lds0+PC_V1)+((lane>>4)&1)*32+(lane&3)*8+(4*hi+((lane&15)>>2))*64;
    f32x16 o[2];o[0]=f32x16{};o[1]=f32x16{};
    #define CPVB(j,PB) do{ const char*pb_=(PB); const u32x4 a0=*(const u32x4*)(pb_),a1=*(const u32x4*)(pb_+1024),a2=*(const u32x4*)(pb_+2048),a3=*(const u32x4*)(pb_+3072); \
        pv(o,vb1+((j)%3)*SLOTB,__builtin_bit_cast(bf16x8,a0),__builtin_bit_cast(bf16x8,a1),__builtin_bit_cast(bf16x8,a2),__builtin_bit_cast(bf16x8,a3)); \
        if((j)+1<NT && wsf[64+(((j)+1)&1)]!=0.f){ _Pragma("unroll") for(int d_=0;d_<2;++d_) _Pragma("unroll") for(int r=0;r<16;++r)o[d_][r]*=wsf[32*(((j)+1)&1)+crow(r,hi)]; } }while(0)
    #define CPV(j) CPVB(j, px+4096*((j)&1)+16*lane)
    DMA_V1(0); DMA_V1(1);
    WAIT_BAR(2);
    WAIT_BAR(2);
    WAIT_BAR(2);
    WAIT_BAR(2);
    #pragma unroll 1
    for(int j=0;j+2<NT;++j){
      if(j+2<NT) DMA_V1(j+2);
      CPV(j);
      if(j+3<NT){ WAIT_BAR(2); } else { WAIT_BAR(0); }
    }
    CPV(NT-2);
    CPVB(NT-1, shm+PC_K+pw*4096+16*lane);
    float rli[16];
    #pragma unroll
    for(int r=0;r<16;++r)rli[r]=__builtin_amdgcn_rcpf(wsf[96+crow(r,hi)]);
    { bf16_t*stg=(bf16_t*)(shm+PC_OST)+wid*2048;
      #pragma unroll
      for(int r=0;r<16;++r){const int orow=crow(r,hi);
        #pragma unroll
        for(int d0=0;d0<2;++d0)stg[orow*64+d0*32+r32]=f2bf(o[d0][r]*rli[r]);}
      asm volatile("s_waitcnt lgkmcnt(0)":::"memory");
      #pragma unroll
      for(int i=0;i<4;++i){const int row=i*8+(lane>>3),ch=lane&7; const u32x4 v=*(const u32x4*)(stg+row*64+ch*8); *(u32x4*)(Ow+(long)row*OP+ch*8)=v;} }
    asm volatile("s_waitcnt lgkmcnt(0)\n\ts_barrier":::"memory");
    #undef DMA_V1
    #undef CPV
    #undef CPVB
  }
  #undef TILE_OF
}
#undef SBAR
#undef WAIT_BAR
}

__device__ __forceinline__ void transpose_item(const float* W, int K, int Nsrc, bf16_t* WT, int roff, int rmul, float* scr, int kb, int nb, int lane) {
    const int k0 = 64 * kb, n0 = 32 * nb;
    float tv[32];
#pragma unroll
    for (int i = 0; i < 32; ++i) { const int kk = 2 * i + (lane >> 5), n = n0 + (lane & 31); tv[i] = (n < Nsrc) ? W[(size_t)(k0 + kk) * Nsrc + n] : 0.f; }
#pragma unroll
    for (int i = 0; i < 32; ++i) scr[(2 * i + (lane >> 5)) * 33 + (lane & 31)] = tv[i];
    lds_fence();
    const int c = lane & 7;
#pragma unroll
    for (int j = 0; j < 4; ++j) { const int n = (lane >> 3) + 8 * j; const float* s = scr + (8 * c) * 33 + n;
        u32x4 o; o.x = pk2(s[0 * 33], s[1 * 33]); o.y = pk2(s[2 * 33], s[3 * 33]); o.z = pk2(s[4 * 33], s[5 * 33]); o.w = pk2(s[6 * 33], s[7 * 33]);
        *(u32x4*)(WT + (size_t)(roff + (n0 + n) * rmul) * K + k0 + 8 * c) = o; }
    lds_fence();
}

__device__ __forceinline__ void stage0(const Params& p, unsigned char* smem) {
    const int tid = opaque_tid(), wid = tid >> 6, lane = tid & 63, G = gridDim.x;
    unsigned char* ws = p.ws;
    for (int it = blockIdx.x; it < 96; it += G) {
        float* ssl = (float*)(smem + 73728);
        float* mp = (float*)(smem + 73728 + 8192);
        for (int i = tid; i < 2048; i += NT) ssl[i] = silu_f(p.in[1][i]);
        __syncthreads();
        const float* wa = p.in[2]; const int j = it * 64 + lane; float a0 = 0.f, a1 = 0.f;
#pragma unroll 1
        for (int k0 = 128 * wid; k0 < 128 * wid + 128; k0 += 32) { float wv[32];
#pragma unroll
            for (int k = 0; k < 32; ++k) wv[k] = wa[(size_t)(k0 + k) * 6144 + j];
#pragma unroll
            for (int k = 0; k < 32; ++k) { a0 += ssl[k0 + k] * wv[k]; a1 += ssl[1024 + k0 + k] * wv[k]; } }
        mp[wid * 128 + lane] = a0; mp[wid * 128 + 64 + lane] = a1;
        __syncthreads();
        if (tid < 128) { float s = p.in[3][it * 64 + (tid & 63)];
#pragma unroll
            for (int w = 0; w < 8; ++w) s += mp[w * 128 + tid];
            ((float*)(ws + WS_MOD))[(tid >> 6) * 6144 + it * 64 + (tid & 63)] = s; }
        __syncthreads();
    }
    {
        float* scr = (float*)(smem + wid * 8448);
        const int gw = blockIdx.x * NW + wid, NGW = G * NW;
        constexpr int I_IN = 16 * 96, I_OUT = 16 * 32, I_E = 256;
        constexpr int NITEMS = I_IN + I_OUT + 64 * 3 * I_E, I_C = 2 * (128 + 4), I_B = 32;
        for (int it = gw; it < I_C + I_B; it += NGW) {
            if (it < I_C) { const int kv = it / 132, r = it % 132;
                if (r < 128) transpose_item(p.in[kv ? 17 : 16], 2048, 128, (bf16_t*)(ws + WS_W1T) + (size_t)kv * 128 * 2048, 0, 1, scr, r >> 2, r & 3, lane);
                else transpose_item(p.in[kv ? 19 : 18], 128, 64, (bf16_t*)(ws + WS_W2T) + (size_t)kv * 64 * 128, 0, 1, scr, (r - 128) >> 1, (r - 128) & 1, lane);
            } else { const int r = it - I_C, kv = r >> 4, kc = r & 15; const float* pos = p.in[kv ? 15 : 14]; const float* w1 = p.in[kv ? 17 : 16];
                float a0 = 0.f, a1 = 0.f;
#pragma unroll 8
                for (int k = kc * 128; k < kc * 128 + 128; ++k) { const float pv = pos[k]; a0 += pv * w1[(size_t)k * 128 + lane]; a1 += pv * w1[(size_t)k * 128 + 64 + lane]; }
                float* b1 = (float*)(ws + WS_B1P) + (kv * 16 + kc) * 128; b1[lane] = a0; b1[64 + lane] = a1; }
        }
        for (int it = gw; it < NITEMS; it += NGW) {
            int r = it;
            if (r < I_IN) { transpose_item(p.in[8], 1024, IN_COLS, (bf16_t*)(ws + WS_WTIN), 0, 1, scr, r / 96, r % 96, lane); continue; } r -= I_IN;
            if (r < I_OUT) { transpose_item(p.in[20], 1024, 1024, (bf16_t*)(ws + WS_WTOUT), 0, 1, scr, r / 32, r % 32, lane); continue; } r -= I_OUT;
            const int e = r / (3 * I_E), q = r % (3 * I_E), kind = q / I_E, ii = q % I_E;
            if (kind == 0) transpose_item(p.in[25] + (size_t)e * 1024 * 512, 1024, 512, (bf16_t*)(ws + WS_WTGU) + (size_t)e * 1024 * 1024, 0, 2, scr, ii / 16, ii % 16, lane);
            else if (kind == 1) transpose_item(p.in[26] + (size_t)e * 1024 * 512, 1024, 512, (bf16_t*)(ws + WS_WTGU) + (size_t)e * 1024 * 1024, 1, 2, scr, ii / 16, ii % 16, lane);
            else transpose_item(p.in[27] + (size_t)e * 512 * 1024, 512, 1024, (bf16_t*)(ws + WS_WTDN) + (size_t)e * 1024 * 512, 0, 1, scr, ii / 32, ii % 32, lane);
        }
    }
    {
        const int gt = blockIdx.x * NT + tid, NGT = G * NT;
        float* wr = (float*)(ws + WS_WR);
        bf16_t* wrh = (bf16_t*)wr; bf16_t* wrl = wrh + 1024 * 80;
        for (int i = gt; i < 1024 * 80; i += NGT) { const int ln = (i >> 3) & 63, jj = (i >> 9) % 5, ks = (i >> 9) / 5, k = 32 * ks + 8 * (ln >> 4) + (i & 7), c = 16 * jj + (ln & 15);
            const float w = c < 64 ? p.in[23][k * 64 + c] : (c < 72 ? p.in[21][k * 8 + (c - 64)] : 0.f);
            const bf16_t hi = f2bf(w); wrh[i] = hi; wrl[i] = f2bf(w - bf2f(hi)); }
    }
}

__device__ __forceinline__ void stage1(const Params& p) {
    const int tid = opaque_tid(), wid = tid >> 6, lane = tid & 63;
    const float* mod = (const float*)(p.ws + WS_MOD);
    bf16_t* xn = (bf16_t*)(p.ws + WS_XN);
    for (int row = blockIdx.x * NW + wid; row < M; row += gridDim.x * NW) {
        const int b = row / SEQ;
        const f32x4* xr = (const f32x4*)(p.in[0] + (size_t)row * DM) + lane;
        f32x4 v[4]; float ss = 0.f;
#pragma unroll
        for (int j = 0; j < 4; ++j) { v[j] = xr[64 * j]; ss += v[j].x * v[j].x + v[j].y * v[j].y + v[j].z * v[j].z + v[j].w * v[j].w; }
        const float rstd = rsqrtf(wave_sum(ss) * (1.f / DM) + 1e-6f);
#pragma unroll
        for (int j = 0; j < 4; ++j) { const int col = lane * 4 + 256 * j;
            const f32x4 g = *(const f32x4*)(p.in[4] + col), sc = *(const f32x4*)(mod + b * 6144 + 1024 + col), sh = *(const f32x4*)(mod + b * 6144 + col);
            const f32x4 h = v[j] * rstd * g * (sc + 1.f) + sh;
            u32x2 o; o.x = pk2(h.x, h.y); o.y = pk2(h.z, h.w);
            *(u32x2*)(xn + (size_t)row * DM + col) = o; }
    }
}

struct EpiBf16Out {
    static constexpr bool PERM = true;
    bf16_t* O; int ldc; int nscale; float sc; unsigned* norm;
    __device__ __forceinline__ void operator()(const f32x4 (&acc)[2][2][4][2], const pg8::Unit& u, int wr, int wc, int fr, int fq) const {
        const int row0 = u.pm * 256 + wr * 64 + fr, col0 = u.pn * 256 + wc * 32 + 8 * fq; const float s_ = ((nscale >> u.pn) & 1) ? sc : 1.f;
        if (norm && u.pn < 4) {
#pragma unroll
            for (int bj = 0; bj < 2; ++bj) { float mx = 0.f;
#pragma unroll
                for (int ai = 0; ai < 2; ++ai)
#pragma unroll
                    for (int m = 0; m < 4; ++m) { const f32x4 v0 = acc[ai][bj][m][0] * s_, v1 = acc[ai][bj][m][1] * s_;
                        float ss = (v0[0] * v0[0] + v0[1] * v0[1]) + (v0[2] * v0[2] + v0[3] * v0[3]) + (v1[0] * v1[0] + v1[1] * v1[1]) + (v1[2] * v1[2] + v1[3] * v1[3]);
                        ss += __shfl_xor(ss, 16); ss += __shfl_xor(ss, 32); mx = fmaxf(mx, ss); }
                mx = fmaxf(mx, __shfl_xor(mx, 1)); mx = fmaxf(mx, __shfl_xor(mx, 2)); mx = fmaxf(mx, __shfl_xor(mx, 4)); mx = fmaxf(mx, __shfl_xor(mx, 8));
                if (fr == 0 && fq == 0) atomicMax(norm + (u.pm >> 5) * 32 + u.pn * 8 + bj * 4 + wc, __float_as_uint(mx * 1.001f)); }
        }
#pragma unroll
        for (int ai = 0; ai < 2; ++ai) { if (ai == 1 && u.half) break;
#pragma unroll
            for (int m = 0; m < 4; ++m) { bf16_t* rowp = O + (size_t)(row0 + ai * 128 + m * 16) * ldc + col0;
#pragma unroll
                for (int bj = 0; bj < 2; ++bj) { const f32x4 v0 = acc[ai][bj][m][0] * s_, v1 = acc[ai][bj][m][1] * s_;
                    u32x4 w; w.x = pg8::cvt_pk_bf16(v0[0], v0[1]); w.y = pg8::cvt_pk_bf16(v0[2], v0[3]); w.z = pg8::cvt_pk_bf16(v1[0], v1[1]); w.w = pg8::cvt_pk_bf16(v1[2], v1[3]);
                    *(u32x4*)(rowp + bj * 128) = w; } } }
    }
};
struct EpiF32Out {
    static constexpr bool PERM = false;
    float* O; int ldc;
    __device__ __forceinline__ void operator()(const f32x4 (&acc)[2][2][4][2], const pg8::Unit& u, int wr, int wc, int fr, int fq) const {
        const int row0 = u.pm * 256 + wr * 64 + fr, col0 = u.pn * 256 + wc * 32 + 4 * fq;
#pragma unroll
        for (int ai = 0; ai < 2; ++ai)
#pragma unroll
            for (int m = 0; m < 4; ++m) { float* rowp = O + (size_t)(row0 + ai * 128 + m * 16) * ldc + col0;
#pragma unroll
                for (int bj = 0; bj < 2; ++bj)
#pragma unroll
                    for (int n = 0; n < 2; ++n) *(f32x4*)(rowp + bj * 128 + n * 16) = acc[ai][bj][m][n]; }
    }
};
__device__ __forceinline__ void stage2(const Params& p, unsigned char* smem) {
    pg8::Gemm g{(const bf16_t*)(p.ws + WS_XN), DM};
    pg8::StaticOrder S; S.init(M, UC, gridDim.x, blockIdx.x, (const bf16_t*)(p.ws + WS_WTIN));
    EpiBf16Out E{(bf16_t*)(p.ws + WS_U), UC, 0xC3, attn_body::C2, (unsigned*)(p.ws + WS_CTL) + CTL_NORM};
    pg8::gemm_phase(( PG8_LAS unsigned char*)smem, g, S, E);
}

__device__ __forceinline__ void diff_attn_block(const Params& p, unsigned char* smem, int vb) {
    const int tid = threadIdx.x;
    const int qb = 15 - vb / 32, rest = vb % 32, b = rest >> 4, h = (rest >> 2) & 3, c = (rest >> 1) & 1, vh = rest & 1;
    const bf16_t* U = (const bf16_t*)(p.ws + WS_U);
    float* Ks = (float*)smem;
    float* Vs = (float*)(smem + 16384);
    const int qrow = qb * 512 + tid; const size_t row = (size_t)b * SEQ + qrow;
    float q[64];
    {
        const u32x4* qp = (const u32x4*)(U + row * UC + C_DQ + h * 128 + c * 64);
#pragma unroll
        for (int i = 0; i < 8; ++i) unpack8(qp[i], q + 8 * i);
#pragma unroll
        for (int i = 0; i < 64; ++i) q[i] *= 0.125f;
    }
    float o[64];
#pragma unroll
    for (int i = 0; i < 64; ++i) o[i] = 0.f;
    float m = -1e30f, l = 0.f;
    const float slope = exp2f(-2.f * (float)(h + 1));
    const int ntiles = (qb * 512 + 512) / 64;
    for (int tile = ntiles - 1; tile >= 0; --tile) {
        __syncthreads();
        {
            const int key = tid >> 3, ch = tid & 7; const size_t krow = (size_t)b * SEQ + tile * 64 + key;
            float t8[8];
            unpack8(*(const u32x4*)(U + krow * UC + C_DK + h * 128 + c * 64 + ch * 8), t8);
#pragma unroll
            for (int e = 0; e < 8; ++e) Ks[key * 64 + ch * 8 + e] = t8[e];
            unpack8(*(const u32x4*)(U + krow * UC + C_DV + h * 128 + vh * 64 + ch * 8), t8);
#pragma unroll
            for (int e = 0; e < 8; ++e) Vs[key * 64 + ch * 8 + e] = t8[e];
        }
        __syncthreads();
        const int k0 = tile * 64;
        if (k0 <= qrow) {
#pragma unroll 1
            for (int j = 63; j >= 0; --j) {
                const int kpos = k0 + j;
                if (kpos <= qrow) {
                    const f32x4* kr = (const f32x4*)(Ks + j * 64);
                    float s0 = 0.f, s1 = 0.f;
#pragma unroll
                    for (int d = 0; d < 16; d += 2) { const f32x4 ka = kr[d], kb = kr[d + 1];
                        s0 += q[4 * d] * ka.x + q[4 * d + 1] * ka.y + q[4 * d + 2] * ka.z + q[4 * d + 3] * ka.w;
                        s1 += q[4 * d + 4] * kb.x + q[4 * d + 5] * kb.y + q[4 * d + 6] * kb.z + q[4 * d + 7] * kb.w; }
                    const float s = s0 + s1 - slope * (float)(qrow - kpos);
                    if (s > m) { const float corr = __expf(m - s); l *= corr;
#pragma unroll
                        for (int e = 0; e < 64; ++e) o[e] *= corr;
                        m = s; }
                    const float pr = __expf(s - m); l += pr;
                    const f32x4* vr = (const f32x4*)(Vs + j * 64);
#pragma unroll
                    for (int e = 0; e < 16; ++e) { const f32x4 vv = vr[e]; o[4 * e] += pr * vv.x; o[4 * e + 1] += pr * vv.y; o[4 * e + 2] += pr * vv.z; o[4 * e + 3] += pr * vv.w; }
                }
            }
        }
    }
    const float il = 1.f / l;
    f32x4* op = (f32x4*)((float*)(p.ws + WS_OC) + ((row * 4 + h) * 2 + c) * 128 + vh * 64);
#pragma unroll
    for (int e = 0; e < 16; ++e) op[e] = (f32x4){o[4 * e] * il, o[4 * e + 1] * il, o[4 * e + 2] * il, o[4 * e + 3] * il};
}

__device__ __forceinline__ void write_frags(const bf16_t* kt, const bf16_t* vt, int pitch, bf16_t* kf_tile, bf16_t* vf_tile, int lane) {
    const int r32 = lane & 31, hi = lane >> 5;
    if (kt) {
#pragma unroll
        for (int d0 = 0; d0 < 4; ++d0) *(u32x4*)(kf_tile + (d0 * 64 + lane) * 8) = *(const u32x4*)(kt + r32 * pitch + 16 * d0 + 8 * hi);
    }
    if (vt) {
#pragma unroll
        for (int d0 = 0; d0 < 2; ++d0)
#pragma unroll
            for (int s = 0; s < 2; ++s) { unsigned w[4];
#pragma unroll
                for (int e2 = 0; e2 < 4; ++e2) { const int j = 2 * e2, t0_ = 16 * s + 8 * (j >> 2) + 4 * hi + (j & 3);
                    w[e2] = (unsigned)vt[t0_ * pitch + 32 * d0 + r32] | ((unsigned)vt[(t0_ + 1) * pitch + 32 * d0 + r32] << 16); }
                *(u32x4*)(vf_tile + ((d0 * 2 + s) * 64 + lane) * 8) = (u32x4){w[0], w[1], w[2], w[3]}; }
    }
}
__device__ __forceinline__ void compress_item(const Params& p, unsigned char* smem, int idx) {
    typedef float f32x16 __attribute__((ext_vector_type(16)));
    int tid_ = threadIdx.x; asm volatile("" : "+v"(tid_));
    const int tid = tid_, wid = tid >> 6, lane = tid & 63, r32 = lane & 31, hi = lane >> 5;
    const int kv = idx >> 6, b = (idx >> 5) & 1, hkv = (idx >> 4) & 1, n0 = (idx & 15) * 32;
    const bf16_t* U = (const bf16_t*)(p.ws + WS_U);
    const bf16_t* w1t = (const bf16_t*)(p.ws + WS_W1T) + (size_t)kv * 128 * 2048;
    const bf16_t* w2t = (const bf16_t*)(p.ws + WS_W2T) + (size_t)kv * 64 * 128;
    const float* b1p = (const float*)(p.ws + WS_B1P) + kv * 16 * 128;
    float* hsum = (float*)smem;
    bf16_t* hb = (bf16_t*)(smem + 131072);
    bf16_t* ot = (bf16_t*)(smem + 131072 + 8704);
    const int col = (kv ? C_CV : C_CK) + hkv * 64;
    __syncthreads();
    f32x16 acc[4];
#pragma unroll
    for (int c = 0; c < 4; ++c) acc[c] = (f32x16){};
    const int n = n0 + r32;
#pragma unroll 1
    for (int ii = 0; ii < 4; ++ii) { const int i = 4 * wid + ii, tok = 16 * n + i; const bool ok = tok < SEQ;
        const bf16_t* arow = U + ((size_t)b * SEQ + (ok ? tok : 0)) * UC + col + 8 * hi;
#pragma unroll
        for (int d0 = 0; d0 < 64; d0 += 16) { bf16x8 a = *(const bf16x8*)(arow + d0); if (!ok) a = (bf16x8){};
            const int kk = i * 64 + d0 + 8 * hi;
#pragma unroll
            for (int c = 0; c < 4; ++c) acc[c] = __builtin_amdgcn_mfma_f32_32x32x16_bf16(a, *(const bf16x8*)(w1t + (size_t)(32 * c + r32) * 2048 + kk), acc[c], 0, 0, 0); } }
#pragma unroll
    for (int c = 0; c < 4; ++c)
#pragma unroll
        for (int r = 0; r < 16; ++r) hsum[wid * 4096 + ((r & 3) + 8 * (r >> 2) + 4 * hi) * 128 + 32 * c + r32] = acc[c][r];
    __syncthreads();
    for (int i = tid; i < 4096; i += NT) { const int row = i >> 7, j = i & 127; float bs = 0.f;
#pragma unroll
        for (int c = 0; c < 16; ++c) bs += b1p[c * 128 + j];
        float hs = 0.f;
#pragma unroll
        for (int w = 0; w < 8; ++w) hs += hsum[w * 4096 + i];
        hb[row * 136 + j] = f2bf(gelu_tanh(hs + bs)); }
    __syncthreads();
    if (wid < 2) {
        f32x16 o = (f32x16){};
#pragma unroll
        for (int k0 = 0; k0 < 128; k0 += 16) o = __builtin_amdgcn_mfma_f32_32x32x16_bf16(*(const bf16x8*)(hb + r32 * 136 + k0 + 8 * hi), *(const bf16x8*)(w2t + (size_t)(32 * wid + r32) * 128 + k0 + 8 * hi), o, 0, 0, 0);
        const int d = 32 * wid + r32;
#pragma unroll
        for (int r = 0; r < 16; ++r) { const int nl = (r & 3) + 8 * (r >> 2) + 4 * hi; ot[nl * 72 + d] = (n0 + nl) < NCMP ? f2bf(o[r]) : (bf16_t)0; }
    }
    __syncthreads();
    if (wid == 0) { bf16_t* dst = (bf16_t*)(p.ws + (kv ? WS_VC : WS_KC)) + ((size_t)(b * 2 + hkv) * 16 + (idx & 15)) * 2048;
        write_frags(kv ? nullptr : ot, kv ? ot : nullptr, 72, dst, dst, lane); }
}

__device__ __forceinline__ void vt_item(const Params& p, bf16_t* scr, int item, int lane) {
    const int kind = item >> 9, b = (item >> 8) & 1, hkv = (item >> 7) & 1, blk = item & 127, tok0 = blk * 64;
    const bf16_t* U = (const bf16_t*)(p.ws + WS_U);
    bf16_t* KF = (bf16_t*)(p.ws + (kind ? WS_KFW : WS_KFS)) + (size_t)(b * 2 + hkv) * 64 * SEQ;
    bf16_t* VF = (bf16_t*)(p.ws + (kind ? WS_VFW : WS_VFS)) + (size_t)(b * 2 + hkv) * 64 * SEQ;
    const int kcol = (kind ? C_WK : C_SK) + hkv * 64, vcol = (kind ? C_WV : C_SV) + hkv * 64;
    bf16_t* ks = scr; bf16_t* vs = scr + 64 * 72;
    lds_fence();
#pragma unroll
    for (int i = 0; i < 8; ++i) { const int row = 8 * i + (lane >> 3), ch = lane & 7; const bf16_t* src = U + ((size_t)b * SEQ + tok0 + row) * UC + ch * 8;
        *(u32x4*)(ks + row * 72 + ch * 8) = *(const u32x4*)(src + kcol); *(u32x4*)(vs + row * 72 + ch * 8) = *(const u32x4*)(src + vcol); }
    lds_fence();
#pragma unroll
    for (int t = 0; t < 2; ++t) write_frags(ks + 32 * t * 72, vs + 32 * t * 72, 72, KF + (size_t)(2 * blk + t) * 2048, VF + (size_t)(2 * blk + t) * 2048, lane);
    lds_fence();
}

__device__ __forceinline__ void stage3(const Params& p, unsigned char* smem) {
    for (int vb = blockIdx.x; vb < 128; vb += gridDim.x) compress_item(p, smem, vb);
    __syncthreads();
    { const int t_ = opaque_tid(), wid = t_ >> 6, lane = t_ & 63;
      const int G = gridDim.x, sh = (G >= 256) ? 128 : 0, vbk = (blockIdx.x + G - sh) % G;
      for (int it = vbk * NW + wid; it < 1024; it += G * NW) vt_item(p, (bf16_t*)(smem + wid * 18432), it, lane); }
    __syncthreads();
    __syncthreads();
    {
        const bf16_t* U = (const bf16_t*)(p.ws + WS_U); bf16_t* OB = (bf16_t*)(p.ws + WS_OC);
        unsigned* qhead = (unsigned*)(p.ws + WS_CTL) + CTL_QHEAD; const float* nrm = (const float*)(p.ws + WS_CTL) + CTL_NORM;
        volatile int* bc = (volatile int*)(smem + LDS_BYTES - 64);
        const int nq = (gridDim.x % 8 == 0) ? 8 : 1, myq = blockIdx.x % nq, qlen = 1024 / nq;
        for (;;) {
            __syncthreads();
            if (threadIdx.x == 0) *bc = (int)atomicAdd(qhead + 16 * myq, 1u);
            __syncthreads();
            const int ri = __builtin_amdgcn_readfirstlane(*bc);
            if (ri >= qlen) break;
            const int x = nq == 8 ? myq : (ri >> 7), r = ri & 127;
            const int b = x >> 2, c = (x >> 1) & 1, par = x & 1;
            int k, h;
            if (r < 64) { k = 31 - (r >> 1); h = 2 + (r & 1); } else if (r < 96) { k = 31 - (r - 64); h = 1; } else { k = 31 - (r - 96); h = 0; }
            const int qb = 2 * k + par;
            const int g = h * 4 + c * 2;
            const float qn2 = nrm[b * 32 + g] + nrm[b * 32 + g + 1], kn2 = nrm[b * 32 + 16 + g] + nrm[b * 32 + 16 + g + 1];
            const float sb_ = sqrtf(qn2) * sqrtf(kn2) * 1.001f, slope2 = exp2f(-2.f * (float)(h + 1)) * 1.4426950408889634f;
            const float sc_ = (2.f * sb_ + 127.f * slope2 + 168.f) / (64.f * slope2);
            int ncap = sc_ < 1000.f ? (int)sc_ + 2 : 1000; ncap = (ncap + 1) & ~1; if (ncap < 4) ncap = 4;
            attn_body::attn_unit_pc<8>(b, h, c, qb, U, OB, (char*)smem, __builtin_amdgcn_readfirstlane(ncap));
        }
    }
}

__device__ __forceinline__ void qk4(const bf16_t* krow, const float* qs, float* s) {
    s[0] = s[1] = s[2] = s[3] = 0.f;
#pragma unroll 2
    for (int c = 0; c < 8; ++c) { float kd[8]; unpack8(*(const u32x4*)(krow + c * 8), kd);
#pragma unroll
        for (int g = 0; g < 4; ++g) { const f32x4 qa = *(const f32x4*)(qs + g * 64 + c * 8), qb = *(const f32x4*)(qs + g * 64 + c * 8 + 4);
            s[g] += kd[0] * qa.x + kd[1] * qa.y + kd[2] * qa.z + kd[3] * qa.w + kd[4] * qb.x + kd[5] * qb.y + kd[6] * qb.z + kd[7] * qb.w; } }
}
__device__ __forceinline__ void pv_block(const float* pw, int pstride, const bf16_t* vbase, size_t vstride, int nrows, float (&os)[4][8], int lane) {
    const int jr = lane >> 3, ch = lane & 7;
#pragma unroll 2
    for (int i = 0; i < 8; ++i) { const int j = jr + 8 * i;
        if (j < nrows) { float vd[8]; unpack8(*(const u32x4*)(vbase + (size_t)j * vstride + ch * 8), vd);
#pragma unroll
            for (int g = 0; g < 4; ++g) { const float pr = pw[g * pstride + j];
#pragma unroll
                for (int e = 0; e < 8; ++e) os[g][e] += pr * vd[e]; } } }
}

__device__ __forceinline__ void nsa_item(const Params& p, float* wl, int item, int lane) {
    const int hkv = item & 1, t = (item >> 1) % SEQ, b = (item >> 1) / SEQ;
    const bf16_t* U = (const bf16_t*)(p.ws + WS_U);
    const bf16_t* KC = (const bf16_t*)(p.ws + WS_KC); const bf16_t* VC = (const bf16_t*)(p.ws + WS_VC);
    const size_t row = (size_t)b * SEQ + t;
    float* qs = wl;
    float* ps = wl + 256;
    lds_fence();
#pragma unroll
    for (int g = 0; g < 4; ++g) qs[g * 64 + lane] = bf2f(U[row * UC + C_NQ + (hkv * 4 + g) * 64 + lane]);
    lds_fence();
    float slope[4], gate[4][3];
#pragma unroll
    for (int g = 0; g < 4; ++g) { slope[g] = exp2f(-(float)(hkv * 4 + g + 1));
#pragma unroll
        for (int i = 0; i < 3; ++i) { const float x = bf2f(U[row * UC + C_NG + (hkv * 4 + g) * 3 + i]); gate[g][i] = 1.f / (1.f + __expf(-x)); } }
    float tot[4][8];
#pragma unroll
    for (int g = 0; g < 4; ++g)
#pragma unroll
        for (int e = 0; e < 8; ++e) tot[g][e] = 0.f;
    const int nvalid = t >= 31 ? min((t - 31) / 16 + 1, NCMP) : 0;
    float cinv[4];
    {
        float mx[4] = {-1e30f, -1e30f, -1e30f, -1e30f};
#pragma unroll 1
        for (int i = 0; i < 8; ++i) { const int n = lane + 64 * i;
            asm volatile("" ::: "memory");
            if (n < nvalid) { float s[4]; qk4(KC + ((size_t)(b * 512 + n) * 2 + hkv) * 64, qs, s);
#pragma unroll
                for (int g = 0; g < 4; ++g) { const float v = s[g] * 0.125f - slope[g] * (float)(t - (16 * n + 31)); ps[g * 512 + n] = v; mx[g] = fmaxf(mx[g], v); } }
            else {
#pragma unroll
                for (int g = 0; g < 4; ++g) ps[g * 512 + n] = -1e30f; } }
        lds_fence();
#pragma unroll
        for (int g = 0; g < 4; ++g) { mx[g] = wave_max(mx[g]); float sum = 0.f;
#pragma unroll 1
            for (int i = 0; i < 8; ++i) { const int n = lane + 64 * i; const float e = n < nvalid ? __expf(ps[g * 512 + n] - mx[g]) : 0.f; ps[g * 512 + n] = e; sum += e; }
            sum = wave_sum(sum); cinv[g] = 1.f / fmaxf(sum, 1e-30f); }
        lds_fence();
        float oc[4][8];
#pragma unroll
        for (int g = 0; g < 4; ++g)
#pragma unroll
            for (int e = 0; e < 8; ++e) oc[g][e] = 0.f;
#pragma unroll 1
        for (int n0 = 0; n0 < nvalid; n0 += 64) pv_block(ps + n0, 512, VC + ((size_t)(b * 512 + n0) * 2 + hkv) * 64, 128, min(64, nvalid - n0), oc, lane);
#pragma unroll
        for (int g = 0; g < 4; ++g)
#pragma unroll
            for (int e = 0; e < 8; ++e) tot[g][e] += gate[g][0] * cinv[g] * oc[g][e];
    }
    const int cur = t >> 6;
    int mysel = 0;
    {
        float sc0, sc1;
        { float i0 = 0.f, i1 = 0.f;
#pragma unroll
            for (int g = 0; g < 4; ++g)
#pragma unroll
                for (int d = -1; d <= 3; ++d) { const int n0 = 4 * lane + d, n1 = 4 * (lane + 64) + d;
                    if (n0 >= 0 && n0 < NCMP) i0 += cinv[g] * ps[g * 512 + n0];
                    if (n1 < NCMP) i1 += cinv[g] * ps[g * 512 + n1]; }
            const int j0 = lane, j1 = lane + 64;
            const bool f0 = (j0 == 0) || (j0 == cur) || (j0 == cur - 1), f1 = (j1 == cur) || (j1 == cur - 1);
            sc0 = (j0 <= cur) ? i0 + (f0 ? 1e4f : 0.f) : -1e30f;
            sc1 = (j1 <= cur) ? i1 + (f1 ? 1e4f : 0.f) : -1e30f; }
        for (int r = 0; r < 16; ++r) {
            float v; int idx;
            if (sc0 >= sc1) { v = sc0; idx = lane; } else { v = sc1; idx = lane + 64; }
#pragma unroll
            for (int o = 32; o > 0; o >>= 1) { const float ov = __shfl_xor(v, o); const int oi = __shfl_xor(idx, o); if (ov > v || (ov == v && oi < idx)) { v = ov; idx = oi; } }
            if (idx == lane) sc0 = -3e38f; else if (idx == lane + 64) sc1 = -3e38f;
            if (lane == r) mysel = idx;
        }
    }
#pragma unroll 1
    for (int br = 0; br < 2; ++br) {
        float ms[4], ls[4], os[4][8];
#pragma unroll
        for (int g = 0; g < 4; ++g) { ms[g] = -1e30f; ls[g] = 0.f;
#pragma unroll
            for (int e = 0; e < 8; ++e) os[g][e] = 0.f; }
        const int kcol = (br == 0 ? C_SK : C_WK) + hkv * 64, vcol = (br == 0 ? C_SV : C_WV) + hkv * 64;
        const int lo = br == 0 ? 0 : max(t - 511, 0);
        const int nb = br == 0 ? 16 : (cur - (lo >> 6) + 1);
#pragma unroll 1
        for (int r = 0; r < nb; ++r) {
            int blk;
            if (br == 0) { blk = __shfl(mysel, r); if (blk > cur) continue; } else blk = (lo >> 6) + r;
            const int tok = blk * 64 + lane; const bool valid = tok <= t && tok >= lo;
            float s[4]; qk4(U + ((size_t)b * SEQ + tok) * UC + kcol, qs, s);
            lds_fence();
#pragma unroll
            for (int g = 0; g < 4; ++g) {
                const float sv = valid ? s[g] * 0.125f - slope[g] * (float)(t - tok) : -1e30f;
                const float mx = wave_max(sv), mnew = fmaxf(ms[g], mx), corr = __expf(ms[g] - mnew);
                const float pr = valid ? __expf(sv - mnew) : 0.f;
                ls[g] = ls[g] * corr + wave_sum(pr); ms[g] = mnew;
#pragma unroll
                for (int e = 0; e < 8; ++e) os[g][e] *= corr;
                ps[g * 64 + lane] = pr; }
            lds_fence();
            pv_block(ps, 64, U + ((size_t)b * SEQ + blk * 64) * UC + vcol, UC, 64, os, lane);
        }
#pragma unroll
        for (int g = 0; g < 4; ++g) { const float gsel = br == 0 ? gate[g][1] : gate[g][2]; const float w = ls[g] > 0.f ? gsel / ls[g] : 0.f;
#pragma unroll
            for (int e = 0; e < 8; ++e) tot[g][e] += w * os[g][e]; }
    }
#pragma unroll
    for (int g = 0; g < 4; ++g)
#pragma unroll
        for (int e = 0; e < 8; ++e) { float v = tot[g][e]; v += __shfl_xor(v, 8); v += __shfl_xor(v, 16); v += __shfl_xor(v, 32); tot[g][e] = v; }
    if (lane < 8) { bf16_t* ao = (bf16_t*)(p.ws + WS_AO) + row * DM + 512;
#pragma unroll
        for (int g = 0; g < 4; ++g) { u32x4 o; o.x = pk2(tot[g][0], tot[g][1]); o.y = pk2(tot[g][2], tot[g][3]); o.z = pk2(tot[g][4], tot[g][5]); o.w = pk2(tot[g][6], tot[g][7]);
            *(u32x4*)(ao + (hkv * 4 + g) * 64 + lane * 8) = o; } }
}


namespace nsa {
typedef float f32x16 __attribute__((ext_vector_type(16)));
constexpr int WL_BYTES = 17408;
constexpr float LOG2E = 1.4426950408889634f;
#define NSA_CR(r) (((r) & 3) + 8 * ((r) >> 2))
__device__ __forceinline__ float quad_xor1(float v) { return __int_as_float(__builtin_amdgcn_update_dpp(0, __float_as_int(v), 0xB1, 0xF, 0xF, true)); }
__device__ __forceinline__ float quad_xor2(float v) { return __int_as_float(__builtin_amdgcn_update_dpp(0, __float_as_int(v), 0x4E, 0xF, 0xF, true)); }
__device__ __forceinline__ float hmax(float v) { auto rr = __builtin_amdgcn_permlane32_swap(__float_as_uint(v), __float_as_uint(v), false, false); return fmaxf(__uint_as_float(rr[0]), __uint_as_float(rr[1])); }
__device__ __forceinline__ float hsum(float v) { auto rr = __builtin_amdgcn_permlane32_swap(__float_as_uint(v), __float_as_uint(v), false, false); return __uint_as_float(rr[0]) + __uint_as_float(rr[1]); }
__device__ __forceinline__ unsigned cvtpk(float lo, float hi) { typedef float f2 __attribute__((ext_vector_type(2))); typedef __bf16 b2 __attribute__((ext_vector_type(2))); f2 v = {lo, hi}; b2 r = __builtin_convertvector(v, b2); return __builtin_bit_cast(unsigned, r); }

__device__ __forceinline__ void k_frags(const bf16_t* ktile, bf16x8 (&kf)[4]) {
#pragma unroll
    for (int d0 = 0; d0 < 4; ++d0) kf[d0] = *(const bf16x8*)(ktile + d0 * 512);
}
__device__ __forceinline__ f32x16 qk_ct(const bf16x8 (&kf)[4], const bf16_t* ql, const f32x16& c) {
    bf16x8 q[4];
#pragma unroll
    for (int d0 = 0; d0 < 4; ++d0) q[d0] = *(const bf16x8*)(ql + d0 * 512);
    f32x16 S = __builtin_amdgcn_mfma_f32_32x32x16_bf16(kf[0], q[0], c, 0, 0, 0);
#pragma unroll
    for (int d0 = 1; d0 < 4; ++d0) S = __builtin_amdgcn_mfma_f32_32x32x16_bf16(kf[d0], q[d0], S, 0, 0, 0);
    return S;
}
template <bool MASKED, class VF>
__device__ __forceinline__ void tile_pass1_f(const bf16x8 (&kf)[4], const bf16_t* qf, const f32x16& c1, const VF& valid, const bool (&colon)[2], float (&m)[2], float (&l)[2]) {
#pragma unroll
    for (int ct = 0; ct < 2; ++ct) {
        f32x16 S = qk_ct(kf, qf + ct * 2048, c1);
        float mx = -INFINITY;
#pragma unroll
        for (int r = 0; r < 16; ++r) { if (MASKED) S[r] = valid(ct, r) ? S[r] : -INFINITY; mx = fmaxf(mx, S[r]); }
        mx = hmax(mx);
        const float mn = fmaxf(m[ct], mx); float sum = 0.f;
#pragma unroll
        for (int r = 0; r < 16; ++r) sum += __builtin_amdgcn_exp2f(S[r] - mn);
        if (colon[ct]) { l[ct] = l[ct] * __builtin_amdgcn_exp2f(m[ct] - mn) + sum; m[ct] = mn; }
    }
}
template <bool MASKED, bool HOOK, class VF, class PH>
__device__ __forceinline__ void tile_pass2_p(const bf16x8 (&kf)[4], const bf16_t* qf, const f32x16& crv, const float (&lm)[2], const VF& valid, u32x4 (&pb)[2][2], const PH& ph) {
#pragma unroll
    for (int ct = 0; ct < 2; ++ct) {
        f32x16 c2;
#pragma unroll
        for (int r = 0; r < 16; ++r) c2[r] = crv[r] + lm[ct];
        const f32x16 S = qk_ct(kf, qf + ct * 2048, c2);
        float pr[16];
#pragma unroll
        for (int r = 0; r < 16; ++r) { pr[r] = __builtin_amdgcn_exp2f(S[r]); if (MASKED) pr[r] = valid(ct, r) ? pr[r] : 0.f; }
        if (HOOK) ph(ct, pr);
#pragma unroll
        for (int s = 0; s < 2; ++s) pb[ct][s] = (u32x4){cvtpk(pr[8 * s], pr[8 * s + 1]), cvtpk(pr[8 * s + 2], pr[8 * s + 3]), cvtpk(pr[8 * s + 4], pr[8 * s + 5]), cvtpk(pr[8 * s + 6], pr[8 * s + 7])};
    }
}
template <bool MASKED, class VF>
__device__ __forceinline__ void tile_online_p(const bf16x8 (&kf)[4], const bf16_t* qf, float slope, float base, const bool (&sb)[2], const VF& valid,
                                              float (&mref)[2], bool (&ini)[2], float (&l)[2], f32x16 (&o)[2][2], u32x4 (&pb)[2][2]) {
    f32x16 S[2];
#pragma unroll
    for (int ct = 0; ct < 2; ++ct) {
        const float lm = sb[ct] ? base - mref[ct] : -INFINITY;
        f32x16 c;
#pragma unroll
        for (int r = 0; r < 16; ++r) c[r] = fmaf(slope, (float)NSA_CR(r), lm);
        S[ct] = qk_ct(kf, qf + ct * 2048, c);
    }
    float mx[2]; bool need[2];
#pragma unroll
    for (int ct = 0; ct < 2; ++ct) {
        float m_ = -INFINITY;
#pragma unroll
        for (int r = 0; r < 16; ++r) { if (MASKED) S[ct][r] = valid(ct, r) ? S[ct][r] : -INFINITY; m_ = fmaxf(m_, S[ct][r]); }
        mx[ct] = hmax(m_);
        need[ct] = ini[ct] ? (mx[ct] > 8.f) : (mx[ct] > -INFINITY);
    }
    if (__any(need[0] || need[1])) {
#pragma unroll
        for (int ct = 0; ct < 2; ++ct) {
            const float delta = need[ct] ? mx[ct] : 0.f, f = (need[ct] && ini[ct]) ? __builtin_amdgcn_exp2f(-delta) : 1.f;
            mref[ct] += delta; l[ct] *= f; ini[ct] = ini[ct] || need[ct];
#pragma unroll
            for (int d0 = 0; d0 < 2; ++d0) o[ct][d0] *= f;
#pragma unroll
            for (int r = 0; r < 16; ++r) S[ct][r] -= delta;
        }
    }
#pragma unroll
    for (int ct = 0; ct < 2; ++ct) {
        float pr[16]; float s0 = 0.f, s1 = 0.f;
#pragma unroll
        for (int r = 0; r < 16; r += 2) { pr[r] = __builtin_amdgcn_exp2f(S[ct][r]); pr[r + 1] = __builtin_amdgcn_exp2f(S[ct][r + 1]); s0 += pr[r]; s1 += pr[r + 1]; }
        l[ct] += s0 + s1;
#pragma unroll
        for (int s = 0; s < 2; ++s) pb[ct][s] = (u32x4){cvtpk(pr[8 * s], pr[8 * s + 1]), cvtpk(pr[8 * s + 2], pr[8 * s + 3]), cvtpk(pr[8 * s + 4], pr[8 * s + 5]), cvtpk(pr[8 * s + 6], pr[8 * s + 7])};
    }
}
__device__ __forceinline__ void tile_pass2_v(const bf16x8 (&vf)[2][2], const u32x4 (&pb)[2][2], f32x16 (&o)[2][2]) {
#pragma unroll
    for (int d0 = 0; d0 < 2; ++d0)
#pragma unroll
        for (int s = 0; s < 2; ++s)
#pragma unroll
            for (int ct = 0; ct < 2; ++ct) o[ct][d0] = __builtin_amdgcn_mfma_f32_32x32x16_bf16(vf[d0][s], __builtin_bit_cast(bf16x8, pb[ct][s]), o[ct][d0], 0, 0, 0);
}
__device__ __forceinline__ void v_frags(const bf16_t* vt, bf16x8 (&vf)[2][2]) {
#pragma unroll
    for (int d0 = 0; d0 < 2; ++d0)
#pragma unroll
        for (int s = 0; s < 2; ++s) vf[d0][s] = *(const bf16x8*)(vt + (d0 * 2 + s) * 512);
}
__device__ __forceinline__ void glds16(const void* gsrc, unsigned lds_dst) { unsigned keep;
    asm volatile("s_mov_b32 %0, m0\n\ts_mov_b32 m0, %2\n\ts_nop 0\n\tglobal_load_lds_dwordx4 %1, off\n\ts_mov_b32 m0, %0" : "=&s"(keep) : "v"(gsrc), "s"(lds_dst) : "memory"); }
__device__ __forceinline__ void dma4(const bf16_t* tile, unsigned slot) {
#pragma unroll
    for (int i = 0; i < 4; ++i) glds16(tile + i * 512, slot + i * 1024);
}

struct LaneC { int c32, hi, hc, head, qi0, qi1, tc0, tc1; float slope2; };
__device__ __forceinline__ LaneC lanec(int lane_, int t0, int hkv) {
    int lane = lane_; asm volatile("" : "+v"(lane));
    LaneC L; L.c32 = lane & 31; L.hi = lane >> 5; L.hc = lane & 3; L.head = hkv * 4 + L.hc; L.qi0 = L.c32 >> 2; L.qi1 = 8 + L.qi0; L.tc0 = t0 + L.qi0; L.tc1 = t0 + L.qi1;
    L.slope2 = exp2f(-(float)(L.head + 1)) * LOG2E; return L;
}
__device__ __forceinline__ float gate_of(const bf16_t* U, size_t rowb, int tcol, int head, int which) { return 1.f / (1.f + __expf(-bf2f(U[(rowb + tcol) * UC + C_NG + head * 3 + which]))); }

__device__ __forceinline__ void item(const Params& p, unsigned char* wl, int it, int lane_) {
    const int B_ = it >> 3, w_ = it & 7, x_ = B_ & 7, k_ = (x_ & 1) * 32 + (B_ >> 3), bh = x_ >> 1, qt = (w_ >> 2) ? 511 - (k_ * 4 + (w_ & 3)) : k_ * 4 + (w_ & 3);
    const int b = bh >> 1, hkv = bh & 1, t0 = qt * 16, cur = t0 >> 6;
    const bf16_t* U = (const bf16_t*)(p.ws + WS_U);
    const size_t rowb = (size_t)b * SEQ;
    float* G = (float*)wl; unsigned* selm = (unsigned*)(wl + 16384); unsigned* uni = selm + 64;
    const bf16_t* qf;
    lds_fence();
    {
        const LaneC L = lanec(lane_, t0, hkv);
        bf16_t* ql = (bf16_t*)(wl + 8192) + (lane_ & 63) * 8; qf = ql;
#pragma unroll
        for (int ct = 0; ct < 2; ++ct) {
            const bf16_t* qrow = U + (rowb + (ct ? L.tc1 : L.tc0)) * UC;
#pragma unroll
            for (int d0 = 0; d0 < 4; ++d0) *(bf16x8*)(ql + (ct * 4 + d0) * 512) = *(const bf16x8*)(qrow + C_NQ + L.head * 64 + 16 * d0 + 8 * L.hi);
        }
    }
    f32x16 o[2][2];
#pragma unroll
    for (int ct = 0; ct < 2; ++ct)
#pragma unroll
        for (int d0 = 0; d0 < 2; ++d0) o[ct][d0] = (f32x16){};
    auto nohook = [](int, float*) {};
    lds_fence();
    for (int i = (lane_ & 63); i < 2048; i += 64) ((unsigned*)wl)[i] = 0u;
    for (int i = (lane_ & 63); i < 68; i += 64) selm[i] = 0u;
    lds_fence();
    {
        const LaneC L = lanec(lane_, t0, hkv);
        const int hi = L.hi, c32 = L.c32;
        const bf16_t* KC = (const bf16_t*)(p.ws + WS_KC) + (size_t)(b * 2 + hkv) * 16 * 2048 + (lane_ & 63) * 8;
        const bf16_t* VCt = (const bf16_t*)(p.ws + WS_VC) + (size_t)(b * 2 + hkv) * 16 * 2048 + (lane_ & 63) * 8;
        const int tc[2] = {L.tc0, L.tc1}, qi[2] = {L.qi0, L.qi1};
        int nv[2];
#pragma unroll
        for (int ct = 0; ct < 2; ++ct) nv[ct] = tc[ct] >= 31 ? min((tc[ct] - 31) / 16 + 1, NCMP) : 0;
        const int tl = t0 + 15, nvmax = tl >= 31 ? min((tl - 31) / 16 + 1, NCMP) : 0, ntl = (nvmax + 31) >> 5, nvmin = t0 >= 31 ? min((t0 - 31) / 16 + 1, NCMP) : 0;
        const float sl16 = L.slope2 * 16.f;
        float m[2] = {-30000.f, -30000.f}, l[2] = {0.f, 0.f};
        f32x16 crv;
#pragma unroll
        for (int r = 0; r < 16; ++r) crv[r] = sl16 * (float)NSA_CR(r);
        const bool on2[2] = {true, true};
        bf16x8 kfn[4];
        if (ntl > 0) k_frags(KC, kfn);
#pragma unroll 1
        for (int nt = 0; nt < ntl; ++nt) {
            const int nb = 32 * nt + 4 * hi; const float base = sl16 * (float)nb;
            auto valid = [&](int ct, int r) { return nb + NSA_CR(r) < nv[ct]; };
            bf16x8 kf[4];
#pragma unroll
            for (int d0 = 0; d0 < 4; ++d0) kf[d0] = kfn[d0];
            if (nt + 1 < ntl) k_frags(KC + (nt + 1) * 2048, kfn);
            f32x16 c1;
#pragma unroll
            for (int r = 0; r < 16; ++r) c1[r] = crv[r] + base;
            if (32 * nt + 32 <= nvmin) tile_pass1_f<false>(kf, qf, c1, valid, on2, m, l); else tile_pass1_f<true>(kf, qf, c1, valid, on2, m, l);
        }
        float lmc[2];
#pragma unroll
        for (int ct = 0; ct < 2; ++ct) { const float lt = hsum(l[ct]); lmc[ct] = lt > 0.f ? -__builtin_amdgcn_logf(lt) - m[ct] : -INFINITY; }
        if (ntl > 0) k_frags(KC, kfn);
#pragma unroll 1
        for (int nt = 0; nt < ntl; ++nt) {
            const int nb = 32 * nt + 4 * hi; const float base = sl16 * (float)nb;
            auto valid = [&](int ct, int r) { return nb + NSA_CR(r) < nv[ct]; };
            auto hook = [&](int ct, float* pr) {
#pragma unroll
                for (int k = 0; k < 4; ++k) { float g4 = (pr[4 * k] + pr[4 * k + 1]) + (pr[4 * k + 2] + pr[4 * k + 3]), e = pr[4 * k + 3];
                    g4 += quad_xor1(g4); g4 += quad_xor2(g4); e += quad_xor1(e); e += quad_xor2(e);
                    const int j = 8 * nt + 2 * k + hi;
                    if (L.hc == 0) { atomicAdd(&G[qi[ct] * 128 + j], g4); if (j + 1 < 128) atomicAdd(&G[qi[ct] * 128 + j + 1], e); } } };
            bf16x8 kf[4], vf[2][2];
#pragma unroll
            for (int d0 = 0; d0 < 4; ++d0) kf[d0] = kfn[d0];
            v_frags(VCt + nt * 2048, vf);
            if (nt + 1 < ntl) k_frags(KC + (nt + 1) * 2048, kfn);
            const float lm[2] = {lmc[0] + base, lmc[1] + base};
            u32x4 pb[2][2];
            if (32 * nt + 32 <= nvmin) tile_pass2_p<false, true>(kf, qf, crv, lm, valid, pb, hook); else tile_pass2_p<true, true>(kf, qf, crv, lm, valid, pb, hook);
            tile_pass2_v(vf, pb, o);
        }
        float* AOF = (float*)(p.ws + WS_AOF);
#pragma unroll
        for (int ct = 0; ct < 2; ++ct) { const float gcv = gate_of(U, rowb, tc[ct], L.head, 0); float* orow = AOF + (rowb + tc[ct]) * 512 + L.head * 64 + 4 * hi;
#pragma unroll
            for (int d0 = 0; d0 < 2; ++d0) {
#pragma unroll
                for (int k = 0; k < 4; ++k) *(f32x4*)(orow + 32 * d0 + 8 * k) = (f32x4){o[ct][d0][4 * k] * gcv, o[ct][d0][4 * k + 1] * gcv, o[ct][d0][4 * k + 2] * gcv, o[ct][d0][4 * k + 3] * gcv};
                o[ct][d0] = (f32x16){}; } }
    }
    lds_fence();
    {
        int lane = lane_; asm volatile("" : "+v"(lane));
        unsigned u0 = 0u, u1 = 0u, u2 = 0u, u3 = 0u;
        const int j0 = lane, j1 = lane + 64;
        const bool f0 = (j0 == 0) || (j0 == cur) || (j0 == cur - 1), f1 = (j1 == cur) || (j1 == cur - 1);
        const bool ok0 = j0 <= cur, ok1 = j1 <= cur;
#pragma unroll 1
        for (int q = 0; q < 16; q += 2) {
            unsigned ka0, ka1, kb0, kb1;
            { const float i0 = G[q * 128 + lane], i1 = G[q * 128 + 64 + lane], i2 = G[(q + 1) * 128 + lane], i3 = G[(q + 1) * 128 + 64 + lane];
              ka0 = ok0 ? ((__float_as_uint(i0 + (f0 ? 1e4f : 0.f)) & ~127u) | (unsigned)(127 - j0)) : 0u;
              ka1 = ok1 ? ((__float_as_uint(i1 + (f1 ? 1e4f : 0.f)) & ~127u) | (unsigned)(127 - j1)) : 0u;
              kb0 = ok0 ? ((__float_as_uint(i2 + (f0 ? 1e4f : 0.f)) & ~127u) | (unsigned)(127 - j0)) : 0u;
              kb1 = ok1 ? ((__float_as_uint(i3 + (f1 ? 1e4f : 0.f)) & ~127u) | (unsigned)(127 - j1)) : 0u; }
            unsigned pa = 0u, pb = 0u;
#pragma unroll
            for (int bit = 30; bit >= 0; --bit) {
                const unsigned ca = pa | (1u << bit), cb = pb | (1u << bit);
                const int na = __popcll(__ballot(ka0 >= ca)) + __popcll(__ballot(ka1 >= ca));
                const int nb = __popcll(__ballot(kb0 >= cb)) + __popcll(__ballot(kb1 >= cb));
                pa = na >= 16 ? ca : pa; pb = nb >= 16 ? cb : pb;
            }
            const unsigned long long a0 = __ballot(ok0 && ka0 >= pa), a1 = __ballot(ok1 && ka1 >= pa), b0 = __ballot(ok0 && kb0 >= pb), b1 = __ballot(ok1 && kb1 >= pb);
            if (lane == 0) { selm[q * 4 + 0] = (unsigned)a0; selm[q * 4 + 1] = (unsigned)(a0 >> 32); selm[q * 4 + 2] = (unsigned)a1; selm[q * 4 + 3] = (unsigned)(a1 >> 32);
                selm[q * 4 + 4] = (unsigned)b0; selm[q * 4 + 5] = (unsigned)(b0 >> 32); selm[q * 4 + 6] = (unsigned)b1; selm[q * 4 + 7] = (unsigned)(b1 >> 32); }
            u0 |= (unsigned)a0 | (unsigned)b0; u1 |= (unsigned)(a0 >> 32) | (unsigned)(b0 >> 32); u2 |= (unsigned)a1 | (unsigned)b1; u3 |= (unsigned)(a1 >> 32) | (unsigned)(b1 >> 32);
        }
        if (lane == 0) { uni[0] = u0; uni[1] = u1; uni[2] = u2; uni[3] = u3; }
    }
    lds_fence();
#pragma unroll 1
    for (int br = 0; br < 2; ++br) {
        const LaneC L = lanec(lane_, t0, hkv);
        const int hi = L.hi; const float slope2 = L.slope2;
        const int tc[2] = {L.tc0, L.tc1}, qi[2] = {L.qi0, L.qi1};
        unsigned short* tl = (unsigned short*)(wl + 16896);
        int ntile = 0;
        if (br == 0) {
            const unsigned um0 = __builtin_amdgcn_readfirstlane(uni[0]), um1 = __builtin_amdgcn_readfirstlane(uni[1]), um2 = __builtin_amdgcn_readfirstlane(uni[2]), um3 = __builtin_amdgcn_readfirstlane(uni[3]);
#pragma unroll 1
            for (int j = cur; j >= 0; --j) { const int ws_ = j >> 5; const unsigned uw = ws_ == 0 ? um0 : ws_ == 1 ? um1 : ws_ == 2 ? um2 : um3;
                if ((uw >> (j & 31)) & 1u) { tl[ntile] = (unsigned short)(2 * j); tl[ntile + 1] = (unsigned short)(2 * j + 1); ntile += 2; } }
        } else {
            const int lo_t = (t0 - 511 > 0 ? t0 - 511 : 0) >> 5, hi_t = (t0 + 15) >> 5;
#pragma unroll 1
            for (int kt = hi_t; kt >= lo_t; --kt) { tl[ntile] = (unsigned short)kt; ++ntile; }
        }
        lds_fence();
        const bf16_t* Kb = (const bf16_t*)(p.ws + (br ? WS_KFW : WS_KFS)) + (size_t)(b * 2 + hkv) * 64 * SEQ + (lane_ & 63) * 8;
        static_assert(WS_VFS - WS_KFS == WS_VFW - WS_KFW, "V images sit at one constant distance behind the K images");
        constexpr size_t VOFF = (WS_VFS - WS_KFS) / 2;
        const unsigned slot = (unsigned)__builtin_amdgcn_readfirstlane((unsigned)(uintptr_t)wl);
        const bf16_t* kl = (const bf16_t*)wl + (lane_ & 63) * 8; const bf16_t* vl = (const bf16_t*)(wl + 4096) + (lane_ & 63) * 8;
        float mref[2] = {0.f, 0.f}, l[2] = {0.f, 0.f}; bool ini[2] = {false, false};
        if (ntile > 0) { const int t_ = __builtin_amdgcn_readfirstlane((int)tl[0]); dma4(Kb + (size_t)t_ * 2048, slot); dma4(Kb + (size_t)t_ * 2048 + VOFF, slot + 4096); }
#pragma unroll 1
        for (int idx = 0; idx < ntile; ++idx) {
            const int tile = __builtin_amdgcn_readfirstlane((int)tl[idx]);
            const bool more = idx + 1 < ntile; const int tnext = more ? __builtin_amdgcn_readfirstlane((int)tl[idx + 1]) : 0;
            asm volatile("s_waitcnt vmcnt(4)" ::: "memory");
            bf16x8 kf[4]; k_frags(kl, kf);
            asm volatile("s_waitcnt lgkmcnt(0)" ::: "memory");
            if (more) dma4(Kb + (size_t)tnext * 2048, slot);
            const int tokb = 32 * tile, tb = tokb + 4 * hi; const float base = slope2 * (float)(tb - t0);
            bool sb[2] = {true, true}; bool interior;
            if (br == 0) { const int j = tile >> 1, ws_ = j >> 5, bp = j & 31;
#pragma unroll
                for (int ct = 0; ct < 2; ++ct) sb[ct] = (selm[qi[ct] * 4 + ws_] >> bp) & 1u;
                interior = (j < cur);
            } else interior = (tokb + 31 <= t0 && tokb >= t0 + 15 - 511);
            const int wlo = br ? 511 : (1 << 30);
            auto valid = [&](int ct, int r) { const int tok = tb + NSA_CR(r); return tok <= tc[ct] && tok >= tc[ct] - wlo; };
            u32x4 pb[2][2];
            if (interior) tile_online_p<false>(kf, qf, slope2, base, sb, valid, mref, ini, l, o, pb); else tile_online_p<true>(kf, qf, slope2, base, sb, valid, mref, ini, l, o, pb);
            if (more) asm volatile("s_waitcnt vmcnt(4)" ::: "memory"); else asm volatile("s_waitcnt vmcnt(0)" ::: "memory");
            bf16x8 vf[2][2]; v_frags(vl, vf);
            asm volatile("s_waitcnt lgkmcnt(0)" ::: "memory");
            if (more) dma4(Kb + (size_t)tnext * 2048 + VOFF, slot + 4096);
            tile_pass2_v(vf, pb, o);
        }
        {
            float* AOF = (float*)(p.ws + WS_AOF); bf16_t* AO = (bf16_t*)(p.ws + WS_AO);
#pragma unroll
            for (int ct = 0; ct < 2; ++ct) { const float lt = hsum(l[ct]); const float cw = lt > 0.f ? gate_of(U, rowb, tc[ct], L.head, 1 + br) / lt : 0.f;
                float* frow = AOF + (rowb + tc[ct]) * 512 + L.head * 64 + 4 * hi; bf16_t* orow = AO + (rowb + tc[ct]) * DM + 512 + L.head * 64 + 4 * hi;
#pragma unroll
                for (int d0 = 0; d0 < 2; ++d0) {
#pragma unroll
                    for (int k = 0; k < 4; ++k) { const f32x4 a = *(const f32x4*)(frow + 32 * d0 + 8 * k);
                        const f32x4 v = {a[0] + cw * o[ct][d0][4 * k], a[1] + cw * o[ct][d0][4 * k + 1], a[2] + cw * o[ct][d0][4 * k + 2], a[3] + cw * o[ct][d0][4 * k + 3]};
                        if (br == 0) *(f32x4*)(frow + 32 * d0 + 8 * k) = v;
                        else { u32x2 w2; w2.x = cvtpk(v[0], v[1]); w2.y = cvtpk(v[2], v[3]); *(u32x2*)(orow + 32 * d0 + 8 * k) = w2; } }
                    o[ct][d0] = (f32x16){}; } }
        }
        lds_fence();
    }
}
#undef NSA_CR
}

__device__ __forceinline__ float diff_lambda(const Params& p, int lane) {
    const float a = p.in[9][lane] * p.in[10][lane], c = p.in[11][lane] * p.in[12][lane];
    return __expf(wave_sum(a)) - __expf(wave_sum(c)) + 0.2f;
}
__device__ __forceinline__ void diffc_rows8(const Params& p, int row0, int lane, float lam) {
    const int h = lane >> 4, l16 = lane & 15;
    const bf16_t* oc = (const bf16_t*)(p.ws + WS_OC) + ((size_t)row0 * 4 + h) * 256 + 8 * l16;
    bf16_t* ao = (bf16_t*)(p.ws + WS_AO) + (size_t)row0 * DM + h * 128 + 8 * l16;
    const f32x4 g0 = *(const f32x4*)(p.in[13] + 8 * l16), g1 = *(const f32x4*)(p.in[13] + 8 * l16 + 4);
    const float g[8] = {g0.x * 0.8f, g0.y * 0.8f, g0.z * 0.8f, g0.w * 0.8f, g1.x * 0.8f, g1.y * 0.8f, g1.z * 0.8f, g1.w * 0.8f};
    u32x4 a[8], c[8];
#pragma unroll
    for (int i = 0; i < 8; ++i) { a[i] = *(const u32x4*)(oc + (size_t)i * 1024); c[i] = *(const u32x4*)(oc + (size_t)i * 1024 + 128); }
#pragma unroll
    for (int i = 0; i < 8; ++i) { float x[8], y[8]; unpack8(a[i], x); unpack8(c[i], y); float ss = 0.f;
#pragma unroll
        for (int e = 0; e < 8; ++e) { x[e] -= lam * y[e]; ss += x[e] * x[e]; }
        ss += nsa::quad_xor1(ss); ss += nsa::quad_xor2(ss);
        ss += __int_as_float(__builtin_amdgcn_update_dpp(0, __float_as_int(ss), 0x141, 0xf, 0xf, true));
        ss += __int_as_float(__builtin_amdgcn_update_dpp(0, __float_as_int(ss), 0x140, 0xf, 0xf, true));
        const float rstd = rsqrtf(ss * (1.f / 128.f) + 1e-6f);
        u32x4 o; o.x = pk2(x[0] * rstd * g[0], x[1] * rstd * g[1]); o.y = pk2(x[2] * rstd * g[2], x[3] * rstd * g[3]); o.z = pk2(x[4] * rstd * g[4], x[5] * rstd * g[5]); o.w = pk2(x[6] * rstd * g[6], x[7] * rstd * g[7]);
        *(u32x4*)(ao + (size_t)i * DM) = o; }
}

__device__ __forceinline__ void stage4(const Params& p, unsigned char* smem) {
    const int tid = opaque_tid(), wid = tid >> 6, lane = tid & 63;
    const int gw = blockIdx.x * NW + wid, NGW = gridDim.x * NW;
    for (int it = gw; it < 2048; it += NGW) nsa::item(p, smem + wid * nsa::WL_BYTES, it, lane);
    const float lam = diff_lambda(p, lane);
    for (int it = gw; it < M / 8; it += NGW) diffc_rows8(p, it * 8, lane, lam);
}

__device__ __forceinline__ void stage5(const Params& p, unsigned char* smem) {
    pg8::Gemm g{(const bf16_t*)(p.ws + WS_AO), DM};
    pg8::StaticOrder S; S.init(M, DM, gridDim.x, blockIdx.x, (const bf16_t*)(p.ws + WS_WTOUT));
    EpiBf16Out E{(bf16_t*)(p.ws + WS_MIX), DM, 0, 1.f, nullptr};
    pg8::gemm_phase((PG8_LAS unsigned char*)smem, g, S, E);
}

__device__ __forceinline__ void stage6(const Params& p, unsigned char* smem) {
    int tid_ = threadIdx.x; asm volatile("" : "+v"(tid_));
    const int tid = tid_, wid = tid >> 6, lane = tid & 63;
    const float* mod = (const float*)(p.ws + WS_MOD); const bf16_t* mix = (const bf16_t*)(p.ws + WS_MIX); const bf16x8* wrh = (const bf16x8*)(p.ws + WS_WR); const bf16x8* wrl = wrh + 1024 * 80 / 8;
    bf16_t* h2 = (bf16_t*)(p.ws + WS_H2); bf16_t* x1b = (bf16_t*)(p.ws + WS_MIX);
    int* cnt = (int*)(p.ws + WS_CTL) + CTL_CNT; int* toke = (int*)(p.ws + WS_TOKE); int* tokp = (int*)(p.ws + WS_TOKP); float* tokw = (float*)(p.ws + WS_TOKW);
    float* hq = (float*)smem;
    float* part = (float*)(smem + 65792);
    float* lgs = (float*)(smem + 65792 + 40960);
    for (int chunk = blockIdx.x; chunk < M / 64; chunk += gridDim.x) {
        const int row0 = chunk * 64, b = row0 / SEQ; const float* mb = mod + b * 6144;
        f32x4 ggt[4], gsc[4], shv[4];
#pragma unroll
        for (int j = 0; j < 4; ++j) { const int col = lane * 4 + 256 * j;
            ggt[j] = *(const f32x4*)(p.in[5] + col) * *(const f32x4*)(mb + 2048 + col);
            gsc[j] = *(const f32x4*)(p.in[6] + col) * (*(const f32x4*)(mb + 4096 + col) + 1.f);
            shv[j] = *(const f32x4*)(mb + 3072 + col); }
        u32x2 pm[2][4]; f32x4 px[2][4];
#define S6_LOAD(T) { _Pragma("unroll") for (int rr = 0; rr < 2; ++rr) { const size_t ro = (size_t)(row0 + 16 * (T) + 2 * wid + rr) * DM + lane * 4; \
            _Pragma("unroll") for (int j = 0; j < 4; ++j) { pm[rr][j] = *(const u32x2*)(mix + ro + 256 * j); px[rr][j] = *(const f32x4*)(p.in[0] + ro + 256 * j); } } }
        S6_LOAD(0)
#pragma unroll 1
        for (int t = 0; t < 4; ++t) {
#pragma unroll
            for (int rr = 0; rr < 2; ++rr) {
                const int lr = 2 * wid + rr, row = row0 + 16 * t + lr;
                f32x4 v[4], x1[4]; float ss = 0.f;
#pragma unroll
                for (int j = 0; j < 4; ++j) { const u32x2 mw = pm[rr][j];
                    v[j] = (f32x4){__uint_as_float(mw.x << 16), __uint_as_float(mw.x & 0xffff0000u), __uint_as_float(mw.y << 16), __uint_as_float(mw.y & 0xffff0000u)};
                    ss += v[j].x * v[j].x + v[j].y * v[j].y + v[j].z * v[j].z + v[j].w * v[j].w; }
                const float rstd = rsqrtf(wave_sum(ss) * (1.f / DM) + 1e-6f); float s2 = 0.f;
#pragma unroll
                for (int j = 0; j < 4; ++j) { const int col = lane * 4 + 256 * j;
                    x1[j] = px[rr][j] + ggt[j] * (v[j] * rstd);
                    { u32x2 xo; xo.x = pk2(x1[j].x, x1[j].y); xo.y = pk2(x1[j].z, x1[j].w); *(u32x2*)(x1b + (size_t)row * DM + col) = xo; }
                    s2 += x1[j].x * x1[j].x + x1[j].y * x1[j].y + x1[j].z * x1[j].z + x1[j].w * x1[j].w; }
                const float rstd2 = rsqrtf(wave_sum(s2) * (1.f / DM) + 1e-6f);
#pragma unroll
                for (int j = 0; j < 4; ++j) { const int col = lane * 4 + 256 * j;
                    const f32x4 h = x1[j] * rstd2 * gsc[j] + shv[j];
                    *(f32x4*)(hq + lr * 1028 + col) = h;
                    u32x2 o; o.x = pk2(h.x, h.y); o.y = pk2(h.z, h.w); *(u32x2*)(h2 + (size_t)row * DM + col) = o; }
            }
            if (t < 3) S6_LOAD(t + 1)
            __syncthreads();
            {
                const int r = lane & 15, q = lane >> 4;
                f32x4 acc[5];
#pragma unroll
                for (int j = 0; j < 5; ++j) acc[j] = (f32x4){0.f, 0.f, 0.f, 0.f};
#pragma unroll 2
                for (int s = 0; s < 4; ++s) {
                    const f32x4 a0 = *(const f32x4*)(hq + r * 1028 + 128 * wid + 32 * s + 8 * q), a1 = *(const f32x4*)(hq + r * 1028 + 128 * wid + 32 * s + 8 * q + 4);
                    u32x4 ahw, alw;
                    { const unsigned h0 = pk2(a0.x, a0.y), h1 = pk2(a0.z, a0.w), h2_ = pk2(a1.x, a1.y), h3 = pk2(a1.z, a1.w);
                      ahw = (u32x4){h0, h1, h2_, h3};
                      alw.x = pk2(a0.x - __uint_as_float(h0 << 16), a0.y - __uint_as_float(h0 & 0xffff0000u)); alw.y = pk2(a0.z - __uint_as_float(h1 << 16), a0.w - __uint_as_float(h1 & 0xffff0000u));
                      alw.z = pk2(a1.x - __uint_as_float(h2_ << 16), a1.y - __uint_as_float(h2_ & 0xffff0000u)); alw.w = pk2(a1.z - __uint_as_float(h3 << 16), a1.w - __uint_as_float(h3 & 0xffff0000u)); }
                    const bf16x8 ah = __builtin_bit_cast(bf16x8, ahw), al = __builtin_bit_cast(bf16x8, alw);
                    bf16x8 bh[5], bl[5];
#pragma unroll
                    for (int j = 0; j < 5; ++j) { bh[j] = wrh[((wid * 4 + s) * 5 + j) * 64 + lane]; bl[j] = wrl[((wid * 4 + s) * 5 + j) * 64 + lane]; }
#pragma unroll
                    for (int j = 0; j < 5; ++j) { acc[j] = __builtin_amdgcn_mfma_f32_16x16x32_bf16(ah, bh[j], acc[j], 0, 0, 0);
                        acc[j] = __builtin_amdgcn_mfma_f32_16x16x32_bf16(ah, bl[j], acc[j], 0, 0, 0); acc[j] = __builtin_amdgcn_mfma_f32_16x16x32_bf16(al, bh[j], acc[j], 0, 0, 0); }
                }
#pragma unroll
                for (int j = 0; j < 5; ++j)
#pragma unroll
                    for (int i = 0; i < 4; ++i) part[(wid * 16 + 4 * q + i) * 80 + 16 * j + r] = acc[j][i];
            }
            __syncthreads();
            for (int idx = tid; idx < 1280; idx += NT) { float s = 0.f;
#pragma unroll
                for (int w = 0; w < 8; ++w) s += part[w * 1280 + idx];
                lgs[t * 1280 + idx] = s; }
        }
#undef S6_LOAD
        __syncthreads();
        if (tid < 64) { const int t = row0 + tid; const float* lg = lgs + tid * 80;
            float best = -3e38f; int grp = 0; float l8[8];
#pragma unroll
            for (int i = 0; i < 8; ++i) { l8[i] = lg[64 + i] + p.in[22][i]; if (l8[i] > best) { best = l8[i]; grp = i; } }
            float den = 0.f;
#pragma unroll
            for (int i = 0; i < 8; ++i) den += __expf(l8[i] - best);
            const float pg = 1.f / den;
            float v1 = -3e38f, v2 = -3e38f; int i1 = 0, i2 = 0;
#pragma unroll
            for (int i = 0; i < 8; ++i) { const float v = lg[grp * 8 + i] + p.in[24][grp * 8 + i];
                if (v > v1) { v2 = v1; i2 = i1; v1 = v; i1 = i; } else if (v > v2) { v2 = v; i2 = i; } }
            const float e2 = __expf(v2 - v1), w1 = pg / (1.f + e2), w2 = pg * e2 / (1.f + e2);
            const int ea = grp * 8 + i1, eb = grp * 8 + i2;
            const int xg = chunk & 7;
            const int pa = atomicAdd(&cnt[(xg * 64 + ea) * 16], 1), pb = atomicAdd(&cnt[(xg * 64 + eb) * 16], 1);
            toke[t * 2] = ea; toke[t * 2 + 1] = eb; tokp[t * 2] = pa; tokp[t * 2 + 1] = pb; tokw[t * 2] = w1; tokw[t * 2 + 1] = w2;
            int* elist = (int*)(p.ws + WS_ELIST); elist[ea * 16384 + xg * 2048 + pa] = t; elist[eb * 16384 + xg * 2048 + pb] = t; }
        __syncthreads();
    }
}

__device__ __forceinline__ void expert_bases(const Params& p, int* lb) {
    const int* cntg = (const int*)(p.ws + WS_CTL) + CTL_CNT;
    __syncthreads();
    if (threadIdx.x < 64) {
        const int e = threadIdx.x; int c8[8];
#pragma unroll
        for (int x = 0; x < 8; ++x) c8[x] = cntg[(x * 64 + e) * 16];
        int cnt = 0;
#pragma unroll
        for (int x = 0; x < 8; ++x) { lb[832 + e * 8 + x] = cnt; cnt += c8[x]; }
        lb[768 + e] = cnt;
        const int pad = (cnt + 255) >> 8; int incl = pad;
#pragma unroll
        for (int d = 1; d < 64; d <<= 1) { const int t = __shfl_up(incl, d); if (e >= d) incl += t; }
        const int tb = incl - pad;
        lb[e] = tb * 256;
        if (e == 63) lb[64] = incl;
        for (int t = 0; t < pad; ++t) { lb[128 + tb + t] = e; lb[320 + tb + t] = (cnt - t * 256) <= 128 ? 1 : 0; }
    }
    __syncthreads();
    if (threadIdx.x < 64) {
        const int lane = threadIdx.x, nt = lb[64];
        unsigned long long bf[3], bh[3]; bool hf[3], ok[3];
#pragma unroll
        for (int c = 0; c < 3; ++c) { const int tile = 64 * c + lane; ok[c] = tile < nt; hf[c] = ok[c] && lb[320 + tile] != 0; bh[c] = __ballot(hf[c]); bf[c] = __ballot(ok[c] && !hf[c]); }
        const int nfull = __popcll(bf[0]) + __popcll(bf[1]) + __popcll(bf[2]);
        const unsigned long long lt = (1ull << lane) - 1ull;
        int fb = 0, hb = 0;
#pragma unroll
        for (int c = 0; c < 3; ++c) { if (ok[c]) lb[512 + (hf[c] ? nfull + hb + __popcll(bh[c] & lt) : fb + __popcll(bf[c] & lt))] = 64 * c + lane;
            fb += __popcll(bf[c]); hb += __popcll(bh[c]); }
    }
    __syncthreads();
}
__device__ __forceinline__ int xcd_major_id() { const int G = gridDim.x, c = blockIdx.x; return (G % 8 == 0) ? (c % 8) * (G / 8) + c / 8 : c; }
struct MoeOrder {
    int ntiles, nN, G, c; const int* lb; const char* wbase; size_t estride; const int* elist; const int* cnt;
    unsigned* sig;
    unsigned* wait;
    __device__ __forceinline__ bool next(int i, pg8::Unit& u) const {
        const int L = i * G + c; if (L >= ntiles * nN) return false;
        u.pm = lb[512 + L / nN]; u.pn = L % nN; const int e = lb[128 + u.pm]; u.bbase = wbase + (size_t)e * estride;
        u.half = lb[320 + u.pm]; return true; }
    __device__ __forceinline__ unsigned arow(const pg8::Unit& u, int r) const {
        if (elist) { const int e = lb[128 + u.pm], off = u.pm * 256 - lb[e] + r;
            if (off >= lb[768 + e]) return 0u;
            int x = 0;
#pragma unroll
            for (int i = 1; i < 8; ++i) x += (off >= lb[832 + e * 8 + i]) ? 1 : 0;
            return (unsigned)elist[e * 16384 + x * 2048 + (off - lb[832 + e * 8 + x])]; }
        return (unsigned)(u.pm * 256 + r); }
    __device__ __forceinline__ void a_ready(const pg8::Unit& u) const {
        if (!wait) return;
        unsigned sp = 0;
        while (__hip_atomic_load(wait + u.pm, __ATOMIC_RELAXED, __HIP_MEMORY_SCOPE_AGENT) < 4u) { __builtin_amdgcn_s_sleep(2); if (++sp > (1u << 22)) break; }
        __builtin_amdgcn_fence(__ATOMIC_ACQUIRE, "agent");
    }
    __device__ __forceinline__ void done(const pg8::Unit& u) const {
        if (!sig) return;
        asm volatile("s_waitcnt vmcnt(0)" ::: "memory");
        __builtin_amdgcn_s_barrier();
        if (threadIdx.x == 0) { __builtin_amdgcn_fence(__ATOMIC_RELEASE, "agent"); asm volatile("s_waitcnt vmcnt(0)" ::: "memory");
            (void)__hip_atomic_fetch_add(sig + u.pm, 1u, __ATOMIC_RELAXED, __HIP_MEMORY_SCOPE_AGENT); }
    }
};

struct EpiGateUp {
    static constexpr bool PERM = true;
    bf16_t* O;
    __device__ __forceinline__ void operator()(const f32x4 (&acc)[2][2][4][2], const pg8::Unit& u, int wr, int wc, int fr, int fq) const {
        const int row0 = u.pm * 256 + wr * 64 + fr, col0 = (u.pn * 256 + wc * 32 + 8 * fq) / 2;
#pragma unroll
        for (int ai = 0; ai < 2; ++ai) { if (ai == 1 && u.half) break;
#pragma unroll
            for (int m = 0; m < 4; ++m) { bf16_t* rowp = O + (size_t)(row0 + ai * 128 + m * 16) * 512 + col0;
#pragma unroll
                for (int bj = 0; bj < 2; ++bj) { const f32x4 v0 = acc[ai][bj][m][0], v1 = acc[ai][bj][m][1];
                    u32x2 w; w.x = pg8::cvt_pk_bf16(silu_f(v0[0]) * v0[1], silu_f(v0[2]) * v0[3]); w.y = pg8::cvt_pk_bf16(silu_f(v1[0]) * v1[1], silu_f(v1[2]) * v1[3]);
                    *(u32x2*)(rowp + bj * 64) = w; } } }
    }
};
__device__ __forceinline__ void stage10(const Params& p, unsigned char* smem) {
    int* lb = (int*)(smem + 131072); expert_bases(p, lb);
    pg8::Gemm g{(const bf16_t*)(p.ws + WS_H2), DM};
    MoeOrder S{lb[64], 4, (int)gridDim.x, xcd_major_id(), lb, (const char*)(p.ws + WS_WTGU), (size_t)1024 * 1024 * 2, (const int*)(p.ws + WS_ELIST), (const int*)(p.ws + WS_CTL), nullptr, nullptr};
    EpiGateUp E{(bf16_t*)(p.ws + WS_HID)};
    pg8::gemm_phase((PG8_LAS unsigned char*)smem, g, S, E);
}

__device__ __forceinline__ void stage11(const Params& p, unsigned char* smem) {
    int* lb = (int*)(smem + 131072); expert_bases(p, lb);
    pg8::Gemm g{(const bf16_t*)(p.ws + WS_HID), 512};
    MoeOrder S{lb[64], 4, (int)gridDim.x, xcd_major_id(), lb, (const char*)(p.ws + WS_WTDN), (size_t)1024 * 512 * 2, nullptr, (const int*)(p.ws + WS_CTL), nullptr, nullptr};
    EpiBf16Out E{(bf16_t*)(p.ws + WS_Y), DM, 0, 1.f, nullptr};
    pg8::gemm_phase((PG8_LAS unsigned char*)smem, g, S, E);
}

__device__ __forceinline__ void stage12(const Params& p, unsigned char* smem) {
    int* lb = (int*)(smem + 131072); expert_bases(p, lb);
    const int tid = opaque_tid(), wid = tid >> 6, lane = tid & 63;
    const float* mod = (const float*)(p.ws + WS_MOD); const bf16_t* Y = (const bf16_t*)(p.ws + WS_Y); const bf16_t* X1 = (const bf16_t*)(p.ws + WS_MIX);
    const int* toke = (const int*)(p.ws + WS_TOKE); const int* tokp = (const int*)(p.ws + WS_TOKP); const float* tokw = (const float*)(p.ws + WS_TOKW);
    for (int rg = blockIdx.x * NW + wid; rg < M / 8; rg += gridDim.x * NW) {
        const int rowb = rg * 8, b = rowb / SEQ, xg = (rowb >> 6) & 7;
        int yr = 0; float tw = 0.f;
        if (lane < 16) { const int te = toke[rowb * 2 + lane]; yr = lb[te] + lb[832 + te * 8 + xg] + tokp[rowb * 2 + lane]; tw = tokw[rowb * 2 + lane]; }
        f32x4 ggt[2][2];
#pragma unroll
        for (int j = 0; j < 2; ++j)
#pragma unroll
            for (int h = 0; h < 2; ++h) { const int col = lane * 8 + 512 * j + 4 * h; ggt[j][h] = *(const f32x4*)(p.in[7] + col) * *(const f32x4*)(mod + b * 6144 + 5120 + col); }
        u32x4 ya[2][2], yb[2][2], xv[2][2];
#define S12_LOAD(I, BF) { const int r0 = __builtin_amdgcn_readlane(yr, 2 * (I)), r1 = __builtin_amdgcn_readlane(yr, 2 * (I) + 1); \
            _Pragma("unroll") for (int j = 0; j < 2; ++j) { const int col = lane * 8 + 512 * j; \
                ya[BF][j] = *(const u32x4*)(Y + (size_t)r0 * DM + col); yb[BF][j] = *(const u32x4*)(Y + (size_t)r1 * DM + col); \
                xv[BF][j] = *(const u32x4*)(X1 + (size_t)(rowb + (I)) * DM + col); } }
        S12_LOAD(0, 0)
#pragma unroll
        for (int i = 0; i < 8; ++i) {
            if (i + 1 < 8) { if ((i + 1) & 1) S12_LOAD(i + 1, 1) else S12_LOAD(i + 1, 0) }
            const float w0 = __int_as_float(__builtin_amdgcn_readlane(__float_as_int(tw), 2 * i)), w1 = __int_as_float(__builtin_amdgcn_readlane(__float_as_int(tw), 2 * i + 1));
            float f[2][8], xf[2][8]; float ss = 0.f;
#pragma unroll
            for (int j = 0; j < 2; ++j) { float a[8], c[8]; unpack8(ya[i & 1][j], a); unpack8(yb[i & 1][j], c); unpack8(xv[i & 1][j], xf[j]);
#pragma unroll
                for (int e = 0; e < 8; ++e) { f[j][e] = a[e] * w0 + c[e] * w1; ss += f[j][e] * f[j][e]; } }
            const float rstd = rsqrtf(wave_sum(ss) * (1.f / DM) + 1e-6f);
#pragma unroll
            for (int j = 0; j < 2; ++j)
#pragma unroll
                for (int h = 0; h < 2; ++h) { const int col = lane * 8 + 512 * j + 4 * h;
                    const f32x4 fv = {f[j][4 * h], f[j][4 * h + 1], f[j][4 * h + 2], f[j][4 * h + 3]};
                    const f32x4 xq = {xf[j][4 * h], xf[j][4 * h + 1], xf[j][4 * h + 2], xf[j][4 * h + 3]};
                    *(f32x4*)(p.out + (size_t)(rowb + i) * DM + col) = xq + ggt[j][h] * (fv * rstd); }
        }
#undef S12_LOAD
    }
}

#define GAS __attribute__((address_space(1)))
#define LAS __attribute__((address_space(3)))
#define XB_TMO      128
#define XB_XCNT(j)  (256  + 64 * (j))
#define XB_XSUB(j)  (1280 + 64 * (j))
#define XB_XGEN(j)  (2304 + 64 * (j))
#define XB_TOP      3328
#define XB_TOPGEN   3392
#define XCD_BAR_WORDS 3456
#define XB_SPIN_CAP (1u << 18)
__device__ __forceinline__ unsigned xb_ld(unsigned* p)              { return __hip_atomic_load(p, __ATOMIC_RELAXED, __HIP_MEMORY_SCOPE_AGENT); }
__device__ __forceinline__ unsigned xb_add(unsigned* p, unsigned v) { return __hip_atomic_fetch_add(p, v, __ATOMIC_RELAXED, __HIP_MEMORY_SCOPE_AGENT); }
__device__ __forceinline__ unsigned xb_xcc_id() { return (unsigned)__builtin_amdgcn_s_getreg((3 << 11) | 20) & 0xFu; }
#define XB_SPIN(cond, bar) do { unsigned _sp = 0; while (cond) { __builtin_amdgcn_s_sleep(1); \
    if ((++_sp & 255u) == 0u) { if (xb_ld(&(bar)[XB_TMO])) break; if (_sp > XB_SPIN_CAP) { atomicAdd(&(bar)[XB_TMO], 1u); break; } } } } while (0)
struct XcdBarrier { unsigned* bar; unsigned x; volatile LAS unsigned* st; };
__device__ __forceinline__ XcdBarrier xcd_barrier_post(unsigned* bar, volatile LAS unsigned* st) {
    XcdBarrier b; b.bar = bar; b.x = xb_xcc_id(); b.st = st;
    if (threadIdx.x == 0) (void)xb_add(&bar[XB_XCNT(b.x)], 1u);
    return b;
}
__device__ __forceinline__ void xcd_barrier_complete(unsigned* bar, unsigned x, unsigned& nloc, unsigned& nx) {
    const unsigned G = gridDim.x * gridDim.y * gridDim.z;
    unsigned sum, cnt, mine, sp = 0u;
    for (;;) {
        sum = 0u; cnt = 0u; mine = 0u;
#pragma unroll
        for (unsigned j = 0; j < 16; ++j) { const unsigned c = xb_ld(&bar[XB_XCNT(j)]); sum += c; cnt += (c > 0u) ? 1u : 0u; mine = (j == x) ? c : mine; }
        if (sum == G) break;
        __builtin_amdgcn_s_sleep(1);
        if ((++sp & 255u) == 0u) { if (xb_ld(&bar[XB_TMO])) break; if (sp > XB_SPIN_CAP) { atomicAdd(&bar[XB_TMO], 1u); break; } }
    }
    nloc = mine > 0u ? mine : 1u; nx = cnt > 0u ? cnt : 1u;
}
__device__ __forceinline__ void xcd_barrier(const XcdBarrier& b) {
    asm volatile("s_waitcnt vmcnt(0)" ::: "memory");
    __syncthreads();
    if (threadIdx.x == 0) {
        unsigned* bar = b.bar;
        __builtin_amdgcn_s_waitcnt(0);
        unsigned nloc = b.st[0], nx = b.st[1];
        if (nloc == 0u) { xcd_barrier_complete(bar, b.x, nloc, nx); b.st[0] = nloc; b.st[1] = nx; }
        const unsigned old = xb_add(&bar[XB_XSUB(b.x)], 1u);
        const unsigned gen = old / nloc;
        if (old + 1u == (gen + 1u) * nloc) {
            __builtin_amdgcn_fence(__ATOMIC_RELEASE, "agent");
            asm volatile("s_waitcnt vmcnt(0)" ::: "memory");
            const unsigned og = xb_add(&bar[XB_TOP], 1u);
            const unsigned tg = og / nx;
            if (og + 1u == (tg + 1u) * nx) xb_add(&bar[XB_TOPGEN], 1u);
            else XB_SPIN(xb_ld(&bar[XB_TOPGEN]) == tg, bar);
            __builtin_amdgcn_fence(__ATOMIC_ACQUIRE, "agent");
            xb_add(&bar[XB_XGEN(b.x)], 1u);
            asm volatile("s_waitcnt vmcnt(0)" ::: "memory");
        } else {
            XB_SPIN(xb_ld(&bar[XB_XGEN(b.x)]) == gen, bar);
            __builtin_amdgcn_fence(__ATOMIC_ACQUIRE, "agent");
            asm volatile("s_waitcnt vmcnt(0)" ::: "memory");
        }
    }
    __syncthreads();
}

__device__ __forceinline__ void ctr_barrier(unsigned* base, unsigned epoch) {
    asm volatile("s_waitcnt vmcnt(0)" ::: "memory");
    __syncthreads();
    if (threadIdx.x == 0) {
        __builtin_amdgcn_fence(__ATOMIC_RELEASE, "agent");
        asm volatile("s_waitcnt vmcnt(0)" ::: "memory");
        const unsigned G = gridDim.x, ngrp = (G % 8u == 0u) ? 8u : 1u, g = blockIdx.x % ngrp, per = G / ngrp;
        unsigned* sub = base + 64u * g; unsigned* gen = base + 64u * (8u + g); unsigned* top = base + 64u * 16u;
        const unsigned old = __hip_atomic_fetch_add(sub, 1u, __ATOMIC_RELAXED, __HIP_MEMORY_SCOPE_AGENT);
        if (old + 1u == epoch * per) {
            const unsigned ot = __hip_atomic_fetch_add(top, 1u, __ATOMIC_RELAXED, __HIP_MEMORY_SCOPE_AGENT);
            if (ot + 1u == epoch * ngrp) { for (unsigned j = 0; j < ngrp; ++j) __hip_atomic_store(base + 64u * (8u + j), epoch, __ATOMIC_RELAXED, __HIP_MEMORY_SCOPE_AGENT); }
        }
        unsigned sp = 0;
        while (__hip_atomic_load(gen, __ATOMIC_RELAXED, __HIP_MEMORY_SCOPE_AGENT) < epoch) { __builtin_amdgcn_s_sleep(1); if (++sp > (1u << 22)) break; }
        __builtin_amdgcn_fence(__ATOMIC_ACQUIRE, "agent");
        asm volatile("s_waitcnt vmcnt(0)" ::: "memory");
    }
    __syncthreads();
}
constexpr int NSTAGE = 13;
template <int S> __device__ __forceinline__ void run_stage(const Params& p, unsigned char* smem) {
    if constexpr (S == 0) stage0(p, smem);
    else if constexpr (S == 1) stage1(p);
    else if constexpr (S == 2) stage2(p, smem);
    else if constexpr (S == 3) stage3(p, smem);
    else if constexpr (S == 4) stage4(p, smem);
    else if constexpr (S == 5) stage5(p, smem);
    else if constexpr (S == 6) stage6(p, smem);
    else if constexpr (S == 10) stage10(p, smem);
    else if constexpr (S == 11) stage11(p, smem);
    else if constexpr (S == 12) stage12(p, smem);
}
typedef const __attribute__((address_space(4))) Params* KParams;
template <int S> __device__ __forceinline__ void run_stage_k(unsigned char* smem) {
    KParams kp = (KParams)__builtin_amdgcn_kernarg_segment_ptr();
    asm volatile("" : "+s"(kp));
    Params lp;
#pragma unroll
    for (int i = 0; i < 28; ++i) lp.in[i] = kp->in[i];
    lp.out = kp->out; lp.ws = kp->ws;
    run_stage<S>(lp, smem);
}
#if MK_FUSED
constexpr int CTL_BAR_WORD = 4096;
constexpr int CTL_ZERO_BYTES = 65536 + 49152;
__global__ void __launch_bounds__(NT, 2) mk(Params p) {
    extern __shared__ __attribute__((aligned(16))) unsigned char smem[];
#define CTR() ((unsigned*)(((KParams)__builtin_amdgcn_kernarg_segment_ptr())->ws + WS_CTL) + CTL_BAR_WORD)
    run_stage_k<0>(smem); ctr_barrier(CTR(), 1u);
    run_stage_k<1>(smem); ctr_barrier(CTR(), 2u);
    run_stage_k<2>(smem); ctr_barrier(CTR(), 3u);
    run_stage_k<3>(smem); ctr_barrier(CTR(), 4u);
    run_stage_k<4>(smem); ctr_barrier(CTR(), 5u);
    run_stage_k<5>(smem); ctr_barrier(CTR(), 6u);
    run_stage_k<6>(smem); ctr_barrier(CTR(), 7u);
    run_stage_k<10>(smem); ctr_barrier(CTR(), 8u);
    run_stage_k<11>(smem); ctr_barrier(CTR(), 9u);
    run_stage_k<12>(smem);
#undef CTR
}
#else
template <int S> __global__ void __launch_bounds__(NT, 2) mk1(Params p) {
    extern __shared__ __attribute__((aligned(16))) unsigned char smem[];
    run_stage<S>(p, smem);
}
template <int S> static void launch_stage(const Params& p, int cus, hipStream_t stream) {
    static int grid = 0;
    if (grid == 0) { int per_cu = 0;
        (void)hipFuncSetAttribute((const void*)mk1<S>, hipFuncAttributeMaxDynamicSharedMemorySize, LDS_BYTES);
        (void)hipOccupancyMaxActiveBlocksPerMultiprocessor(&per_cu, (const void*)mk1<S>, NT, LDS_BYTES);
        if (per_cu < 1) per_cu = 1;
        grid = cus * per_cu; (void)hipGetLastError(); }
    hipLaunchKernelGGL(mk1<S>, dim3(grid), dim3(NT), LDS_BYTES, stream, p);
}
#endif

extern "C" void kernel_launch(void* const* d_in, const int* in_sizes, int n_in, void* d_out, int out_size, void* d_ws, size_t ws_size, hipStream_t stream) {
    static int grid = 0, cus = 0;
    if (grid == 0) {
        if (n_in != 28 || out_size != M * DM || ws_size < WS_END) { fprintf(stderr, "kernel_launch: unexpected shapes (n_in %d out %d ws %zu)\n", n_in, out_size, ws_size); grid = -1; return; }
        int dev = 0;
        (void)hipGetDevice(&dev); (void)hipDeviceGetAttribute(&cus, hipDeviceAttributeMultiprocessorCount, dev);
        grid = cus;
#if MK_FUSED
        int per_cu = 0;
        (void)hipFuncSetAttribute((const void*)mk, hipFuncAttributeMaxDynamicSharedMemorySize, LDS_BYTES);
        (void)hipOccupancyMaxActiveBlocksPerMultiprocessor(&per_cu, (const void*)mk, NT, LDS_BYTES);
        if (per_cu < 1) fprintf(stderr, "kernel_launch: occupancy query reports %d workgroups per CU\n", per_cu);
        grid = cus;
#endif
        (void)hipGetLastError();
    }
    if (grid < 0) return;
    Params p{};
    for (int i = 0; i < 28; ++i) p.in[i] = (const float*)d_in[i];
    p.out = (float*)d_out; p.ws = (unsigned char*)d_ws;
#if MK_FUSED
    (void)hipMemsetAsync((char*)d_ws + WS_CTL, 0, CTL_ZERO_BYTES, stream);
    hipLaunchKernelGGL(mk, dim3(grid), dim3(NT), LDS_BYTES, stream, p);
#else
    (void)hipMemsetAsync((char*)d_ws + WS_CTL, 0, 65536 + 49152, stream);
    launch_stage<0>(p, cus, stream); launch_stage<1>(p, cus, stream); launch_stage<2>(p, cus, stream); launch_stage<3>(p, cus, stream);
    launch_stage<4>(p, cus, stream); launch_stage<5>(p, cus, stream); launch_stage<6>(p, cus, stream);
    launch_stage<10>(p, cus, stream); launch_stage<11>(p, cus, stream);
    launch_stage<12>(p, cus, stream);
#endif
}
```

```cpp
#include <hip/hip_runtime.h>
#include <hip/hip_cooperative_groups.h>
#include <cstdio>
#include <cstdint>
namespace cg = cooperative_groups;

#ifndef MK_FUSED
#define MK_FUSED 1
#endif

typedef unsigned short bf16_t;
typedef short bf16x8 __attribute__((ext_vector_type(8)));
typedef float f32x4 __attribute__((ext_vector_type(4)));
typedef unsigned u32x4 __attribute__((ext_vector_type(4)));
typedef unsigned u32x2 __attribute__((ext_vector_type(2)));

constexpr int NT = 512, NW = 8;
constexpr int BATCH = 2, SEQ = 8192, DM = 1024, M = BATCH * SEQ;
constexpr int UC = 3072, IN_COLS = 2840;
constexpr int C_DQ = 0, C_DK = 512, C_DV = 1024, C_NQ = 1536, C_CK = 2048, C_CV = 2176, C_SK = 2304, C_SV = 2432, C_WK = 2560, C_WV = 2688, C_NG = 2816;
constexpr int NEXP = 64, RMAX = 49152, NCMP = 511;
constexpr int LDS_BYTES = 147456;

constexpr size_t MiB = 1u << 20;
constexpr size_t WS_CTL = 0;
constexpr size_t WS_MOD = 65536;
constexpr size_t WS_KC = 2 * MiB;
constexpr size_t WS_VC = 3 * MiB;
constexpr size_t WS_ELIST = 4 * MiB;
constexpr size_t WS_TOKE = 10 * MiB;
constexpr size_t WS_TOKP = WS_TOKE + 128 * 1024;
constexpr size_t WS_TOKW = WS_TOKP + 128 * 1024;
constexpr size_t WS_TOKR = WS_TOKW + 128 * 1024;
constexpr size_t WS_ROWT = 11 * MiB;
constexpr size_t WS_WR = 14 * MiB;
constexpr size_t WS_W1T = 14 * MiB + 512 * 1024;
constexpr size_t WS_W2T = 15 * MiB + 512 * 1024;
constexpr int CTL_NORM = 384;
constexpr int CTL_CNT = 8192;
constexpr int CTL_TREADY = 1024;
constexpr int CTL_TQ = 320;
constexpr int CTL_QHEAD = 448;
constexpr size_t WS_B1P = 15 * MiB + 768 * 1024;
constexpr size_t WS_WTIN = 16 * MiB;
constexpr size_t WS_WTOUT = 22 * MiB;
constexpr size_t WS_WTGU = 24 * MiB;
constexpr size_t WS_WTDN = 152 * MiB;
constexpr size_t WS_XN = 216 * MiB;
constexpr size_t WS_U = 248 * MiB;
constexpr size_t WS_OC = 344 * MiB;
constexpr size_t WS_AO = 408 * MiB;
constexpr size_t WS_MIX = 440 * MiB;
constexpr size_t WS_KFS = 440 * MiB, WS_KFW = 444 * MiB, WS_VFS = 448 * MiB, WS_VFW = 452 * MiB;
constexpr size_t WS_AOF = 456 * MiB;
constexpr size_t WS_H2 = WS_XN;
constexpr size_t WS_H2F = WS_OC;
constexpr size_t WS_HID = WS_U;
constexpr size_t WS_Y = 296 * MiB;
constexpr size_t WS_END = 504 * MiB;

struct Params { const float* in[28]; float* out; unsigned char* ws; };

__device__ __forceinline__ int opaque_tid() { int t = threadIdx.x; asm volatile("" : "+v"(t)); return t; }
__device__ __forceinline__ float bf2f(bf16_t v) { return __uint_as_float(((unsigned)v) << 16); }
__device__ __forceinline__ bf16_t f2bf(float f) { unsigned u = __float_as_uint(f); return (bf16_t)((u + 0x7fffu + ((u >> 16) & 1u)) >> 16); }
__device__ __forceinline__ unsigned pk2(float lo, float hi) { return (unsigned)f2bf(lo) | ((unsigned)f2bf(hi) << 16); }
__device__ __forceinline__ float wave_sum(float v) {
    v += __int_as_float(__builtin_amdgcn_update_dpp(0, __float_as_int(v), 0xB1, 0xF, 0xF, true));
    v += __int_as_float(__builtin_amdgcn_update_dpp(0, __float_as_int(v), 0x4E, 0xF, 0xF, true));
    v += __int_as_float(__builtin_amdgcn_update_dpp(0, __float_as_int(v), 0x141, 0xF, 0xF, true));
    v += __int_as_float(__builtin_amdgcn_update_dpp(0, __float_as_int(v), 0x140, 0xF, 0xF, true));
    const float r0 = __int_as_float(__builtin_amdgcn_readlane(__float_as_int(v), 0)), r1 = __int_as_float(__builtin_amdgcn_readlane(__float_as_int(v), 16));
    const float r2 = __int_as_float(__builtin_amdgcn_readlane(__float_as_int(v), 32)), r3 = __int_as_float(__builtin_amdgcn_readlane(__float_as_int(v), 48));
    return (r0 + r1) + (r2 + r3);
}
__device__ __forceinline__ float wave_max(float v) {
#pragma unroll
    for (int o = 32; o > 0; o >>= 1) v = fmaxf(v, __shfl_xor(v, o));
    return v;
}
__device__ __forceinline__ void lds_fence() { asm volatile("s_waitcnt lgkmcnt(0)" ::: "memory"); }
__device__ __forceinline__ float silu_f(float x) { return x / (1.f + __expf(-x)); }
__device__ __forceinline__ float gelu_tanh(float x) { return 0.5f * x * (1.f + tanhf(0.7978845608028654f * (x + 0.044715f * x * x * x))); }
__device__ __forceinline__ void unpack8(const u32x4 w, float* v) {
    v[0] = __uint_as_float(w.x << 16); v[1] = __uint_as_float(w.x & 0xffff0000u);
    v[2] = __uint_as_float(w.y << 16); v[3] = __uint_as_float(w.y & 0xffff0000u);
    v[4] = __uint_as_float(w.z << 16); v[5] = __uint_as_float(w.z & 0xffff0000u);
    v[6] = __uint_as_float(w.w << 16); v[7] = __uint_as_float(w.w & 0xffff0000u);
}

template <class AF, class Epi>
__device__ __forceinline__ void gemm128(const AF& arow, const bf16_t* Bt, int K, const Epi& epi) {
    const int tid = threadIdx.x, wid = tid >> 6, lane = tid & 63, fr = lane & 15, fq = lane >> 4, wr = wid >> 2, wc = wid & 3;
    const bf16_t* ap[4]; const bf16_t* bp[2];
#pragma unroll
    for (int m = 0; m < 4; ++m) ap[m] = arow(wr * 64 + m * 16 + fr) + fq * 8;
#pragma unroll
    for (int n = 0; n < 2; ++n) bp[n] = Bt + (size_t)(wc * 32 + n * 16 + fr) * K + fq * 8;
    f32x4 acc[4][2];
#pragma unroll
    for (int m = 0; m < 4; ++m)
#pragma unroll
        for (int n = 0; n < 2; ++n) acc[m][n] = (f32x4){0.f, 0.f, 0.f, 0.f};
#pragma unroll 2
    for (int k0 = 0; k0 < K; k0 += 32) {
        bf16x8 a[4], b[2];
#pragma unroll
        for (int m = 0; m < 4; ++m) a[m] = *(const bf16x8*)(ap[m] + k0);
#pragma unroll
        for (int n = 0; n < 2; ++n) b[n] = *(const bf16x8*)(bp[n] + k0);
#pragma unroll
        for (int m = 0; m < 4; ++m)
#pragma unroll
            for (int n = 0; n < 2; ++n) acc[m][n] = __builtin_amdgcn_mfma_f32_16x16x32_bf16(b[n], a[m], acc[m][n], 0, 0, 0);
    }
#pragma unroll
    for (int m = 0; m < 4; ++m)
#pragma unroll
        for (int n = 0; n < 2; ++n) epi(wr * 64 + m * 16 + fr, wc * 32 + n * 16 + fq * 4, acc[m][n]);
}


namespace pg8 {
#define PG8_LAS __attribute__((address_space(3)))
constexpr int BM = 256, BK = 64, HALF = 128, HTB = HALF * BK * 2, STAGE_BYTES = 8 * HTB, NXCD = 8, WGM = 8;
__host__ __device__ __forceinline__ int lds_byte(int r, int c) { const int st = (r >> 4) * 2 + (c >> 5), rr = r & 15, cc = c & 31, ob = rr * 64 + cc * 2; return st * 1024 + (ob ^ (((ob >> 9) & 1) << 5)); }
__host__ __device__ __forceinline__ void stage_rc(int b, int& R, int& C) { const int st = b / 1024, sb = b % 1024, swz = sb ^ (((sb >> 9) & 1) << 5); R = (st >> 1) * 16 + swz / 64; C = (st & 1) * 32 + (swz % 64) / 2; }
__host__ __device__ __forceinline__ int perm32(int rho) { const int n = rho >> 4, i = rho & 15; return 8 * (i >> 2) + 4 * n + (i & 3); }

struct Unit { int pm, pn; const char* bbase; int half; };
struct Gemm { const bf16_t* A; int K; };

struct StaticOrder {
    int nM, nN, nwg, G, c; const char* bt;
    __device__ void init(int Mr, int N, int G_, int c_, const bf16_t* Bt) { nM = Mr / BM; nN = N / BM; nwg = nM * nN; G = G_; c = c_; bt = (const char*)Bt; }
    __device__ bool next(int i, Unit& u) const {
        const long L = (long)i * G + c; if (L >= nwg) return false;
        int wgid = (int)L; { const int q = nwg / NXCD, r = nwg % NXCD, xcd = wgid % NXCD, off = wgid / NXCD; wgid = (xcd < r ? xcd * (q + 1) : r * (q + 1) + (xcd - r) * q) + off; }
        const int nig = WGM * nN, gid = wgid / nig, fm = gid * WGM, gsz = (nM - fm) < WGM ? (nM - fm) : WGM;
        u.pm = fm + ((wgid % nig) % gsz); u.pn = (wgid % nig) / gsz; u.bbase = bt; u.half = 0; return true;
    }
    __device__ __forceinline__ unsigned arow(const Unit& u, int r) const { return (unsigned)(u.pm * BM + r); }
    __device__ __forceinline__ void a_ready(const Unit&) const {}
    __device__ __forceinline__ void done(const Unit&) const {}
};

__device__ __forceinline__ unsigned cvt_pk_bf16(float lo, float hi) { unsigned r; asm volatile("v_cvt_pk_bf16_f32 %0, %1, %2" : "=v"(r) : "v"(lo), "v"(hi)); return r; }

template <class Epi, class Sched>
__device__ __forceinline__ void gemm_phase(PG8_LAS unsigned char* lds, const Gemm g, const Sched& S, const Epi& E) {
    int tid_ = threadIdx.x; asm volatile("" : "+v"(tid_));
    const int tid = tid_, wid = __builtin_amdgcn_readfirstlane(tid >> 6), lane = tid & 63, wr = wid >> 2, wc = wid & 3, fr = lane & 15, fq = lane >> 4;
    const int K = g.K, nt = K / BK;
    int RA[2], CA[2]; unsigned voffB[2];
#pragma unroll
    for (int i = 0; i < 2; ++i) { int R, C; stage_rc(tid * 16 + i * 8192, R, C); const int Rb = Epi::PERM ? ((R & ~31) + perm32(R & 31)) : R;
        RA[i] = R; CA[i] = C; voffB[i] = (unsigned)(Rb * K + C) * 2u; }
    const size_t kstep = (size_t)(BK * 2);
    const size_t hstep = (size_t)HALF * K * 2;
    const size_t tstep = 2 * hstep;
    const unsigned ldsw = (unsigned)wid * 1024u;
    const int aoff = lds_byte(wr * 64 + fr, fq * 8), boff = lds_byte(wc * 32 + fr, fq * 8);
    const char* Abase = (const char*)g.A;
#define PG8_SA(b, h) (((b) * 2 + (h)) * HTB)
#define PG8_SB(b, h) ((4 + (b) * 2 + (h)) * HTB)
#define PG8_STAGE(bufoff, gbase, voff) do { _Pragma("unroll") for (int _i = 0; _i < 2; ++_i) \
        __builtin_amdgcn_global_load_lds((const unsigned*)((const char*)(gbase) + (voff)[_i]), (PG8_LAS unsigned*)(lds + (bufoff) + ldsw + _i * 8192), 16, 0, 0); } while (0)
#define PG8_LDA(dst, b, h) do { _Pragma("unroll") for (int m = 0; m < 4; ++m) _Pragma("unroll") for (int k = 0; k < 2; ++k) dst[m][k] = *(const PG8_LAS bf16x8*)(lds + PG8_SA(b, h) + aoff + m * 2048 + k * 1024); } while (0)
#define PG8_LDB(dst, b, h) do { _Pragma("unroll") for (int n = 0; n < 2; ++n) _Pragma("unroll") for (int k = 0; k < 2; ++k) dst[n][k] = *(const PG8_LAS bf16x8*)(lds + PG8_SB(b, h) + boff + n * 2048 + k * 1024); } while (0)
#define PG8_MMA(ai, bj, At, Bt) do { __builtin_amdgcn_s_setprio(1); _Pragma("unroll") for (int m = 0; m < 4; ++m) _Pragma("unroll") for (int n = 0; n < 2; ++n) _Pragma("unroll") for (int k = 0; k < 2; ++k) \
        acc[ai][bj][m][n] = __builtin_amdgcn_mfma_f32_16x16x32_bf16(Bt[n][k], At[m][k], acc[ai][bj][m][n], 0, 0, 0); __builtin_amdgcn_s_setprio(0); } while (0)
#define PG8_WAIT_V(n) asm volatile("s_waitcnt vmcnt(" #n ")" ::: "memory")
#define PG8_WAIT_L(n) asm volatile("s_waitcnt lgkmcnt(" #n ")" ::: "memory")
#define PG8_BAR __builtin_amdgcn_s_barrier()
#define PG8_SCHED __builtin_amdgcn_sched_barrier(0)
#define PG8_AOFFS(dst, u) do { _Pragma("unroll") for (int _h = 0; _h < 2; ++_h) _Pragma("unroll") for (int _i = 0; _i < 2; ++_i) \
        dst[_h][_i] = (S.arow(u, _h * HALF + RA[_i]) * (unsigned)K + (unsigned)CA[_i]) * 2u; } while (0)
    Unit cur, nxt; int ui = 0;
    if (!S.next(0, cur)) return;
    f32x4 acc[2][2][4][2];
#pragma unroll
    for (int a = 0; a < 2; ++a)
#pragma unroll
        for (int b = 0; b < 2; ++b)
#pragma unroll
            for (int m = 0; m < 4; ++m)
#pragma unroll
                for (int n = 0; n < 2; ++n) acc[a][b][m][n] = (f32x4){0.f, 0.f, 0.f, 0.f};
    bf16x8 At[4][2], B0[2][2], B1[2][2];
    unsigned ca[2][2], na[2][2];
    S.a_ready(cur);
    PG8_AOFFS(ca, cur);
    const char* cB = cur.bbase + (size_t)cur.pn * tstep;
    PG8_STAGE(PG8_SB(0, 0), cB, voffB); PG8_STAGE(PG8_SB(0, 1), cB + hstep, voffB); PG8_STAGE(PG8_SA(0, 0), Abase, ca[0]); PG8_STAGE(PG8_SA(0, 1), Abase, ca[1]);
    if (wr == 1) PG8_BAR;
    PG8_WAIT_V(2); PG8_BAR;
    PG8_STAGE(PG8_SB(1, 0), cB + kstep, voffB); PG8_STAGE(PG8_SA(1, 0), Abase + kstep, ca[0]); PG8_STAGE(PG8_SB(1, 1), cB + hstep + kstep, voffB);
    PG8_WAIT_V(6); PG8_BAR;
    for (;;) {
        const bool has_next = S.next(ui + 1, nxt);
        if (has_next) { PG8_AOFFS(na, nxt); } else {
#pragma unroll
            for (int _h = 0; _h < 2; ++_h)
#pragma unroll
                for (int _i = 0; _i < 2; ++_i) na[_h][_i] = ca[_h][_i]; }
        const char* nB = has_next ? nxt.bbase + (size_t)nxt.pn * tstep : cB;
        const bool full = cur.half == 0;
        for (int t = 0; t < nt; t += 2) {
            const bool last = (t == nt - 2);
            if (last && has_next) S.a_ready(nxt);
            const char* a1 = Abase + (size_t)(t + 1) * kstep;
            const char* a2 = last ? Abase : Abase + (size_t)(t + 2) * kstep; const char* b2 = last ? nB : cB + (size_t)(t + 2) * kstep;
            const char* a3 = a2 + kstep; const char* b3 = b2 + kstep;
            unsigned o2[2][2];
#pragma unroll
            for (int _h = 0; _h < 2; ++_h)
#pragma unroll
                for (int _i = 0; _i < 2; ++_i) o2[_h][_i] = last ? na[_h][_i] : ca[_h][_i];
            PG8_LDB(B0, 0, 0); PG8_LDB(B1, 0, 1); PG8_SCHED; PG8_LDA(At, 0, 0); PG8_STAGE(PG8_SA(1, 1), a1, ca[1]);
            PG8_WAIT_V(8); PG8_WAIT_L(0); PG8_BAR; PG8_MMA(0, 0, At, B0); PG8_MMA(0, 1, At, B1); PG8_BAR; PG8_SCHED;
            PG8_LDA(At, 0, 1); PG8_STAGE(PG8_SB(0, 0), b2, voffB); PG8_STAGE(PG8_SB(0, 1), b2 + hstep, voffB); PG8_STAGE(PG8_SA(0, 0), a2, o2[0]);
            PG8_WAIT_V(8); PG8_WAIT_L(0); PG8_BAR; if (full) { PG8_MMA(1, 0, At, B0); PG8_MMA(1, 1, At, B1); } PG8_BAR; PG8_SCHED;
            PG8_LDB(B0, 1, 0); PG8_LDB(B1, 1, 1); PG8_SCHED; PG8_LDA(At, 1, 0); PG8_STAGE(PG8_SA(0, 1), a2, o2[1]);
            PG8_WAIT_V(8); PG8_WAIT_L(0); PG8_BAR; PG8_MMA(0, 0, At, B0); PG8_MMA(0, 1, At, B1); PG8_BAR; PG8_SCHED;
            PG8_LDA(At, 1, 1); PG8_STAGE(PG8_SB(1, 0), b3, voffB); PG8_STAGE(PG8_SB(1, 1), b3 + hstep, voffB); PG8_STAGE(PG8_SA(1, 0), a3, o2[0]);
            PG8_WAIT_V(8); PG8_WAIT_L(0); PG8_BAR; if (full) { PG8_MMA(1, 0, At, B0); PG8_MMA(1, 1, At, B1); } PG8_BAR; PG8_SCHED;
        }
        if (wr == 0) PG8_BAR;
        E(acc, cur, wr, wc, fr, fq);
        S.done(cur);
        if (!has_next) break;
#pragma unroll
        for (int a = 0; a < 2; ++a)
#pragma unroll
            for (int b = 0; b < 2; ++b)
#pragma unroll
                for (int m = 0; m < 4; ++m)
#pragma unroll
                    for (int n = 0; n < 2; ++n) acc[a][b][m][n] = (f32x4){0.f, 0.f, 0.f, 0.f};
        cur = nxt; cB = nB; ++ui;
#pragma unroll
        for (int _h = 0; _h < 2; ++_h)
#pragma unroll
            for (int _i = 0; _i < 2; ++_i) ca[_h][_i] = na[_h][_i];
        if (wr == 1) PG8_BAR;
    }
    PG8_WAIT_V(0);
    PG8_BAR;
#undef PG8_SA
#undef PG8_SB
#undef PG8_STAGE
#undef PG8_LDA
#undef PG8_LDB
#undef PG8_MMA
#undef PG8_WAIT_V
#undef PG8_WAIT_L
#undef PG8_BAR
#undef PG8_SCHED
#undef PG8_AOFFS
}
}


namespace attn_body {
using bf16x8=__attribute__((ext_vector_type(8)))short;
using s16x4=__attribute__((ext_vector_type(4)))short;
using f32x16=__attribute__((ext_vector_type(16)))float;
constexpr int D=64;
constexpr int QBLK=32,QB=256,KVBLK=64;
constexpr int KP=UC, OP=DM;
__device__ __forceinline__ int crow(int r,int hi){return (r&3)+8*(r>>2)+4*hi;}
#define SBAR() __builtin_amdgcn_sched_barrier(0)
__device__ __forceinline__ void cmask(f32x16&p0,f32x16&p1,int jb,int qrel,int hi){
  const float NEG=-INFINITY; int kb=64*jb+4*hi;
  #pragma unroll
  for(int r=0;r<16;++r){int kv=kb+(r&3)+8*(r>>2); if(kv>qrel)p0[r]=NEG; if(kv+32>qrel)p1[r]=NEG;}
}
constexpr int NSLOT=3, SLOTB=8192;
constexpr int LDS_K=0, LDS_V=NSLOT*SLOTB, LDS_WS=2*NSLOT*SLOTB, LDS_OST=LDS_WS+NW*64*4, LDS_BYTES_A=LDS_OST+NW*4096;
constexpr float C2=0.125f*1.4426950408889634f;
__device__ __forceinline__ void glds16(const void*gsrc,unsigned lds_dst){unsigned keep;
  asm volatile("s_mov_b32 %0, m0\n\ts_mov_b32 m0, %2\n\ts_nop 0\n\tglobal_load_lds_dwordx4 %1, off\n\ts_mov_b32 m0, %0":"=&s"(keep):"v"(gsrc),"s"(lds_dst):"memory");}
__device__ __forceinline__ float max3f(float a,float b,float c){float r;asm("v_max3_f32 %0, %1, %2, %3":"=v"(r):"v"(a),"v"(b),"v"(c));return r;}
__device__ __forceinline__ float max2f(float a,float b){float r;asm("v_max_f32_e32 %0, %1, %2":"=v"(r):"v"(a),"v"(b));return r;}
__device__ __forceinline__ float fsub_s(float a,float b){float r;asm("v_sub_f32_e32 %0, %1, %2":"=v"(r):"v"(a),"v"(b));return r;}
typedef float f32x2_t __attribute__((ext_vector_type(2))); typedef __bf16 bf16x2_t __attribute__((ext_vector_type(2)));
__device__ __forceinline__ unsigned cvtpk_s(float lo,float hi){f32x2_t v={lo,hi};bf16x2_t b=__builtin_convertvector(v,bf16x2_t);return __builtin_bit_cast(unsigned,b);}
#define WAIT_BAR(N) asm volatile("s_waitcnt vmcnt(" #N ") lgkmcnt(0)\n\ts_barrier":::"memory")

__device__ __forceinline__ void qkt(f32x16&p0,f32x16&p1,const char*Kslot,const bf16x8*qr,const f32x16&negm,int r32,int hi){
  const char*kb=Kslot+hi*1024+r32*16;
  #pragma unroll
  for(int d0=0;d0<4;++d0){
    const bf16x8 b0=*reinterpret_cast<const bf16x8*>(kb+d0*2048);
    const bf16x8 b1=*reinterpret_cast<const bf16x8*>(kb+d0*2048+512);
    if(d0==0){p0=__builtin_amdgcn_mfma_f32_32x32x16_bf16(b0,qr[0],negm,0,0,0);p1=__builtin_amdgcn_mfma_f32_32x32x16_bf16(b1,qr[0],negm,0,0,0);}
    else{p0=__builtin_amdgcn_mfma_f32_32x32x16_bf16(b0,qr[d0],p0,0,0,0);p1=__builtin_amdgcn_mfma_f32_32x32x16_bf16(b1,qr[d0],p1,0,0,0);}}
}
typedef __attribute__((address_space(3))) const char* lds_cptr;
typedef short v4i16_t __attribute__((ext_vector_type(4)));
__device__ __forceinline__ void kload8(bf16x8*kf,lds_cptr kp){
  kf[0]=*(const __attribute__((address_space(3))) bf16x8*)(kp);      kf[1]=*(const __attribute__((address_space(3))) bf16x8*)(kp+512);
  kf[2]=*(const __attribute__((address_space(3))) bf16x8*)(kp+2048); kf[3]=*(const __attribute__((address_space(3))) bf16x8*)(kp+2560);
  kf[4]=*(const __attribute__((address_space(3))) bf16x8*)(kp+4096); kf[5]=*(const __attribute__((address_space(3))) bf16x8*)(kp+4608);
  kf[6]=*(const __attribute__((address_space(3))) bf16x8*)(kp+6144); kf[7]=*(const __attribute__((address_space(3))) bf16x8*)(kp+6656);
}
__device__ __forceinline__ void kload2(bf16x8*kf,lds_cptr kp,int j){ kf[2*j]=*(const __attribute__((address_space(3))) bf16x8*)(kp+j*2048); kf[2*j+1]=*(const __attribute__((address_space(3))) bf16x8*)(kp+j*2048+512); }
__device__ __forceinline__ s16x4 vtr(lds_cptr p){ return __builtin_bit_cast(s16x4,__builtin_amdgcn_ds_read_tr16_b64_v4i16((__attribute__((address_space(3))) v4i16_t*)p)); }
__device__ __forceinline__ float rowmax(const f32x16&p0,const f32x16&p1){
  float a=max3f(p0[0],p0[1],p1[0]),b=max3f(p0[2],p0[3],p1[1]);a=max3f(a,p1[2],p1[3]);
  #pragma unroll
  for(int r=4;r<16;r+=4){a=max3f(a,p0[r],p0[r+1]);b=max3f(b,p0[r+2],p0[r+3]);a=max3f(a,p1[r],p1[r+1]);b=max3f(b,p1[r+2],p1[r+3]);}
  const float m=max2f(a,b);
  auto rr=__builtin_amdgcn_permlane32_swap(__float_as_uint(m),__float_as_uint(m),false,false);
  return max2f(__uint_as_float(rr[0]),__uint_as_float(rr[1]));
}
__device__ __forceinline__ void pv(f32x16*o,int vb,bf16x8 pa0,bf16x8 pa1,bf16x8 pa2,bf16x8 pa3){
  #pragma unroll
  for(int d0=0;d0<2;++d0){s16x4 lo[4],hi[4];
    #pragma unroll
    for(int ks=0;ks<4;++ks){
      asm volatile("ds_read_b64_tr_b16 %0,%1 offset:%c2":"=&v"(lo[ks]):"v"(vb),"i"(d0*4096+ks*1024):"memory");
      asm volatile("ds_read_b64_tr_b16 %0,%1 offset:%c2":"=&v"(hi[ks]):"v"(vb),"i"(d0*4096+ks*1024+512):"memory");}
    asm volatile("s_waitcnt lgkmcnt(0)":::"memory");SBAR();
    #define PK(k) (bf16x8){lo[k][0],lo[k][1],lo[k][2],lo[k][3],hi[k][0],hi[k][1],hi[k][2],hi[k][3]}
    o[d0]=__builtin_amdgcn_mfma_f32_32x32x16_bf16(pa0,PK(0),o[d0],0,0,0);
    o[d0]=__builtin_amdgcn_mfma_f32_32x32x16_bf16(pa1,PK(1),o[d0],0,0,0);
    o[d0]=__builtin_amdgcn_mfma_f32_32x32x16_bf16(pa2,PK(2),o[d0],0,0,0);
    o[d0]=__builtin_amdgcn_mfma_f32_32x32x16_bf16(pa3,PK(3),o[d0],0,0,0);
    #undef PK
  }
}

template<int THRL> __device__ __forceinline__ void attn_unit(int b,int vh,int qb,const bf16_t*U,bf16_t*O,char*shm,int ncap){
  int tid_=threadIdx.x; asm volatile("":"+v"(tid_));
  const int tid=tid_,lane=tid&63,r32=lane&31,hi=lane>>5; const int wid=__builtin_amdgcn_readfirstlane(tid>>6);
  const int hh=vh>>2, cc=(vh>>1)&1, vhalf=vh&1;
  const long rowbase=(long)b*SEQ; const int q0=qb*QB;
  const bf16_t*Qw=U+(rowbase+q0+wid*QBLK)*KP+C_DQ+hh*128+cc*64;
  const bf16_t*Kh=U+rowbase*KP+C_DK+hh*128+cc*64,*Vh=U+rowbase*KP+C_DV+hh*128+vhalf*64;
  const float slope2=__uint_as_float(__builtin_amdgcn_readfirstlane(__float_as_uint(exp2f(-2.f*(float)(hh+1))*1.4426950408889634f)));
  const float s64=__uint_as_float(__builtin_amdgcn_readfirstlane(__float_as_uint(64.f*slope2))), s32=__uint_as_float(__builtin_amdgcn_readfirstlane(__float_as_uint(32.f*slope2)));
  const unsigned lds0=(unsigned)(uintptr_t)shm;
  float*wsf=(float*)(shm+LDS_WS)+wid*64;
  const bf16_t*ksrc=Kh+(long)lane*KP+wid*8;
  const bf16_t*vsrc=Vh+(long)(16*(wid&3)+(lane>>2))*KP+(wid>>2)*32+(lane&3)*8;
  const unsigned kdst=lds0+LDS_K+wid*1024, vdst=lds0+LDS_V+wid*1024;
  const int NTT=(q0+QB)/KVBLK;
  const int NT=NTT<ncap?NTT:ncap;
  #define DMA_K(s,slot) glds16(ksrc+(long)(NTT-1-(s))*KVBLK*KP,(unsigned)__builtin_amdgcn_readfirstlane(kdst+(slot)))
  #define DMA_V(s,slot) glds16(vsrc+(long)(NTT-1-(s))*KVBLK*KP,(unsigned)__builtin_amdgcn_readfirstlane(vdst+(slot)))
  const int vb0=(int)(lds0+LDS_V)+((lane>>4)&1)*32+(lane&3)*8+(4*hi+((lane&15)>>2))*64;
  const char*Kbase=shm+LDS_K; bf16x8 kf[8];
  const lds_cptr shm3=(lds_cptr)shm; const lds_cptr kp0=shm3+LDS_K+hi*1024+r32*16; const lds_cptr vp0=shm3+LDS_V+((lane>>4)&1)*32+(lane&3)*8+(4*hi+((lane&15)>>2))*64;
  DMA_K(0,0);DMA_V(0,0);DMA_K(1,SLOTB);
  bf16x8 qr[4];
  #pragma unroll
  for(int d0=0;d0<4;++d0)qr[d0]=*reinterpret_cast<const bf16x8*>(&Qw[(long)r32*KP+d0*16+hi*8]);
  float l_reg=0.f;f32x16 o[2];o[0]=f32x16{};o[1]=f32x16{};
  f32x16 negm;
  #pragma unroll
  for(int r=0;r<16;++r)negm[r]=slope2*(float)(crow(r,hi)-63);
  asm volatile("":"+v"(negm));
  const int qrel=wid*QBLK+r32;
  #define CMASK(P0,P1,s) do{ if((s)<4)cmask(P0,P1,3-(s),qrel,hi);}while(0)
  #define BIAS1(P1) do{ _Pragma("unroll") for(int r=0;r<16;++r)P1[r]+=s32; }while(0)
  #define NEXTTILE() do{ _Pragma("unroll") for(int r=0;r<16;++r)negm[r]-=s64; asm volatile("":"+v"(negm)); }while(0)
  bool resc=false;
  #define START(P0,P1) do{ const float rm=rowmax(P0,P1); resc=false; \
    { const float dl=__builtin_fmaxf(rm,-8192.f); \
      _Pragma("unroll") for(int r=0;r<16;++r){P0[r]=fsub_s(P0[r],dl);P1[r]=fsub_s(P1[r],dl);} \
      _Pragma("unroll") for(int r=0;r<16;++r)negm[r]-=dl; asm volatile("":"+v"(negm)); } \
    _Pragma("unroll") for(int r=0;r<16;++r)P0[r]=__builtin_amdgcn_exp2f(P0[r]); }while(0)
  #define RESC() do{ if(resc){ asm volatile("s_waitcnt lgkmcnt(0)":::"memory"); \
      _Pragma("unroll") for(int d_=0;d_<2;++d_) _Pragma("unroll") for(int r=0;r<16;++r)o[d_][r]*=wsf[crow(r,hi)]; } }while(0)
  f32x16 pA0,pA1,pB0,pB1;
  int sl_prev=0,sl_cur=0,sl_next=SLOTB;
  #define ROT() do{sl_prev=sl_cur;sl_cur=sl_next;sl_next=(sl_next==(NSLOT-1)*SLOTB)?0:sl_next+SLOTB;}while(0)
  DMA_K(2,2*SLOTB);
  WAIT_BAR(3);
  qkt(pA0,pA1,Kbase,qr,negm,r32,hi);asm volatile("s_nop 15\n\ts_nop 7":"+v"(pA0),"+v"(pA1));BIAS1(pA1);CMASK(pA0,pA1,0);
  START(pA0,pA1);
  NEXTTILE();
  _Pragma("unroll") for(int r=0;r<16;++r)pA1[r]=__builtin_amdgcn_exp2f(pA1[r]);
  WAIT_BAR(0);
  DMA_K(3,0);DMA_V(1,SLOTB);
  ROT();
  kload8(kf,kp0+sl_cur);
  WAIT_BAR(2);
  s16x4 vlo[8],vhi[8]; u32x4 pw0,pw1,pw2,pw3;
  #define PKW(P,B) cvtpk_s(P[B],P[B+1])
  #define PAF(k) __builtin_bit_cast(bf16x8,pw##k)
  #define VFR(i) (bf16x8){vlo[i][0],vlo[i][1],vlo[i][2],vlo[i][3],vhi[i][0],vhi[i][1],vhi[i][2],vhi[i][3]}
  #define PIN(x) asm volatile("":"+v"(x))
  #define MX3(a,b,c) __builtin_fmaxf(__builtin_fmaxf((a),(b)),(c))
  #define GAPA(MF,A0,A1,A2,A3,W0,W1,PW) do{ MF; sacc+=A0; sacc+=A1; sacc+=A2; sacc+=A3; PIN(sacc); W0; W1; PIN(PW); SBAR(); }while(0)
  #define EX(v) __builtin_amdgcn_exp2f(v)
  #define GAPB(MF,X,B) do{ MF; X[B]=EX(X[B]); X[B+1]=EX(X[B+1]); X[B+2]=EX(X[B+2]); X[B+3]=EX(X[B+3]); PIN(X); SBAR(); }while(0)
  #define VRD(i) do{ vlo[i]=vtr(vp_+(((i)>>2)*4096+((i)&3)*1024)); vhi[i]=vtr(vp_+(((i)>>2)*4096+((i)&3)*1024+512)); }while(0)
  #define KRD(G,j) do{ if(G){ kload2(kf,kp0+sl_next,j); SBAR(); } }while(0)
  #define STEP(C0,C1,P0,P1,t,GK,GV,GL) do{ SBAR(); \
    const lds_cptr vp_=vp0+sl_prev; \
    VRD(0); SBAR(); float sacc=(P0[0]+P0[1]); \
    GAPA(C0=__builtin_amdgcn_mfma_f32_32x32x16_bf16(kf[0],qr[0],negm,0,0,0), P0[2],P0[3],P0[4],P0[5],     pw0[0]=PKW(P0,0), pw0[1]=PKW(P0,2), pw0); \
    VRD(4); SBAR(); GAPA(C1=__builtin_amdgcn_mfma_f32_32x32x16_bf16(kf[1],qr[0],negm,0,0,0), P0[6],P0[7],P0[8],P0[9],     pw0[2]=PKW(P0,4), pw0[3]=PKW(P0,6), pw0); \
    VRD(1); SBAR(); GAPA(C0=__builtin_amdgcn_mfma_f32_32x32x16_bf16(kf[2],qr[1],C0,0,0,0),   P0[10],P0[11],P0[12],P0[13], pw1[0]=PKW(P0,8), pw1[1]=PKW(P0,10), pw1); \
    VRD(5); SBAR(); GAPA(C1=__builtin_amdgcn_mfma_f32_32x32x16_bf16(kf[3],qr[1],C1,0,0,0),   P0[14],P0[15],P1[0],P1[1],   pw1[2]=PKW(P0,12),pw1[3]=PKW(P0,14), pw1); \
    VRD(2); SBAR(); GAPA(C0=__builtin_amdgcn_mfma_f32_32x32x16_bf16(kf[4],qr[2],C0,0,0,0),   P1[2],P1[3],P1[4],P1[5],     pw2[0]=PKW(P1,0), pw2[1]=PKW(P1,2), pw2); \
    VRD(6); SBAR(); GAPA(C1=__builtin_amdgcn_mfma_f32_32x32x16_bf16(kf[5],qr[2],C1,0,0,0),   P1[6],P1[7],P1[8],P1[9],     pw2[2]=PKW(P1,4), pw2[3]=PKW(P1,6), pw2); \
    VRD(3); SBAR(); GAPA(C0=__builtin_amdgcn_mfma_f32_32x32x16_bf16(kf[6],qr[3],C0,0,0,0),   P1[10],P1[11],P1[12],P1[13], pw3[0]=PKW(P1,8), pw3[1]=PKW(P1,10), pw3); \
    VRD(7); SBAR(); GAPA(C1=__builtin_amdgcn_mfma_f32_32x32x16_bf16(kf[7],qr[3],C1,0,0,0),   P1[14],P1[15],0.f,0.f,       pw3[2]=PKW(P1,12),pw3[3]=PKW(P1,14), pw3); \
    l_reg+=sacc; \
    if(GK){DMA_K((t)+3,sl_cur);} if(GV){DMA_V((t)+1,sl_next);} \
    BIAS1(C1); CMASK(C0,C1,t); \
    { float a=MX3(C0[0],C0[1],C1[0]),b=MX3(C0[2],C0[3],C1[1]); a=MX3(a,C1[2],C1[3]); \
      _Pragma("unroll") for(int r=4;r<16;r+=4){a=MX3(a,C0[r],C0[r+1]);b=MX3(b,C0[r+2],C0[r+3]);a=MX3(a,C1[r],C1[r+1]);b=MX3(b,C1[r+2],C1[r+3]);} \
      float rm=__builtin_fmaxf(a,b); { auto rr=__builtin_amdgcn_permlane32_swap(__float_as_uint(rm),__float_as_uint(rm),false,false); rm=__builtin_fmaxf(__uint_as_float(rr[0]),__uint_as_float(rr[1])); } \
      resc=false; \
      if(__builtin_expect(__any(rm>(float)THRL),0)){ const float dl=__builtin_fmaxf(rm,0.f); \
        _Pragma("unroll") for(int r=0;r<16;++r){C0[r]-=dl;C1[r]-=dl;} \
        _Pragma("unroll") for(int r=0;r<16;++r)negm[r]-=dl; asm volatile("":"+v"(negm)); \
        const float f=__builtin_amdgcn_exp2f(-dl); l_reg*=f; if(hi==0)wsf[r32]=f; resc=true; } } \
    NEXTTILE(); \
    SBAR(); \
    GAPB(o[0]=__builtin_amdgcn_mfma_f32_32x32x16_bf16(PAF(0),VFR(0),o[0],0,0,0), C0,0); \
    GAPB(o[1]=__builtin_amdgcn_mfma_f32_32x32x16_bf16(PAF(0),VFR(4),o[1],0,0,0), C0,4); \
    KRD(GL,0); GAPB(o[0]=__builtin_amdgcn_mfma_f32_32x32x16_bf16(PAF(1),VFR(1),o[0],0,0,0), C0,8); \
    KRD(GL,1); GAPB(o[1]=__builtin_amdgcn_mfma_f32_32x32x16_bf16(PAF(1),VFR(5),o[1],0,0,0), C0,12); \
    KRD(GL,2); GAPB(o[0]=__builtin_amdgcn_mfma_f32_32x32x16_bf16(PAF(2),VFR(2),o[0],0,0,0), C1,0); \
    KRD(GL,3); GAPB(o[1]=__builtin_amdgcn_mfma_f32_32x32x16_bf16(PAF(2),VFR(6),o[1],0,0,0), C1,4); \
    GAPB(o[0]=__builtin_amdgcn_mfma_f32_32x32x16_bf16(PAF(3),VFR(3),o[0],0,0,0), C1,8); \
    GAPB(o[1]=__builtin_amdgcn_mfma_f32_32x32x16_bf16(PAF(3),VFR(7),o[1],0,0,0), C1,12); \
    }while(0)
  int t=1;
  for(;t+5<NT;t+=2){
    STEP(pB0,pB1,pA0,pA1,t,true,true,true);     WAIT_BAR(2); RESC(); ROT();
    STEP(pA0,pA1,pB0,pB1,t+1,true,true,true);   WAIT_BAR(2); RESC(); ROT();
  }
  #define ENDW(tt) do{ if((tt)+3<NT){WAIT_BAR(2);} else if((tt)+2<NT){WAIT_BAR(1);} else {WAIT_BAR(0);} }while(0)
  for(;t+1<NT;t+=2){
    STEP(pB0,pB1,pA0,pA1,t,(t+3<NT),(t+1<NT),(t+1<NT));       ENDW(t);   RESC(); ROT();
    STEP(pA0,pA1,pB0,pB1,t+1,(t+4<NT),(t+2<NT),(t+2<NT));     ENDW(t+1); RESC(); ROT();
  }
  STEP(pB0,pB1,pA0,pA1,NT-1,false,false,false); RESC();
  { float sacc=pB0[0]+pB0[1]; _Pragma("unroll") for(int r=2;r<16;++r)sacc+=pB0[r]; _Pragma("unroll") for(int r=0;r<16;++r)sacc+=pB1[r]; l_reg+=sacc;
    pw0=(u32x4){PKW(pB0,0),PKW(pB0,2),PKW(pB0,4),PKW(pB0,6)};pw1=(u32x4){PKW(pB0,8),PKW(pB0,10),PKW(pB0,12),PKW(pB0,14)};pw2=(u32x4){PKW(pB1,0),PKW(pB1,2),PKW(pB1,4),PKW(pB1,6)};pw3=(u32x4){PKW(pB1,8),PKW(pB1,10),PKW(pB1,12),PKW(pB1,14)};
    SBAR(); pv(o,vb0+sl_cur,PAF(0),PAF(1),PAF(2),PAF(3)); }
  #undef PKW
  #undef PAF
  #undef VFR
  #undef PIN
  #undef MX3
  #undef GAPA
  #undef GAPB
  #undef EX
  #undef VRD
  #undef KRD
  #undef STEP
  #undef ENDW
  {auto rr=__builtin_amdgcn_permlane32_swap(__float_as_uint(l_reg),__float_as_uint(l_reg),false,false);l_reg=__uint_as_float(rr[0])+__uint_as_float(rr[1]);}
  if(hi==0)wsf[32+r32]=l_reg;asm volatile("s_waitcnt lgkmcnt(0)":::"memory");
  float rli[16];
  #pragma unroll
  for(int r=0;r<16;++r)rli[r]=__builtin_amdgcn_rcpf(wsf[32+crow(r,hi)]);
  bf16_t*Ow=O+(rowbase+q0+wid*QBLK)*OP+vh*D;
  { bf16_t*stg=(bf16_t*)(shm+LDS_OST)+wid*2048;
    #pragma unroll
    for(int r=0;r<16;++r){const int orow=crow(r,hi);
      #pragma unroll
      for(int d0=0;d0<2;++d0)stg[orow*64+d0*32+r32]=f2bf(o[d0][r]*rli[r]);}
    asm volatile("s_waitcnt lgkmcnt(0)":::"memory");
    #pragma unroll
    for(int i=0;i<4;++i){const int row=i*8+(lane>>3),ch=lane&7; const u32x4 v=*(const u32x4*)(stg+row*64+ch*8); *(u32x4*)(Ow+(long)row*OP+ch*8)=v;} }
  asm volatile("s_waitcnt lgkmcnt(0)\n\ts_barrier":::"memory");
  #undef DMA_K
  #undef DMA_V
  #undef CMASK
  #undef BIAS1
  #undef NEXTTILE
  #undef START
  #undef RESC
  #undef ROT
}

constexpr int PC_K=0, PC_V0=24576, PC_V1=49152, PC_PX=73728, PC_WS=106496, PC_OST=108544, PC_BYTES=PC_OST+8*4096;
template<int THRL> __device__ __forceinline__ void attn_unit_pc(int b,int hh,int cc,int qb,const bf16_t*U,bf16_t*O,char*shm,int ncap){
  int tid_=threadIdx.x; asm volatile("":"+v"(tid_));
  const int tid=tid_,lane=tid&63,r32=lane&31,hi=lane>>5; const int wid=__builtin_amdgcn_readfirstlane(tid>>6);
  const bool prod=wid<4; const int pw=wid&3;
  const long rowbase=(long)b*SEQ; const int q0=qb*128;
  const float slope2=__uint_as_float(__builtin_amdgcn_readfirstlane(__float_as_uint(exp2f(-2.f*(float)(hh+1))*1.4426950408889634f)));
  const float s64=__uint_as_float(__builtin_amdgcn_readfirstlane(__float_as_uint(64.f*slope2))), s32=__uint_as_float(__builtin_amdgcn_readfirstlane(__float_as_uint(32.f*slope2)));
  const unsigned lds0=(unsigned)(uintptr_t)shm;
  const int NTT=(q0+128)/KVBLK;
  int NT=NTT<ncap?NTT:ncap; if(NT<4)NT=4;
  float*wsf=(float*)(shm+PC_WS)+pw*128;
  char*px=shm+PC_PX+pw*8192;
  bf16_t*Ow=O+(rowbase+q0+pw*QBLK)*OP+(hh*4+cc*2+(prod?0:1))*D;
  #define TILE_OF(s) ((NTT-1-(s))>0?(NTT-1-(s)):0)
  if(prod){
    const bf16_t*Qw=U+(rowbase+q0+pw*QBLK)*KP+C_DQ+hh*128+cc*64;
    const bf16_t*Kh=U+rowbase*KP+C_DK+hh*128+cc*64,*Vh=U+rowbase*KP+C_DV+hh*128;
    const bf16_t*ksrc=Kh+(long)lane*KP+(2*pw)*8;
    const bf16_t*vsrc0=Vh+(long)(16*((2*pw)&3)+(lane>>2))*KP+((2*pw)>>2)*32+(lane&3)*8;
    const bf16_t*vsrc1=Vh+(long)(16*((2*pw+1)&3)+(lane>>2))*KP+((2*pw+1)>>2)*32+(lane&3)*8;
    const unsigned kdst=lds0+PC_K+(2*pw)*1024, vdst=lds0+PC_V0+(2*pw)*1024;
    #define DMA_K(s,slot) do{ const long to_=(long)TILE_OF(s)*KVBLK*KP; const unsigned d_=(unsigned)__builtin_amdgcn_readfirstlane(kdst+(slot)); glds16(ksrc+to_,d_); glds16(ksrc+to_+8,d_+1024); }while(0)
    #define DMA_V(s,slot) do{ const long to_=(long)TILE_OF(s)*KVBLK*KP; const unsigned d_=(unsigned)__builtin_amdgcn_readfirstlane(vdst+(slot)); glds16(vsrc0+to_,d_); glds16(vsrc1+to_,d_+1024); }while(0)
    const int vb0=(int)(lds0+PC_V0)+((lane>>4)&1)*32+(lane&3)*8+(4*hi+((lane&15)>>2))*64;
    const char*Kbase=shm+PC_K; bf16x8 kf[8];
    const lds_cptr shm3=(lds_cptr)shm; const lds_cptr kp0=shm3+PC_K+hi*1024+r32*16; const lds_cptr vp0=shm3+PC_V0+((lane>>4)&1)*32+(lane&3)*8+(4*hi+((lane&15)>>2))*64;
    DMA_K(0,0);DMA_V(0,0);DMA_K(1,SLOTB);
    bf16x8 qr[4];
    #pragma unroll
    for(int d0=0;d0<4;++d0)qr[d0]=*reinterpret_cast<const bf16x8*>(&Qw[(long)r32*KP+d0*16+hi*8]);
    float l_reg=0.f;f32x16 o[2];o[0]=f32x16{};o[1]=f32x16{};
    f32x16 negm;
    #pragma unroll
    for(int r=0;r<16;++r)negm[r]=slope2*(float)(crow(r,hi)-63);
    asm volatile("":"+v"(negm));
    const int qrel=pw*QBLK+r32;
    #define CMASK(P0,P1,s) do{ if((s)<2)cmask(P0,P1,1-(s),qrel,hi); else if(NTT-1-(s)<0){ _Pragma("unroll") for(int r=0;r<16;++r){P0[r]=-INFINITY;P1[r]=-INFINITY;} } }while(0)
    #define BIAS1(P1) do{ _Pragma("unroll") for(int r=0;r<16;++r)P1[r]+=s32; }while(0)
    #define NEXTTILE() do{ _Pragma("unroll") for(int r=0;r<16;++r)negm[r]-=s64; asm volatile("":"+v"(negm)); }while(0)
    bool resc=false;
    #define START(P0,P1) do{ const float rm=rowmax(P0,P1); resc=false; \
      { const float dl=__builtin_fmaxf(rm,-8192.f); \
        _Pragma("unroll") for(int r=0;r<16;++r){P0[r]=fsub_s(P0[r],dl);P1[r]=fsub_s(P1[r],dl);} \
        _Pragma("unroll") for(int r=0;r<16;++r)negm[r]-=dl; asm volatile("":"+v"(negm)); } \
      _Pragma("unroll") for(int r=0;r<16;++r)P0[r]=__builtin_amdgcn_exp2f(P0[r]); }while(0)
    #define RESC(t) do{ if(resc){ asm volatile("s_waitcnt lgkmcnt(0)":::"memory"); \
        _Pragma("unroll") for(int d_=0;d_<2;++d_) _Pragma("unroll") for(int r=0;r<16;++r)o[d_][r]*=wsf[32*((t)&1)+crow(r,hi)]; } }while(0)
    f32x16 pA0,pA1,pB0,pB1;
    int sl_prev=0,sl_cur=0,sl_next=SLOTB;
    #define ROT() do{sl_prev=sl_cur;sl_cur=sl_next;sl_next=(sl_next==(NSLOT-1)*SLOTB)?0:sl_next+SLOTB;}while(0)
    DMA_K(2,2*SLOTB);
    WAIT_BAR(6);
    qkt(pA0,pA1,Kbase,qr,negm,r32,hi);asm volatile("s_nop 15\n\ts_nop 7":"+v"(pA0),"+v"(pA1));BIAS1(pA1);CMASK(pA0,pA1,0);
    START(pA0,pA1);
    NEXTTILE();
    _Pragma("unroll") for(int r=0;r<16;++r)pA1[r]=__builtin_amdgcn_exp2f(pA1[r]);
    WAIT_BAR(0);
    DMA_K(3,0);DMA_V(1,SLOTB);
    ROT();
    kload8(kf,kp0+sl_cur);
    WAIT_BAR(4);
    s16x4 vlo[8],vhi[8]; u32x4 pw0,pw1,pw2,pw3;
    #define PKW(P,B) cvtpk_s(P[B],P[B+1])
    #define PAF(k) __builtin_bit_cast(bf16x8,pw##k)
    #define VFR(i) (bf16x8){vlo[i][0],vlo[i][1],vlo[i][2],vlo[i][3],vhi[i][0],vhi[i][1],vhi[i][2],vhi[i][3]}
    #define PIN(x) asm volatile("":"+v"(x))
    #define MX3(a,b,c) __builtin_fmaxf(__builtin_fmaxf((a),(b)),(c))
    #define GAPA(MF,A0,A1,A2,A3,W0,W1,PW) do{ MF; sacc+=A0; sacc+=A1; sacc+=A2; sacc+=A3; PIN(sacc); W0; W1; PIN(PW); SBAR(); }while(0)
    #define EX(v) __builtin_amdgcn_exp2f(v)
    #define GAPB(MF,X,B) do{ MF; X[B]=EX(X[B]); X[B+1]=EX(X[B+1]); X[B+2]=EX(X[B+2]); X[B+3]=EX(X[B+3]); PIN(X); SBAR(); }while(0)
    #define VRD(i) do{ vlo[i]=vtr(vp_+(((i)>>2)*4096+((i)&3)*1024)); vhi[i]=vtr(vp_+(((i)>>2)*4096+((i)&3)*1024+512)); }while(0)
    #define KRD(G,j) do{ if(G){ kload2(kf,kp0+sl_next,j); SBAR(); } }while(0)
    #define PXW(tt) do{ char*pb_=px+4096*((tt)&1)+16*lane; *(u32x4*)(pb_)=pw0; *(u32x4*)(pb_+1024)=pw1; *(u32x4*)(pb_+2048)=pw2; *(u32x4*)(pb_+3072)=pw3; }while(0)
    #define STEP(C0,C1,P0,P1,t,GK,GV,GL) do{ SBAR(); \
      const lds_cptr vp_=vp0+sl_prev; \
      VRD(0); SBAR(); float sacc=(P0[0]+P0[1]); \
      GAPA(C0=__builtin_amdgcn_mfma_f32_32x32x16_bf16(kf[0],qr[0],negm,0,0,0), P0[2],P0[3],P0[4],P0[5],     pw0[0]=PKW(P0,0), pw0[1]=PKW(P0,2), pw0); \
      VRD(4); SBAR(); GAPA(C1=__builtin_amdgcn_mfma_f32_32x32x16_bf16(kf[1],qr[0],negm,0,0,0), P0[6],P0[7],P0[8],P0[9],     pw0[2]=PKW(P0,4), pw0[3]=PKW(P0,6), pw0); \
      VRD(1); SBAR(); GAPA(C0=__builtin_amdgcn_mfma_f32_32x32x16_bf16(kf[2],qr[1],C0,0,0,0),   P0[10],P0[11],P0[12],P0[13], pw1[0]=PKW(P0,8), pw1[1]=PKW(P0,10), pw1); \
      VRD(5); SBAR(); GAPA(C1=__builtin_amdgcn_mfma_f32_32x32x16_bf16(kf[3],qr[1],C1,0,0,0),   P0[14],P0[15],P1[0],P1[1],   pw1[2]=PKW(P0,12),pw1[3]=PKW(P0,14), pw1); \
      VRD(2); SBAR(); GAPA(C0=__builtin_amdgcn_mfma_f32_32x32x16_bf16(kf[4],qr[2],C0,0,0,0),   P1[2],P1[3],P1[4],P1[5],     pw2[0]=PKW(P1,0), pw2[1]=PKW(P1,2), pw2); \
      VRD(6); SBAR(); GAPA(C1=__builtin_amdgcn_mfma_f32_32x32x16_bf16(kf[5],qr[2],C1,0,0,0),   P1[6],P1[7],P1[8],P1[9],     pw2[2]=PKW(P1,4), pw2[3]=PKW(P1,6), pw2); \
      VRD(3); SBAR(); GAPA(C0=__builtin_amdgcn_mfma_f32_32x32x16_bf16(kf[6],qr[3],C0,0,0,0),   P1[10],P1[11],P1[12],P1[13], pw3[0]=PKW(P1,8), pw3[1]=PKW(P1,10), pw3); \
      VRD(7); SBAR(); GAPA(C1=__builtin_amdgcn_mfma_f32_32x32x16_bf16(kf[7],qr[3],C1,0,0,0),   P1[14],P1[15],0.f,0.f,       pw3[2]=PKW(P1,12),pw3[3]=PKW(P1,14), pw3); \
      l_reg+=sacc; PXW((t)-1); \
      if(GK){DMA_K((t)+3,sl_cur);} if(GV){DMA_V((t)+1,sl_next);} \
      BIAS1(C1); CMASK(C0,C1,t); \
      { float a=MX3(C0[0],C0[1],C1[0]),b=MX3(C0[2],C0[3],C1[1]); a=MX3(a,C1[2],C1[3]); \
        _Pragma("unroll") for(int r=4;r<16;r+=4){a=MX3(a,C0[r],C0[r+1]);b=MX3(b,C0[r+2],C0[r+3]);a=MX3(a,C1[r],C1[r+1]);b=MX3(b,C1[r+2],C1[r+3]);} \
        float rm=__builtin_fmaxf(a,b); { auto rr=__builtin_amdgcn_permlane32_swap(__float_as_uint(rm),__float_as_uint(rm),false,false); rm=__builtin_fmaxf(__uint_as_float(rr[0]),__uint_as_float(rr[1])); } \
        resc=false; \
        if(__builtin_expect(__any(rm>(float)THRL),0)){ const float dl=__builtin_fmaxf(rm,0.f); \
          _Pragma("unroll") for(int r=0;r<16;++r){C0[r]-=dl;C1[r]-=dl;} \
          _Pragma("unroll") for(int r=0;r<16;++r)negm[r]-=dl; asm volatile("":"+v"(negm)); \
          const float f=__builtin_amdgcn_exp2f(-dl); l_reg*=f; if(hi==0)wsf[32*((t)&1)+r32]=f; resc=true; } \
        if(lane==0)wsf[64+((t)&1)]=resc?1.f:0.f; } \
      NEXTTILE(); \
      SBAR(); \
      GAPB(o[0]=__builtin_amdgcn_mfma_f32_32x32x16_bf16(PAF(0),VFR(0),o[0],0,0,0), C0,0); \
      GAPB(o[1]=__builtin_amdgcn_mfma_f32_32x32x16_bf16(PAF(0),VFR(4),o[1],0,0,0), C0,4); \
      KRD(GL,0); GAPB(o[0]=__builtin_amdgcn_mfma_f32_32x32x16_bf16(PAF(1),VFR(1),o[0],0,0,0), C0,8); \
      KRD(GL,1); GAPB(o[1]=__builtin_amdgcn_mfma_f32_32x32x16_bf16(PAF(1),VFR(5),o[1],0,0,0), C0,12); \
      KRD(GL,2); GAPB(o[0]=__builtin_amdgcn_mfma_f32_32x32x16_bf16(PAF(2),VFR(2),o[0],0,0,0), C1,0); \
      KRD(GL,3); GAPB(o[1]=__builtin_amdgcn_mfma_f32_32x32x16_bf16(PAF(2),VFR(6),o[1],0,0,0), C1,4); \
      GAPB(o[0]=__builtin_amdgcn_mfma_f32_32x32x16_bf16(PAF(3),VFR(3),o[0],0,0,0), C1,8); \
      GAPB(o[1]=__builtin_amdgcn_mfma_f32_32x32x16_bf16(PAF(3),VFR(7),o[1],0,0,0), C1,12); \
      }while(0)
    int t=1;
    for(;t+5<NT;t+=2){
      STEP(pB0,pB1,pA0,pA1,t,true,true,true);     WAIT_BAR(4); RESC(t);   ROT();
      STEP(pA0,pA1,pB0,pB1,t+1,true,true,true);   WAIT_BAR(4); RESC(t+1); ROT();
    }
    #define ENDW(tt) do{ if((tt)+3<NT){WAIT_BAR(4);} else if((tt)+2<NT){WAIT_BAR(2);} else {WAIT_BAR(0);} }while(0)
    for(;t+1<NT;t+=2){
      STEP(pB0,pB1,pA0,pA1,t,(t+3<NT),(t+1<NT),(t+1<NT));       ENDW(t);   RESC(t);   ROT();
      STEP(pA0,pA1,pB0,pB1,t+1,(t+4<NT),(t+2<NT),(t+2<NT));     ENDW(t+1); RESC(t+1); ROT();
    }
    STEP(pB0,pB1,pA0,pA1,NT-1,false,false,false); RESC(NT-1);
    { float sacc=pB0[0]+pB0[1]; _Pragma("unroll") for(int r=2;r<16;++r)sacc+=pB0[r]; _Pragma("unroll") for(int r=0;r<16;++r)sacc+=pB1[r]; l_reg+=sacc;
      pw0=(u32x4){PKW(pB0,0),PKW(pB0,2),PKW(pB0,4),PKW(pB0,6)};pw1=(u32x4){PKW(pB0,8),PKW(pB0,10),PKW(pB0,12),PKW(pB0,14)};pw2=(u32x4){PKW(pB1,0),PKW(pB1,2),PKW(pB1,4),PKW(pB1,6)};pw3=(u32x4){PKW(pB1,8),PKW(pB1,10),PKW(pB1,12),PKW(pB1,14)};
      { char*pb_=shm+PC_K+pw*4096+16*lane; *(u32x4*)(pb_)=pw0; *(u32x4*)(pb_+1024)=pw1; *(u32x4*)(pb_+2048)=pw2; *(u32x4*)(pb_+3072)=pw3; }
      SBAR(); pv(o,vb0+sl_cur,PAF(0),PAF(1),PAF(2),PAF(3)); }
    {auto rr=__builtin_amdgcn_permlane32_swap(__float_as_uint(l_reg),__float_as_uint(l_reg),false,false);l_reg=__uint_as_float(rr[0])+__uint_as_float(rr[1]);}
    if(hi==0)wsf[96+r32]=l_reg;
    WAIT_BAR(0);
    float rli[16];
    #pragma unroll
    for(int r=0;r<16;++r)rli[r]=__builtin_amdgcn_rcpf(wsf[96+crow(r,hi)]);
    { bf16_t*stg=(bf16_t*)(shm+PC_OST)+wid*2048;
      #pragma unroll
      for(int r=0;r<16;++r){const int orow=crow(r,hi);
        #pragma unroll
        for(int d0=0;d0<2;++d0)stg[orow*64+d0*32+r32]=f2bf(o[d0][r]*rli[r]);}
      asm volatile("s_waitcnt lgkmcnt(0)":::"memory");
      #pragma unroll
      for(int i=0;i<4;++i){const int row=i*8+(lane>>3),ch=lane&7; const u32x4 v=*(const u32x4*)(stg+row*64+ch*8); *(u32x4*)(Ow+(long)row*OP+ch*8)=v;} }
    asm volatile("s_waitcnt lgkmcnt(0)\n\ts_barrier":::"memory");
    #undef PKW
    #undef PAF
    #undef VFR
    #undef PIN
    #undef MX3
    #undef GAPA
    #undef GAPB
    #undef EX
    #undef VRD
    #undef KRD
    #undef PXW
    #undef STEP
    #undef ENDW
    #undef DMA_K
    #undef DMA_V
    #undef CMASK
    #undef BIAS1
    #undef NEXTTILE
    #undef START
    #undef RESC
    #undef ROT
  } else {
    const bf16_t*Vh=U+rowbase*KP+C_DV+hh*128+64;
    const bf16_t*vsrc0=Vh+(long)(16*((2*pw)&3)+(lane>>2))*KP+((2*pw)>>2)*32+(lane&3)*8;
    const bf16_t*vsrc1=Vh+(long)(16*((2*pw+1)&3)+(lane>>2))*KP+((2*pw+1)>>2)*32+(lane&3)*8;
    const unsigned vdst=lds0+PC_V1+(2*pw)*1024;
    #define DMA_V1(j) do{ const long to_=(long)TILE_OF(j)*KVBLK*KP; const unsigned d_=(unsigned)__builtin_amdgcn_readfirstlane(vdst+((j)%3)*SLOTB); glds16(vsrc0+to_,d_); glds16(vsrc1+to_,d_+1024); }while(0)
    const int vb1=(int)(lds0+PC_V1)+((lane>>4)&1)*32+(lane&3)*8+(4*hi+((lane&15)>>2))*64;
    f32x16 o[2];o[0]=f32x16{};o[1]=f32x16{};
    #define CPVB(j,PB) do{ const char*pb_=(PB); const u32x4 a0=*(const u32x4*)(pb_),a1=*(const u32x4*)(pb_+1024),a2=*(const u32x4*)(pb_+2048),a3=*(const u32x4*)(pb_+3072); \
        pv(o,vb1+((j)%3)*SLOTB,__builtin_bit_cast(bf16x8,a0),__builtin_bit_cast(bf16x8,a1),__builtin_bit_cast(bf16x8,a2),__builtin_bit_cast(bf16x8,a3)); \
        if((j)+1<NT && wsf[64+(((j)+1)&1)]!=0.f){ _Pragma("unroll") for(int d_=0;d_<2;++d_) _Pragma("unroll") for(int r=0;r<16;++r)o[d_][r]*=wsf[32*(((j)+1)&1)+crow(r,hi)]; } }while(0)
    #define CPV(j) CPVB(j, px+4096*((j)&1)+16*lane)
    DMA_V1(0); DMA_V1(1);
    WAIT_BAR(2);
    WAIT_BAR(2);
    WAIT_BAR(2);
    WAIT_BAR(2);
    #pragma unroll 1
    for(int j=0;j+2<NT;++j){
      if(j+2<NT) DMA_V1(j+2);
      CPV(j);
      if(j+3<NT){ WAIT_BAR(2); } else { WAIT_BAR(0); }
    }
    CPV(NT-2);
    CPVB(NT-1, shm+PC_K+pw*4096+16*lane);
    float rli[16];
    #pragma unroll
    for(int r=0;r<16;++r)rli[r]=__builtin_amdgcn_rcpf(wsf[96+crow(r,hi)]);
    { bf16_t*stg=(bf16_t*)(shm+PC_OST)+wid*2048;
      #pragma unroll
      for(int r=0;r<16;++r){const int orow=crow(r,hi);
        #pragma unroll
        for(int d0=0;d0<2;++d0)stg[orow*64+d0*32+r32]=f2bf(o[d0][r]*rli[r]);}
      asm volatile("s_waitcnt lgkmcnt(0)":::"memory");
      #pragma unroll
      for(int i=0;i<4;++i){const int row=i*8+(lane>>3),ch=lane&7; const u32x4 v=*(const u32x4*)(stg+row*64+ch*8); *(u32x4*)(Ow+(long)row*OP+ch*8)=v;} }
    asm volatile("s_waitcnt lgkmcnt(0)\n\ts_barrier":::"memory");
    #undef DMA_V1
    #undef CPV
    #undef CPVB
  }
  #undef TILE_OF
}
#undef SBAR
#undef WAIT_BAR
}

__device__ __forceinline__ void transpose_item(const float* W, int K, int Nsrc, bf16_t* WT, int roff, int rmul, float* scr, int kb, int nb, int lane) {
    const int k0 = 64 * kb, n0 = 32 * nb;
    float tv[32];
#pragma unroll
    for (int i = 0; i < 32; ++i) { const int kk = 2 * i + (lane >> 5), n = n0 + (lane & 31); tv[i] = (n < Nsrc) ? __builtin_nontemporal_load(W + (size_t)(k0 + kk) * Nsrc + n) : 0.f; }
#pragma unroll
    for (int i = 0; i < 32; ++i) scr[(2 * i + (lane >> 5)) * 33 + (lane & 31)] = tv[i];
    lds_fence();
    const int c = lane & 7;
#pragma unroll
    for (int j = 0; j < 4; ++j) { const int n = (lane >> 3) + 8 * j; const float* s = scr + (8 * c) * 33 + n;
        u32x4 o; o.x = pk2(s[0 * 33], s[1 * 33]); o.y = pk2(s[2 * 33], s[3 * 33]); o.z = pk2(s[4 * 33], s[5 * 33]); o.w = pk2(s[6 * 33], s[7 * 33]);
        __builtin_nontemporal_store(o, (u32x4*)(WT + (size_t)(roff + (n0 + n) * rmul) * K + k0 + 8 * c)); }
    lds_fence();
}

__device__ __forceinline__ void stage0(const Params& p, unsigned char* smem) {
    const int tid = opaque_tid(), wid = tid >> 6, lane = tid & 63, G = gridDim.x;
    unsigned char* ws = p.ws;
    for (int it = blockIdx.x; it < 96; it += G) {
        float* ssl = (float*)(smem + 73728);
        float* mp = (float*)(smem + 73728 + 8192);
        for (int i = tid; i < 2048; i += NT) ssl[i] = silu_f(p.in[1][i]);
        __syncthreads();
        const float* wa = p.in[2]; const int j = it * 64 + lane; float a0 = 0.f, a1 = 0.f;
#pragma unroll 1
        for (int k0 = 128 * wid; k0 < 128 * wid + 128; k0 += 32) { float wv[32];
#pragma unroll
            for (int k = 0; k < 32; ++k) wv[k] = __builtin_nontemporal_load(wa + (size_t)(k0 + k) * 6144 + j);
#pragma unroll
            for (int k = 0; k < 32; ++k) { a0 += ssl[k0 + k] * wv[k]; a1 += ssl[1024 + k0 + k] * wv[k]; } }
        mp[wid * 128 + lane] = a0; mp[wid * 128 + 64 + lane] = a1;
        __syncthreads();
        if (tid < 128) { float s = p.in[3][it * 64 + (tid & 63)];
#pragma unroll
            for (int w = 0; w < 8; ++w) s += mp[w * 128 + tid];
            ((float*)(ws + WS_MOD))[(tid >> 6) * 6144 + it * 64 + (tid & 63)] = s; }
        __syncthreads();
    }
    {
        float* scr = (float*)(smem + wid * 8448);
        const int gw = blockIdx.x * NW + wid, NGW = G * NW;
        constexpr int I_IN = 16 * 96, I_OUT = 16 * 32, I_E = 256;
        constexpr int NITEMS = I_IN + I_OUT + 64 * 3 * I_E, I_C = 2 * (128 + 4), I_B = 32;
        for (int it = gw; it < I_C + I_B; it += NGW) {
            if (it < I_C) { const int kv = it / 132, r = it % 132;
                if (r < 128) transpose_item(p.in[kv ? 17 : 16], 2048, 128, (bf16_t*)(ws + WS_W1T) + (size_t)kv * 128 * 2048, 0, 1, scr, r >> 2, r & 3, lane);
                else transpose_item(p.in[kv ? 19 : 18], 128, 64, (bf16_t*)(ws + WS_W2T) + (size_t)kv * 64 * 128, 0, 1, scr, (r - 128) >> 1, (r - 128) & 1, lane);
            } else { const int r = it - I_C, kv = r >> 4, kc = r & 15; const float* pos = p.in[kv ? 15 : 14]; const float* w1 = p.in[kv ? 17 : 16];
                float a0 = 0.f, a1 = 0.f;
#pragma unroll 8
                for (int k = kc * 128; k < kc * 128 + 128; ++k) { const float pv = pos[k]; a0 += pv * w1[(size_t)k * 128 + lane]; a1 += pv * w1[(size_t)k * 128 + 64 + lane]; }
                float* b1 = (float*)(ws + WS_B1P) + (kv * 16 + kc) * 128; b1[lane] = a0; b1[64 + lane] = a1; }
        }
        for (int it = gw; it < NITEMS; it += NGW) {
            int r = it;
            if (r < I_IN) { transpose_item(p.in[8], 1024, IN_COLS, (bf16_t*)(ws + WS_WTIN), 0, 1, scr, r / 96, r % 96, lane); continue; } r -= I_IN;
            if (r < I_OUT) { transpose_item(p.in[20], 1024, 1024, (bf16_t*)(ws + WS_WTOUT), 0, 1, scr, r / 32, r % 32, lane); continue; } r -= I_OUT;
            const int e = r / (3 * I_E), q = r % (3 * I_E), kind = q / I_E, ii = q % I_E;
            if (kind == 0) transpose_item(p.in[25] + (size_t)e * 1024 * 512, 1024, 512, (bf16_t*)(ws + WS_WTGU) + (size_t)e * 1024 * 1024, 0, 2, scr, ii / 16, ii % 16, lane);
            else if (kind == 1) transpose_item(p.in[26] + (size_t)e * 1024 * 512, 1024, 512, (bf16_t*)(ws + WS_WTGU) + (size_t)e * 1024 * 1024, 1, 2, scr, ii / 16, ii % 16, lane);
            else transpose_item(p.in[27] + (size_t)e * 512 * 1024, 512, 1024, (bf16_t*)(ws + WS_WTDN) + (size_t)e * 1024 * 512, 0, 1, scr, ii / 32, ii % 32, lane);
        }
    }
    {
        const int gt = blockIdx.x * NT + tid, NGT = G * NT;
        float* wr = (float*)(ws + WS_WR);
        bf16_t* wrh = (bf16_t*)wr; bf16_t* wrl = wrh + 1024 * 80;
        for (int i = gt; i < 1024 * 80; i += NGT) { const int ln = (i >> 3) & 63, jj = (i >> 9) % 5, ks = (i >> 9) / 5, k = 32 * ks + 8 * (ln >> 4) + (i & 7), c = 16 * jj + (ln & 15);
            const float w = c < 64 ? p.in[23][k * 64 + c] : (c < 72 ? p.in[21][k * 8 + (c - 64)] : 0.f);
            const bf16_t hi = f2bf(w); wrh[i] = hi; wrl[i] = f2bf(w - bf2f(hi)); }
    }
}

__device__ __forceinline__ void stage1(const Params& p) {
    const int tid = opaque_tid(), wid = tid >> 6, lane = tid & 63;
    const float* mod = (const float*)(p.ws + WS_MOD);
    bf16_t* xn = (bf16_t*)(p.ws + WS_XN);
    for (int row = blockIdx.x * NW + wid; row < M; row += gridDim.x * NW) {
        const int b = row / SEQ;
        const f32x4* xr = (const f32x4*)(p.in[0] + (size_t)row * DM) + lane;
        f32x4 v[4]; float ss = 0.f;
#pragma unroll
        for (int j = 0; j < 4; ++j) { v[j] = __builtin_nontemporal_load(xr + 64 * j); ss += v[j].x * v[j].x + v[j].y * v[j].y + v[j].z * v[j].z + v[j].w * v[j].w; }
        const float rstd = rsqrtf(wave_sum(ss) * (1.f / DM) + 1e-6f);
#pragma unroll
        for (int j = 0; j < 4; ++j) { const int col = lane * 4 + 256 * j;
            const f32x4 g = *(const f32x4*)(p.in[4] + col), sc = *(const f32x4*)(mod + b * 6144 + 1024 + col), sh = *(const f32x4*)(mod + b * 6144 + col);
            const f32x4 h = v[j] * rstd * g * (sc + 1.f) + sh;
            u32x2 o; o.x = pk2(h.x, h.y); o.y = pk2(h.z, h.w);
            *(u32x2*)(xn + (size_t)row * DM + col) = o; }
    }
}

struct EpiBf16Out {
    static constexpr bool PERM = true;
    bf16_t* O; int ldc; int nscale; float sc; unsigned* norm;
    __device__ __forceinline__ void operator()(const f32x4 (&acc)[2][2][4][2], const pg8::Unit& u, int wr, int wc, int fr, int fq) const {
        const int row0 = u.pm * 256 + wr * 64 + fr, col0 = u.pn * 256 + wc * 32 + 8 * fq; const float s_ = ((nscale >> u.pn) & 1) ? sc : 1.f;
        if (norm && u.pn < 4) {
#pragma unroll
            for (int bj = 0; bj < 2; ++bj) { float mx = 0.f;
#pragma unroll
                for (int ai = 0; ai < 2; ++ai)
#pragma unroll
                    for (int m = 0; m < 4; ++m) { const f32x4 v0 = acc[ai][bj][m][0] * s_, v1 = acc[ai][bj][m][1] * s_;
                        float ss = (v0[0] * v0[0] + v0[1] * v0[1]) + (v0[2] * v0[2] + v0[3] * v0[3]) + (v1[0] * v1[0] + v1[1] * v1[1]) + (v1[2] * v1[2] + v1[3] * v1[3]);
                        ss += __shfl_xor(ss, 16); ss += __shfl_xor(ss, 32); mx = fmaxf(mx, ss); }
                mx = fmaxf(mx, __shfl_xor(mx, 1)); mx = fmaxf(mx, __shfl_xor(mx, 2)); mx = fmaxf(mx, __shfl_xor(mx, 4)); mx = fmaxf(mx, __shfl_xor(mx, 8));
                if (fr == 0 && fq == 0) atomicMax(norm + (u.pm >> 5) * 32 + u.pn * 8 + bj * 4 + wc, __float_as_uint(mx * 1.001f)); }
        }
#pragma unroll
        for (int ai = 0; ai < 2; ++ai) { if (ai == 1 && u.half) break;
#pragma unroll
            for (int m = 0; m < 4; ++m) { bf16_t* rowp = O + (size_t)(row0 + ai * 128 + m * 16) * ldc + col0;
#pragma unroll
                for (int bj = 0; bj < 2; ++bj) { const f32x4 v0 = acc[ai][bj][m][0] * s_, v1 = acc[ai][bj][m][1] * s_;
                    u32x4 w; w.x = pg8::cvt_pk_bf16(v0[0], v0[1]); w.y = pg8::cvt_pk_bf16(v0[2], v0[3]); w.z = pg8::cvt_pk_bf16(v1[0], v1[1]); w.w = pg8::cvt_pk_bf16(v1[2], v1[3]);
                    *(u32x4*)(rowp + bj * 128) = w; } } }
    }
};
struct EpiF32Out {
    static constexpr bool PERM = false;
    float* O; int ldc;
    __device__ __forceinline__ void operator()(const f32x4 (&acc)[2][2][4][2], const pg8::Unit& u, int wr, int wc, int fr, int fq) const {
        const int row0 = u.pm * 256 + wr * 64 + fr, col0 = u.pn * 256 + wc * 32 + 4 * fq;
#pragma unroll
        for (int ai = 0; ai < 2; ++ai)
#pragma unroll
            for (int m = 0; m < 4; ++m) { float* rowp = O + (size_t)(row0 + ai * 128 + m * 16) * ldc + col0;
#pragma unroll
                for (int bj = 0; bj < 2; ++bj)
#pragma unroll
                    for (int n = 0; n < 2; ++n) *(f32x4*)(rowp + bj * 128 + n * 16) = acc[ai][bj][m][n]; }
    }
};
__device__ __forceinline__ void stage2(const Params& p, unsigned char* smem) {
    pg8::Gemm g{(const bf16_t*)(p.ws + WS_XN), DM};
    pg8::StaticOrder S; S.init(M, UC, gridDim.x, blockIdx.x, (const bf16_t*)(p.ws + WS_WTIN));
    EpiBf16Out E{(bf16_t*)(p.ws + WS_U), UC, 0xC3, attn_body::C2, (unsigned*)(p.ws + WS_CTL) + CTL_NORM};
    pg8::gemm_phase(( PG8_LAS unsigned char*)smem, g, S, E);
}

__device__ __forceinline__ void diff_attn_block(const Params& p, unsigned char* smem, int vb) {
    const int tid = threadIdx.x;
    const int qb = 15 - vb / 32, rest = vb % 32, b = rest >> 4, h = (rest >> 2) & 3, c = (rest >> 1) & 1, vh = rest & 1;
    const bf16_t* U = (const bf16_t*)(p.ws + WS_U);
    float* Ks = (float*)smem;
    float* Vs = (float*)(smem + 16384);
    const int qrow = qb * 512 + tid; const size_t row = (size_t)b * SEQ + qrow;
    float q[64];
    {
        const u32x4* qp = (const u32x4*)(U + row * UC + C_DQ + h * 128 + c * 64);
#pragma unroll
        for (int i = 0; i < 8; ++i) unpack8(qp[i], q + 8 * i);
#pragma unroll
        for (int i = 0; i < 64; ++i) q[i] *= 0.125f;
    }
    float o[64];
#pragma unroll
    for (int i = 0; i < 64; ++i) o[i] = 0.f;
    float m = -1e30f, l = 0.f;
    const float slope = exp2f(-2.f * (float)(h + 1));
    const int ntiles = (qb * 512 + 512) / 64;
    for (int tile = ntiles - 1; tile >= 0; --tile) {
        __syncthreads();
        {
            const int key = tid >> 3, ch = tid & 7; const size_t krow = (size_t)b * SEQ + tile * 64 + key;
            float t8[8];
            unpack8(*(const u32x4*)(U + krow * UC + C_DK + h * 128 + c * 64 + ch * 8), t8);
#pragma unroll
            for (int e = 0; e < 8; ++e) Ks[key * 64 + ch * 8 + e] = t8[e];
            unpack8(*(const u32x4*)(U + krow * UC + C_DV + h * 128 + vh * 64 + ch * 8), t8);
#pragma unroll
            for (int e = 0; e < 8; ++e) Vs[key * 64 + ch * 8 + e] = t8[e];
        }
        __syncthreads();
        const int k0 = tile * 64;
        if (k0 <= qrow) {
#pragma unroll 1
            for (int j = 63; j >= 0; --j) {
                const int kpos = k0 + j;
                if (kpos <= qrow) {
                    const f32x4* kr = (const f32x4*)(Ks + j * 64);
                    float s0 = 0.f, s1 = 0.f;
#pragma unroll
                    for (int d = 0; d < 16; d += 2) { const f32x4 ka = kr[d], kb = kr[d + 1];
                        s0 += q[4 * d] * ka.x + q[4 * d + 1] * ka.y + q[4 * d + 2] * ka.z + q[4 * d + 3] * ka.w;
                        s1 += q[4 * d + 4] * kb.x + q[4 * d + 5] * kb.y + q[4 * d + 6] * kb.z + q[4 * d + 7] * kb.w; }
                    const float s = s0 + s1 - slope * (float)(qrow - kpos);
                    if (s > m) { const float corr = __expf(m - s); l *= corr;
#pragma unroll
                        for (int e = 0; e < 64; ++e) o[e] *= corr;
                        m = s; }
                    const float pr = __expf(s - m); l += pr;
                    const f32x4* vr = (const f32x4*)(Vs + j * 64);
#pragma unroll
                    for (int e = 0; e < 16; ++e) { const f32x4 vv = vr[e]; o[4 * e] += pr * vv.x; o[4 * e + 1] += pr * vv.y; o[4 * e + 2] += pr * vv.z; o[4 * e + 3] += pr * vv.w; }
                }
            }
        }
    }
    const float il = 1.f / l;
    f32x4* op = (f32x4*)((float*)(p.ws + WS_OC) + ((row * 4 + h) * 2 + c) * 128 + vh * 64);
#pragma unroll
    for (int e = 0; e < 16; ++e) op[e] = (f32x4){o[4 * e] * il, o[4 * e + 1] * il, o[4 * e + 2] * il, o[4 * e + 3] * il};
}

__device__ __forceinline__ void write_frags(const bf16_t* kt, const bf16_t* vt, int pitch, bf16_t* kf_tile, bf16_t* vf_tile, int lane) {
    const int r32 = lane & 31, hi = lane >> 5;
    if (kt) {
#pragma unroll
        for (int d0 = 0; d0 < 4; ++d0) *(u32x4*)(kf_tile + (d0 * 64 + lane) * 8) = *(const u32x4*)(kt + r32 * pitch + 16 * d0 + 8 * hi);
    }
    if (vt) {
#pragma unroll
        for (int d0 = 0; d0 < 2; ++d0)
#pragma unroll
            for (int s = 0; s < 2; ++s) { unsigned w[4];
#pragma unroll
                for (int e2 = 0; e2 < 4; ++e2) { const int j = 2 * e2, t0_ = 16 * s + 8 * (j >> 2) + 4 * hi + (j & 3);
                    w[e2] = (unsigned)vt[t0_ * pitch + 32 * d0 + r32] | ((unsigned)vt[(t0_ + 1) * pitch + 32 * d0 + r32] << 16); }
                *(u32x4*)(vf_tile + ((d0 * 2 + s) * 64 + lane) * 8) = (u32x4){w[0], w[1], w[2], w[3]}; }
    }
}
__device__ __forceinline__ void compress_item(const Params& p, unsigned char* smem, int idx) {
    typedef float f32x16 __attribute__((ext_vector_type(16)));
    int tid_ = threadIdx.x; asm volatile("" : "+v"(tid_));
    const int tid = tid_, wid = tid >> 6, lane = tid & 63, r32 = lane & 31, hi = lane >> 5;
    const int kv = idx >> 6, b = (idx >> 5) & 1, hkv = (idx >> 4) & 1, n0 = (idx & 15) * 32;
    const bf16_t* U = (const bf16_t*)(p.ws + WS_U);
    const bf16_t* w1t = (const bf16_t*)(p.ws + WS_W1T) + (size_t)kv * 128 * 2048;
    const bf16_t* w2t = (const bf16_t*)(p.ws + WS_W2T) + (size_t)kv * 64 * 128;
    const float* b1p = (const float*)(p.ws + WS_B1P) + kv * 16 * 128;
    float* hsum = (float*)smem;
    bf16_t* hb = (bf16_t*)(smem + 131072);
    bf16_t* ot = (bf16_t*)(smem + 131072 + 8704);
    const int col = (kv ? C_CV : C_CK) + hkv * 64;
    __syncthreads();
    f32x16 acc[4];
#pragma unroll
    for (int c = 0; c < 4; ++c) acc[c] = (f32x16){};
    const int n = n0 + r32;
#pragma unroll 1
    for (int ii = 0; ii < 4; ++ii) { const int i = 4 * wid + ii, tok = 16 * n + i; const bool ok = tok < SEQ;
        const bf16_t* arow = U + ((size_t)b * SEQ + (ok ? tok : 0)) * UC + col + 8 * hi;
#pragma unroll
        for (int d0 = 0; d0 < 64; d0 += 16) { bf16x8 a = *(const bf16x8*)(arow + d0); if (!ok) a = (bf16x8){};
            const int kk = i * 64 + d0 + 8 * hi;
#pragma unroll
            for (int c = 0; c < 4; ++c) acc[c] = __builtin_amdgcn_mfma_f32_32x32x16_bf16(a, *(const bf16x8*)(w1t + (size_t)(32 * c + r32) * 2048 + kk), acc[c], 0, 0, 0); } }
#pragma unroll
    for (int c = 0; c < 4; ++c)
#pragma unroll
        for (int r = 0; r < 16; ++r) hsum[wid * 4096 + ((r & 3) + 8 * (r >> 2) + 4 * hi) * 128 + 32 * c + r32] = acc[c][r];
    __syncthreads();
    for (int i = tid; i < 4096; i += NT) { const int row = i >> 7, j = i & 127; float bs = 0.f;
#pragma unroll
        for (int c = 0; c < 16; ++c) bs += b1p[c * 128 + j];
        float hs = 0.f;
#pragma unroll
        for (int w = 0; w < 8; ++w) hs += hsum[w * 4096 + i];
        hb[row * 136 + j] = f2bf(gelu_tanh(hs + bs)); }
    __syncthreads();
    if (wid < 2) {
        f32x16 o = (f32x16){};
#pragma unroll
        for (int k0 = 0; k0 < 128; k0 += 16) o = __builtin_amdgcn_mfma_f32_32x32x16_bf16(*(const bf16x8*)(hb + r32 * 136 + k0 + 8 * hi), *(const bf16x8*)(w2t + (size_t)(32 * wid + r32) * 128 + k0 + 8 * hi), o, 0, 0, 0);
        const int d = 32 * wid + r32;
#pragma unroll
        for (int r = 0; r < 16; ++r) { const int nl = (r & 3) + 8 * (r >> 2) + 4 * hi; ot[nl * 72 + d] = (n0 + nl) < NCMP ? f2bf(o[r]) : (bf16_t)0; }
    }
    __syncthreads();
    if (wid == 0) { bf16_t* dst = (bf16_t*)(p.ws + (kv ? WS_VC : WS_KC)) + ((size_t)(b * 2 + hkv) * 16 + (idx & 15)) * 2048;
        write_frags(kv ? nullptr : ot, kv ? ot : nullptr, 72, dst, dst, lane); }
}

__device__ __forceinline__ void vt_item(const Params& p, bf16_t* scr, int item, int lane) {
    const int kind = item >> 9, b = (item >> 8) & 1, hkv = (item >> 7) & 1, blk = item & 127, tok0 = blk * 64;
    const bf16_t* U = (const bf16_t*)(p.ws + WS_U);
    bf16_t* KF = (bf16_t*)(p.ws + (kind ? WS_KFW : WS_KFS)) + (size_t)(b * 2 + hkv) * 64 * SEQ;
    bf16_t* VF = (bf16_t*)(p.ws + (kind ? WS_VFW : WS_VFS)) + (size_t)(b * 2 + hkv) * 64 * SEQ;
    const int kcol = (kind ? C_WK : C_SK) + hkv * 64, vcol = (kind ? C_WV : C_SV) + hkv * 64;
    bf16_t* ks = scr; bf16_t* vs = scr + 64 * 72;
    lds_fence();
#pragma unroll
    for (int i = 0; i < 8; ++i) { const int row = 8 * i + (lane >> 3), ch = lane & 7; const bf16_t* src = U + ((size_t)b * SEQ + tok0 + row) * UC + ch * 8;
        *(u32x4*)(ks + row * 72 + ch * 8) = *(const u32x4*)(src + kcol); *(u32x4*)(vs + row * 72 + ch * 8) = *(const u32x4*)(src + vcol); }
    lds_fence();
#pragma unroll
    for (int t = 0; t < 2; ++t) write_frags(ks + 32 * t * 72, vs + 32 * t * 72, 72, KF + (size_t)(2 * blk + t) * 2048, VF + (size_t)(2 * blk + t) * 2048, lane);
    lds_fence();
}

__device__ __forceinline__ void stage3(const Params& p, unsigned char* smem) {
    for (int vb = blockIdx.x; vb < 128; vb += gridDim.x) compress_item(p, smem, vb);
    __syncthreads();
    { const int t_ = opaque_tid(), wid = t_ >> 6, lane = t_ & 63;
      const int G = gridDim.x, sh = (G >= 256) ? 128 : 0, vbk = (blockIdx.x + G - sh) % G;
      for (int it = vbk * NW + wid; it < 1024; it += G * NW) vt_item(p, (bf16_t*)(smem + wid * 18432), it, lane); }
    __syncthreads();
    __syncthreads();
    {
        const bf16_t* U = (const bf16_t*)(p.ws + WS_U); bf16_t* OB = (bf16_t*)(p.ws + WS_OC);
        unsigned* qhead = (unsigned*)(p.ws + WS_CTL) + CTL_QHEAD; const float* nrm = (const float*)(p.ws + WS_CTL) + CTL_NORM;
        volatile int* bc = (volatile int*)(smem + LDS_BYTES - 64);
        const int nq = (gridDim.x % 8 == 0) ? 8 : 1, myq = blockIdx.x % nq, qlen = 1024 / nq;
        for (;;) {
            __syncthreads();
            if (threadIdx.x == 0) *bc = (int)atomicAdd(qhead + 16 * myq, 1u);
            __syncthreads();
            const int ri = __builtin_amdgcn_readfirstlane(*bc);
            if (ri >= qlen) break;
            const int x = nq == 8 ? myq : (ri >> 7), r = ri & 127;
            const int b = x >> 2, c = (x >> 1) & 1, par = x & 1;
            int k, h;
            if (r < 64) { k = 31 - (r >> 1); h = 2 + (r & 1); } else if (r < 96) { k = 31 - (r - 64); h = 1; } else { k = 31 - (r - 96); h = 0; }
            const int qb = 2 * k + par;
            const int g = h * 4 + c * 2;
            const float qn2 = nrm[b * 32 + g] + nrm[b * 32 + g + 1], kn2 = nrm[b * 32 + 16 + g] + nrm[b * 32 + 16 + g + 1];
            const float sb_ = sqrtf(qn2) * sqrtf(kn2) * 1.001f, slope2 = exp2f(-2.f * (float)(h + 1)) * 1.4426950408889634f;
            const float sc_ = (2.f * sb_ + 127.f * slope2 + 168.f) / (64.f * slope2);
            int ncap = sc_ < 1000.f ? (int)sc_ + 2 : 1000; ncap = (ncap + 1) & ~1; if (ncap < 4) ncap = 4;
            attn_body::attn_unit_pc<8>(b, h, c, qb, U, OB, (char*)smem, __builtin_amdgcn_readfirstlane(ncap));
        }
    }
}

__device__ __forceinline__ void qk4(const bf16_t* krow, const float* qs, float* s) {
    s[0] = s[1] = s[2] = s[3] = 0.f;
#pragma unroll 2
    for (int c = 0; c < 8; ++c) { float kd[8]; unpack8(*(const u32x4*)(krow + c * 8), kd);
#pragma unroll
        for (int g = 0; g < 4; ++g) { const f32x4 qa = *(const f32x4*)(qs + g * 64 + c * 8), qb = *(const f32x4*)(qs + g * 64 + c * 8 + 4);
            s[g] += kd[0] * qa.x + kd[1] * qa.y + kd[2] * qa.z + kd[3] * qa.w + kd[4] * qb.x + kd[5] * qb.y + kd[6] * qb.z + kd[7] * qb.w; } }
}
__device__ __forceinline__ void pv_block(const float* pw, int pstride, const bf16_t* vbase, size_t vstride, int nrows, float (&os)[4][8], int lane) {
    const int jr = lane >> 3, ch = lane & 7;
#pragma unroll 2
    for (int i = 0; i < 8; ++i) { const int j = jr + 8 * i;
        if (j < nrows) { float vd[8]; unpack8(*(const u32x4*)(vbase + (size_t)j * vstride + ch * 8), vd);
#pragma unroll
            for (int g = 0; g < 4; ++g) { const float pr = pw[g * pstride + j];
#pragma unroll
                for (int e = 0; e < 8; ++e) os[g][e] += pr * vd[e]; } } }
}

__device__ __forceinline__ void nsa_item(const Params& p, float* wl, int item, int lane) {
    const int hkv = item & 1, t = (item >> 1) % SEQ, b = (item >> 1) / SEQ;
    const bf16_t* U = (const bf16_t*)(p.ws + WS_U);
    const bf16_t* KC = (const bf16_t*)(p.ws + WS_KC); const bf16_t* VC = (const bf16_t*)(p.ws + WS_VC);
    const size_t row = (size_t)b * SEQ + t;
    float* qs = wl;
    float* ps = wl + 256;
    lds_fence();
#pragma unroll
    for (int g = 0; g < 4; ++g) qs[g * 64 + lane] = bf2f(U[row * UC + C_NQ + (hkv * 4 + g) * 64 + lane]);
    lds_fence();
    float slope[4], gate[4][3];
#pragma unroll
    for (int g = 0; g < 4; ++g) { slope[g] = exp2f(-(float)(hkv * 4 + g + 1));
#pragma unroll
        for (int i = 0; i < 3; ++i) { const float x = bf2f(U[row * UC + C_NG + (hkv * 4 + g) * 3 + i]); gate[g][i] = 1.f / (1.f + __expf(-x)); } }
    float tot[4][8];
#pragma unroll
    for (int g = 0; g < 4; ++g)
#pragma unroll
        for (int e = 0; e < 8; ++e) tot[g][e] = 0.f;
    const int nvalid = t >= 31 ? min((t - 31) / 16 + 1, NCMP) : 0;
    float cinv[4];
    {
        float mx[4] = {-1e30f, -1e30f, -1e30f, -1e30f};
#pragma unroll 1
        for (int i = 0; i < 8; ++i) { const int n = lane + 64 * i;
            asm volatile("" ::: "memory");
            if (n < nvalid) { float s[4]; qk4(KC + ((size_t)(b * 512 + n) * 2 + hkv) * 64, qs, s);
#pragma unroll
                for (int g = 0; g < 4; ++g) { const float v = s[g] * 0.125f - slope[g] * (float)(t - (16 * n + 31)); ps[g * 512 + n] = v; mx[g] = fmaxf(mx[g], v); } }
            else {
#pragma unroll
                for (int g = 0; g < 4; ++g) ps[g * 512 + n] = -1e30f; } }
        lds_fence();
#pragma unroll
        for (int g = 0; g < 4; ++g) { mx[g] = wave_max(mx[g]); float sum = 0.f;
#pragma unroll 1
            for (int i = 0; i < 8; ++i) { const int n = lane + 64 * i; const float e = n < nvalid ? __expf(ps[g * 512 + n] - mx[g]) : 0.f; ps[g * 512 + n] = e; sum += e; }
            sum = wave_sum(sum); cinv[g] = 1.f / fmaxf(sum, 1e-30f); }
        lds_fence();
        float oc[4][8];
#pragma unroll
        for (int g = 0; g < 4; ++g)
#pragma unroll
            for (int e = 0; e < 8; ++e) oc[g][e] = 0.f;
#pragma unroll 1
        for (int n0 = 0; n0 < nvalid; n0 += 64) pv_block(ps + n0, 512, VC + ((size_t)(b * 512 + n0) * 2 + hkv) * 64, 128, min(64, nvalid - n0), oc, lane);
#pragma unroll
        for (int g = 0; g < 4; ++g)
#pragma unroll
            for (int e = 0; e < 8; ++e) tot[g][e] += gate[g][0] * cinv[g] * oc[g][e];
    }
    const int cur = t >> 6;
    int mysel = 0;
    {
        float sc0, sc1;
        { float i0 = 0.f, i1 = 0.f;
#pragma unroll
            for (int g = 0; g < 4; ++g)
#pragma unroll
                for (int d = -1; d <= 3; ++d) { const int n0 = 4 * lane + d, n1 = 4 * (lane + 64) + d;
                    if (n0 >= 0 && n0 < NCMP) i0 += cinv[g] * ps[g * 512 + n0];
                    if (n1 < NCMP) i1 += cinv[g] * ps[g * 512 + n1]; }
            const int j0 = lane, j1 = lane + 64;
            const bool f0 = (j0 == 0) || (j0 == cur) || (j0 == cur - 1), f1 = (j1 == cur) || (j1 == cur - 1);
            sc0 = (j0 <= cur) ? i0 + (f0 ? 1e4f : 0.f) : -1e30f;
            sc1 = (j1 <= cur) ? i1 + (f1 ? 1e4f : 0.f) : -1e30f; }
        for (int r = 0; r < 16; ++r) {
            float v; int idx;
            if (sc0 >= sc1) { v = sc0; idx = lane; } else { v = sc1; idx = lane + 64; }
#pragma unroll
            for (int o = 32; o > 0; o >>= 1) { const float ov = __shfl_xor(v, o); const int oi = __shfl_xor(idx, o); if (ov > v || (ov == v && oi < idx)) { v = ov; idx = oi; } }
            if (idx == lane) sc0 = -3e38f; else if (idx == lane + 64) sc1 = -3e38f;
            if (lane == r) mysel = idx;
        }
    }
#pragma unroll 1
    for (int br = 0; br < 2; ++br) {
        float ms[4], ls[4], os[4][8];
#pragma unroll
        for (int g = 0; g < 4; ++g) { ms[g] = -1e30f; ls[g] = 0.f;
#pragma unroll
            for (int e = 0; e < 8; ++e) os[g][e] = 0.f; }
        const int kcol = (br == 0 ? C_SK : C_WK) + hkv * 64, vcol = (br == 0 ? C_SV : C_WV) + hkv * 64;
        const int lo = br == 0 ? 0 : max(t - 511, 0);
        const int nb = br == 0 ? 16 : (cur - (lo >> 6) + 1);
#pragma unroll 1
        for (int r = 0; r < nb; ++r) {
            int blk;
            if (br == 0) { blk = __shfl(mysel, r); if (blk > cur) continue; } else blk = (lo >> 6) + r;
            const int tok = blk * 64 + lane; const bool valid = tok <= t && tok >= lo;
            float s[4]; qk4(U + ((size_t)b * SEQ + tok) * UC + kcol, qs, s);
            lds_fence();
#pragma unroll
            for (int g = 0; g < 4; ++g) {
                const float sv = valid ? s[g] * 0.125f - slope[g] * (float)(t - tok) : -1e30f;
                const float mx = wave_max(sv), mnew = fmaxf(ms[g], mx), corr = __expf(ms[g] - mnew);
                const float pr = valid ? __expf(sv - mnew) : 0.f;
                ls[g] = ls[g] * corr + wave_sum(pr); ms[g] = mnew;
#pragma unroll
                for (int e = 0; e < 8; ++e) os[g][e] *= corr;
                ps[g * 64 + lane] = pr; }
            lds_fence();
            pv_block(ps, 64, U + ((size_t)b * SEQ + blk * 64) * UC + vcol, UC, 64, os, lane);
        }
#pragma unroll
        for (int g = 0; g < 4; ++g) { const float gsel = br == 0 ? gate[g][1] : gate[g][2]; const float w = ls[g] > 0.f ? gsel / ls[g] : 0.f;
#pragma unroll
            for (int e = 0; e < 8; ++e) tot[g][e] += w * os[g][e]; }
    }
#pragma unroll
    for (int g = 0; g < 4; ++g)
#pragma unroll
        for (int e = 0; e < 8; ++e) { float v = tot[g][e]; v += __shfl_xor(v, 8); v += __shfl_xor(v, 16); v += __shfl_xor(v, 32); tot[g][e] = v; }
    if (lane < 8) { bf16_t* ao = (bf16_t*)(p.ws + WS_AO) + row * DM + 512;
#pragma unroll
        for (int g = 0; g < 4; ++g) { u32x4 o; o.x = pk2(tot[g][0], tot[g][1]); o.y = pk2(tot[g][2], tot[g][3]); o.z = pk2(tot[g][4], tot[g][5]); o.w = pk2(tot[g][6], tot[g][7]);
            *(u32x4*)(ao + (hkv * 4 + g) * 64 + lane * 8) = o; } }
}


namespace nsa {
typedef float f32x16 __attribute__((ext_vector_type(16)));
constexpr int WL_BYTES = 17408;
constexpr float LOG2E = 1.4426950408889634f;
#define NSA_CR(r) (((r) & 3) + 8 * ((r) >> 2))
__device__ __forceinline__ float quad_xor1(float v) { return __int_as_float(__builtin_amdgcn_update_dpp(0, __float_as_int(v), 0xB1, 0xF, 0xF, true)); }
__device__ __forceinline__ float quad_xor2(float v) { return __int_as_float(__builtin_amdgcn_update_dpp(0, __float_as_int(v), 0x4E, 0xF, 0xF, true)); }
__device__ __forceinline__ float hmax(float v) { auto rr = __builtin_amdgcn_permlane32_swap(__float_as_uint(v), __float_as_uint(v), false, false); return fmaxf(__uint_as_float(rr[0]), __uint_as_float(rr[1])); }
__device__ __forceinline__ float hsum(float v) { auto rr = __builtin_amdgcn_permlane32_swap(__float_as_uint(v), __float_as_uint(v), false, false); return __uint_as_float(rr[0]) + __uint_as_float(rr[1]); }
__device__ __forceinline__ unsigned cvtpk(float lo, float hi) { typedef float f2 __attribute__((ext_vector_type(2))); typedef __bf16 b2 __attribute__((ext_vector_type(2))); f2 v = {lo, hi}; b2 r = __builtin_convertvector(v, b2); return __builtin_bit_cast(unsigned, r); }

__device__ __forceinline__ void k_frags(const bf16_t* ktile, bf16x8 (&kf)[4]) {
#pragma unroll
    for (int d0 = 0; d0 < 4; ++d0) kf[d0] = *(const bf16x8*)(ktile + d0 * 512);
}
__device__ __forceinline__ f32x16 qk_ct(const bf16x8 (&kf)[4], const bf16_t* ql, const f32x16& c) {
    bf16x8 q[4];
#pragma unroll
    for (int d0 = 0; d0 < 4; ++d0) q[d0] = *(const bf16x8*)(ql + d0 * 512);
    f32x16 S = __builtin_amdgcn_mfma_f32_32x32x16_bf16(kf[0], q[0], c, 0, 0, 0);
#pragma unroll
    for (int d0 = 1; d0 < 4; ++d0) S = __builtin_amdgcn_mfma_f32_32x32x16_bf16(kf[d0], q[d0], S, 0, 0, 0);
    return S;
}
template <bool MASKED, class VF>
__device__ __forceinline__ void tile_pass1_f(const bf16x8 (&kf)[4], const bf16_t* qf, const f32x16& c1, const VF& valid, const bool (&colon)[2], float (&m)[2], float (&l)[2]) {
#pragma unroll
    for (int ct = 0; ct < 2; ++ct) {
        f32x16 S = qk_ct(kf, qf + ct * 2048, c1);
        float mx = -INFINITY;
#pragma unroll
        for (int r = 0; r < 16; ++r) { if (MASKED) S[r] = valid(ct, r) ? S[r] : -INFINITY; mx = fmaxf(mx, S[r]); }
        mx = hmax(mx);
        const float mn = fmaxf(m[ct], mx); float sum = 0.f;
#pragma unroll
        for (int r = 0; r < 16; ++r) sum += __builtin_amdgcn_exp2f(S[r] - mn);
        if (colon[ct]) { l[ct] = l[ct] * __builtin_amdgcn_exp2f(m[ct] - mn) + sum; m[ct] = mn; }
    }
}
template <bool MASKED, bool HOOK, class VF, class PH>
__device__ __forceinline__ void tile_pass2_p(const bf16x8 (&kf)[4], const bf16_t* qf, const f32x16& crv, const float (&lm)[2], const VF& valid, u32x4 (&pb)[2][2], const PH& ph) {
#pragma unroll
    for (int ct = 0; ct < 2; ++ct) {
        f32x16 c2;
#pragma unroll
        for (int r = 0; r < 16; ++r) c2[r] = crv[r] + lm[ct];
        const f32x16 S = qk_ct(kf, qf + ct * 2048, c2);
        float pr[16];
#pragma unroll
        for (int r = 0; r < 16; ++r) { pr[r] = __builtin_amdgcn_exp2f(S[r]); if (MASKED) pr[r] = valid(ct, r) ? pr[r] : 0.f; }
        if (HOOK) ph(ct, pr);
#pragma unroll
        for (int s = 0; s < 2; ++s) pb[ct][s] = (u32x4){cvtpk(pr[8 * s], pr[8 * s + 1]), cvtpk(pr[8 * s + 2], pr[8 * s + 3]), cvtpk(pr[8 * s + 4], pr[8 * s + 5]), cvtpk(pr[8 * s + 6], pr[8 * s + 7])};
    }
}
template <bool MASKED, class VF>
__device__ __forceinline__ void tile_online_p(const bf16x8 (&kf)[4], const bf16_t* qf, float slope, float base, const bool (&sb)[2], const VF& valid,
                                              float (&mref)[2], bool (&ini)[2], float (&l)[2], f32x16 (&o)[2][2], u32x4 (&pb)[2][2]) {
    f32x16 S[2];
#pragma unroll
    for (int ct = 0; ct < 2; ++ct) {
        const float lm = sb[ct] ? base - mref[ct] : -INFINITY;
        f32x16 c;
#pragma unroll
        for (int r = 0; r < 16; ++r) c[r] = fmaf(slope, (float)NSA_CR(r), lm);
        S[ct] = qk_ct(kf, qf + ct * 2048, c);
    }
    float mx[2]; bool need[2];
#pragma unroll
    for (int ct = 0; ct < 2; ++ct) {
        float m_ = -INFINITY;
#pragma unroll
        for (int r = 0; r < 16; ++r) { if (MASKED) S[ct][r] = valid(ct, r) ? S[ct][r] : -INFINITY; m_ = fmaxf(m_, S[ct][r]); }
        mx[ct] = hmax(m_);
        need[ct] = ini[ct] ? (mx[ct] > 8.f) : (mx[ct] > -INFINITY);
    }
    if (__any(need[0] || need[1])) {
#pragma unroll
        for (int ct = 0; ct < 2; ++ct) {
            const float delta = need[ct] ? mx[ct] : 0.f, f = (need[ct] && ini[ct]) ? __builtin_amdgcn_exp2f(-delta) : 1.f;
            mref[ct] += delta; l[ct] *= f; ini[ct] = ini[ct] || need[ct];
#pragma unroll
            for (int d0 = 0; d0 < 2; ++d0) o[ct][d0] *= f;
#pragma unroll
            for (int r = 0; r < 16; ++r) S[ct][r] -= delta;
        }
    }
#pragma unroll
    for (int ct = 0; ct < 2; ++ct) {
        float pr[16]; float s0 = 0.f, s1 = 0.f;
#pragma unroll
        for (int r = 0; r < 16; r += 2) { pr[r] = __builtin_amdgcn_exp2f(S[ct][r]); pr[r + 1] = __builtin_amdgcn_exp2f(S[ct][r + 1]); s0 += pr[r]; s1 += pr[r + 1]; }
        l[ct] += s0 + s1;
#pragma unroll
        for (int s = 0; s < 2; ++s) pb[ct][s] = (u32x4){cvtpk(pr[8 * s], pr[8 * s + 1]), cvtpk(pr[8 * s + 2], pr[8 * s + 3]), cvtpk(pr[8 * s + 4], pr[8 * s + 5]), cvtpk(pr[8 * s + 6], pr[8 * s + 7])};
    }
}
__device__ __forceinline__ void tile_pass2_v(const bf16x8 (&vf)[2][2], const u32x4 (&pb)[2][2], f32x16 (&o)[2][2]) {
#pragma unroll
    for (int d0 = 0; d0 < 2; ++d0)
#pragma unroll
        for (int s = 0; s < 2; ++s)
#pragma unroll
            for (int ct = 0; ct < 2; ++ct) o[ct][d0] = __builtin_amdgcn_mfma_f32_32x32x16_bf16(vf[d0][s], __builtin_bit_cast(bf16x8, pb[ct][s]), o[ct][d0], 0, 0, 0);
}
__device__ __forceinline__ void v_frags(const bf16_t* vt, bf16x8 (&vf)[2][2]) {
#pragma unroll
    for (int d0 = 0; d0 < 2; ++d0)
#pragma unroll
        for (int s = 0; s < 2; ++s) vf[d0][s] = *(const bf16x8*)(vt + (d0 * 2 + s) * 512);
}
__device__ __forceinline__ void glds16(const void* gsrc, unsigned lds_dst) { unsigned keep;
    asm volatile("s_mov_b32 %0, m0\n\ts_mov_b32 m0, %2\n\ts_nop 0\n\tglobal_load_lds_dwordx4 %1, off\n\ts_mov_b32 m0, %0" : "=&s"(keep) : "v"(gsrc), "s"(lds_dst) : "memory"); }
__device__ __forceinline__ void dma4(const bf16_t* tile, unsigned slot) {
#pragma unroll
    for (int i = 0; i < 4; ++i) glds16(tile + i * 512, slot + i * 1024);
}

struct LaneC { int c32, hi, hc, head, qi0, qi1, tc0, tc1; float slope2; };
__device__ __forceinline__ LaneC lanec(int lane_, int t0, int hkv) {
    int lane = lane_; asm volatile("" : "+v"(lane));
    LaneC L; L.c32 = lane & 31; L.hi = lane >> 5; L.hc = lane & 3; L.head = hkv * 4 + L.hc; L.qi0 = L.c32 >> 2; L.qi1 = 8 + L.qi0; L.tc0 = t0 + L.qi0; L.tc1 = t0 + L.qi1;
    L.slope2 = exp2f(-(float)(L.head + 1)) * LOG2E; return L;
}
__device__ __forceinline__ float gate_of(const bf16_t* U, size_t rowb, int tcol, int head, int which) { return 1.f / (1.f + __expf(-bf2f(U[(rowb + tcol) * UC + C_NG + head * 3 + which]))); }

__device__ __forceinline__ void item(const Params& p, unsigned char* wl, int it, int lane_) {
    const int B_ = it >> 3, w_ = it & 7, x_ = B_ & 7, k_ = (x_ & 1) * 32 + (B_ >> 3), bh = x_ >> 1, qt = (w_ >> 2) ? 511 - (k_ * 4 + (w_ & 3)) : k_ * 4 + (w_ & 3);
    const int b = bh >> 1, hkv = bh & 1, t0 = qt * 16, cur = t0 >> 6;
    const bf16_t* U = (const bf16_t*)(p.ws + WS_U);
    const size_t rowb = (size_t)b * SEQ;
    float* G = (float*)wl; unsigned* selm = (unsigned*)(wl + 16384); unsigned* uni = selm + 64;
    const bf16_t* qf;
    lds_fence();
    {
        const LaneC L = lanec(lane_, t0, hkv);
        bf16_t* ql = (bf16_t*)(wl + 8192) + (lane_ & 63) * 8; qf = ql;
#pragma unroll
        for (int ct = 0; ct < 2; ++ct) {
            const bf16_t* qrow = U + (rowb + (ct ? L.tc1 : L.tc0)) * UC;
#pragma unroll
            for (int d0 = 0; d0 < 4; ++d0) *(bf16x8*)(ql + (ct * 4 + d0) * 512) = *(const bf16x8*)(qrow + C_NQ + L.head * 64 + 16 * d0 + 8 * L.hi);
        }
    }
    f32x16 o[2][2];
#pragma unroll
    for (int ct = 0; ct < 2; ++ct)
#pragma unroll
        for (int d0 = 0; d0 < 2; ++d0) o[ct][d0] = (f32x16){};
    auto nohook = [](int, float*) {};
    lds_fence();
    for (int i = (lane_ & 63); i < 2048; i += 64) ((unsigned*)wl)[i] = 0u;
    for (int i = (lane_ & 63); i < 68; i += 64) selm[i] = 0u;
    lds_fence();
    {
        const LaneC L = lanec(lane_, t0, hkv);
        const int hi = L.hi, c32 = L.c32;
        const bf16_t* KC = (const bf16_t*)(p.ws + WS_KC) + (size_t)(b * 2 + hkv) * 16 * 2048 + (lane_ & 63) * 8;
        const bf16_t* VCt = (const bf16_t*)(p.ws + WS_VC) + (size_t)(b * 2 + hkv) * 16 * 2048 + (lane_ & 63) * 8;
        const int tc[2] = {L.tc0, L.tc1}, qi[2] = {L.qi0, L.qi1};
        int nv[2];
#pragma unroll
        for (int ct = 0; ct < 2; ++ct) nv[ct] = tc[ct] >= 31 ? min((tc[ct] - 31) / 16 + 1, NCMP) : 0;
        const int tl = t0 + 15, nvmax = tl >= 31 ? min((tl - 31) / 16 + 1, NCMP) : 0, ntl = (nvmax + 31) >> 5, nvmin = t0 >= 31 ? min((t0 - 31) / 16 + 1, NCMP) : 0;
        const float sl16 = L.slope2 * 16.f;
        float m[2] = {-30000.f, -30000.f}, l[2] = {0.f, 0.f};
        f32x16 crv;
#pragma unroll
        for (int r = 0; r < 16; ++r) crv[r] = sl16 * (float)NSA_CR(r);
        const bool on2[2] = {true, true};
        bf16x8 kfn[4];
        if (ntl > 0) k_frags(KC, kfn);
#pragma unroll 1
        for (int nt = 0; nt < ntl; ++nt) {
            const int nb = 32 * nt + 4 * hi; const float base = sl16 * (float)nb;
            auto valid = [&](int ct, int r) { return nb + NSA_CR(r) < nv[ct]; };
            bf16x8 kf[4];
#pragma unroll
            for (int d0 = 0; d0 < 4; ++d0) kf[d0] = kfn[d0];
            if (nt + 1 < ntl) k_frags(KC + (nt + 1) * 2048, kfn);
            f32x16 c1;
#pragma unroll
            for (int r = 0; r < 16; ++r) c1[r] = crv[r] + base;
            if (32 * nt + 32 <= nvmin) tile_pass1_f<false>(kf, qf, c1, valid, on2, m, l); else tile_pass1_f<true>(kf, qf, c1, valid, on2, m, l);
        }
        float lmc[2];
#pragma unroll
        for (int ct = 0; ct < 2; ++ct) { const float lt = hsum(l[ct]); lmc[ct] = lt > 0.f ? -__builtin_amdgcn_logf(lt) - m[ct] : -INFINITY; }
        if (ntl > 0) k_frags(KC, kfn);
#pragma unroll 1
        for (int nt = 0; nt < ntl; ++nt) {
            const int nb = 32 * nt + 4 * hi; const float base = sl16 * (float)nb;
            auto valid = [&](int ct, int r) { return nb + NSA_CR(r) < nv[ct]; };
            auto hook = [&](int ct, float* pr) {
#pragma unroll
                for (int k = 0; k < 4; ++k) { float g4 = (pr[4 * k] + pr[4 * k + 1]) + (pr[4 * k + 2] + pr[4 * k + 3]), e = pr[4 * k + 3];
                    g4 += quad_xor1(g4); g4 += quad_xor2(g4); e += quad_xor1(e); e += quad_xor2(e);
                    const int j = 8 * nt + 2 * k + hi;
                    if (L.hc == 0) { atomicAdd(&G[qi[ct] * 128 + j], g4); if (j + 1 < 128) atomicAdd(&G[qi[ct] * 128 + j + 1], e); } } };
            bf16x8 kf[4], vf[2][2];
#pragma unroll
            for (int d0 = 0; d0 < 4; ++d0) kf[d0] = kfn[d0];
            v_frags(VCt + nt * 2048, vf);
            if (nt + 1 < ntl) k_frags(KC + (nt + 1) * 2048, kfn);
            const float lm[2] = {lmc[0] + base, lmc[1] + base};
            u32x4 pb[2][2];
            if (32 * nt + 32 <= nvmin) tile_pass2_p<false, true>(kf, qf, crv, lm, valid, pb, hook); else tile_pass2_p<true, true>(kf, qf, crv, lm, valid, pb, hook);
            tile_pass2_v(vf, pb, o);
        }
        float* AOF = (float*)(p.ws + WS_AOF);
#pragma unroll
        for (int ct = 0; ct < 2; ++ct) { const float gcv = gate_of(U, rowb, tc[ct], L.head, 0); float* orow = AOF + (rowb + tc[ct]) * 512 + L.head * 64 + 4 * hi;
#pragma unroll
            for (int d0 = 0; d0 < 2; ++d0) {
#pragma unroll
                for (int k = 0; k < 4; ++k) *(f32x4*)(orow + 32 * d0 + 8 * k) = (f32x4){o[ct][d0][4 * k] * gcv, o[ct][d0][4 * k + 1] * gcv, o[ct][d0][4 * k + 2] * gcv, o[ct][d0][4 * k + 3] * gcv};
                o[ct][d0] = (f32x16){}; } }
    }
    lds_fence();
    {
        int lane = lane_; asm volatile("" : "+v"(lane));
        unsigned u0 = 0u, u1 = 0u, u2 = 0u, u3 = 0u;
        const int j0 = lane, j1 = lane + 64;
        const bool f0 = (j0 == 0) || (j0 == cur) || (j0 == cur - 1), f1 = (j1 == cur) || (j1 == cur - 1);
        const bool ok0 = j0 <= cur, ok1 = j1 <= cur;
#pragma unroll 1
        for (int q = 0; q < 16; q += 2) {
            unsigned ka0, ka1, kb0, kb1;
            { const float i0 = G[q * 128 + lane], i1 = G[q * 128 + 64 + lane], i2 = G[(q + 1) * 128 + lane], i3 = G[(q + 1) * 128 + 64 + lane];
              ka0 = ok0 ? ((__float_as_uint(i0 + (f0 ? 1e4f : 0.f)) & ~127u) | (unsigned)(127 - j0)) : 0u;
              ka1 = ok1 ? ((__float_as_uint(i1 + (f1 ? 1e4f : 0.f)) & ~127u) | (unsigned)(127 - j1)) : 0u;
              kb0 = ok0 ? ((__float_as_uint(i2 + (f0 ? 1e4f : 0.f)) & ~127u) | (unsigned)(127 - j0)) : 0u;
              kb1 = ok1 ? ((__float_as_uint(i3 + (f1 ? 1e4f : 0.f)) & ~127u) | (unsigned)(127 - j1)) : 0u; }
            unsigned pa = 0u, pb = 0u;
#pragma unroll
            for (int bit = 30; bit >= 0; --bit) {
                const unsigned ca = pa | (1u << bit), cb = pb | (1u << bit);
                const int na = __popcll(__ballot(ka0 >= ca)) + __popcll(__ballot(ka1 >= ca));
                const int nb = __popcll(__ballot(kb0 >= cb)) + __popcll(__ballot(kb1 >= cb));
                pa = na >= 16 ? ca : pa; pb = nb >= 16 ? cb : pb;
            }
            const unsigned long long a0 = __ballot(ok0 && ka0 >= pa), a1 = __ballot(ok1 && ka1 >= pa), b0 = __ballot(ok0 && kb0 >= pb), b1 = __ballot(ok1 && kb1 >= pb);
            if (lane == 0) { selm[q * 4 + 0] = (unsigned)a0; selm[q * 4 + 1] = (unsigned)(a0 >> 32); selm[q * 4 + 2] = (unsigned)a1; selm[q * 4 + 3] = (unsigned)(a1 >> 32);
                selm[q * 4 + 4] = (unsigned)b0; selm[q * 4 + 5] = (unsigned)(b0 >> 32); selm[q * 4 + 6] = (unsigned)b1; selm[q * 4 + 7] = (unsigned)(b1 >> 32); }
            u0 |= (unsigned)a0 | (unsigned)b0; u1 |= (unsigned)(a0 >> 32) | (unsigned)(b0 >> 32); u2 |= (unsigned)a1 | (unsigned)b1; u3 |= (unsigned)(a1 >> 32) | (unsigned)(b1 >> 32);
        }
        if (lane == 0) { uni[0] = u0; uni[1] = u1; uni[2] = u2; uni[3] = u3; }
    }
    lds_fence();
#pragma unroll 1
    for (int br = 0; br < 2; ++br) {
        const LaneC L = lanec(lane_, t0, hkv);
        const int hi = L.hi; const float slope2 = L.slope2;
        const int tc[2] = {L.tc0, L.tc1}, qi[2] = {L.qi0, L.qi1};
        unsigned short* tl = (unsigned short*)(wl + 16896);
        int ntile = 0;
        if (br == 0) {
            const unsigned um0 = __builtin_amdgcn_readfirstlane(uni[0]), um1 = __builtin_amdgcn_readfirstlane(uni[1]), um2 = __builtin_amdgcn_readfirstlane(uni[2]), um3 = __builtin_amdgcn_readfirstlane(uni[3]);
#pragma unroll 1
            for (int j = cur; j >= 0; --j) { const int ws_ = j >> 5; const unsigned uw = ws_ == 0 ? um0 : ws_ == 1 ? um1 : ws_ == 2 ? um2 : um3;
                if ((uw >> (j & 31)) & 1u) { tl[ntile] = (unsigned short)(2 * j); tl[ntile + 1] = (unsigned short)(2 * j + 1); ntile += 2; } }
        } else {
            const int lo_t = (t0 - 511 > 0 ? t0 - 511 : 0) >> 5, hi_t = (t0 + 15) >> 5;
#pragma unroll 1
            for (int kt = hi_t; kt >= lo_t; --kt) { tl[ntile] = (unsigned short)kt; ++ntile; }
        }
        lds_fence();
        const bf16_t* Kb = (const bf16_t*)(p.ws + (br ? WS_KFW : WS_KFS)) + (size_t)(b * 2 + hkv) * 64 * SEQ + (lane_ & 63) * 8;
        static_assert(WS_VFS - WS_KFS == WS_VFW - WS_KFW, "V images sit at one constant distance behind the K images");
        constexpr size_t VOFF = (WS_VFS - WS_KFS) / 2;
        const unsigned slot = (unsigned)__builtin_amdgcn_readfirstlane((unsigned)(uintptr_t)wl);
        const bf16_t* kl = (const bf16_t*)wl + (lane_ & 63) * 8; const bf16_t* vl = (const bf16_t*)(wl + 4096) + (lane_ & 63) * 8;
        float mref[2] = {0.f, 0.f}, l[2] = {0.f, 0.f}; bool ini[2] = {false, false};
        if (ntile > 0) { const int t_ = __builtin_amdgcn_readfirstlane((int)tl[0]); dma4(Kb + (size_t)t_ * 2048, slot); dma4(Kb + (size_t)t_ * 2048 + VOFF, slot + 4096); }
#pragma unroll 1
        for (int idx = 0; idx < ntile; ++idx) {
            const int tile = __builtin_amdgcn_readfirstlane((int)tl[idx]);
            const bool more = idx + 1 < ntile; const int tnext = more ? __builtin_amdgcn_readfirstlane((int)tl[idx + 1]) : 0;
            asm volatile("s_waitcnt vmcnt(4)" ::: "memory");
            bf16x8 kf[4]; k_frags(kl, kf);
            asm volatile("s_waitcnt lgkmcnt(0)" ::: "memory");
            if (more) dma4(Kb + (size_t)tnext * 2048, slot);
            const int tokb = 32 * tile, tb = tokb + 4 * hi; const float base = slope2 * (float)(tb - t0);
            bool sb[2] = {true, true}; bool interior;
            if (br == 0) { const int j = tile >> 1, ws_ = j >> 5, bp = j & 31;
#pragma unroll
                for (int ct = 0; ct < 2; ++ct) sb[ct] = (selm[qi[ct] * 4 + ws_] >> bp) & 1u;
                interior = (j < cur);
            } else interior = (tokb + 31 <= t0 && tokb >= t0 + 15 - 511);
            const int wlo = br ? 511 : (1 << 30);
            auto valid = [&](int ct, int r) { const int tok = tb + NSA_CR(r); return tok <= tc[ct] && tok >= tc[ct] - wlo; };
            u32x4 pb[2][2];
            if (interior) tile_online_p<false>(kf, qf, slope2, base, sb, valid, mref, ini, l, o, pb); else tile_online_p<true>(kf, qf, slope2, base, sb, valid, mref, ini, l, o, pb);
            if (more) asm volatile("s_waitcnt vmcnt(4)" ::: "memory"); else asm volatile("s_waitcnt vmcnt(0)" ::: "memory");
            bf16x8 vf[2][2]; v_frags(vl, vf);
            asm volatile("s_waitcnt lgkmcnt(0)" ::: "memory");
            if (more) dma4(Kb + (size_t)tnext * 2048 + VOFF, slot + 4096);
            tile_pass2_v(vf, pb, o);
        }
        {
            float* AOF = (float*)(p.ws + WS_AOF); bf16_t* AO = (bf16_t*)(p.ws + WS_AO);
#pragma unroll
            for (int ct = 0; ct < 2; ++ct) { const float lt = hsum(l[ct]); const float cw = lt > 0.f ? gate_of(U, rowb, tc[ct], L.head, 1 + br) / lt : 0.f;
                float* frow = AOF + (rowb + tc[ct]) * 512 + L.head * 64 + 4 * hi; bf16_t* orow = AO + (rowb + tc[ct]) * DM + 512 + L.head * 64 + 4 * hi;
#pragma unroll
                for (int d0 = 0; d0 < 2; ++d0) {
#pragma unroll
                    for (int k = 0; k < 4; ++k) { const f32x4 a = *(const f32x4*)(frow + 32 * d0 + 8 * k);
                        const f32x4 v = {a[0] + cw * o[ct][d0][4 * k], a[1] + cw * o[ct][d0][4 * k + 1], a[2] + cw * o[ct][d0][4 * k + 2], a[3] + cw * o[ct][d0][4 * k + 3]};
                        if (br == 0) *(f32x4*)(frow + 32 * d0 + 8 * k) = v;
                        else { u32x2 w2; w2.x = cvtpk(v[0], v[1]); w2.y = cvtpk(v[2], v[3]); *(u32x2*)(orow + 32 * d0 + 8 * k) = w2; } }
                    o[ct][d0] = (f32x16){}; } }
        }
        lds_fence();
    }
}
#undef NSA_CR
}

__device__ __forceinline__ float diff_lambda(const Params& p, int lane) {
    const float a = p.in[9][lane] * p.in[10][lane], c = p.in[11][lane] * p.in[12][lane];
    return __expf(wave_sum(a)) - __expf(wave_sum(c)) + 0.2f;
}
__device__ __forceinline__ void diffc_rows8(const Params& p, int row0, int lane, float lam) {
    const int h = lane >> 4, l16 = lane & 15;
    const bf16_t* oc = (const bf16_t*)(p.ws + WS_OC) + ((size_t)row0 * 4 + h) * 256 + 8 * l16;
    bf16_t* ao = (bf16_t*)(p.ws + WS_AO) + (size_t)row0 * DM + h * 128 + 8 * l16;
    const f32x4 g0 = *(const f32x4*)(p.in[13] + 8 * l16), g1 = *(const f32x4*)(p.in[13] + 8 * l16 + 4);
    const float g[8] = {g0.x * 0.8f, g0.y * 0.8f, g0.z * 0.8f, g0.w * 0.8f, g1.x * 0.8f, g1.y * 0.8f, g1.z * 0.8f, g1.w * 0.8f};
    u32x4 a[8], c[8];
#pragma unroll
    for (int i = 0; i < 8; ++i) { a[i] = *(const u32x4*)(oc + (size_t)i * 1024); c[i] = *(const u32x4*)(oc + (size_t)i * 1024 + 128); }
#pragma unroll
    for (int i = 0; i < 8; ++i) { float x[8], y[8]; unpack8(a[i], x); unpack8(c[i], y); float ss = 0.f;
#pragma unroll
        for (int e = 0; e < 8; ++e) { x[e] -= lam * y[e]; ss += x[e] * x[e]; }
        ss += nsa::quad_xor1(ss); ss += nsa::quad_xor2(ss);
        ss += __int_as_float(__builtin_amdgcn_update_dpp(0, __float_as_int(ss), 0x141, 0xf, 0xf, true));
        ss += __int_as_float(__builtin_amdgcn_update_dpp(0, __float_as_int(ss), 0x140, 0xf, 0xf, true));
        const float rstd = rsqrtf(ss * (1.f / 128.f) + 1e-6f);
        u32x4 o; o.x = pk2(x[0] * rstd * g[0], x[1] * rstd * g[1]); o.y = pk2(x[2] * rstd * g[2], x[3] * rstd * g[3]); o.z = pk2(x[4] * rstd * g[4], x[5] * rstd * g[5]); o.w = pk2(x[6] * rstd * g[6], x[7] * rstd * g[7]);
        *(u32x4*)(ao + (size_t)i * DM) = o; }
}

__device__ __forceinline__ void stage4(const Params& p, unsigned char* smem) {
    const int tid = opaque_tid(), wid = tid >> 6, lane = tid & 63;
    const int gw = blockIdx.x * NW + wid, NGW = gridDim.x * NW;
    for (int it = gw; it < 2048; it += NGW) nsa::item(p, smem + wid * nsa::WL_BYTES, it, lane);
    const float lam = diff_lambda(p, lane);
    for (int it = gw; it < M / 8; it += NGW) diffc_rows8(p, it * 8, lane, lam);
}

__device__ __forceinline__ void stage5(const Params& p, unsigned char* smem) {
    pg8::Gemm g{(const bf16_t*)(p.ws + WS_AO), DM};
    pg8::StaticOrder S; S.init(M, DM, gridDim.x, blockIdx.x, (const bf16_t*)(p.ws + WS_WTOUT));
    EpiBf16Out E{(bf16_t*)(p.ws + WS_MIX), DM, 0, 1.f, nullptr};
    pg8::gemm_phase((PG8_LAS unsigned char*)smem, g, S, E);
}

__device__ __forceinline__ void stage6(const Params& p, unsigned char* smem) {
    int tid_ = threadIdx.x; asm volatile("" : "+v"(tid_));
    const int tid = tid_, wid = tid >> 6, lane = tid & 63;
    const float* mod = (const float*)(p.ws + WS_MOD); const bf16_t* mix = (const bf16_t*)(p.ws + WS_MIX); const bf16x8* wrh = (const bf16x8*)(p.ws + WS_WR); const bf16x8* wrl = wrh + 1024 * 80 / 8;
    bf16_t* h2 = (bf16_t*)(p.ws + WS_H2); bf16_t* x1b = (bf16_t*)(p.ws + WS_MIX);
    int* cnt = (int*)(p.ws + WS_CTL) + CTL_CNT; int* toke = (int*)(p.ws + WS_TOKE); int* tokp = (int*)(p.ws + WS_TOKP); float* tokw = (float*)(p.ws + WS_TOKW);
    float* hq = (float*)smem;
    float* part = (float*)(smem + 65792);
    float* lgs = (float*)(smem + 65792 + 40960);
    for (int chunk = blockIdx.x; chunk < M / 64; chunk += gridDim.x) {
        const int row0 = chunk * 64, b = row0 / SEQ; const float* mb = mod + b * 6144;
        f32x4 ggt[4], gsc[4], shv[4];
#pragma unroll
        for (int j = 0; j < 4; ++j) { const int col = lane * 4 + 256 * j;
            ggt[j] = *(const f32x4*)(p.in[5] + col) * *(const f32x4*)(mb + 2048 + col);
            gsc[j] = *(const f32x4*)(p.in[6] + col) * (*(const f32x4*)(mb + 4096 + col) + 1.f);
            shv[j] = *(const f32x4*)(mb + 3072 + col); }
        u32x2 pm[2][4]; f32x4 px[2][4];
#define S6_LOAD(T) { _Pragma("unroll") for (int rr = 0; rr < 2; ++rr) { const size_t ro = (size_t)(row0 + 16 * (T) + 2 * wid + rr) * DM + lane * 4; \
            _Pragma("unroll") for (int j = 0; j < 4; ++j) { pm[rr][j] = __builtin_nontemporal_load((const u32x2*)(mix + ro + 256 * j)); px[rr][j] = __builtin_nontemporal_load((const f32x4*)(p.in[0] + ro + 256 * j)); } } }
        S6_LOAD(0)
#pragma unroll 1
        for (int t = 0; t < 4; ++t) {
#pragma unroll
            for (int rr = 0; rr < 2; ++rr) {
                const int lr = 2 * wid + rr, row = row0 + 16 * t + lr;
                f32x4 v[4], x1[4]; float ss = 0.f;
#pragma unroll
                for (int j = 0; j < 4; ++j) { const u32x2 mw = pm[rr][j];
                    v[j] = (f32x4){__uint_as_float(mw.x << 16), __uint_as_float(mw.x & 0xffff0000u), __uint_as_float(mw.y << 16), __uint_as_float(mw.y & 0xffff0000u)};
                    ss += v[j].x * v[j].x + v[j].y * v[j].y + v[j].z * v[j].z + v[j].w * v[j].w; }
                const float rstd = rsqrtf(wave_sum(ss) * (1.f / DM) + 1e-6f); float s2 = 0.f;
#pragma unroll
                for (int j = 0; j < 4; ++j) { const int col = lane * 4 + 256 * j;
                    x1[j] = px[rr][j] + ggt[j] * (v[j] * rstd);
                    { u32x2 xo; xo.x = pk2(x1[j].x, x1[j].y); xo.y = pk2(x1[j].z, x1[j].w); __builtin_nontemporal_store(xo, (u32x2*)(x1b + (size_t)row * DM + col)); }
                    s2 += x1[j].x * x1[j].x + x1[j].y * x1[j].y + x1[j].z * x1[j].z + x1[j].w * x1[j].w; }
                const float rstd2 = rsqrtf(wave_sum(s2) * (1.f / DM) + 1e-6f);
#pragma unroll
                for (int j = 0; j < 4; ++j) { const int col = lane * 4 + 256 * j;
                    const f32x4 h = x1[j] * rstd2 * gsc[j] + shv[j];
                    *(f32x4*)(hq + lr * 1028 + col) = h;
                    u32x2 o; o.x = pk2(h.x, h.y); o.y = pk2(h.z, h.w); *(u32x2*)(h2 + (size_t)row * DM + col) = o; }
            }
            if (t < 3) S6_LOAD(t + 1)
            __syncthreads();
            {
                const int r = lane & 15, q = lane >> 4;
                f32x4 acc[5];
#pragma unroll
                for (int j = 0; j < 5; ++j) acc[j] = (f32x4){0.f, 0.f, 0.f, 0.f};
#pragma unroll 2
                for (int s = 0; s < 4; ++s) {
                    const f32x4 a0 = *(const f32x4*)(hq + r * 1028 + 128 * wid + 32 * s + 8 * q), a1 = *(const f32x4*)(hq + r * 1028 + 128 * wid + 32 * s + 8 * q + 4);
                    u32x4 ahw, alw;
                    { const unsigned h0 = pk2(a0.x, a0.y), h1 = pk2(a0.z, a0.w), h2_ = pk2(a1.x, a1.y), h3 = pk2(a1.z, a1.w);
                      ahw = (u32x4){h0, h1, h2_, h3};
                      alw.x = pk2(a0.x - __uint_as_float(h0 << 16), a0.y - __uint_as_float(h0 & 0xffff0000u)); alw.y = pk2(a0.z - __uint_as_float(h1 << 16), a0.w - __uint_as_float(h1 & 0xffff0000u));
                      alw.z = pk2(a1.x - __uint_as_float(h2_ << 16), a1.y - __uint_as_float(h2_ & 0xffff0000u)); alw.w = pk2(a1.z - __uint_as_float(h3 << 16), a1.w - __uint_as_float(h3 & 0xffff0000u)); }
                    const bf16x8 ah = __builtin_bit_cast(bf16x8, ahw), al = __builtin_bit_cast(bf16x8, alw);
                    bf16x8 bh[5], bl[5];
#pragma unroll
                    for (int j = 0; j < 5; ++j) { bh[j] = wrh[((wid * 4 + s) * 5 + j) * 64 + lane]; bl[j] = wrl[((wid * 4 + s) * 5 + j) * 64 + lane]; }
#pragma unroll
                    for (int j = 0; j < 5; ++j) { acc[j] = __builtin_amdgcn_mfma_f32_16x16x32_bf16(ah, bh[j], acc[j], 0, 0, 0);
                        acc[j] = __builtin_amdgcn_mfma_f32_16x16x32_bf16(ah, bl[j], acc[j], 0, 0, 0); acc[j] = __builtin_amdgcn_mfma_f32_16x16x32_bf16(al, bh[j], acc[j], 0, 0, 0); }
                }
#pragma unroll
                for (int j = 0; j < 5; ++j)
#pragma unroll
                    for (int i = 0; i < 4; ++i) part[(wid * 16 + 4 * q + i) * 80 + 16 * j + r] = acc[j][i];
            }
            __syncthreads();
            for (int idx = tid; idx < 1280; idx += NT) { float s = 0.f;
#pragma unroll
                for (int w = 0; w < 8; ++w) s += part[w * 1280 + idx];
                lgs[t * 1280 + idx] = s; }
        }
#undef S6_LOAD
        __syncthreads();
        if (tid < 64) { const int t = row0 + tid; const float* lg = lgs + tid * 80;
            float best = -3e38f; int grp = 0; float l8[8];
#pragma unroll
            for (int i = 0; i < 8; ++i) { l8[i] = lg[64 + i] + p.in[22][i]; if (l8[i] > best) { best = l8[i]; grp = i; } }
            float den = 0.f;
#pragma unroll
            for (int i = 0; i < 8; ++i) den += __expf(l8[i] - best);
            const float pg = 1.f / den;
            float v1 = -3e38f, v2 = -3e38f; int i1 = 0, i2 = 0;
#pragma unroll
            for (int i = 0; i < 8; ++i) { const float v = lg[grp * 8 + i] + p.in[24][grp * 8 + i];
                if (v > v1) { v2 = v1; i2 = i1; v1 = v; i1 = i; } else if (v > v2) { v2 = v; i2 = i; } }
            const float e2 = __expf(v2 - v1), w1 = pg / (1.f + e2), w2 = pg * e2 / (1.f + e2);
            const int ea = grp * 8 + i1, eb = grp * 8 + i2;
            const int xg = chunk & 7;
            const int pa = atomicAdd(&cnt[(xg * 64 + ea) * 16], 1), pb = atomicAdd(&cnt[(xg * 64 + eb) * 16], 1);
            toke[t * 2] = ea; toke[t * 2 + 1] = eb; tokp[t * 2] = pa; tokp[t * 2 + 1] = pb; tokw[t * 2] = w1; tokw[t * 2 + 1] = w2;
            int* elist = (int*)(p.ws + WS_ELIST); elist[ea * 16384 + xg * 2048 + pa] = t; elist[eb * 16384 + xg * 2048 + pb] = t; }
        __syncthreads();
    }
}

__device__ __forceinline__ void expert_bases(const Params& p, int* lb) {
    const int* cntg = (const int*)(p.ws + WS_CTL) + CTL_CNT;
    __syncthreads();
    if (threadIdx.x < 64) {
        const int e = threadIdx.x; int c8[8];
#pragma unroll
        for (int x = 0; x < 8; ++x) c8[x] = cntg[(x * 64 + e) * 16];
        int cnt = 0;
#pragma unroll
        for (int x = 0; x < 8; ++x) { lb[832 + e * 8 + x] = cnt; cnt += c8[x]; }
        lb[768 + e] = cnt;
        const int pad = (cnt + 255) >> 8; int incl = pad;
#pragma unroll
        for (int d = 1; d < 64; d <<= 1) { const int t = __shfl_up(incl, d); if (e >= d) incl += t; }
        const int tb = incl - pad;
        lb[e] = tb * 256;
        if (e == 63) lb[64] = incl;
        for (int t = 0; t < pad; ++t) { lb[128 + tb + t] = e; lb[320 + tb + t] = (cnt - t * 256) <= 128 ? 1 : 0; }
    }
    __syncthreads();
    if (threadIdx.x < 64) {
        const int lane = threadIdx.x, nt = lb[64];
        unsigned long long bf[3], bh[3]; bool hf[3], ok[3];
#pragma unroll
        for (int c = 0; c < 3; ++c) { const int tile = 64 * c + lane; ok[c] = tile < nt; hf[c] = ok[c] && lb[320 + tile] != 0; bh[c] = __ballot(hf[c]); bf[c] = __ballot(ok[c] && !hf[c]); }
        const int nfull = __popcll(bf[0]) + __popcll(bf[1]) + __popcll(bf[2]);
        const unsigned long long lt = (1ull << lane) - 1ull;
        int fb = 0, hb = 0;
#pragma unroll
        for (int c = 0; c < 3; ++c) { if (ok[c]) lb[512 + (hf[c] ? nfull + hb + __popcll(bh[c] & lt) : fb + __popcll(bf[c] & lt))] = 64 * c + lane;
            fb += __popcll(bf[c]); hb += __popcll(bh[c]); }
    }
    __syncthreads();
}
__device__ __forceinline__ int xcd_major_id() { const int G = gridDim.x, c = blockIdx.x; return (G % 8 == 0) ? (c % 8) * (G / 8) + c / 8 : c; }
struct MoeOrder {
    int ntiles, nN, G, c; const int* lb; const char* wbase; size_t estride; const int* elist; const int* cnt;
    unsigned* sig;
    unsigned* wait;
    __device__ __forceinline__ bool next(int i, pg8::Unit& u) const {
        const int L = i * G + c; if (L >= ntiles * nN) return false;
        u.pm = lb[512 + L / nN]; u.pn = L % nN; const int e = lb[128 + u.pm]; u.bbase = wbase + (size_t)e * estride;
        u.half = lb[320 + u.pm]; return true; }
    __device__ __forceinline__ unsigned arow(const pg8::Unit& u, int r) const {
        if (elist) { const int e = lb[128 + u.pm], off = u.pm * 256 - lb[e] + r;
            if (off >= lb[768 + e]) return 0u;
            int x = 0;
#pragma unroll
            for (int i = 1; i < 8; ++i) x += (off >= lb[832 + e * 8 + i]) ? 1 : 0;
            return (unsigned)elist[e * 16384 + x * 2048 + (off - lb[832 + e * 8 + x])]; }
        return (unsigned)(u.pm * 256 + r); }
    __device__ __forceinline__ void a_ready(const pg8::Unit& u) const {
        if (!wait) return;
        unsigned sp = 0;
        while (__hip_atomic_load(wait + u.pm, __ATOMIC_RELAXED, __HIP_MEMORY_SCOPE_AGENT) < 4u) { __builtin_amdgcn_s_sleep(2); if (++sp > (1u << 22)) break; }
        __builtin_amdgcn_fence(__ATOMIC_ACQUIRE, "agent");
    }
    __device__ __forceinline__ void done(const pg8::Unit& u) const {
        if (!sig) return;
        asm volatile("s_waitcnt vmcnt(0)" ::: "memory");
        __builtin_amdgcn_s_barrier();
        if (threadIdx.x == 0) { __builtin_amdgcn_fence(__ATOMIC_RELEASE, "agent"); asm volatile("s_waitcnt vmcnt(0)" ::: "memory");
            (void)__hip_atomic_fetch_add(sig + u.pm, 1u, __ATOMIC_RELAXED, __HIP_MEMORY_SCOPE_AGENT); }
    }
};

struct EpiGateUp {
    static constexpr bool PERM = true;
    bf16_t* O;
    __device__ __forceinline__ void operator()(const f32x4 (&acc)[2][2][4][2], const pg8::Unit& u, int wr, int wc, int fr, int fq) const {
        const int row0 = u.pm * 256 + wr * 64 + fr, col0 = (u.pn * 256 + wc * 32 + 8 * fq) / 2;
#pragma unroll
        for (int ai = 0; ai < 2; ++ai) { if (ai == 1 && u.half) break;
#pragma unroll
            for (int m = 0; m < 4; ++m) { bf16_t* rowp = O + (size_t)(row0 + ai * 128 + m * 16) * 512 + col0;
#pragma unroll
                for (int bj = 0; bj < 2; ++bj) { const f32x4 v0 = acc[ai][bj][m][0], v1 = acc[ai][bj][m][1];
                    u32x2 w; w.x = pg8::cvt_pk_bf16(silu_f(v0[0]) * v0[1], silu_f(v0[2]) * v0[3]); w.y = pg8::cvt_pk_bf16(silu_f(v1[0]) * v1[1], silu_f(v1[2]) * v1[3]);
                    *(u32x2*)(rowp + bj * 64) = w; } } }
    }
};
__device__ __forceinline__ void stage10(const Params& p, unsigned char* smem) {
    int* lb = (int*)(smem + 131072); expert_bases(p, lb);
    pg8::Gemm g{(const bf16_t*)(p.ws + WS_H2), DM};
    MoeOrder S{lb[64], 4, (int)gridDim.x, xcd_major_id(), lb, (const char*)(p.ws + WS_WTGU), (size_t)1024 * 1024 * 2, (const int*)(p.ws + WS_ELIST), (const int*)(p.ws + WS_CTL), nullptr, nullptr};
    EpiGateUp E{(bf16_t*)(p.ws + WS_HID)};
    pg8::gemm_phase((PG8_LAS unsigned char*)smem, g, S, E);
}

__device__ __forceinline__ void stage11(const Params& p, unsigned char* smem) {
    int* lb = (int*)(smem + 131072); expert_bases(p, lb);
    pg8::Gemm g{(const bf16_t*)(p.ws + WS_HID), 512};
    MoeOrder S{lb[64], 4, (int)gridDim.x, xcd_major_id(), lb, (const char*)(p.ws + WS_WTDN), (size_t)1024 * 512 * 2, nullptr, (const int*)(p.ws + WS_CTL), nullptr, nullptr};
    EpiBf16Out E{(bf16_t*)(p.ws + WS_Y), DM, 0, 1.f, nullptr};
    pg8::gemm_phase((PG8_LAS unsigned char*)smem, g, S, E);
}

__device__ __forceinline__ void stage12(const Params& p, unsigned char* smem) {
    int* lb = (int*)(smem + 131072); expert_bases(p, lb);
    const int tid = opaque_tid(), wid = tid >> 6, lane = tid & 63;
    const float* mod = (const float*)(p.ws + WS_MOD); const bf16_t* Y = (const bf16_t*)(p.ws + WS_Y); const bf16_t* X1 = (const bf16_t*)(p.ws + WS_MIX);
    const int* toke = (const int*)(p.ws + WS_TOKE); const int* tokp = (const int*)(p.ws + WS_TOKP); const float* tokw = (const float*)(p.ws + WS_TOKW);
    for (int rg = blockIdx.x * NW + wid; rg < M / 8; rg += gridDim.x * NW) {
        const int rowb = rg * 8, b = rowb / SEQ, xg = (rowb >> 6) & 7;
        int yr = 0; float tw = 0.f;
        if (lane < 16) { const int te = toke[rowb * 2 + lane]; yr = lb[te] + lb[832 + te * 8 + xg] + tokp[rowb * 2 + lane]; tw = tokw[rowb * 2 + lane]; }
        f32x4 ggt[2][2];
#pragma unroll
        for (int j = 0; j < 2; ++j)
#pragma unroll
            for (int h = 0; h < 2; ++h) { const int col = lane * 8 + 512 * j + 4 * h; ggt[j][h] = *(const f32x4*)(p.in[7] + col) * *(const f32x4*)(mod + b * 6144 + 5120 + col); }
        u32x4 ya[2][2], yb[2][2], xv[2][2];
#define S12_LOAD(I, BF) { const int r0 = __builtin_amdgcn_readlane(yr, 2 * (I)), r1 = __builtin_amdgcn_readlane(yr, 2 * (I) + 1); \
            _Pragma("unroll") for (int j = 0; j < 2; ++j) { const int col = lane * 8 + 512 * j; \
                ya[BF][j] = __builtin_nontemporal_load((const u32x4*)(Y + (size_t)r0 * DM + col)); yb[BF][j] = __builtin_nontemporal_load((const u32x4*)(Y + (size_t)r1 * DM + col)); \
                xv[BF][j] = __builtin_nontemporal_load((const u32x4*)(X1 + (size_t)(rowb + (I)) * DM + col)); } }
        S12_LOAD(0, 0)
#pragma unroll
        for (int i = 0; i < 8; ++i) {
            if (i + 1 < 8) { if ((i + 1) & 1) S12_LOAD(i + 1, 1) else S12_LOAD(i + 1, 0) }
            const float w0 = __int_as_float(__builtin_amdgcn_readlane(__float_as_int(tw), 2 * i)), w1 = __int_as_float(__builtin_amdgcn_readlane(__float_as_int(tw), 2 * i + 1));
            float f[2][8], xf[2][8]; float ss = 0.f;
#pragma unroll
            for (int j = 0; j < 2; ++j) { float a[8], c[8]; unpack8(ya[i & 1][j], a); unpack8(yb[i & 1][j], c); unpack8(xv[i & 1][j], xf[j]);
#pragma unroll
                for (int e = 0; e < 8; ++e) { f[j][e] = a[e] * w0 + c[e] * w1; ss += f[j][e] * f[j][e]; } }
            const float rstd = rsqrtf(wave_sum(ss) * (1.f / DM) + 1e-6f);
#pragma unroll
            for (int j = 0; j < 2; ++j)
#pragma unroll
                for (int h = 0; h < 2; ++h) { const int col = lane * 8 + 512 * j + 4 * h;
                    const f32x4 fv = {f[j][4 * h], f[j][4 * h + 1], f[j][4 * h + 2], f[j][4 * h + 3]};
                    const f32x4 xq = {xf[j][4 * h], xf[j][4 * h + 1], xf[j][4 * h + 2], xf[j][4 * h + 3]};
                    __builtin_nontemporal_store(xq + ggt[j][h] * (fv * rstd), (f32x4*)(p.out + (size_t)(rowb + i) * DM + col)); }
        }
#undef S12_LOAD
    }
}

#define GAS __attribute__((address_space(1)))
#define LAS __attribute__((address_space(3)))
#define XB_TMO      128
#define XB_XCNT(j)  (256  + 64 * (j))
#define XB_XSUB(j)  (1280 + 64 * (j))
#define XB_XGEN(j)  (2304 + 64 * (j))
#define XB_TOP      3328
#define XB_TOPGEN   3392
#define XCD_BAR_WORDS 3456
#define XB_SPIN_CAP (1u << 18)
__device__ __forceinline__ unsigned xb_ld(unsigned* p)              { return __hip_atomic_load(p, __ATOMIC_RELAXED, __HIP_MEMORY_SCOPE_AGENT); }
__device__ __forceinline__ unsigned xb_add(unsigned* p, unsigned v) { return __hip_atomic_fetch_add(p, v, __ATOMIC_RELAXED, __HIP_MEMORY_SCOPE_AGENT); }
__device__ __forceinline__ unsigned xb_xcc_id() { return (unsigned)__builtin_amdgcn_s_getreg((3 << 11) | 20) & 0xFu; }
#define XB_SPIN(cond, bar) do { unsigned _sp = 0; while (cond) { __builtin_amdgcn_s_sleep(1); \
    if ((++_sp & 255u) == 0u) { if (xb_ld(&(bar)[XB_TMO])) break; if (_sp > XB_SPIN_CAP) { atomicAdd(&(bar)[XB_TMO], 1u); break; } } } } while (0)
struct XcdBarrier { unsigned* bar; unsigned x; volatile LAS unsigned* st; };
__device__ __forceinline__ XcdBarrier xcd_barrier_post(unsigned* bar, volatile LAS unsigned* st) {
    XcdBarrier b; b.bar = bar; b.x = xb_xcc_id(); b.st = st;
    if (threadIdx.x == 0) (void)xb_add(&bar[XB_XCNT(b.x)], 1u);
    return b;
}
__device__ __forceinline__ void xcd_barrier_complete(unsigned* bar, unsigned x, unsigned& nloc, unsigned& nx) {
    const unsigned G = gridDim.x * gridDim.y * gridDim.z;
    unsigned sum, cnt, mine, sp = 0u;
    for (;;) {
        sum = 0u; cnt = 0u; mine = 0u;
#pragma unroll
        for (unsigned j = 0; j < 16; ++j) { const unsigned c = xb_ld(&bar[XB_XCNT(j)]); sum += c; cnt += (c > 0u) ? 1u : 0u; mine = (j == x) ? c : mine; }
        if (sum == G) break;
        __builtin_amdgcn_s_sleep(1);
        if ((++sp & 255u) == 0u) { if (xb_ld(&bar[XB_TMO])) break; if (sp > XB_SPIN_CAP) { atomicAdd(&bar[XB_TMO], 1u); break; } }
    }
    nloc = mine > 0u ? mine : 1u; nx = cnt > 0u ? cnt : 1u;
}
__device__ __forceinline__ void xcd_barrier(const XcdBarrier& b) {
    asm volatile("s_waitcnt vmcnt(0)" ::: "memory");
    __syncthreads();
    if (threadIdx.x == 0) {
        unsigned* bar = b.bar;
        __builtin_amdgcn_s_waitcnt(0);
        unsigned nloc = b.st[0], nx = b.st[1];
        if (nloc == 0u) { xcd_barrier_complete(bar, b.x, nloc, nx); b.st[0] = nloc; b.st[1] = nx; }
        const unsigned old = xb_add(&bar[XB_XSUB(b.x)], 1u);
        const unsigned gen = old / nloc;
        if (old + 1u == (gen + 1u) * nloc) {
            __builtin_amdgcn_fence(__ATOMIC_RELEASE, "agent");
            asm volatile("s_waitcnt vmcnt(0)" ::: "memory");
            const unsigned og = xb_add(&bar[XB_TOP], 1u);
            const unsigned tg = og / nx;
            if (og + 1u == (tg + 1u) * nx) xb_add(&bar[XB_TOPGEN], 1u);
            else XB_SPIN(xb_ld(&bar[XB_TOPGEN]) == tg, bar);
            __builtin_amdgcn_fence(__ATOMIC_ACQUIRE, "agent");
            xb_add(&bar[XB_XGEN(b.x)], 1u);
            asm volatile("s_waitcnt vmcnt(0)" ::: "memory");
        } else {
            XB_SPIN(xb_ld(&bar[XB_XGEN(b.x)]) == gen, bar);
            __builtin_amdgcn_fence(__ATOMIC_ACQUIRE, "agent");
            asm volatile("s_waitcnt vmcnt(0)" ::: "memory");
        }
    }
    __syncthreads();
}

__device__ __forceinline__ void ctr_barrier(unsigned* base, unsigned epoch) {
    asm volatile("s_waitcnt vmcnt(0)" ::: "memory");
    __syncthreads();
    if (threadIdx.x == 0) {
        __builtin_amdgcn_fence(__ATOMIC_RELEASE, "agent");
        asm volatile("s_waitcnt vmcnt(0)" ::: "memory");
        const unsigned G = gridDim.x, ngrp = (G % 8u == 0u) ? 8u : 1u, g = blockIdx.x % ngrp, per = G / ngrp;
        unsigned* sub = base + 64u * g; unsigned* gen = base + 64u * (8u + g); unsigned* top = base + 64u * 16u;
        const unsigned old = __hip_atomic_fetch_add(sub, 1u, __ATOMIC_RELAXED, __HIP_MEMORY_SCOPE_AGENT);
        if (old + 1u == epoch * per) {
            const unsigned ot = __hip_atomic_fetch_add(top, 1u, __ATOMIC_RELAXED, __HIP_MEMORY_SCOPE_AGENT);
            if (ot + 1u == epoch * ngrp) { for (unsigned j = 0; j < ngrp; ++j) __hip_atomic_store(base + 64u * (8u + j), epoch, __ATOMIC_RELAXED, __HIP_MEMORY_SCOPE_AGENT); }
        }
        unsigned sp = 0;
        while (__hip_atomic_load(gen, __ATOMIC_RELAXED, __HIP_MEMORY_SCOPE_AGENT) < epoch) { __builtin_amdgcn_s_sleep(1); if (++sp > (1u << 22)) break; }
        __builtin_amdgcn_fence(__ATOMIC_ACQUIRE, "agent");
        asm volatile("s_waitcnt vmcnt(0)" ::: "memory");
    }
    __syncthreads();
}
constexpr int NSTAGE = 13;
template <int S> __device__ __forceinline__ void run_stage(const Params& p, unsigned char* smem) {
    if constexpr (S == 0) stage0(p, smem);
    else if constexpr (S == 1) stage1(p);
    else if constexpr (S == 2) stage2(p, smem);
    else if constexpr (S == 3) stage3(p, smem);
    else if constexpr (S == 4) stage4(p, smem);
    else if constexpr (S == 5) stage5(p, smem);
    else if constexpr (S == 6) stage6(p, smem);
    else if constexpr (S == 10) stage10(p, smem);
    else if constexpr (S == 11) stage11(p, smem);
    else if constexpr (S == 12) stage12(p, smem);
}
typedef const __attribute__((address_space(4))) Params* KParams;
template <int S> __device__ __forceinline__ void run_stage_k(unsigned char* smem) {
    KParams kp = (KParams)__builtin_amdgcn_kernarg_segment_ptr();
    asm volatile("" : "+s"(kp));
    Params lp;
#pragma unroll
    for (int i = 0; i < 28; ++i) lp.in[i] = kp->in[i];
    lp.out = kp->out; lp.ws = kp->ws;
    run_stage<S>(lp, smem);
}
#if MK_FUSED
constexpr int CTL_BAR_WORD = 4096;
constexpr int CTL_ZERO_BYTES = 65536 + 49152;
__global__ void __launch_bounds__(NT, 2) mk(Params p) {
    extern __shared__ __attribute__((aligned(16))) unsigned char smem[];
#define CTR() ((unsigned*)(((KParams)__builtin_amdgcn_kernarg_segment_ptr())->ws + WS_CTL) + CTL_BAR_WORD)
    run_stage_k<0>(smem); ctr_barrier(CTR(), 1u);
    run_stage_k<1>(smem); ctr_barrier(CTR(), 2u);
    run_stage_k<2>(smem); ctr_barrier(CTR(), 3u);
    run_stage_k<3>(smem); ctr_barrier(CTR(), 4u);
    run_stage_k<4>(smem); ctr_barrier(CTR(), 5u);
    run_stage_k<5>(smem); ctr_barrier(CTR(), 6u);
    run_stage_k<6>(smem); ctr_barrier(CTR(), 7u);
    run_stage_k<10>(smem); ctr_barrier(CTR(), 8u);
    run_stage_k<11>(smem); ctr_barrier(CTR(), 9u);
    run_stage_k<12>(smem);
#undef CTR
}
#else
template <int S> __global__ void __launch_bounds__(NT, 2) mk1(Params p) {
    extern __shared__ __attribute__((aligned(16))) unsigned char smem[];
    run_stage<S>(p, smem);
}
template <int S> static void launch_stage(const Params& p, int cus, hipStream_t stream) {
    static int grid = 0;
    if (grid == 0) { int per_cu = 0;
        (void)hipFuncSetAttribute((const void*)mk1<S>, hipFuncAttributeMaxDynamicSharedMemorySize, LDS_BYTES);
        (void)hipOccupancyMaxActiveBlocksPerMultiprocessor(&per_cu, (const void*)mk1<S>, NT, LDS_BYTES);
        if (per_cu < 1) per_cu = 1;
        grid = cus * per_cu; (void)hipGetLastError(); }
    hipLaunchKernelGGL(mk1<S>, dim3(grid), dim3(NT), LDS_BYTES, stream, p);
}
#endif

extern "C" void kernel_launch(void* const* d_in, const int* in_sizes, int n_in, void* d_out, int out_size, void* d_ws, size_t ws_size, hipStream_t stream) {
    static int grid = 0, cus = 0;
    if (grid == 0) {
        if (n_in != 28 || out_size != M * DM || ws_size < WS_END) { fprintf(stderr, "kernel_launch: unexpected shapes (n_in %d out %d ws %zu)\n", n_in, out_size, ws_size); grid = -1; return; }
        int dev = 0;
        (void)hipGetDevice(&dev); (void)hipDeviceGetAttribute(&cus, hipDeviceAttributeMultiprocessorCount, dev);
        grid = cus;
#if MK_FUSED
        int per_cu = 0;
        (void)hipFuncSetAttribute((const void*)mk, hipFuncAttributeMaxDynamicSharedMemorySize, LDS_BYTES);
        (void)hipOccupancyMaxActiveBlocksPerMultiprocessor(&per_cu, (const void*)mk, NT, LDS_BYTES);
        if (per_cu < 1) fprintf(stderr, "kernel_launch: occupancy query reports %d workgroups per CU\n", per_cu);
        grid = cus;
#endif
        (void)hipGetLastError();
    }
    if (grid < 0) return;
    Params p{};
    for (int i = 0; i < 28; ++i) p.in[i] = (const float*)d_in[i];
    p.out = (float*)d_out; p.ws = (unsigned char*)d_ws;
#if MK_FUSED
    (void)hipMemsetAsync((char*)d_ws + WS_CTL, 0, CTL_ZERO_BYTES, stream);
    hipLaunchKernelGGL(mk, dim3(grid), dim3(NT), LDS_BYTES, stream, p);
#else
    (void)hipMemsetAsync((char*)d_ws + WS_CTL, 0, 65536 + 49152, stream);
    launch_stage<0>(p, cus, stream); launch_stage<1>(p, cus, stream); launch_stage<2>(p, cus, stream); launch_stage<3>(p, cus, stream);
    launch_stage<4>(p, cus, stream); launch_stage<5>(p, cus, stream); launch_stage<6>(p, cus, stream);
    launch_stage<10>(p, cus, stream); launch_stage<11>(p, cus, stream);
    launch_stage<12>(p, cus, stream);
#endif
}
```

```cpp
#include <hip/hip_runtime.h>
#include <hip/hip_cooperative_groups.h>
#include <cstdio>
#include <cstdint>
namespace cg = cooperative_groups;

#ifndef MK_FUSED
#define MK_FUSED 1
#endif

typedef unsigned short bf16_t;
typedef short bf16x8 __attribute__((ext_vector_type(8)));
typedef float f32x4 __attribute__((ext_vector_type(4)));
typedef unsigned u32x4 __attribute__((ext_vector_type(4)));
typedef unsigned u32x2 __attribute__((ext_vector_type(2)));

constexpr int NT = 512, NW = 8;
constexpr int BATCH = 2, SEQ = 8192, DM = 1024, M = BATCH * SEQ;
constexpr int UC = 3072, IN_COLS = 2840;
constexpr int C_DQ = 0, C_DK = 512, C_DV = 1024, C_NQ = 1536, C_CK = 2048, C_CV = 2176, C_SK = 2304, C_SV = 2432, C_WK = 2560, C_WV = 2688, C_NG = 2816;
constexpr int NEXP = 64, RMAX = 49152, NCMP = 511;
constexpr int LDS_BYTES = 147456;

constexpr size_t MiB = 1u << 20;
constexpr size_t WS_CTL = 0;
constexpr size_t WS_MOD = 65536;
constexpr size_t WS_KC = 2 * MiB;
constexpr size_t WS_VC = 3 * MiB;
constexpr size_t WS_ELIST = 4 * MiB;
constexpr size_t WS_TOKE = 10 * MiB;
constexpr size_t WS_TOKP = WS_TOKE + 128 * 1024;
constexpr size_t WS_TOKW = WS_TOKP + 128 * 1024;
constexpr size_t WS_TOKR = WS_TOKW + 128 * 1024;
constexpr size_t WS_ROWT = 11 * MiB;
constexpr size_t WS_WR = 14 * MiB;
constexpr size_t WS_W1T = 14 * MiB + 512 * 1024;
constexpr size_t WS_W2T = 15 * MiB + 512 * 1024;
constexpr int CTL_NORM = 384;
constexpr int CTL_CNT = 8192;
constexpr int CTL_TREADY = 1024;
constexpr int CTL_TQ = 320;
constexpr int CTL_CVQ = 352;
constexpr int CTL_MODRDY = 336;
constexpr int CTL_QHEAD = 448;
constexpr size_t WS_B1P = 15 * MiB + 768 * 1024;
constexpr size_t WS_WTIN = 16 * MiB;
constexpr size_t WS_WTOUT = 22 * MiB;
constexpr size_t WS_WTGU = 24 * MiB;
constexpr size_t WS_WTDN = 152 * MiB;
constexpr size_t WS_XN = 216 * MiB;
constexpr size_t WS_U = 248 * MiB;
constexpr size_t WS_OC = 344 * MiB;
constexpr size_t WS_AO = 408 * MiB;
constexpr size_t WS_MIX = 440 * MiB;
constexpr size_t WS_KFS = 440 * MiB, WS_KFW = 444 * MiB, WS_VFS = 448 * MiB, WS_VFW = 452 * MiB;
constexpr size_t WS_AOF = 456 * MiB;
constexpr size_t WS_H2 = WS_XN;
constexpr size_t WS_H2F = WS_OC;
constexpr size_t WS_HID = WS_U;
constexpr size_t WS_Y = 296 * MiB;
constexpr size_t WS_WTIN1 = 488 * MiB;
constexpr size_t WS_BETAP = 495 * MiB;
constexpr size_t WS_MODP = 497 * MiB;
constexpr size_t WS_END = 504 * MiB;

struct Params { const float* in[28]; float* out; unsigned char* ws; };

__device__ __forceinline__ int opaque_tid() { int t = threadIdx.x; asm volatile("" : "+v"(t)); return t; }
__device__ __forceinline__ float bf2f(bf16_t v) { return __uint_as_float(((unsigned)v) << 16); }
__device__ __forceinline__ bf16_t f2bf(float f) { unsigned u = __float_as_uint(f); return (bf16_t)((u + 0x7fffu + ((u >> 16) & 1u)) >> 16); }
__device__ __forceinline__ unsigned pk2(float lo, float hi) { return (unsigned)f2bf(lo) | ((unsigned)f2bf(hi) << 16); }
__device__ __forceinline__ float wave_sum(float v) {
    v += __int_as_float(__builtin_amdgcn_update_dpp(0, __float_as_int(v), 0xB1, 0xF, 0xF, true));
    v += __int_as_float(__builtin_amdgcn_update_dpp(0, __float_as_int(v), 0x4E, 0xF, 0xF, true));
    v += __int_as_float(__builtin_amdgcn_update_dpp(0, __float_as_int(v), 0x141, 0xF, 0xF, true));
    v += __int_as_float(__builtin_amdgcn_update_dpp(0, __float_as_int(v), 0x140, 0xF, 0xF, true));
    const float r0 = __int_as_float(__builtin_amdgcn_readlane(__float_as_int(v), 0)), r1 = __int_as_float(__builtin_amdgcn_readlane(__float_as_int(v), 16));
    const float r2 = __int_as_float(__builtin_amdgcn_readlane(__float_as_int(v), 32)), r3 = __int_as_float(__builtin_amdgcn_readlane(__float_as_int(v), 48));
    return (r0 + r1) + (r2 + r3);
}
__device__ __forceinline__ float wave_max(float v) {
#pragma unroll
    for (int o = 32; o > 0; o >>= 1) v = fmaxf(v, __shfl_xor(v, o));
    return v;
}
__device__ __forceinline__ void lds_fence() { asm volatile("s_waitcnt lgkmcnt(0)" ::: "memory"); }
__device__ __forceinline__ float silu_f(float x) { return x / (1.f + __expf(-x)); }
__device__ __forceinline__ float gelu_tanh(float x) { return 0.5f * x * (1.f + tanhf(0.7978845608028654f * (x + 0.044715f * x * x * x))); }
__device__ __forceinline__ void unpack8(const u32x4 w, float* v) {
    v[0] = __uint_as_float(w.x << 16); v[1] = __uint_as_float(w.x & 0xffff0000u);
    v[2] = __uint_as_float(w.y << 16); v[3] = __uint_as_float(w.y & 0xffff0000u);
    v[4] = __uint_as_float(w.z << 16); v[5] = __uint_as_float(w.z & 0xffff0000u);
    v[6] = __uint_as_float(w.w << 16); v[7] = __uint_as_float(w.w & 0xffff0000u);
}

template <class AF, class Epi>
__device__ __forceinline__ void gemm128(const AF& arow, const bf16_t* Bt, int K, const Epi& epi) {
    const int tid = threadIdx.x, wid = tid >> 6, lane = tid & 63, fr = lane & 15, fq = lane >> 4, wr = wid >> 2, wc = wid & 3;
    const bf16_t* ap[4]; const bf16_t* bp[2];
#pragma unroll
    for (int m = 0; m < 4; ++m) ap[m] = arow(wr * 64 + m * 16 + fr) + fq * 8;
#pragma unroll
    for (int n = 0; n < 2; ++n) bp[n] = Bt + (size_t)(wc * 32 + n * 16 + fr) * K + fq * 8;
    f32x4 acc[4][2];
#pragma unroll
    for (int m = 0; m < 4; ++m)
#pragma unroll
        for (int n = 0; n < 2; ++n) acc[m][n] = (f32x4){0.f, 0.f, 0.f, 0.f};
#pragma unroll 2
    for (int k0 = 0; k0 < K; k0 += 32) {
        bf16x8 a[4], b[2];
#pragma unroll
        for (int m = 0; m < 4; ++m) a[m] = *(const bf16x8*)(ap[m] + k0);
#pragma unroll
        for (int n = 0; n < 2; ++n) b[n] = *(const bf16x8*)(bp[n] + k0);
#pragma unroll
        for (int m = 0; m < 4; ++m)
#pragma unroll
            for (int n = 0; n < 2; ++n) acc[m][n] = __builtin_amdgcn_mfma_f32_16x16x32_bf16(b[n], a[m], acc[m][n], 0, 0, 0);
    }
#pragma unroll
    for (int m = 0; m < 4; ++m)
#pragma unroll
        for (int n = 0; n < 2; ++n) epi(wr * 64 + m * 16 + fr, wc * 32 + n * 16 + fq * 4, acc[m][n]);
}


namespace pg8 {
#define PG8_LAS __attribute__((address_space(3)))
constexpr int BM = 256, BK = 64, HALF = 128, HTB = HALF * BK * 2, STAGE_BYTES = 8 * HTB, NXCD = 8, WGM = 4;
__host__ __device__ __forceinline__ int lds_byte(int r, int c) { const int st = (r >> 4) * 2 + (c >> 5), rr = r & 15, cc = c & 31, ob = rr * 64 + cc * 2; return st * 1024 + (ob ^ (((ob >> 9) & 1) << 5)); }
__host__ __device__ __forceinline__ void stage_rc(int b, int& R, int& C) { const int st = b / 1024, sb = b % 1024, swz = sb ^ (((sb >> 9) & 1) << 5); R = (st >> 1) * 16 + swz / 64; C = (st & 1) * 32 + (swz % 64) / 2; }
__host__ __device__ __forceinline__ int perm32(int rho) { const int n = rho >> 4, i = rho & 15; return 8 * (i >> 2) + 4 * n + (i & 3); }

struct Unit { int pm, pn; const char* bbase; int half; int slot; };
struct Gemm { const bf16_t* A; int K; };

struct StaticOrder {
    int nM, nN, nwg, G, c; const char* bt;
    __device__ void init(int Mr, int N, int G_, int c_, const bf16_t* Bt) { nM = Mr / BM; nN = N / BM; nwg = nM * nN; G = G_; c = c_; bt = (const char*)Bt; }
    __device__ bool next(int i, Unit& u) const {
        const long L = (long)i * G + c; if (L >= nwg) return false;
        int wgid = (int)L; { const int q = nwg / NXCD, r = nwg % NXCD, xcd = wgid % NXCD, off = wgid / NXCD; wgid = (xcd < r ? xcd * (q + 1) : r * (q + 1) + (xcd - r) * q) + off; }
        const int nig = WGM * nN, gid = wgid / nig, fm = gid * WGM, gsz = (nM - fm) < WGM ? (nM - fm) : WGM;
        u.pm = fm + ((wgid % nig) % gsz); u.pn = (wgid % nig) / gsz; u.bbase = bt; u.half = 0; u.slot = 0; return true;
    }
    __device__ __forceinline__ unsigned arow(const Unit& u, int r) const { return (unsigned)(u.pm * BM + r); }
    __device__ __forceinline__ void a_ready(const Unit&) const {}
    __device__ __forceinline__ void done(const Unit&) const {}
};

__device__ __forceinline__ unsigned cvt_pk_bf16(float lo, float hi) { unsigned r; asm volatile("v_cvt_pk_bf16_f32 %0, %1, %2" : "=v"(r) : "v"(lo), "v"(hi)); return r; }

template <class Epi, class Sched>
__device__ __forceinline__ void gemm_phase(PG8_LAS unsigned char* lds, const Gemm g, const Sched& S, const Epi& E) {
    int tid_ = threadIdx.x; asm volatile("" : "+v"(tid_));
    const int tid = tid_, wid = __builtin_amdgcn_readfirstlane(tid >> 6), lane = tid & 63, wr = wid >> 2, wc = wid & 3, fr = lane & 15, fq = lane >> 4;
    const int K = g.K, nt = K / BK;
    int RA[2], CA[2]; unsigned voffB[2];
#pragma unroll
    for (int i = 0; i < 2; ++i) { int R, C; stage_rc(tid * 16 + i * 8192, R, C); const int Rb = Epi::PERM ? ((R & ~31) + perm32(R & 31)) : R;
        RA[i] = R; CA[i] = C; voffB[i] = (unsigned)(Rb * K + C) * 2u; }
    const size_t kstep = (size_t)(BK * 2);
    const size_t hstep = (size_t)HALF * K * 2;
    const size_t tstep = 2 * hstep;
    const unsigned ldsw = (unsigned)wid * 1024u;
    const int aoff = lds_byte(wr * 64 + fr, fq * 8), boff = lds_byte(wc * 32 + fr, fq * 8);
    const char* Abase = (const char*)g.A;
#define PG8_SA(b, h) (((b) * 2 + (h)) * HTB)
#define PG8_SB(b, h) ((4 + (b) * 2 + (h)) * HTB)
#define PG8_STAGE(bufoff, gbase, voff) do { _Pragma("unroll") for (int _i = 0; _i < 2; ++_i) \
        __builtin_amdgcn_global_load_lds((const unsigned*)((const char*)(gbase) + (voff)[_i]), (PG8_LAS unsigned*)(lds + (bufoff) + ldsw + _i * 8192), 16, 0, 0); } while (0)
#define PG8_LDA(dst, b, h) do { _Pragma("unroll") for (int m = 0; m < 4; ++m) _Pragma("unroll") for (int k = 0; k < 2; ++k) dst[m][k] = *(const PG8_LAS bf16x8*)(lds + PG8_SA(b, h) + aoff + m * 2048 + k * 1024); } while (0)
#define PG8_LDB(dst, b, h) do { _Pragma("unroll") for (int n = 0; n < 2; ++n) _Pragma("unroll") for (int k = 0; k < 2; ++k) dst[n][k] = *(const PG8_LAS bf16x8*)(lds + PG8_SB(b, h) + boff + n * 2048 + k * 1024); } while (0)
#define PG8_MMA(ai, bj, At, Bt) do { __builtin_amdgcn_s_setprio(1); _Pragma("unroll") for (int m = 0; m < 4; ++m) _Pragma("unroll") for (int n = 0; n < 2; ++n) _Pragma("unroll") for (int k = 0; k < 2; ++k) \
        acc[ai][bj][m][n] = __builtin_amdgcn_mfma_f32_16x16x32_bf16(Bt[n][k], At[m][k], acc[ai][bj][m][n], 0, 0, 0); __builtin_amdgcn_s_setprio(0); } while (0)
#define PG8_WAIT_V(n) asm volatile("s_waitcnt vmcnt(" #n ")" ::: "memory")
#define PG8_WAIT_L(n) asm volatile("s_waitcnt lgkmcnt(" #n ")" ::: "memory")
#define PG8_BAR __builtin_amdgcn_s_barrier()
#define PG8_SCHED __builtin_amdgcn_sched_barrier(0)
#define PG8_AOFFS(dst, u) do { _Pragma("unroll") for (int _h = 0; _h < 2; ++_h) _Pragma("unroll") for (int _i = 0; _i < 2; ++_i) \
        dst[_h][_i] = (S.arow(u, _h * HALF + RA[_i]) * (unsigned)K + (unsigned)CA[_i]) * 2u; } while (0)
    Unit cur, nxt; int ui = 0;
    if (!S.next(0, cur)) return;
    f32x4 acc[2][2][4][2];
#pragma unroll
    for (int a = 0; a < 2; ++a)
#pragma unroll
        for (int b = 0; b < 2; ++b)
#pragma unroll
            for (int m = 0; m < 4; ++m)
#pragma unroll
                for (int n = 0; n < 2; ++n) acc[a][b][m][n] = (f32x4){0.f, 0.f, 0.f, 0.f};
    bf16x8 At[4][2], B0[2][2], B1[2][2];
    unsigned ca[2][2], na[2][2];
    S.a_ready(cur);
    PG8_AOFFS(ca, cur);
    const char* cB = cur.bbase + (size_t)cur.pn * tstep;
    PG8_STAGE(PG8_SB(0, 0), cB, voffB); PG8_STAGE(PG8_SB(0, 1), cB + hstep, voffB); PG8_STAGE(PG8_SA(0, 0), Abase, ca[0]); PG8_STAGE(PG8_SA(0, 1), Abase, ca[1]);
    if (wr == 1) PG8_BAR;
    PG8_WAIT_V(2); PG8_BAR;
    PG8_STAGE(PG8_SB(1, 0), cB + kstep, voffB); PG8_STAGE(PG8_SA(1, 0), Abase + kstep, ca[0]); PG8_STAGE(PG8_SB(1, 1), cB + hstep + kstep, voffB);
    PG8_WAIT_V(6); PG8_BAR;
    for (;;) {
        const bool has_next = S.next(ui + 1, nxt);
        if (has_next) { PG8_AOFFS(na, nxt); } else {
#pragma unroll
            for (int _h = 0; _h < 2; ++_h)
#pragma unroll
                for (int _i = 0; _i < 2; ++_i) na[_h][_i] = ca[_h][_i]; }
        const char* nB = has_next ? nxt.bbase + (size_t)nxt.pn * tstep : cB;
        const bool full = cur.half == 0;
        for (int t = 0; t < nt; t += 2) {
            const bool last = (t == nt - 2);
            if (last && has_next) S.a_ready(nxt);
            const char* a1 = Abase + (size_t)(t + 1) * kstep;
            const char* a2 = last ? Abase : Abase + (size_t)(t + 2) * kstep; const char* b2 = last ? nB : cB + (size_t)(t + 2) * kstep;
            const char* a3 = a2 + kstep; const char* b3 = b2 + kstep;
            unsigned o2[2][2];
#pragma unroll
            for (int _h = 0; _h < 2; ++_h)
#pragma unroll
                for (int _i = 0; _i < 2; ++_i) o2[_h][_i] = last ? na[_h][_i] : ca[_h][_i];
            PG8_LDB(B0, 0, 0); PG8_LDB(B1, 0, 1); PG8_SCHED; PG8_LDA(At, 0, 0); PG8_STAGE(PG8_SA(1, 1), a1, ca[1]);
            PG8_WAIT_V(8); PG8_WAIT_L(0); PG8_BAR; PG8_MMA(0, 0, At, B0); PG8_MMA(0, 1, At, B1); PG8_BAR; PG8_SCHED;
            PG8_LDA(At, 0, 1); PG8_STAGE(PG8_SB(0, 0), b2, voffB); PG8_STAGE(PG8_SB(0, 1), b2 + hstep, voffB); PG8_STAGE(PG8_SA(0, 0), a2, o2[0]);
            PG8_WAIT_V(8); PG8_WAIT_L(0); PG8_BAR; if (full) { PG8_MMA(1, 0, At, B0); PG8_MMA(1, 1, At, B1); } PG8_BAR; PG8_SCHED;
            PG8_LDB(B0, 1, 0); PG8_LDB(B1, 1, 1); PG8_SCHED; PG8_LDA(At, 1, 0); PG8_STAGE(PG8_SA(0, 1), a2, o2[1]);
            PG8_WAIT_V(8); PG8_WAIT_L(0); PG8_BAR; PG8_MMA(0, 0, At, B0); PG8_MMA(0, 1, At, B1); PG8_BAR; PG8_SCHED;
            PG8_LDA(At, 1, 1); PG8_STAGE(PG8_SB(1, 0), b3, voffB); PG8_STAGE(PG8_SB(1, 1), b3 + hstep, voffB); PG8_STAGE(PG8_SA(1, 0), a3, o2[0]);
            PG8_WAIT_V(8); PG8_WAIT_L(0); PG8_BAR; if (full) { PG8_MMA(1, 0, At, B0); PG8_MMA(1, 1, At, B1); } PG8_BAR; PG8_SCHED;
        }
        if (wr == 0) PG8_BAR;
        E(acc, cur, wr, wc, fr, fq);
        S.done(cur);
        if (!has_next) break;
#pragma unroll
        for (int a = 0; a < 2; ++a)
#pragma unroll
            for (int b = 0; b < 2; ++b)
#pragma unroll
                for (int m = 0; m < 4; ++m)
#pragma unroll
                    for (int n = 0; n < 2; ++n) acc[a][b][m][n] = (f32x4){0.f, 0.f, 0.f, 0.f};
        cur = nxt; cB = nB; ++ui;
#pragma unroll
        for (int _h = 0; _h < 2; ++_h)
#pragma unroll
            for (int _i = 0; _i < 2; ++_i) ca[_h][_i] = na[_h][_i];
        if (wr == 1) PG8_BAR;
    }
    PG8_WAIT_V(0);
    PG8_BAR;
#undef PG8_SA
#undef PG8_SB
#undef PG8_STAGE
#undef PG8_LDA
#undef PG8_LDB
#undef PG8_MMA
#undef PG8_WAIT_V
#undef PG8_WAIT_L
#undef PG8_BAR
#undef PG8_SCHED
#undef PG8_AOFFS
}
}


namespace attn_body {
using bf16x8=__attribute__((ext_vector_type(8)))short;
using s16x4=__attribute__((ext_vector_type(4)))short;
using f32x16=__attribute__((ext_vector_type(16)))float;
constexpr int D=64;
constexpr int QBLK=32,QB=256,KVBLK=64;
constexpr int KP=UC, OP=DM;
__device__ __forceinline__ int crow(int r,int hi){return (r&3)+8*(r>>2)+4*hi;}
#define SBAR() __builtin_amdgcn_sched_barrier(0)
__device__ __forceinline__ void cmask(f32x16&p0,f32x16&p1,int jb,int qrel,int hi){
  const float NEG=-INFINITY; int kb=64*jb+4*hi;
  #pragma unroll
  for(int r=0;r<16;++r){int kv=kb+(r&3)+8*(r>>2); if(kv>qrel)p0[r]=NEG; if(kv+32>qrel)p1[r]=NEG;}
}
constexpr int NSLOT=3, SLOTB=8192;
constexpr int LDS_K=0, LDS_V=NSLOT*SLOTB, LDS_WS=2*NSLOT*SLOTB, LDS_OST=LDS_WS+NW*64*4, LDS_BYTES_A=LDS_OST+NW*4096;
constexpr float C2=0.125f*1.4426950408889634f;
__device__ __forceinline__ void glds16(const void*gsrc,unsigned lds_dst){unsigned keep;
  asm volatile("s_mov_b32 %0, m0\n\ts_mov_b32 m0, %2\n\ts_nop 0\n\tglobal_load_lds_dwordx4 %1, off\n\ts_mov_b32 m0, %0":"=&s"(keep):"v"(gsrc),"s"(lds_dst):"memory");}
__device__ __forceinline__ float max3f(float a,float b,float c){float r;asm("v_max3_f32 %0, %1, %2, %3":"=v"(r):"v"(a),"v"(b),"v"(c));return r;}
__device__ __forceinline__ float max2f(float a,float b){float r;asm("v_max_f32_e32 %0, %1, %2":"=v"(r):"v"(a),"v"(b));return r;}
__device__ __forceinline__ float fsub_s(float a,float b){float r;asm("v_sub_f32_e32 %0, %1, %2":"=v"(r):"v"(a),"v"(b));return r;}
typedef float f32x2_t __attribute__((ext_vector_type(2))); typedef __bf16 bf16x2_t __attribute__((ext_vector_type(2)));
__device__ __forceinline__ unsigned cvtpk_s(float lo,float hi){f32x2_t v={lo,hi};bf16x2_t b=__builtin_convertvector(v,bf16x2_t);return __builtin_bit_cast(unsigned,b);}
#define WAIT_BAR(N) asm volatile("s_waitcnt vmcnt(" #N ") lgkmcnt(0)\n\ts_barrier":::"memory")

__device__ __forceinline__ void qkt(f32x16&p0,f32x16&p1,const char*Kslot,const bf16x8*qr,const f32x16&negm,int r32,int hi){
  const char*kb=Kslot+hi*1024+r32*16;
  #pragma unroll
  for(int d0=0;d0<4;++d0){
    const bf16x8 b0=*reinterpret_cast<const bf16x8*>(kb+d0*2048);
    const bf16x8 b1=*reinterpret_cast<const bf16x8*>(kb+d0*2048+512);
    if(d0==0){p0=__builtin_amdgcn_mfma_f32_32x32x16_bf16(b0,qr[0],negm,0,0,0);p1=__builtin_amdgcn_mfma_f32_32x32x16_bf16(b1,qr[0],negm,0,0,0);}
    else{p0=__builtin_amdgcn_mfma_f32_32x32x16_bf16(b0,qr[d0],p0,0,0,0);p1=__builtin_amdgcn_mfma_f32_32x32x16_bf16(b1,qr[d0],p1,0,0,0);}}
}
typedef __attribute__((address_space(3))) const char* lds_cptr;
typedef short v4i16_t __attribute__((ext_vector_type(4)));
__device__ __forceinline__ void kload8(bf16x8*kf,lds_cptr kp){
  kf[0]=*(const __attribute__((address_space(3))) bf16x8*)(kp);      kf[1]=*(const __attribute__((address_space(3))) bf16x8*)(kp+512);
  kf[2]=*(const __attribute__((address_space(3))) bf16x8*)(kp+2048); kf[3]=*(const __attribute__((address_space(3))) bf16x8*)(kp+2560);
  kf[4]=*(const __attribute__((address_space(3))) bf16x8*)(kp+4096); kf[5]=*(const __attribute__((address_space(3))) bf16x8*)(kp+4608);
  kf[6]=*(const __attribute__((address_space(3))) bf16x8*)(kp+6144); kf[7]=*(const __attribute__((address_space(3))) bf16x8*)(kp+6656);
}
__device__ __forceinline__ void kload2(bf16x8*kf,lds_cptr kp,int j){ kf[2*j]=*(const __attribute__((address_space(3))) bf16x8*)(kp+j*2048); kf[2*j+1]=*(const __attribute__((address_space(3))) bf16x8*)(kp+j*2048+512); }
__device__ __forceinline__ s16x4 vtr(lds_cptr p){ return __builtin_bit_cast(s16x4,__builtin_amdgcn_ds_read_tr16_b64_v4i16((__attribute__((address_space(3))) v4i16_t*)p)); }
__device__ __forceinline__ float rowmax(const f32x16&p0,const f32x16&p1){
  float a=max3f(p0[0],p0[1],p1[0]),b=max3f(p0[2],p0[3],p1[1]);a=max3f(a,p1[2],p1[3]);
  #pragma unroll
  for(int r=4;r<16;r+=4){a=max3f(a,p0[r],p0[r+1]);b=max3f(b,p0[r+2],p0[r+3]);a=max3f(a,p1[r],p1[r+1]);b=max3f(b,p1[r+2],p1[r+3]);}
  const float m=max2f(a,b);
  auto rr=__builtin_amdgcn_permlane32_swap(__float_as_uint(m),__float_as_uint(m),false,false);
  return max2f(__uint_as_float(rr[0]),__uint_as_float(rr[1]));
}
__device__ __forceinline__ void pv(f32x16*o,int vb,bf16x8 pa0,bf16x8 pa1,bf16x8 pa2,bf16x8 pa3){
  #pragma unroll
  for(int d0=0;d0<2;++d0){s16x4 lo[4],hi[4];
    #pragma unroll
    for(int ks=0;ks<4;++ks){
      asm volatile("ds_read_b64_tr_b16 %0,%1 offset:%c2":"=&v"(lo[ks]):"v"(vb),"i"(d0*4096+ks*1024):"memory");
      asm volatile("ds_read_b64_tr_b16 %0,%1 offset:%c2":"=&v"(hi[ks]):"v"(vb),"i"(d0*4096+ks*1024+512):"memory");}
    asm volatile("s_waitcnt lgkmcnt(0)":::"memory");SBAR();
    #define PK(k) (bf16x8){lo[k][0],lo[k][1],lo[k][2],lo[k][3],hi[k][0],hi[k][1],hi[k][2],hi[k][3]}
    o[d0]=__builtin_amdgcn_mfma_f32_32x32x16_bf16(pa0,PK(0),o[d0],0,0,0);
    o[d0]=__builtin_amdgcn_mfma_f32_32x32x16_bf16(pa1,PK(1),o[d0],0,0,0);
    o[d0]=__builtin_amdgcn_mfma_f32_32x32x16_bf16(pa2,PK(2),o[d0],0,0,0);
    o[d0]=__builtin_amdgcn_mfma_f32_32x32x16_bf16(pa3,PK(3),o[d0],0,0,0);
    #undef PK
  }
}

template<int THRL> __device__ __forceinline__ void attn_unit(int b,int vh,int qb,const bf16_t*U,bf16_t*O,char*shm,int ncap){
  int tid_=threadIdx.x; asm volatile("":"+v"(tid_));
  const int tid=tid_,lane=tid&63,r32=lane&31,hi=lane>>5; const int wid=__builtin_amdgcn_readfirstlane(tid>>6);
  const int hh=vh>>2, cc=(vh>>1)&1, vhalf=vh&1;
  const long rowbase=(long)b*SEQ; const int q0=qb*QB;
  const bf16_t*Qw=U+(rowbase+q0+wid*QBLK)*KP+C_DQ+hh*128+cc*64;
  const bf16_t*Kh=U+rowbase*KP+C_DK+hh*128+cc*64,*Vh=U+rowbase*KP+C_DV+hh*128+vhalf*64;
  const float slope2=__uint_as_float(__builtin_amdgcn_readfirstlane(__float_as_uint(exp2f(-2.f*(float)(hh+1))*1.4426950408889634f)));
  const float s64=__uint_as_float(__builtin_amdgcn_readfirstlane(__float_as_uint(64.f*slope2))), s32=__uint_as_float(__builtin_amdgcn_readfirstlane(__float_as_uint(32.f*slope2)));
  const unsigned lds0=(unsigned)(uintptr_t)shm;
  float*wsf=(float*)(shm+LDS_WS)+wid*64;
  const bf16_t*ksrc=Kh+(long)lane*KP+wid*8;
  const bf16_t*vsrc=Vh+(long)(16*(wid&3)+(lane>>2))*KP+(wid>>2)*32+(lane&3)*8;
  const unsigned kdst=lds0+LDS_K+wid*1024, vdst=lds0+LDS_V+wid*1024;
  const int NTT=(q0+QB)/KVBLK;
  const int NT=NTT<ncap?NTT:ncap;
  #define DMA_K(s,slot) glds16(ksrc+(long)(NTT-1-(s))*KVBLK*KP,(unsigned)__builtin_amdgcn_readfirstlane(kdst+(slot)))
  #define DMA_V(s,slot) glds16(vsrc+(long)(NTT-1-(s))*KVBLK*KP,(unsigned)__builtin_amdgcn_readfirstlane(vdst+(slot)))
  const int vb0=(int)(lds0+LDS_V)+((lane>>4)&1)*32+(lane&3)*8+(4*hi+((lane&15)>>2))*64;
  const char*Kbase=shm+LDS_K; bf16x8 kf[8];
  const lds_cptr shm3=(lds_cptr)shm; const lds_cptr kp0=shm3+LDS_K+hi*1024+r32*16; const lds_cptr vp0=shm3+LDS_V+((lane>>4)&1)*32+(lane&3)*8+(4*hi+((lane&15)>>2))*64;
  DMA_K(0,0);DMA_V(0,0);DMA_K(1,SLOTB);
  bf16x8 qr[4];
  #pragma unroll
  for(int d0=0;d0<4;++d0)qr[d0]=*reinterpret_cast<const bf16x8*>(&Qw[(long)r32*KP+d0*16+hi*8]);
  float l_reg=0.f;f32x16 o[2];o[0]=f32x16{};o[1]=f32x16{};
  f32x16 negm;
  #pragma unroll
  for(int r=0;r<16;++r)negm[r]=slope2*(float)(crow(r,hi)-63);
  asm volatile("":"+v"(negm));
  const int qrel=wid*QBLK+r32;
  #define CMASK(P0,P1,s) do{ if((s)<4)cmask(P0,P1,3-(s),qrel,hi);}while(0)
  #define BIAS1(P1) do{ _Pragma("unroll") for(int r=0;r<16;++r)P1[r]+=s32; }while(0)
  #define NEXTTILE() do{ _Pragma("unroll") for(int r=0;r<16;++r)negm[r]-=s64; asm volatile("":"+v"(negm)); }while(0)
  bool resc=false;
  #define START(P0,P1) do{ const float rm=rowmax(P0,P1); resc=false; \
    { const float dl=__builtin_fmaxf(rm,-8192.f); \
      _Pragma("unroll") for(int r=0;r<16;++r){P0[r]=fsub_s(P0[r],dl);P1[r]=fsub_s(P1[r],dl);} \
      _Pragma("unroll") for(int r=0;r<16;++r)negm[r]-=dl; asm volatile("":"+v"(negm)); } \
    _Pragma("unroll") for(int r=0;r<16;++r)P0[r]=__builtin_amdgcn_exp2f(P0[r]); }while(0)
  #define RESC() do{ if(resc){ asm volatile("s_waitcnt lgkmcnt(0)":::"memory"); \
      _Pragma("unroll") for(int d_=0;d_<2;++d_) _Pragma("unroll") for(int r=0;r<16;++r)o[d_][r]*=wsf[crow(r,hi)]; } }while(0)
  f32x16 pA0,pA1,pB0,pB1;
  int sl_prev=0,sl_cur=0,sl_next=SLOTB;
  #define ROT() do{sl_prev=sl_cur;sl_cur=sl_next;sl_next=(sl_next==(NSLOT-1)*SLOTB)?0:sl_next+SLOTB;}while(0)
  DMA_K(2,2*SLOTB);
  WAIT_BAR(3);
  qkt(pA0,pA1,Kbase,qr,negm,r32,hi);asm volatile("s_nop 15\n\ts_nop 7":"+v"(pA0),"+v"(pA1));BIAS1(pA1);CMASK(pA0,pA1,0);
  START(pA0,pA1);
  NEXTTILE();
  _Pragma("unroll") for(int r=0;r<16;++r)pA1[r]=__builtin_amdgcn_exp2f(pA1[r]);
  WAIT_BAR(0);
  DMA_K(3,0);DMA_V(1,SLOTB);
  ROT();
  kload8(kf,kp0+sl_cur);
  WAIT_BAR(2);
  s16x4 vlo[8],vhi[8]; u32x4 pw0,pw1,pw2,pw3;
  #define PKW(P,B) cvtpk_s(P[B],P[B+1])
  #define PAF(k) __builtin_bit_cast(bf16x8,pw##k)
  #define VFR(i) (bf16x8){vlo[i][0],vlo[i][1],vlo[i][2],vlo[i][3],vhi[i][0],vhi[i][1],vhi[i][2],vhi[i][3]}
  #define PIN(x) asm volatile("":"+v"(x))
  #define MX3(a,b,c) __builtin_fmaxf(__builtin_fmaxf((a),(b)),(c))
  #define GAPA(MF,A0,A1,A2,A3,W0,W1,PW) do{ MF; sacc+=A0; sacc+=A1; sacc+=A2; sacc+=A3; PIN(sacc); W0; W1; PIN(PW); SBAR(); }while(0)
  #define EX(v) __builtin_amdgcn_exp2f(v)
  #define GAPB(MF,X,B) do{ MF; X[B]=EX(X[B]); X[B+1]=EX(X[B+1]); X[B+2]=EX(X[B+2]); X[B+3]=EX(X[B+3]); PIN(X); SBAR(); }while(0)
  #define VRD(i) do{ vlo[i]=vtr(vp_+(((i)>>2)*4096+((i)&3)*1024)); vhi[i]=vtr(vp_+(((i)>>2)*4096+((i)&3)*1024+512)); }while(0)
  #define KRD(G,j) do{ if(G){ kload2(kf,kp0+sl_next,j); SBAR(); } }while(0)
  #define STEP(C0,C1,P0,P1,t,GK,GV,GL) do{ SBAR(); \
    const lds_cptr vp_=vp0+sl_prev; \
    VRD(0); SBAR(); float sacc=(P0[0]+P0[1]); \
    GAPA(C0=__builtin_amdgcn_mfma_f32_32x32x16_bf16(kf[0],qr[0],negm,0,0,0), P0[2],P0[3],P0[4],P0[5],     pw0[0]=PKW(P0,0), pw0[1]=PKW(P0,2), pw0); \
    VRD(4); SBAR(); GAPA(C1=__builtin_amdgcn_mfma_f32_32x32x16_bf16(kf[1],qr[0],negm,0,0,0), P0[6],P0[7],P0[8],P0[9],     pw0[2]=PKW(P0,4), pw0[3]=PKW(P0,6), pw0); \
    VRD(1); SBAR(); GAPA(C0=__builtin_amdgcn_mfma_f32_32x32x16_bf16(kf[2],qr[1],C0,0,0,0),   P0[10],P0[11],P0[12],P0[13], pw1[0]=PKW(P0,8), pw1[1]=PKW(P0,10), pw1); \
    VRD(5); SBAR(); GAPA(C1=__builtin_amdgcn_mfma_f32_32x32x16_bf16(kf[3],qr[1],C1,0,0,0),   P0[14],P0[15],P1[0],P1[1],   pw1[2]=PKW(P0,12),pw1[3]=PKW(P0,14), pw1); \
    VRD(2); SBAR(); GAPA(C0=__builtin_amdgcn_mfma_f32_32x32x16_bf16(kf[4],qr[2],C0,0,0,0),   P1[2],P1[3],P1[4],P1[5],     pw2[0]=PKW(P1,0), pw2[1]=PKW(P1,2), pw2); \
    VRD(6); SBAR(); GAPA(C1=__builtin_amdgcn_mfma_f32_32x32x16_bf16(kf[5],qr[2],C1,0,0,0),   P1[6],P1[7],P1[8],P1[9],     pw2[2]=PKW(P1,4), pw2[3]=PKW(P1,6), pw2); \
    VRD(3); SBAR(); GAPA(C0=__builtin_amdgcn_mfma_f32_32x32x16_bf16(kf[6],qr[3],C0,0,0,0),   P1[10],P1[11],P1[12],P1[13], pw3[0]=PKW(P1,8), pw3[1]=PKW(P1,10), pw3); \
    VRD(7); SBAR(); GAPA(C1=__builtin_amdgcn_mfma_f32_32x32x16_bf16(kf[7],qr[3],C1,0,0,0),   P1[14],P1[15],0.f,0.f,       pw3[2]=PKW(P1,12),pw3[3]=PKW(P1,14), pw3); \
    l_reg+=sacc; \
    if(GK){DMA_K((t)+3,sl_cur);} if(GV){DMA_V((t)+1,sl_next);} \
    BIAS1(C1); CMASK(C0,C1,t); \
    { float a=MX3(C0[0],C0[1],C1[0]),b=MX3(C0[2],C0[3],C1[1]); a=MX3(a,C1[2],C1[3]); \
      _Pragma("unroll") for(int r=4;r<16;r+=4){a=MX3(a,C0[r],C0[r+1]);b=MX3(b,C0[r+2],C0[r+3]);a=MX3(a,C1[r],C1[r+1]);b=MX3(b,C1[r+2],C1[r+3]);} \
      float rm=__builtin_fmaxf(a,b); { auto rr=__builtin_amdgcn_permlane32_swap(__float_as_uint(rm),__float_as_uint(rm),false,false); rm=__builtin_fmaxf(__uint_as_float(rr[0]),__uint_as_float(rr[1])); } \
      resc=false; \
      if(__builtin_expect(__any(rm>(float)THRL),0)){ const float dl=__builtin_fmaxf(rm,0.f); \
        _Pragma("unroll") for(int r=0;r<16;++r){C0[r]-=dl;C1[r]-=dl;} \
        _Pragma("unroll") for(int r=0;r<16;++r)negm[r]-=dl; asm volatile("":"+v"(negm)); \
        const float f=__builtin_amdgcn_exp2f(-dl); l_reg*=f; if(hi==0)wsf[r32]=f; resc=true; } } \
    NEXTTILE(); \
    SBAR(); \
    GAPB(o[0]=__builtin_amdgcn_mfma_f32_32x32x16_bf16(PAF(0),VFR(0),o[0],0,0,0), C0,0); \
    GAPB(o[1]=__builtin_amdgcn_mfma_f32_32x32x16_bf16(PAF(0),VFR(4),o[1],0,0,0), C0,4); \
    KRD(GL,0); GAPB(o[0]=__builtin_amdgcn_mfma_f32_32x32x16_bf16(PAF(1),VFR(1),o[0],0,0,0), C0,8); \
    KRD(GL,1); GAPB(o[1]=__builtin_amdgcn_mfma_f32_32x32x16_bf16(PAF(1),VFR(5),o[1],0,0,0), C0,12); \
    KRD(GL,2); GAPB(o[0]=__builtin_amdgcn_mfma_f32_32x32x16_bf16(PAF(2),VFR(2),o[0],0,0,0), C1,0); \
    KRD(GL,3); GAPB(o[1]=__builtin_amdgcn_mfma_f32_32x32x16_bf16(PAF(2),VFR(6),o[1],0,0,0), C1,4); \
    GAPB(o[0]=__builtin_amdgcn_mfma_f32_32x32x16_bf16(PAF(3),VFR(3),o[0],0,0,0), C1,8); \
    GAPB(o[1]=__builtin_amdgcn_mfma_f32_32x32x16_bf16(PAF(3),VFR(7),o[1],0,0,0), C1,12); \
    }while(0)
  int t=1;
  for(;t+5<NT;t+=2){
    STEP(pB0,pB1,pA0,pA1,t,true,true,true);     WAIT_BAR(2); RESC(); ROT();
    STEP(pA0,pA1,pB0,pB1,t+1,true,true,true);   WAIT_BAR(2); RESC(); ROT();
  }
  #define ENDW(tt) do{ if((tt)+3<NT){WAIT_BAR(2);} else if((tt)+2<NT){WAIT_BAR(1);} else {WAIT_BAR(0);} }while(0)
  for(;t+1<NT;t+=2){
    STEP(pB0,pB1,pA0,pA1,t,(t+3<NT),(t+1<NT),(t+1<NT));       ENDW(t);   RESC(); ROT();
    STEP(pA0,pA1,pB0,pB1,t+1,(t+4<NT),(t+2<NT),(t+2<NT));     ENDW(t+1); RESC(); ROT();
  }
  STEP(pB0,pB1,pA0,pA1,NT-1,false,false,false); RESC();
  { float sacc=pB0[0]+pB0[1]; _Pragma("unroll") for(int r=2;r<16;++r)sacc+=pB0[r]; _Pragma("unroll") for(int r=0;r<16;++r)sacc+=pB1[r]; l_reg+=sacc;
    pw0=(u32x4){PKW(pB0,0),PKW(pB0,2),PKW(pB0,4),PKW(pB0,6)};pw1=(u32x4){PKW(pB0,8),PKW(pB0,10),PKW(pB0,12),PKW(pB0,14)};pw2=(u32x4){PKW(pB1,0),PKW(pB1,2),PKW(pB1,4),PKW(pB1,6)};pw3=(u32x4){PKW(pB1,8),PKW(pB1,10),PKW(pB1,12),PKW(pB1,14)};
    SBAR(); pv(o,vb0+sl_cur,PAF(0),PAF(1),PAF(2),PAF(3)); }
  #undef PKW
  #undef PAF
  #undef VFR
  #undef PIN
  #undef MX3
  #undef GAPA
  #undef GAPB
  #undef EX
  #undef VRD
  #undef KRD
  #undef STEP
  #undef ENDW
  {auto rr=__builtin_amdgcn_permlane32_swap(__float_as_uint(l_reg),__float_as_uint(l_reg),false,false);l_reg=__uint_as_float(rr[0])+__uint_as_float(rr[1]);}
  if(hi==0)wsf[32+r32]=l_reg;asm volatile("s_waitcnt lgkmcnt(0)":::"memory");
  float rli[16];
  #pragma unroll
  for(int r=0;r<16;++r)rli[r]=__builtin_amdgcn_rcpf(wsf[32+crow(r,hi)]);
  bf16_t*Ow=O+(rowbase+q0+wid*QBLK)*OP+vh*D;
  { bf16_t*stg=(bf16_t*)(shm+LDS_OST)+wid*2048;
    #pragma unroll
    for(int r=0;r<16;++r){const int orow=crow(r,hi);
      #pragma unroll
      for(int d0=0;d0<2;++d0)stg[orow*64+d0*32+r32]=f2bf(o[d0][r]*rli[r]);}
    asm volatile("s_waitcnt lgkmcnt(0)":::"memory");
    #pragma unroll
    for(int i=0;i<4;++i){const int row=i*8+(lane>>3),ch=lane&7; const u32x4 v=*(const u32x4*)(stg+row*64+ch*8); *(u32x4*)(Ow+(long)row*OP+ch*8)=v;} }
  asm volatile("s_waitcnt lgkmcnt(0)\n\ts_barrier":::"memory");
  #undef DMA_K
  #undef DMA_V
  #undef CMASK
  #undef BIAS1
  #undef NEXTTILE
  #undef START
  #undef RESC
  #undef ROT
}

constexpr int PC_K=0, PC_V0=24576, PC_V1=49152, PC_PX=73728, PC_WS=106496, PC_OST=108544, PC_BYTES=PC_OST+8*4096;
struct BgConv { const float* w25; const float* w26; const float* w27; bf16_t* wtgu; bf16_t* wtdn; int base; int np; };
template<int THRL> __device__ __forceinline__ void attn_unit_pc(int b,int hh,int cc,int qb,const bf16_t*U,bf16_t*O,char*shm,int ncap,const BgConv bg){
  int tid_=threadIdx.x; asm volatile("":"+v"(tid_));
  const int tid=tid_,lane=tid&63,r32=lane&31,hi=lane>>5; const int wid=__builtin_amdgcn_readfirstlane(tid>>6);
  const bool prod=wid<4; const int pw=wid&3;
  const long rowbase=(long)b*SEQ; const int q0=qb*128;
  const float slope2=__uint_as_float(__builtin_amdgcn_readfirstlane(__float_as_uint(exp2f(-2.f*(float)(hh+1))*1.4426950408889634f)));
  const float s64=__uint_as_float(__builtin_amdgcn_readfirstlane(__float_as_uint(64.f*slope2))), s32=__uint_as_float(__builtin_amdgcn_readfirstlane(__float_as_uint(32.f*slope2)));
  const unsigned lds0=(unsigned)(uintptr_t)shm;
  const int NTT=(q0+128)/KVBLK;
  int NT=NTT<ncap?NTT:ncap; if(NT<4)NT=4;
  float*wsf=(float*)(shm+PC_WS)+pw*128;
  char*px=shm+PC_PX+pw*8192;
  bf16_t*Ow=O+(rowbase+q0+pw*QBLK)*OP+(hh*4+cc*2+(prod?0:1))*D;
  #define TILE_OF(s) ((NTT-1-(s))>0?(NTT-1-(s)):0)
  if(prod){
    const bf16_t*Qw=U+(rowbase+q0+pw*QBLK)*KP+C_DQ+hh*128+cc*64;
    const bf16_t*Kh=U+rowbase*KP+C_DK+hh*128+cc*64,*Vh=U+rowbase*KP+C_DV+hh*128;
    const bf16_t*ksrc=Kh+(long)lane*KP+(2*pw)*8;
    const bf16_t*vsrc0=Vh+(long)(16*((2*pw)&3)+(lane>>2))*KP+((2*pw)>>2)*32+(lane&3)*8;
    const bf16_t*vsrc1=Vh+(long)(16*((2*pw+1)&3)+(lane>>2))*KP+((2*pw+1)>>2)*32+(lane&3)*8;
    const unsigned kdst=lds0+PC_K+(2*pw)*1024, vdst=lds0+PC_V0+(2*pw)*1024;
    #define DMA_K(s,slot) do{ const long to_=(long)TILE_OF(s)*KVBLK*KP; const unsigned d_=(unsigned)__builtin_amdgcn_readfirstlane(kdst+(slot)); glds16(ksrc+to_,d_); glds16(ksrc+to_+8,d_+1024); }while(0)
    #define DMA_V(s,slot) do{ const long to_=(long)TILE_OF(s)*KVBLK*KP; const unsigned d_=(unsigned)__builtin_amdgcn_readfirstlane(vdst+(slot)); glds16(vsrc0+to_,d_); glds16(vsrc1+to_,d_+1024); }while(0)
    const int vb0=(int)(lds0+PC_V0)+((lane>>4)&1)*32+(lane&3)*8+(4*hi+((lane&15)>>2))*64;
    const char*Kbase=shm+PC_K; bf16x8 kf[8];
    const lds_cptr shm3=(lds_cptr)shm; const lds_cptr kp0=shm3+PC_K+hi*1024+r32*16; const lds_cptr vp0=shm3+PC_V0+((lane>>4)&1)*32+(lane&3)*8+(4*hi+((lane&15)>>2))*64;
    DMA_K(0,0);DMA_V(0,0);DMA_K(1,SLOTB);
    bf16x8 qr[4];
    #pragma unroll
    for(int d0=0;d0<4;++d0)qr[d0]=*reinterpret_cast<const bf16x8*>(&Qw[(long)r32*KP+d0*16+hi*8]);
    float l_reg=0.f;f32x16 o[2];o[0]=f32x16{};o[1]=f32x16{};
    f32x16 negm;
    #pragma unroll
    for(int r=0;r<16;++r)negm[r]=slope2*(float)(crow(r,hi)-63);
    asm volatile("":"+v"(negm));
    const int qrel=pw*QBLK+r32;
    #define CMASK(P0,P1,s) do{ if((s)<2)cmask(P0,P1,1-(s),qrel,hi); else if(NTT-1-(s)<0){ _Pragma("unroll") for(int r=0;r<16;++r){P0[r]=-INFINITY;P1[r]=-INFINITY;} } }while(0)
    #define BIAS1(P1) do{ _Pragma("unroll") for(int r=0;r<16;++r)P1[r]+=s32; }while(0)
    #define NEXTTILE() do{ _Pragma("unroll") for(int r=0;r<16;++r)negm[r]-=s64; asm volatile("":"+v"(negm)); }while(0)
    bool resc=false;
    #define START(P0,P1) do{ const float rm=rowmax(P0,P1); resc=false; \
      { const float dl=__builtin_fmaxf(rm,-8192.f); \
        _Pragma("unroll") for(int r=0;r<16;++r){P0[r]=fsub_s(P0[r],dl);P1[r]=fsub_s(P1[r],dl);} \
        _Pragma("unroll") for(int r=0;r<16;++r)negm[r]-=dl; asm volatile("":"+v"(negm)); } \
      _Pragma("unroll") for(int r=0;r<16;++r)P0[r]=__builtin_amdgcn_exp2f(P0[r]); }while(0)
    #define RESC(t) do{ if(resc){ asm volatile("s_waitcnt lgkmcnt(0)":::"memory"); \
        _Pragma("unroll") for(int d_=0;d_<2;++d_) _Pragma("unroll") for(int r=0;r<16;++r)o[d_][r]*=wsf[32*((t)&1)+crow(r,hi)]; } }while(0)
    f32x16 pA0,pA1,pB0,pB1;
    int sl_prev=0,sl_cur=0,sl_next=SLOTB;
    #define ROT() do{sl_prev=sl_cur;sl_cur=sl_next;sl_next=(sl_next==(NSLOT-1)*SLOTB)?0:sl_next+SLOTB;}while(0)
    DMA_K(2,2*SLOTB);
    WAIT_BAR(6);
    qkt(pA0,pA1,Kbase,qr,negm,r32,hi);asm volatile("s_nop 15\n\ts_nop 7":"+v"(pA0),"+v"(pA1));BIAS1(pA1);CMASK(pA0,pA1,0);
    START(pA0,pA1);
    NEXTTILE();
    _Pragma("unroll") for(int r=0;r<16;++r)pA1[r]=__builtin_amdgcn_exp2f(pA1[r]);
    WAIT_BAR(0);
    DMA_K(3,0);DMA_V(1,SLOTB);
    ROT();
    kload8(kf,kp0+sl_cur);
    WAIT_BAR(4);
    s16x4 vlo[8],vhi[8]; u32x4 pw0,pw1,pw2,pw3;
    #define PKW(P,B) cvtpk_s(P[B],P[B+1])
    #define PAF(k) __builtin_bit_cast(bf16x8,pw##k)
    #define VFR(i) (bf16x8){vlo[i][0],vlo[i][1],vlo[i][2],vlo[i][3],vhi[i][0],vhi[i][1],vhi[i][2],vhi[i][3]}
    #define PIN(x) asm volatile("":"+v"(x))
    #define MX3(a,b,c) __builtin_fmaxf(__builtin_fmaxf((a),(b)),(c))
    #define GAPA(MF,A0,A1,A2,A3,W0,W1,PW) do{ MF; sacc+=A0; sacc+=A1; sacc+=A2; sacc+=A3; PIN(sacc); W0; W1; PIN(PW); SBAR(); }while(0)
    #define EX(v) __builtin_amdgcn_exp2f(v)
    #define GAPB(MF,X,B) do{ MF; X[B]=EX(X[B]); X[B+1]=EX(X[B+1]); X[B+2]=EX(X[B+2]); X[B+3]=EX(X[B+3]); PIN(X); SBAR(); }while(0)
    #define VRD(i) do{ vlo[i]=vtr(vp_+(((i)>>2)*4096+((i)&3)*1024)); vhi[i]=vtr(vp_+(((i)>>2)*4096+((i)&3)*1024+512)); }while(0)
    #define KRD(G,j) do{ if(G){ kload2(kf,kp0+sl_next,j); SBAR(); } }while(0)
    #define PXW(tt) do{ char*pb_=px+4096*((tt)&1)+16*lane; *(u32x4*)(pb_)=pw0; *(u32x4*)(pb_+1024)=pw1; *(u32x4*)(pb_+2048)=pw2; *(u32x4*)(pb_+3072)=pw3; }while(0)
    #define STEP(C0,C1,P0,P1,t,GK,GV,GL) do{ SBAR(); \
      const lds_cptr vp_=vp0+sl_prev; \
      VRD(0); SBAR(); float sacc=(P0[0]+P0[1]); \
      GAPA(C0=__builtin_amdgcn_mfma_f32_32x32x16_bf16(kf[0],qr[0],negm,0,0,0), P0[2],P0[3],P0[4],P0[5],     pw0[0]=PKW(P0,0), pw0[1]=PKW(P0,2), pw0); \
      VRD(4); SBAR(); GAPA(C1=__builtin_amdgcn_mfma_f32_32x32x16_bf16(kf[1],qr[0],negm,0,0,0), P0[6],P0[7],P0[8],P0[9],     pw0[2]=PKW(P0,4), pw0[3]=PKW(P0,6), pw0); \
      VRD(1); SBAR(); GAPA(C0=__builtin_amdgcn_mfma_f32_32x32x16_bf16(kf[2],qr[1],C0,0,0,0),   P0[10],P0[11],P0[12],P0[13], pw1[0]=PKW(P0,8), pw1[1]=PKW(P0,10), pw1); \
      VRD(5); SBAR(); GAPA(C1=__builtin_amdgcn_mfma_f32_32x32x16_bf16(kf[3],qr[1],C1,0,0,0),   P0[14],P0[15],P1[0],P1[1],   pw1[2]=PKW(P0,12),pw1[3]=PKW(P0,14), pw1); \
      VRD(2); SBAR(); GAPA(C0=__builtin_amdgcn_mfma_f32_32x32x16_bf16(kf[4],qr[2],C0,0,0,0),   P1[2],P1[3],P1[4],P1[5],     pw2[0]=PKW(P1,0), pw2[1]=PKW(P1,2), pw2); \
      VRD(6); SBAR(); GAPA(C1=__builtin_amdgcn_mfma_f32_32x32x16_bf16(kf[5],qr[2],C1,0,0,0),   P1[6],P1[7],P1[8],P1[9],     pw2[2]=PKW(P1,4), pw2[3]=PKW(P1,6), pw2); \
      VRD(3); SBAR(); GAPA(C0=__builtin_amdgcn_mfma_f32_32x32x16_bf16(kf[6],qr[3],C0,0,0,0),   P1[10],P1[11],P1[12],P1[13], pw3[0]=PKW(P1,8), pw3[1]=PKW(P1,10), pw3); \
      VRD(7); SBAR(); GAPA(C1=__builtin_amdgcn_mfma_f32_32x32x16_bf16(kf[7],qr[3],C1,0,0,0),   P1[14],P1[15],0.f,0.f,       pw3[2]=PKW(P1,12),pw3[3]=PKW(P1,14), pw3); \
      l_reg+=sacc; PXW((t)-1); \
      if(GK){DMA_K((t)+3,sl_cur);} if(GV){DMA_V((t)+1,sl_next);} \
      BIAS1(C1); CMASK(C0,C1,t); \
      { float a=MX3(C0[0],C0[1],C1[0]),b=MX3(C0[2],C0[3],C1[1]); a=MX3(a,C1[2],C1[3]); \
        _Pragma("unroll") for(int r=4;r<16;r+=4){a=MX3(a,C0[r],C0[r+1]);b=MX3(b,C0[r+2],C0[r+3]);a=MX3(a,C1[r],C1[r+1]);b=MX3(b,C1[r+2],C1[r+3]);} \
        float rm=__builtin_fmaxf(a,b); { auto rr=__builtin_amdgcn_permlane32_swap(__float_as_uint(rm),__float_as_uint(rm),false,false); rm=__builtin_fmaxf(__uint_as_float(rr[0]),__uint_as_float(rr[1])); } \
        resc=false; \
        if(__builtin_expect(__any(rm>(float)THRL),0)){ const float dl=__builtin_fmaxf(rm,0.f); \
          _Pragma("unroll") for(int r=0;r<16;++r){C0[r]-=dl;C1[r]-=dl;} \
          _Pragma("unroll") for(int r=0;r<16;++r)negm[r]-=dl; asm volatile("":"+v"(negm)); \
          const float f=__builtin_amdgcn_exp2f(-dl); l_reg*=f; if(hi==0)wsf[32*((t)&1)+r32]=f; resc=true; } \
        if(lane==0)wsf[64+((t)&1)]=resc?1.f:0.f; } \
      NEXTTILE(); \
      SBAR(); \
      GAPB(o[0]=__builtin_amdgcn_mfma_f32_32x32x16_bf16(PAF(0),VFR(0),o[0],0,0,0), C0,0); \
      GAPB(o[1]=__builtin_amdgcn_mfma_f32_32x32x16_bf16(PAF(0),VFR(4),o[1],0,0,0), C0,4); \
      KRD(GL,0); GAPB(o[0]=__builtin_amdgcn_mfma_f32_32x32x16_bf16(PAF(1),VFR(1),o[0],0,0,0), C0,8); \
      KRD(GL,1); GAPB(o[1]=__builtin_amdgcn_mfma_f32_32x32x16_bf16(PAF(1),VFR(5),o[1],0,0,0), C0,12); \
      KRD(GL,2); GAPB(o[0]=__builtin_amdgcn_mfma_f32_32x32x16_bf16(PAF(2),VFR(2),o[0],0,0,0), C1,0); \
      KRD(GL,3); GAPB(o[1]=__builtin_amdgcn_mfma_f32_32x32x16_bf16(PAF(2),VFR(6),o[1],0,0,0), C1,4); \
      GAPB(o[0]=__builtin_amdgcn_mfma_f32_32x32x16_bf16(PAF(3),VFR(3),o[0],0,0,0), C1,8); \
      GAPB(o[1]=__builtin_amdgcn_mfma_f32_32x32x16_bf16(PAF(3),VFR(7),o[1],0,0,0), C1,12); \
      }while(0)
    int t=1;
    for(;t+5<NT;t+=2){
      STEP(pB0,pB1,pA0,pA1,t,true,true,true);     WAIT_BAR(4); RESC(t);   ROT();
      STEP(pA0,pA1,pB0,pB1,t+1,true,true,true);   WAIT_BAR(4); RESC(t+1); ROT();
    }
    #define ENDW(tt) do{ if((tt)+3<NT){WAIT_BAR(4);} else if((tt)+2<NT){WAIT_BAR(2);} else {WAIT_BAR(0);} }while(0)
    for(;t+1<NT;t+=2){
      STEP(pB0,pB1,pA0,pA1,t,(t+3<NT),(t+1<NT),(t+1<NT));       ENDW(t);   RESC(t);   ROT();
      STEP(pA0,pA1,pB0,pB1,t+1,(t+4<NT),(t+2<NT),(t+2<NT));     ENDW(t+1); RESC(t+1); ROT();
    }
    STEP(pB0,pB1,pA0,pA1,NT-1,false,false,false); RESC(NT-1);
    { float sacc=pB0[0]+pB0[1]; _Pragma("unroll") for(int r=2;r<16;++r)sacc+=pB0[r]; _Pragma("unroll") for(int r=0;r<16;++r)sacc+=pB1[r]; l_reg+=sacc;
      pw0=(u32x4){PKW(pB0,0),PKW(pB0,2),PKW(pB0,4),PKW(pB0,6)};pw1=(u32x4){PKW(pB0,8),PKW(pB0,10),PKW(pB0,12),PKW(pB0,14)};pw2=(u32x4){PKW(pB1,0),PKW(pB1,2),PKW(pB1,4),PKW(pB1,6)};pw3=(u32x4){PKW(pB1,8),PKW(pB1,10),PKW(pB1,12),PKW(pB1,14)};
      { char*pb_=shm+PC_K+pw*4096+16*lane; *(u32x4*)(pb_)=pw0; *(u32x4*)(pb_+1024)=pw1; *(u32x4*)(pb_+2048)=pw2; *(u32x4*)(pb_+3072)=pw3; }
      SBAR(); pv(o,vb0+sl_cur,PAF(0),PAF(1),PAF(2),PAF(3)); }
    {auto rr=__builtin_amdgcn_permlane32_swap(__float_as_uint(l_reg),__float_as_uint(l_reg),false,false);l_reg=__uint_as_float(rr[0])+__uint_as_float(rr[1]);}
    if(hi==0)wsf[96+r32]=l_reg;
    WAIT_BAR(0);
    float rli[16];
    #pragma unroll
    for(int r=0;r<16;++r)rli[r]=__builtin_amdgcn_rcpf(wsf[96+crow(r,hi)]);
    { bf16_t*stg=(bf16_t*)(shm+PC_OST)+wid*2048;
      #pragma unroll
      for(int r=0;r<16;++r){const int orow=crow(r,hi);
        #pragma unroll
        for(int d0=0;d0<2;++d0)stg[orow*64+d0*32+r32]=f2bf(o[d0][r]*rli[r]);}
      asm volatile("s_waitcnt lgkmcnt(0)":::"memory");
      #pragma unroll
      for(int i=0;i<4;++i){const int row=i*8+(lane>>3),ch=lane&7; const u32x4 v=*(const u32x4*)(stg+row*64+ch*8); *(u32x4*)(Ow+(long)row*OP+ch*8)=v;} }
    asm volatile("s_waitcnt lgkmcnt(0)\n\ts_barrier":::"memory");
    #undef PKW
    #undef PAF
    #undef VFR
    #undef PIN
    #undef MX3
    #undef GAPA
    #undef GAPB
    #undef EX
    #undef VRD
    #undef KRD
    #undef PXW
    #undef STEP
    #undef ENDW
    #undef DMA_K
    #undef DMA_V
    #undef CMASK
    #undef BIAS1
    #undef NEXTTILE
    #undef START
    #undef RESC
    #undef ROT
  } else {
    const bf16_t*Vh=U+rowbase*KP+C_DV+hh*128+64;
    const bf16_t*vsrc0=Vh+(long)(16*((2*pw)&3)+(lane>>2))*KP+((2*pw)>>2)*32+(lane&3)*8;
    const bf16_t*vsrc1=Vh+(long)(16*((2*pw+1)&3)+(lane>>2))*KP+((2*pw+1)>>2)*32+(lane&3)*8;
    const unsigned vdst=lds0+PC_V1+(2*pw)*1024;
    #define DMA_V1(j) do{ const long to_=(long)TILE_OF(j)*KVBLK*KP; const unsigned d_=(unsigned)__builtin_amdgcn_readfirstlane(vdst+((j)%3)*SLOTB); glds16(vsrc0+to_,d_); glds16(vsrc1+to_,d_+1024); }while(0)
    const int vb1=(int)(lds0+PC_V1)+((lane>>4)&1)*32+(lane&3)*8+(4*hi+((lane&15)>>2))*64;
    f32x16 o[2];o[0]=f32x16{};o[1]=f32x16{};
    #define CPVB(j,PB) do{ const char*pb_=(PB); const u32x4 a0=*(const u32x4*)(pb_),a1=*(const u32x4*)(pb_+1024),a2=*(const u32x4*)(pb_+2048),a3=*(const u32x4*)(pb_+3072); \
        pv(o,vb1+((j)%3)*SLOTB,__builtin_bit_cast(bf16x8,a0),__builtin_bit_cast(bf16x8,a1),__builtin_bit_cast(bf16x8,a2),__builtin_bit_cast(bf16x8,a3)); \
        if((j)+1<NT && wsf[64+(((j)+1)&1)]!=0.f){ _Pragma("unroll") for(int d_=0;d_<2;++d_) _Pragma("unroll") for(int r=0;r<16;++r)o[d_][r]*=wsf[32*(((j)+1)&1)+crow(r,hi)]; } }while(0)
    #define CPV(j) CPVB(j, px+4096*((j)&1)+16*lane)
    DMA_V1(0); DMA_V1(1);
    WAIT_BAR(2);
    WAIT_BAR(2);
    WAIT_BAR(2);
    WAIT_BAR(2);
    int j=0;
    int NP=bg.np; { int npm=((NT-6)>>1)&~3; if(npm<0)npm=0; if(NP>npm)NP=npm; }
    if(NP>0){
      float xa[16],ya[16],xb[16],yb[16];
      unsigned*sw=(unsigned*)(shm+PC_OST+pw*8192);
      const int n_=lane&31,kq_=lane>>5;
      #define BG_DEC(P) const int it_=8*(bg.base+((P)>>2))+2*((P)&3)+(pw>>1), e_=it_/384, q_=it_%384, kind_=q_>>7, ii_=q_&127; \
        const bool gu_=kind_<2; const int K_=gu_?1024:512, Ns_=gu_?512:1024, roff_=gu_?kind_:0, rmul_=gu_?2:1, k0_=128*(gu_?(ii_>>4):(ii_>>5))+64*(pw&1), n0_=32*(gu_?(ii_&15):(ii_&31)); \
        const float*W_=(gu_?(kind_?bg.w26:bg.w25):bg.w27)+(size_t)e_*524288; bf16_t*WT_=gu_?bg.wtgu+(size_t)e_*1048576:bg.wtdn+(size_t)e_*524288;
      #define BG_LOAD(T,P,H) do{ BG_DEC(P) (void)roff_;(void)rmul_;(void)K_;(void)WT_; const float*s_=W_+(size_t)(k0_+32*(H)+2*kq_)*Ns_+n0_+n_; \
        _Pragma("unroll") for(int m=0;m<8;++m){ T[2*m]=__builtin_nontemporal_load(s_+(size_t)(4*m)*Ns_); T[2*m+1]=__builtin_nontemporal_load(s_+(size_t)(4*m+1)*Ns_); } }while(0)
      #define BG_CONS(T,H) do{ _Pragma("unroll") for(int m=0;m<8;++m) sw[n_*33+16*(H)+2*m+kq_]=cvtpk_s(T[2*m],T[2*m+1]); }while(0)
      #define BG_OUT(P) do{ BG_DEC(P) (void)W_;(void)Ns_; _Pragma("unroll") for(int jj=0;jj<4;++jj){ const int nn_=(lane>>3)+8*jj,c_=lane&7; const unsigned*r_=sw+nn_*33+4*c_; \
          u32x4 o_; o_.x=r_[0];o_.y=r_[1];o_.z=r_[2];o_.w=r_[3]; __builtin_nontemporal_store(o_,(u32x4*)(WT_+(size_t)(roff_+(n0_+nn_)*rmul_)*K_+k0_+8*c_)); } }while(0)
      DMA_V1(j+2); BG_LOAD(xa,0,0); CPV(j); WAIT_BAR(18); ++j;
      DMA_V1(j+2); BG_LOAD(ya,0,1); CPV(j); WAIT_BAR(34); ++j;
      DMA_V1(j+2); BG_LOAD(xb,1,0); CPV(j); WAIT_BAR(34); ++j;
      DMA_V1(j+2); BG_LOAD(yb,1,1); BG_CONS(xa,0); CPV(j); WAIT_BAR(34); ++j;
      #pragma unroll 1
      for(int P=2;P<NP;P+=2){
        DMA_V1(j+2); BG_CONS(ya,1); BG_OUT(P-2); BG_LOAD(xa,P,0);   CPV(j); WAIT_BAR(34); ++j;
        DMA_V1(j+2); BG_LOAD(ya,P,1);   BG_CONS(xb,0);              CPV(j); WAIT_BAR(34); ++j;
        DMA_V1(j+2); BG_CONS(yb,1); BG_OUT(P-1); BG_LOAD(xb,P+1,0); CPV(j); WAIT_BAR(34); ++j;
        DMA_V1(j+2); BG_LOAD(yb,P+1,1); BG_CONS(xa,0);              CPV(j); WAIT_BAR(34); ++j;
      }
      asm volatile("s_waitcnt vmcnt(0)":::"memory");
      BG_CONS(ya,1); BG_OUT(NP-2); BG_CONS(xb,0); BG_CONS(yb,1); BG_OUT(NP-1);
      #undef BG_DEC
      #undef BG_LOAD
      #undef BG_CONS
      #undef BG_OUT
    }
    #pragma unroll 1
    for(;j+2<NT;++j){
      if(j+2<NT) DMA_V1(j+2);
      CPV(j);
      if(j+3<NT){ WAIT_BAR(2); } else { WAIT_BAR(0); }
    }
    CPV(NT-2);
    CPVB(NT-1, shm+PC_K+pw*4096+16*lane);
    float rli[16];
    #pragma unroll
    for(int r=0;r<16;++r)rli[r]=__builtin_amdgcn_rcpf(wsf[96+crow(r,hi)]);
    { bf16_t*stg=(bf16_t*)(shm+PC_OST)+wid*2048;
      #pragma unroll
      for(int r=0;r<16;++r){const int orow=crow(r,hi);
        #pragma unroll
        for(int d0=0;d0<2;++d0)stg[orow*64+d0*32+r32]=f2bf(o[d0][r]*rli[r]);}
      asm volatile("s_waitcnt lgkmcnt(0)":::"memory");
      #pragma unroll
      for(int i=0;i<4;++i){const int row=i*8+(lane>>3),ch=lane&7; const u32x4 v=*(const u32x4*)(stg+row*64+ch*8); *(u32x4*)(Ow+(long)row*OP+ch*8)=v;} }
    asm volatile("s_waitcnt lgkmcnt(0)\n\ts_barrier":::"memory");
    #undef DMA_V1
    #undef CPV
    #undef CPVB
  }
  #undef TILE_OF
}
#undef SBAR
#undef WAIT_BAR
}

__device__ __forceinline__ void transpose_item(const float* W, int K, int Nsrc, bf16_t* WT, int roff, int rmul, float* scr, int kb, int nb, int lane) {
    const int k0 = 64 * kb, n0 = 32 * nb;
    float tv[32];
#pragma unroll
    for (int i = 0; i < 32; ++i) { const int kk = 2 * i + (lane >> 5), n = n0 + (lane & 31); tv[i] = (n < Nsrc) ? __builtin_nontemporal_load(W + (size_t)(k0 + kk) * Nsrc + n) : 0.f; }
#pragma unroll
    for (int i = 0; i < 32; ++i) scr[(2 * i + (lane >> 5)) * 33 + (lane & 31)] = tv[i];
    lds_fence();
    const int c = lane & 7;
#pragma unroll
    for (int j = 0; j < 4; ++j) { const int n = (lane >> 3) + 8 * j; const float* s = scr + (8 * c) * 33 + n;
        u32x4 o; o.x = pk2(s[0 * 33], s[1 * 33]); o.y = pk2(s[2 * 33], s[3 * 33]); o.z = pk2(s[4 * 33], s[5 * 33]); o.w = pk2(s[6 * 33], s[7 * 33]);
        *(u32x4*)(WT + (size_t)(roff + (n0 + n) * rmul) * K + k0 + 8 * c) = o; }
    lds_fence();
}

__device__ __forceinline__ void transpose_win_item(const float* W, const float* mod, bf16_t* WT0, bf16_t* WT1, float* betap, float* scr, int kb, int nb, int lane) {
    const int k0 = 64 * kb, n0 = 32 * nb, nl = lane & 31, hi = lane >> 5;
    float tv[32];
#pragma unroll
    for (int i = 0; i < 32; ++i) { const int n = n0 + nl; tv[i] = (n < IN_COLS) ? __builtin_nontemporal_load(W + (size_t)(k0 + 2 * i + hi) * IN_COLS + n) : 0.f; }
    const int c = lane & 7;
    const f32x4 s0a = *(const f32x4*)(mod + 1024 + k0 + 8 * c) + 1.f, s0b = *(const f32x4*)(mod + 1024 + k0 + 8 * c + 4) + 1.f;
    const f32x4 s1a = *(const f32x4*)(mod + 6144 + 1024 + k0 + 8 * c) + 1.f, s1b = *(const f32x4*)(mod + 6144 + 1024 + k0 + 8 * c + 4) + 1.f;
    const f32x4 h0a = *(const f32x4*)(mod + k0 + 8 * c), h0b = *(const f32x4*)(mod + k0 + 8 * c + 4);
    const f32x4 h1a = *(const f32x4*)(mod + 6144 + k0 + 8 * c), h1b = *(const f32x4*)(mod + 6144 + k0 + 8 * c + 4);
#pragma unroll
    for (int i = 0; i < 32; ++i) scr[(2 * i + hi) * 33 + nl] = tv[i];
    lds_fence();
#pragma unroll
    for (int j = 0; j < 4; ++j) { const int n = (lane >> 3) + 8 * j; const float* s = scr + (8 * c) * 33 + n;
        const float e0 = s[0 * 33], e1 = s[1 * 33], e2 = s[2 * 33], e3 = s[3 * 33], e4 = s[4 * 33], e5 = s[5 * 33], e6 = s[6 * 33], e7 = s[7 * 33];
        u32x4 o; o.x = pk2(e0 * s0a.x, e1 * s0a.y); o.y = pk2(e2 * s0a.z, e3 * s0a.w); o.z = pk2(e4 * s0b.x, e5 * s0b.y); o.w = pk2(e6 * s0b.z, e7 * s0b.w);
        *(u32x4*)(WT0 + (size_t)(n0 + n) * 1024 + k0 + 8 * c) = o;
        o.x = pk2(e0 * s1a.x, e1 * s1a.y); o.y = pk2(e2 * s1a.z, e3 * s1a.w); o.z = pk2(e4 * s1b.x, e5 * s1b.y); o.w = pk2(e6 * s1b.z, e7 * s1b.w);
        *(u32x4*)(WT1 + (size_t)(n0 + n) * 1024 + k0 + 8 * c) = o;
        float b0 = ((e0 * h0a.x + e1 * h0a.y) + (e2 * h0a.z + e3 * h0a.w)) + ((e4 * h0b.x + e5 * h0b.y) + (e6 * h0b.z + e7 * h0b.w));
        float b1 = ((e0 * h1a.x + e1 * h1a.y) + (e2 * h1a.z + e3 * h1a.w)) + ((e4 * h1b.x + e5 * h1b.y) + (e6 * h1b.z + e7 * h1b.w));
        b0 += __shfl_xor(b0, 1); b1 += __shfl_xor(b1, 1); b0 += __shfl_xor(b0, 2); b1 += __shfl_xor(b1, 2); b0 += __shfl_xor(b0, 4); b1 += __shfl_xor(b1, 4);
        if (c == 0) { betap[(0 * 16 + kb) * 3072 + n0 + n] = b0; betap[(1 * 16 + kb) * 3072 + n0 + n] = b1; } }
    lds_fence();
}
__device__ __forceinline__ void transpose_item2(const float* W, int K, int Nsrc, bf16_t* WT, int roff, int rmul, float* scr, int kb, int nb, int lane) {
    const int k0 = 128 * kb, n0 = 32 * nb, n = lane & 31, kq = lane >> 5;
    float tv[64];
    const float* src = W + (size_t)(k0 + 2 * kq) * Nsrc + n0 + n;
#pragma unroll
    for (int m = 0; m < 32; ++m) { tv[2 * m] = __builtin_nontemporal_load(src + (size_t)(4 * m) * Nsrc); tv[2 * m + 1] = __builtin_nontemporal_load(src + (size_t)(4 * m + 1) * Nsrc); }
    unsigned* sw = (unsigned*)scr;
#pragma unroll
    for (int m = 0; m < 32; ++m) sw[n * 65 + 2 * m + kq] = pk2(tv[2 * m], tv[2 * m + 1]);
    lds_fence();
    const int c = lane & 15;
#pragma unroll
    for (int j = 0; j < 8; ++j) { const int nn = (lane >> 4) + 4 * j; const unsigned* s = sw + nn * 65 + 4 * c;
        u32x4 o; o.x = s[0]; o.y = s[1]; o.z = s[2]; o.w = s[3];
        __builtin_nontemporal_store(o, (u32x4*)(WT + (size_t)(roff + (n0 + nn) * rmul) * K + k0 + 8 * c)); }
    lds_fence();
}
__device__ __forceinline__ void expert_item(const Params& p, float* scr2, int it, int lane) {
    unsigned char* ws = p.ws;
    const int e = it / 384, q = it % 384, kind = q >> 7, ii = q & 127;
    if (kind == 0) transpose_item2(p.in[25] + (size_t)e * 1024 * 512, 1024, 512, (bf16_t*)(ws + WS_WTGU) + (size_t)e * 1024 * 1024, 0, 2, scr2, ii >> 4, ii & 15, lane);
    else if (kind == 1) transpose_item2(p.in[26] + (size_t)e * 1024 * 512, 1024, 512, (bf16_t*)(ws + WS_WTGU) + (size_t)e * 1024 * 1024, 1, 2, scr2, ii >> 4, ii & 15, lane);
    else transpose_item2(p.in[27] + (size_t)e * 512 * 1024, 512, 1024, (bf16_t*)(ws + WS_WTDN) + (size_t)e * 1024 * 512, 0, 1, scr2, ii >> 5, ii & 31, lane);
}

__device__ __forceinline__ void stage1(const Params& p, int bi, int nb);
__device__ __forceinline__ void stage0(const Params& p, unsigned char* smem) {
    const int tid = opaque_tid(), wid = tid >> 6, lane = tid & 63, G = gridDim.x;
    unsigned char* ws = p.ws;
    for (int it = blockIdx.x; it < 96; it += G) {
        const int gcol = it >> 2, ks = it & 3;
        float* ssl = (float*)(smem + 73728);
        f32x4* mp = (f32x4*)(smem + 73728 + 8192);
        volatile int* lastf = (volatile int*)(smem + 73728 + 8192 + 16384);
        for (int i = tid; i < 2048; i += NT) ssl[i] = silu_f(p.in[1][i]);
        __syncthreads();
        const float* wa = p.in[2] + 256 * gcol + 4 * lane; f32x4 a0 = {0.f, 0.f, 0.f, 0.f}, a1 = a0;
#pragma unroll 1
        for (int k0 = 256 * ks + 32 * wid; k0 < 256 * ks + 32 * wid + 32; k0 += 16) { f32x4 wv[16];
#pragma unroll
            for (int k = 0; k < 16; ++k) wv[k] = __builtin_nontemporal_load((const f32x4*)(wa + (size_t)(k0 + k) * 6144));
#pragma unroll
            for (int k = 0; k < 16; ++k) { a0 += wv[k] * ssl[k0 + k]; a1 += wv[k] * ssl[1024 + k0 + k]; } }
        mp[wid * 128 + lane] = a0; mp[wid * 128 + 64 + lane] = a1;
        __syncthreads();
        float* part = (float*)(ws + WS_MODP) + (size_t)(gcol * 4 + ks) * 512;
        { const float* mpf = (const float*)mp; const int bsel = tid >> 8, cl = tid & 255; float s = 0.f;
#pragma unroll
          for (int w = 0; w < 8; ++w) s += mpf[((w * 2 + bsel) * 64 + (cl >> 2)) * 4 + (cl & 3)];
          part[tid] = s; }
        asm volatile("s_waitcnt vmcnt(0)" ::: "memory");
        __syncthreads();
        if (tid == 0) { __builtin_amdgcn_fence(__ATOMIC_RELEASE, "agent");
            const unsigned old = __hip_atomic_fetch_add((unsigned*)(ws + WS_CTL) + CTL_TREADY + 128 + gcol, 1u, __ATOMIC_RELAXED, __HIP_MEMORY_SCOPE_AGENT);
            *lastf = (old == 3u) ? 1 : 0;
            if (old == 3u) __builtin_amdgcn_fence(__ATOMIC_ACQUIRE, "agent"); }
        __syncthreads();
        if (*lastf) {
            const int bsel = tid >> 8, cl = tid & 255; const float* pg = (const float*)(ws + WS_MODP) + (size_t)gcol * 4 * 512 + tid;
            float s = p.in[3][256 * gcol + cl];
#pragma unroll
            for (int q = 0; q < 4; ++q) s += pg[q * 512];
            ((float*)(ws + WS_MOD))[bsel * 6144 + 256 * gcol + cl] = s;
            asm volatile("s_waitcnt vmcnt(0)" ::: "memory");
            __syncthreads();
            if (tid == 0) { __builtin_amdgcn_fence(__ATOMIC_RELEASE, "agent"); (void)__hip_atomic_fetch_add((unsigned*)(ws + WS_CTL) + CTL_MODRDY, 1u, __ATOMIC_RELAXED, __HIP_MEMORY_SCOPE_AGENT); }
        }
        __syncthreads();
    }
    const bool split_ = G >= 192;
    if (!split_ || blockIdx.x >= 96) stage1(p, split_ ? (int)blockIdx.x - 96 : (int)blockIdx.x, split_ ? G - 96 : G);
    if (G < 192 || blockIdx.x >= 96) {
        float* scr = (float*)(smem + wid * 8448);
        const int NGW = (G < 192 ? G : G - 96) * NW, gw = (G < 192 ? (int)blockIdx.x : (int)blockIdx.x - 96) * NW + wid;
        constexpr int I_OUT = 16 * 32;
        constexpr int I_C = 2 * (128 + 4);
        for (int it = gw; it < I_C + 128; it += NGW) {
            if (it < I_C) { const int kv = it / 132, r = it % 132;
                if (r < 128) transpose_item(p.in[kv ? 17 : 16], 2048, 128, (bf16_t*)(ws + WS_W1T) + (size_t)kv * 128 * 2048, 0, 1, scr, r >> 2, r & 3, lane);
                else transpose_item(p.in[kv ? 19 : 18], 128, 64, (bf16_t*)(ws + WS_W2T) + (size_t)kv * 64 * 128, 0, 1, scr, (r - 128) >> 1, (r - 128) & 1, lane);
            } else { const int r = it - I_C, kv = r >> 6, kc = r & 63; const float* pos = p.in[kv ? 15 : 14]; const float* w1 = p.in[kv ? 17 : 16];
                float a0 = 0.f, a1 = 0.f;
#pragma unroll
                for (int k = 0; k < 32; ++k) { const float pv = pos[kc * 32 + k]; a0 += pv * w1[(size_t)(kc * 32 + k) * 128 + lane]; a1 += pv * w1[(size_t)(kc * 32 + k) * 128 + 64 + lane]; }
                float* b1 = (float*)(ws + WS_B1P) + (kv * 64 + kc) * 128; b1[lane] = a0; b1[64 + lane] = a1; }
        }
        for (int it = gw; it < I_OUT; it += NGW) transpose_item(p.in[20], 1024, 1024, (bf16_t*)(ws + WS_WTOUT), 0, 1, scr, it / 32, it % 32, lane);
    }
    if (G < 192 || blockIdx.x >= 96) {
        const int gt = (G < 192 ? (int)blockIdx.x : (int)blockIdx.x - 96) * NT + tid, NGT = (G < 192 ? G : G - 96) * NT;
        float* wr = (float*)(ws + WS_WR);
        bf16_t* wrh = (bf16_t*)wr; bf16_t* wrl = wrh + 1024 * 80;
        for (int i = gt; i < 1024 * 80; i += NGT) { const int ln = (i >> 3) & 63, jj = (i >> 9) % 5, ks = (i >> 9) / 5, k = 32 * ks + 8 * (ln >> 4) + (i & 7), c = 16 * jj + (ln & 15);
            const float w = c < 64 ? p.in[23][k * 64 + c] : (c < 72 ? p.in[21][k * 8 + (c - 64)] : 0.f);
            const bf16_t hi = f2bf(w); wrh[i] = hi; wrl[i] = f2bf(w - bf2f(hi)); }
    }
    if (!split_ || blockIdx.x < 96) {
        __syncthreads();
        if (tid == 0) { unsigned sp = 0;
            while (__hip_atomic_load((unsigned*)(ws + WS_CTL) + CTL_MODRDY, __ATOMIC_RELAXED, __HIP_MEMORY_SCOPE_AGENT) < 24u) { __builtin_amdgcn_s_sleep(2); if (++sp > (1u << 22)) break; }
            __builtin_amdgcn_fence(__ATOMIC_ACQUIRE, "agent"); }
        __syncthreads();
        const int nbw = (split_ ? 96 : G) * NW;
        for (int it = blockIdx.x * NW + wid; it < 16 * 96; it += nbw)
            transpose_win_item(p.in[8], (const float*)(ws + WS_MOD), (bf16_t*)(ws + WS_WTIN), (bf16_t*)(ws + WS_WTIN1), (float*)(ws + WS_BETAP), (float*)(smem + wid * 8448), it / 96, it % 96, lane);
    }
}

__device__ __forceinline__ void stage1(const Params& p, int bi, int nb) {
    const int tid = opaque_tid(), wid = tid >> 6, lane = tid & 63;
    const float* mod = (const float*)(p.ws + WS_MOD);
    bf16_t* xn = (bf16_t*)(p.ws + WS_XN);
    for (int bb = 0; bb < BATCH; ++bb) {
        f32x4 gs[4], sh[4];
#pragma unroll
        for (int j = 0; j < 4; ++j) { const int col = lane * 4 + 256 * j;
            gs[j] = *(const f32x4*)(p.in[4] + col); sh[j] = (f32x4){0.f, 0.f, 0.f, 0.f}; }
        for (int row = bb * SEQ + bi * NW + wid; row < (bb + 1) * SEQ; row += 4 * nb * NW) {
            const int st = nb * NW, lim = (bb + 1) * SEQ;
            f32x4 v[4][4]; float rs[4];
#pragma unroll
            for (int i = 0; i < 4; ++i) { const int ri = row + i * st < lim ? row + i * st : row; const f32x4* xr = (const f32x4*)(p.in[0] + (size_t)ri * DM) + lane;
#pragma unroll
                for (int j = 0; j < 4; ++j) v[i][j] = __builtin_nontemporal_load(xr + 64 * j); }
#pragma unroll
            for (int i = 0; i < 4; ++i) { float ss = 0.f;
#pragma unroll
                for (int j = 0; j < 4; ++j) ss += v[i][j].x * v[i][j].x + v[i][j].y * v[i][j].y + v[i][j].z * v[i][j].z + v[i][j].w * v[i][j].w;
                rs[i] = rsqrtf(wave_sum(ss) * (1.f / DM) + 1e-6f); }
#pragma unroll
            for (int i = 0; i < 4; ++i) { if (row + i * st < lim) {
#pragma unroll
                for (int j = 0; j < 4; ++j) { const int col = lane * 4 + 256 * j; const f32x4 h = v[i][j] * rs[i] * gs[j] + sh[j];
                    u32x2 o; o.x = pk2(h.x, h.y); o.y = pk2(h.z, h.w); *(u32x2*)(xn + (size_t)(row + i * st) * DM + col) = o; } } }
        }
    }
}

struct EpiBf16Out {
    static constexpr bool PERM = true;
    bf16_t* O; int ldc; int nscale; float sc; unsigned* norm; const float* betat = nullptr;
    __device__ __forceinline__ void operator()(const f32x4 (&acc)[2][2][4][2], const pg8::Unit& u, int wr, int wc, int fr, int fq) const {
        const int row0 = u.pm * 256 + wr * 64 + fr, col0 = u.pn * 256 + wc * 32 + 8 * fq; const float s_ = ((nscale >> u.pn) & 1) ? sc : 1.f;
#define EPI_BIAS(bj) f32x4 b0_ = (f32x4){0.f, 0.f, 0.f, 0.f}, b1_ = b0_; if (betat) { const float* bp_ = betat + u.slot * 256 + (bj) * 128 + wc * 32 + 8 * fq; b0_ = *(const f32x4*)bp_; b1_ = *(const f32x4*)(bp_ + 4); }
        if (norm && u.pn < 4) {
#pragma unroll
            for (int bj = 0; bj < 2; ++bj) { float mx = 0.f; EPI_BIAS(bj)
#pragma unroll
                for (int ai = 0; ai < 2; ++ai)
#pragma unroll
                    for (int m = 0; m < 4; ++m) { const f32x4 v0 = (acc[ai][bj][m][0] + b0_) * s_, v1 = (acc[ai][bj][m][1] + b1_) * s_;
                        float ss = (v0[0] * v0[0] + v0[1] * v0[1]) + (v0[2] * v0[2] + v0[3] * v0[3]) + (v1[0] * v1[0] + v1[1] * v1[1]) + (v1[2] * v1[2] + v1[3] * v1[3]);
                        ss += __shfl_xor(ss, 16); ss += __shfl_xor(ss, 32); mx = fmaxf(mx, ss); }
                mx = fmaxf(mx, __shfl_xor(mx, 1)); mx = fmaxf(mx, __shfl_xor(mx, 2)); mx = fmaxf(mx, __shfl_xor(mx, 4)); mx = fmaxf(mx, __shfl_xor(mx, 8));
                if (fr == 0 && fq == 0) atomicMax(norm + (u.pm >> 5) * 32 + u.pn * 8 + bj * 4 + wc, __float_as_uint(mx * 1.001f)); }
        }
#pragma unroll
        for (int bj = 0; bj < 2; ++bj) { EPI_BIAS(bj)
#pragma unroll
            for (int ai = 0; ai < 2; ++ai) { if (ai == 1 && u.half) break;
#pragma unroll
                for (int m = 0; m < 4; ++m) { bf16_t* rowp = O + (size_t)(row0 + ai * 128 + m * 16) * ldc + col0;
                    const f32x4 v0 = (acc[ai][bj][m][0] + b0_) * s_, v1 = (acc[ai][bj][m][1] + b1_) * s_;
                    u32x4 w; w.x = pg8::cvt_pk_bf16(v0[0], v0[1]); w.y = pg8::cvt_pk_bf16(v0[2], v0[3]); w.z = pg8::cvt_pk_bf16(v1[0], v1[1]); w.w = pg8::cvt_pk_bf16(v1[2], v1[3]);
                    *(u32x4*)(rowp + bj * 128) = w; } } }
#undef EPI_BIAS
    }
};
struct EpiF32Out {
    static constexpr bool PERM = false;
    float* O; int ldc;
    __device__ __forceinline__ void operator()(const f32x4 (&acc)[2][2][4][2], const pg8::Unit& u, int wr, int wc, int fr, int fq) const {
        const int row0 = u.pm * 256 + wr * 64 + fr, col0 = u.pn * 256 + wc * 32 + 4 * fq;
#pragma unroll
        for (int ai = 0; ai < 2; ++ai)
#pragma unroll
            for (int m = 0; m < 4; ++m) { float* rowp = O + (size_t)(row0 + ai * 128 + m * 16) * ldc + col0;
#pragma unroll
                for (int bj = 0; bj < 2; ++bj)
#pragma unroll
                    for (int n = 0; n < 2; ++n) *(f32x4*)(rowp + bj * 128 + n * 16) = acc[ai][bj][m][n]; }
    }
};
struct InOrder : pg8::StaticOrder {
    const char* bt1;
    __device__ __forceinline__ bool next(int i, pg8::Unit& u) const {
        if (!pg8::StaticOrder::next(i, u)) return false;
        if (u.pm >= M / 512) u.bbase = bt1;
        u.slot = i; return true; }
};
__device__ __forceinline__ void stage2(const Params& p, unsigned char* smem) {
    pg8::Gemm g{(const bf16_t*)(p.ws + WS_XN), DM};
    InOrder S; S.init(M, UC, gridDim.x, blockIdx.x, (const bf16_t*)(p.ws + WS_WTIN)); S.bt1 = (const char*)(p.ws + WS_WTIN1);
    float* betat = (float*)(smem + 131072);
    { const int tid_ = opaque_tid(); const float* bp = (const float*)(p.ws + WS_BETAP);
      if (tid_ < 192) { pg8::Unit u_; if (S.next(tid_ >> 6, u_)) { const int col = u_.pn * 256 + 4 * (tid_ & 63), b_ = u_.pm >= M / 512 ? 1 : 0; f32x4 s = {0.f, 0.f, 0.f, 0.f};
#pragma unroll
              for (int kb = 0; kb < 16; ++kb) s += *(const f32x4*)(bp + (b_ * 16 + kb) * 3072 + col);
              *(f32x4*)(betat + (tid_ >> 6) * 256 + 4 * (tid_ & 63)) = s; } }
      __syncthreads(); }
    EpiBf16Out E{(bf16_t*)(p.ws + WS_U), UC, 0xC3, attn_body::C2, (unsigned*)(p.ws + WS_CTL) + CTL_NORM, betat};
    pg8::gemm_phase(( PG8_LAS unsigned char*)smem, g, S, E);
}

__device__ __forceinline__ void diff_attn_block(const Params& p, unsigned char* smem, int vb) {
    const int tid = threadIdx.x;
    const int qb = 15 - vb / 32, rest = vb % 32, b = rest >> 4, h = (rest >> 2) & 3, c = (rest >> 1) & 1, vh = rest & 1;
    const bf16_t* U = (const bf16_t*)(p.ws + WS_U);
    float* Ks = (float*)smem;
    float* Vs = (float*)(smem + 16384);
    const int qrow = qb * 512 + tid; const size_t row = (size_t)b * SEQ + qrow;
    float q[64];
    {
        const u32x4* qp = (const u32x4*)(U + row * UC + C_DQ + h * 128 + c * 64);
#pragma unroll
        for (int i = 0; i < 8; ++i) unpack8(qp[i], q + 8 * i);
#pragma unroll
        for (int i = 0; i < 64; ++i) q[i] *= 0.125f;
    }
    float o[64];
#pragma unroll
    for (int i = 0; i < 64; ++i) o[i] = 0.f;
    float m = -1e30f, l = 0.f;
    const float slope = exp2f(-2.f * (float)(h + 1));
    const int ntiles = (qb * 512 + 512) / 64;
    for (int tile = ntiles - 1; tile >= 0; --tile) {
        __syncthreads();
        {
            const int key = tid >> 3, ch = tid & 7; const size_t krow = (size_t)b * SEQ + tile * 64 + key;
            float t8[8];
            unpack8(*(const u32x4*)(U + krow * UC + C_DK + h * 128 + c * 64 + ch * 8), t8);
#pragma unroll
            for (int e = 0; e < 8; ++e) Ks[key * 64 + ch * 8 + e] = t8[e];
            unpack8(*(const u32x4*)(U + krow * UC + C_DV + h * 128 + vh * 64 + ch * 8), t8);
#pragma unroll
            for (int e = 0; e < 8; ++e) Vs[key * 64 + ch * 8 + e] = t8[e];
        }
        __syncthreads();
        const int k0 = tile * 64;
        if (k0 <= qrow) {
#pragma unroll 1
            for (int j = 63; j >= 0; --j) {
                const int kpos = k0 + j;
                if (kpos <= qrow) {
                    const f32x4* kr = (const f32x4*)(Ks + j * 64);
                    float s0 = 0.f, s1 = 0.f;
#pragma unroll
                    for (int d = 0; d < 16; d += 2) { const f32x4 ka = kr[d], kb = kr[d + 1];
                        s0 += q[4 * d] * ka.x + q[4 * d + 1] * ka.y + q[4 * d + 2] * ka.z + q[4 * d + 3] * ka.w;
                        s1 += q[4 * d + 4] * kb.x + q[4 * d + 5] * kb.y + q[4 * d + 6] * kb.z + q[4 * d + 7] * kb.w; }
                    const float s = s0 + s1 - slope * (float)(qrow - kpos);
                    if (s > m) { const float corr = __expf(m - s); l *= corr;
#pragma unroll
                        for (int e = 0; e < 64; ++e) o[e] *= corr;
                        m = s; }
                    const float pr = __expf(s - m); l += pr;
                    const f32x4* vr = (const f32x4*)(Vs + j * 64);
#pragma unroll
                    for (int e = 0; e < 16; ++e) { const f32x4 vv = vr[e]; o[4 * e] += pr * vv.x; o[4 * e + 1] += pr * vv.y; o[4 * e + 2] += pr * vv.z; o[4 * e + 3] += pr * vv.w; }
                }
            }
        }
    }
    const float il = 1.f / l;
    f32x4* op = (f32x4*)((float*)(p.ws + WS_OC) + ((row * 4 + h) * 2 + c) * 128 + vh * 64);
#pragma unroll
    for (int e = 0; e < 16; ++e) op[e] = (f32x4){o[4 * e] * il, o[4 * e + 1] * il, o[4 * e + 2] * il, o[4 * e + 3] * il};
}

__device__ __forceinline__ void write_frags(const bf16_t* kt, const bf16_t* vt, int pitch, bf16_t* kf_tile, bf16_t* vf_tile, int lane) {
    const int r32 = lane & 31, hi = lane >> 5;
    if (kt) {
#pragma unroll
        for (int d0 = 0; d0 < 4; ++d0) *(u32x4*)(kf_tile + (d0 * 64 + lane) * 8) = *(const u32x4*)(kt + r32 * pitch + 16 * d0 + 8 * hi);
    }
    if (vt) {
#pragma unroll
        for (int d0 = 0; d0 < 2; ++d0)
#pragma unroll
            for (int s = 0; s < 2; ++s) { unsigned w[4];
#pragma unroll
                for (int e2 = 0; e2 < 4; ++e2) { const int j = 2 * e2, t0_ = 16 * s + 8 * (j >> 2) + 4 * hi + (j & 3);
                    w[e2] = (unsigned)vt[t0_ * pitch + 32 * d0 + r32] | ((unsigned)vt[(t0_ + 1) * pitch + 32 * d0 + r32] << 16); }
                *(u32x4*)(vf_tile + ((d0 * 2 + s) * 64 + lane) * 8) = (u32x4){w[0], w[1], w[2], w[3]}; }
    }
}
__device__ __forceinline__ void compress_item(const Params& p, unsigned char* smem, int idx) {
    typedef float f32x16 __attribute__((ext_vector_type(16)));
    int tid_ = threadIdx.x; asm volatile("" : "+v"(tid_));
    const int tid = tid_, wid = tid >> 6, lane = tid & 63, r32 = lane & 31, hi = lane >> 5;
    const int kv = idx >> 6, b = (idx >> 5) & 1, hkv = (idx >> 4) & 1, n0 = (idx & 15) * 32;
    const bf16_t* U = (const bf16_t*)(p.ws + WS_U);
    const bf16_t* w1t = (const bf16_t*)(p.ws + WS_W1T) + (size_t)kv * 128 * 2048;
    const bf16_t* w2t = (const bf16_t*)(p.ws + WS_W2T) + (size_t)kv * 64 * 128;
    const float* b1p = (const float*)(p.ws + WS_B1P) + kv * 64 * 128;
    float* hsum = (float*)smem;
    bf16_t* hb = (bf16_t*)(smem + 131072);
    bf16_t* ot = (bf16_t*)(smem + 131072 + 8704);
    const int col = (kv ? C_CV : C_CK) + hkv * 64;
    float* bsum = (float*)(smem + 131072 + 8704 + 4608);
    __syncthreads();
    if (tid < 128) { float bs = 0.f;
#pragma unroll
        for (int c = 0; c < 64; ++c) bs += b1p[c * 128 + tid];
        bsum[tid] = bs; }
    f32x16 acc[4];
#pragma unroll
    for (int c = 0; c < 4; ++c) acc[c] = (f32x16){};
    const int n = n0 + r32;
#pragma unroll 1
    for (int ii = 0; ii < 4; ++ii) { const int i = 4 * wid + ii, tok = 16 * n + i; const bool ok = tok < SEQ;
        const bf16_t* arow = U + ((size_t)b * SEQ + (ok ? tok : 0)) * UC + col + 8 * hi;
#pragma unroll
        for (int d0 = 0; d0 < 64; d0 += 16) { bf16x8 a = *(const bf16x8*)(arow + d0); if (!ok) a = (bf16x8){};
            const int kk = i * 64 + d0 + 8 * hi;
#pragma unroll
            for (int c = 0; c < 4; ++c) acc[c] = __builtin_amdgcn_mfma_f32_32x32x16_bf16(a, *(const bf16x8*)(w1t + (size_t)(32 * c + r32) * 2048 + kk), acc[c], 0, 0, 0); } }
#pragma unroll
    for (int c = 0; c < 4; ++c)
#pragma unroll
        for (int r = 0; r < 16; ++r) hsum[wid * 4096 + ((r & 3) + 8 * (r >> 2) + 4 * hi) * 128 + 32 * c + r32] = acc[c][r];
    __syncthreads();
    for (int i = tid; i < 4096; i += NT) { const int row = i >> 7, j = i & 127; const float bs = bsum[j];
        float hs = 0.f;
#pragma unroll
        for (int w = 0; w < 8; ++w) hs += hsum[w * 4096 + i];
        hb[row * 136 + j] = f2bf(gelu_tanh(hs + bs)); }
    __syncthreads();
    if (wid < 2) {
        f32x16 o = (f32x16){};
#pragma unroll
        for (int k0 = 0; k0 < 128; k0 += 16) o = __builtin_amdgcn_mfma_f32_32x32x16_bf16(*(const bf16x8*)(hb + r32 * 136 + k0 + 8 * hi), *(const bf16x8*)(w2t + (size_t)(32 * wid + r32) * 128 + k0 + 8 * hi), o, 0, 0, 0);
        const int d = 32 * wid + r32;
#pragma unroll
        for (int r = 0; r < 16; ++r) { const int nl = (r & 3) + 8 * (r >> 2) + 4 * hi; ot[nl * 72 + d] = (n0 + nl) < NCMP ? f2bf(o[r]) : (bf16_t)0; }
    }
    __syncthreads();
    if (wid == 0) { bf16_t* dst = (bf16_t*)(p.ws + (kv ? WS_VC : WS_KC)) + ((size_t)(b * 2 + hkv) * 16 + (idx & 15)) * 2048;
        write_frags(kv ? nullptr : ot, kv ? ot : nullptr, 72, dst, dst, lane); }
}

__device__ __forceinline__ void vt_item(const Params& p, bf16_t* scr, int item, int lane) {
    const int kind = item >> 9, b = (item >> 8) & 1, hkv = (item >> 7) & 1, blk = item & 127, tok0 = blk * 64;
    const bf16_t* U = (const bf16_t*)(p.ws + WS_U);
    bf16_t* KF = (bf16_t*)(p.ws + (kind ? WS_KFW : WS_KFS)) + (size_t)(b * 2 + hkv) * 64 * SEQ;
    bf16_t* VF = (bf16_t*)(p.ws + (kind ? WS_VFW : WS_VFS)) + (size_t)(b * 2 + hkv) * 64 * SEQ;
    const int kcol = (kind ? C_WK : C_SK) + hkv * 64, vcol = (kind ? C_WV : C_SV) + hkv * 64;
    bf16_t* ks = scr; bf16_t* vs = scr + 64 * 72;
    lds_fence();
#pragma unroll
    for (int i = 0; i < 8; ++i) { const int row = 8 * i + (lane >> 3), ch = lane & 7; const bf16_t* src = U + ((size_t)b * SEQ + tok0 + row) * UC + ch * 8;
        *(u32x4*)(ks + row * 72 + ch * 8) = *(const u32x4*)(src + kcol); *(u32x4*)(vs + row * 72 + ch * 8) = *(const u32x4*)(src + vcol); }
    lds_fence();
#pragma unroll
    for (int t = 0; t < 2; ++t) write_frags(ks + 32 * t * 72, vs + 32 * t * 72, 72, KF + (size_t)(2 * blk + t) * 2048, VF + (size_t)(2 * blk + t) * 2048, lane);
    lds_fence();
}

constexpr int CV_CLAIM = 10;
__device__ __forceinline__ void convert_range(const Params& p, unsigned char* smem, int u0, int u1) {
    const int t_ = opaque_tid(), wid = t_ >> 6, lane = t_ & 63;
    __syncthreads();
    for (int u = u0; u < u1; ++u) expert_item(p, (float*)(smem + wid * 16896), 8 * u + wid, lane);
    __syncthreads();
}
__device__ __forceinline__ bool convert_units(const Params& p, unsigned char* smem, int k) {
    const int t_ = opaque_tid(), wid = t_ >> 6, lane = t_ & 63;
    volatile int* bc = (volatile int*)(smem + LDS_BYTES - 64);
    __syncthreads();
    if (t_ == 0) *bc = (int)atomicAdd((unsigned*)(p.ws + WS_CTL) + CTL_CVQ, (unsigned)k);
    __syncthreads();
    const int base = __builtin_amdgcn_readfirstlane(*bc);
    for (int u = base; u < base + k && u < 3072; ++u) expert_item(p, (float*)(smem + wid * 16896), 8 * u + wid, lane);
    __syncthreads();
    return base < 3072;
}

__device__ __forceinline__ void stage3(const Params& p, unsigned char* smem) {
    for (int vb = blockIdx.x; vb < 128; vb += gridDim.x) compress_item(p, smem, vb);
    __syncthreads();
    { const int t_ = opaque_tid(), wid = t_ >> 6, lane = t_ & 63;
      const int G = gridDim.x, sh = (G >= 256) ? 128 : 0, vbk = (blockIdx.x + G - sh) % G;
      for (int it = vbk * NW + wid; it < 1024; it += G * NW) vt_item(p, (bf16_t*)(smem + wid * 18432), it, lane); }
    __syncthreads();
    __syncthreads();
    {
        const bf16_t* U = (const bf16_t*)(p.ws + WS_U); bf16_t* OB = (bf16_t*)(p.ws + WS_OC);
        unsigned* qhead = (unsigned*)(p.ws + WS_CTL) + CTL_QHEAD; const float* nrm = (const float*)(p.ws + WS_CTL) + CTL_NORM;
        volatile int* bc = (volatile int*)(smem + LDS_BYTES - 64);
        const int nq = (gridDim.x % 8 == 0) ? 8 : 1, myq = blockIdx.x % nq, qlen = 1024 / nq;
        for (;;) {
            __syncthreads();
            if (threadIdx.x == 0) { const int a_ = (int)atomicAdd(qhead + 16 * myq, 1u), c_ = (int)atomicAdd((unsigned*)(p.ws + WS_CTL) + CTL_CVQ, (unsigned)CV_CLAIM); bc[0] = a_; bc[1] = c_; }
            __syncthreads();
            const int ri = __builtin_amdgcn_readfirstlane(bc[0]), cvb = __builtin_amdgcn_readfirstlane(bc[1]);
            int cva = 3072 - cvb; cva = cva < 0 ? 0 : (cva > CV_CLAIM ? CV_CLAIM : cva);
            if (ri >= qlen) { if (cva > 0) convert_range(p, smem, cvb, cvb + cva); break; }
            const int x = nq == 8 ? myq : (ri >> 7), r = ri & 127;
            const int b = x >> 2, c = (x >> 1) & 1, par = x & 1;
            int k, h;
            if (r < 64) { k = 31 - (r >> 1); h = 2 + (r & 1); } else if (r < 96) { k = 31 - (r - 64); h = 1; } else { k = 31 - (r - 96); h = 0; }
            const int qb = 2 * k + par;
            const int g = h * 4 + c * 2;
            const float qn2 = nrm[b * 32 + g] + nrm[b * 32 + g + 1], kn2 = nrm[b * 32 + 16 + g] + nrm[b * 32 + 16 + g + 1];
            const float sb_ = sqrtf(qn2) * sqrtf(kn2) * 1.001f, slope2 = exp2f(-2.f * (float)(h + 1)) * 1.4426950408889634f;
            const float sc_ = (2.f * sb_ + 127.f * slope2 + 168.f) / (64.f * slope2);
            int ncap = sc_ < 1000.f ? (int)sc_ + 2 : 1000; ncap = (ncap + 1) & ~1; if (ncap < 4) ncap = 4;
            int ntu = 2 * (qb + 1); ntu = ntu < ncap ? ntu : ncap; if (ntu < 4) ntu = 4;
            int np = ((ntu - 6) >> 1) & ~3; if (np < 0) np = 0; if (np > 4 * cva) np = 4 * cva;
            const attn_body::BgConv bgc{p.in[25], p.in[26], p.in[27], (bf16_t*)(p.ws + WS_WTGU), (bf16_t*)(p.ws + WS_WTDN), cvb, np};
            attn_body::attn_unit_pc<8>(b, h, c, qb, U, OB, (char*)smem, __builtin_amdgcn_readfirstlane(ncap), bgc);
            if (cvb + (np >> 2) < cvb + cva) convert_range(p, smem, cvb + (np >> 2), cvb + cva);
        }
        for (;;) { if (!convert_units(p, smem, 4)) break; }
    }
}

__device__ __forceinline__ void qk4(const bf16_t* krow, const float* qs, float* s) {
    s[0] = s[1] = s[2] = s[3] = 0.f;
#pragma unroll 2
    for (int c = 0; c < 8; ++c) { float kd[8]; unpack8(*(const u32x4*)(krow + c * 8), kd);
#pragma unroll
        for (int g = 0; g < 4; ++g) { const f32x4 qa = *(const f32x4*)(qs + g * 64 + c * 8), qb = *(const f32x4*)(qs + g * 64 + c * 8 + 4);
            s[g] += kd[0] * qa.x + kd[1] * qa.y + kd[2] * qa.z + kd[3] * qa.w + kd[4] * qb.x + kd[5] * qb.y + kd[6] * qb.z + kd[7] * qb.w; } }
}
__device__ __forceinline__ void pv_block(const float* pw, int pstride, const bf16_t* vbase, size_t vstride, int nrows, float (&os)[4][8], int lane) {
    const int jr = lane >> 3, ch = lane & 7;
#pragma unroll 2
    for (int i = 0; i < 8; ++i) { const int j = jr + 8 * i;
        if (j < nrows) { float vd[8]; unpack8(*(const u32x4*)(vbase + (size_t)j * vstride + ch * 8), vd);
#pragma unroll
            for (int g = 0; g < 4; ++g) { const float pr = pw[g * pstride + j];
#pragma unroll
                for (int e = 0; e < 8; ++e) os[g][e] += pr * vd[e]; } } }
}

__device__ __forceinline__ void nsa_item(const Params& p, float* wl, int item, int lane) {
    const int hkv = item & 1, t = (item >> 1) % SEQ, b = (item >> 1) / SEQ;
    const bf16_t* U = (const bf16_t*)(p.ws + WS_U);
    const bf16_t* KC = (const bf16_t*)(p.ws + WS_KC); const bf16_t* VC = (const bf16_t*)(p.ws + WS_VC);
    const size_t row = (size_t)b * SEQ + t;
    float* qs = wl;
    float* ps = wl + 256;
    lds_fence();
#pragma unroll
    for (int g = 0; g < 4; ++g) qs[g * 64 + lane] = bf2f(U[row * UC + C_NQ + (hkv * 4 + g) * 64 + lane]);
    lds_fence();
    float slope[4], gate[4][3];
#pragma unroll
    for (int g = 0; g < 4; ++g) { slope[g] = exp2f(-(float)(hkv * 4 + g + 1));
#pragma unroll
        for (int i = 0; i < 3; ++i) { const float x = bf2f(U[row * UC + C_NG + (hkv * 4 + g) * 3 + i]); gate[g][i] = 1.f / (1.f + __expf(-x)); } }
    float tot[4][8];
#pragma unroll
    for (int g = 0; g < 4; ++g)
#pragma unroll
        for (int e = 0; e < 8; ++e) tot[g][e] = 0.f;
    const int nvalid = t >= 31 ? min((t - 31) / 16 + 1, NCMP) : 0;
    float cinv[4];
    {
        float mx[4] = {-1e30f, -1e30f, -1e30f, -1e30f};
#pragma unroll 1
        for (int i = 0; i < 8; ++i) { const int n = lane + 64 * i;
            asm volatile("" ::: "memory");
            if (n < nvalid) { float s[4]; qk4(KC + ((size_t)(b * 512 + n) * 2 + hkv) * 64, qs, s);
#pragma unroll
                for (int g = 0; g < 4; ++g) { const float v = s[g] * 0.125f - slope[g] * (float)(t - (16 * n + 31)); ps[g * 512 + n] = v; mx[g] = fmaxf(mx[g], v); } }
            else {
#pragma unroll
                for (int g = 0; g < 4; ++g) ps[g * 512 + n] = -1e30f; } }
        lds_fence();
#pragma unroll
        for (int g = 0; g < 4; ++g) { mx[g] = wave_max(mx[g]); float sum = 0.f;
#pragma unroll 1
            for (int i = 0; i < 8; ++i) { const int n = lane + 64 * i; const float e = n < nvalid ? __expf(ps[g * 512 + n] - mx[g]) : 0.f; ps[g * 512 + n] = e; sum += e; }
            sum = wave_sum(sum); cinv[g] = 1.f / fmaxf(sum, 1e-30f); }
        lds_fence();
        float oc[4][8];
#pragma unroll
        for (int g = 0; g < 4; ++g)
#pragma unroll
            for (int e = 0; e < 8; ++e) oc[g][e] = 0.f;
#pragma unroll 1
        for (int n0 = 0; n0 < nvalid; n0 += 64) pv_block(ps + n0, 512, VC + ((size_t)(b * 512 + n0) * 2 + hkv) * 64, 128, min(64, nvalid - n0), oc, lane);
#pragma unroll
        for (int g = 0; g < 4; ++g)
#pragma unroll
            for (int e = 0; e < 8; ++e) tot[g][e] += gate[g][0] * cinv[g] * oc[g][e];
    }
    const int cur = t >> 6;
    int mysel = 0;
    {
        float sc0, sc1;
        { float i0 = 0.f, i1 = 0.f;
#pragma unroll
            for (int g = 0; g < 4; ++g)
#pragma unroll
                for (int d = -1; d <= 3; ++d) { const int n0 = 4 * lane + d, n1 = 4 * (lane + 64) + d;
                    if (n0 >= 0 && n0 < NCMP) i0 += cinv[g] * ps[g * 512 + n0];
                    if (n1 < NCMP) i1 += cinv[g] * ps[g * 512 + n1]; }
            const int j0 = lane, j1 = lane + 64;
            const bool f0 = (j0 == 0) || (j0 == cur) || (j0 == cur - 1), f1 = (j1 == cur) || (j1 == cur - 1);
            sc0 = (j0 <= cur) ? i0 + (f0 ? 1e4f : 0.f) : -1e30f;
            sc1 = (j1 <= cur) ? i1 + (f1 ? 1e4f : 0.f) : -1e30f; }
        for (int r = 0; r < 16; ++r) {
            float v; int idx;
            if (sc0 >= sc1) { v = sc0; idx = lane; } else { v = sc1; idx = lane + 64; }
#pragma unroll
            for (int o = 32; o > 0; o >>= 1) { const float ov = __shfl_xor(v, o); const int oi = __shfl_xor(idx, o); if (ov > v || (ov == v && oi < idx)) { v = ov; idx = oi; } }
            if (idx == lane) sc0 = -3e38f; else if (idx == lane + 64) sc1 = -3e38f;
            if (lane == r) mysel = idx;
        }
    }
#pragma unroll 1
    for (int br = 0; br < 2; ++br) {
        float ms[4], ls[4], os[4][8];
#pragma unroll
        for (int g = 0; g < 4; ++g) { ms[g] = -1e30f; ls[g] = 0.f;
#pragma unroll
            for (int e = 0; e < 8; ++e) os[g][e] = 0.f; }
        const int kcol = (br == 0 ? C_SK : C_WK) + hkv * 64, vcol = (br == 0 ? C_SV : C_WV) + hkv * 64;
        const int lo = br == 0 ? 0 : max(t - 511, 0);
        const int nb = br == 0 ? 16 : (cur - (lo >> 6) + 1);
#pragma unroll 1
        for (int r = 0; r < nb; ++r) {
            int blk;
            if (br == 0) { blk = __shfl(mysel, r); if (blk > cur) continue; } else blk = (lo >> 6) + r;
            const int tok = blk * 64 + lane; const bool valid = tok <= t && tok >= lo;
            float s[4]; qk4(U + ((size_t)b * SEQ + tok) * UC + kcol, qs, s);
            lds_fence();
#pragma unroll
            for (int g = 0; g < 4; ++g) {
                const float sv = valid ? s[g] * 0.125f - slope[g] * (float)(t - tok) : -1e30f;
                const float mx = wave_max(sv), mnew = fmaxf(ms[g], mx), corr = __expf(ms[g] - mnew);
                const float pr = valid ? __expf(sv - mnew) : 0.f;
                ls[g] = ls[g] * corr + wave_sum(pr); ms[g] = mnew;
#pragma unroll
                for (int e = 0; e < 8; ++e) os[g][e] *= corr;
                ps[g * 64 + lane] = pr; }
            lds_fence();
            pv_block(ps, 64, U + ((size_t)b * SEQ + blk * 64) * UC + vcol, UC, 64, os, lane);
        }
#pragma unroll
        for (int g = 0; g < 4; ++g) { const float gsel = br == 0 ? gate[g][1] : gate[g][2]; const float w = ls[g] > 0.f ? gsel / ls[g] : 0.f;
#pragma unroll
            for (int e = 0; e < 8; ++e) tot[g][e] += w * os[g][e]; }
    }
#pragma unroll
    for (int g = 0; g < 4; ++g)
#pragma unroll
        for (int e = 0; e < 8; ++e) { float v = tot[g][e]; v += __shfl_xor(v, 8); v += __shfl_xor(v, 16); v += __shfl_xor(v, 32); tot[g][e] = v; }
    if (lane < 8) { bf16_t* ao = (bf16_t*)(p.ws + WS_AO) + row * DM + 512;
#pragma unroll
        for (int g = 0; g < 4; ++g) { u32x4 o; o.x = pk2(tot[g][0], tot[g][1]); o.y = pk2(tot[g][2], tot[g][3]); o.z = pk2(tot[g][4], tot[g][5]); o.w = pk2(tot[g][6], tot[g][7]);
            *(u32x4*)(ao + (hkv * 4 + g) * 64 + lane * 8) = o; } }
}


namespace nsa {
typedef float f32x16 __attribute__((ext_vector_type(16)));
constexpr int WL_BYTES = 17408;
constexpr float LOG2E = 1.4426950408889634f;
#define NSA_CR(r) (((r) & 3) + 8 * ((r) >> 2))
__device__ __forceinline__ float quad_xor1(float v) { return __int_as_float(__builtin_amdgcn_update_dpp(0, __float_as_int(v), 0xB1, 0xF, 0xF, true)); }
__device__ __forceinline__ float quad_xor2(float v) { return __int_as_float(__builtin_amdgcn_update_dpp(0, __float_as_int(v), 0x4E, 0xF, 0xF, true)); }
__device__ __forceinline__ float hmax(float v) { auto rr = __builtin_amdgcn_permlane32_swap(__float_as_uint(v), __float_as_uint(v), false, false); return fmaxf(__uint_as_float(rr[0]), __uint_as_float(rr[1])); }
__device__ __forceinline__ float hsum(float v) { auto rr = __builtin_amdgcn_permlane32_swap(__float_as_uint(v), __float_as_uint(v), false, false); return __uint_as_float(rr[0]) + __uint_as_float(rr[1]); }
__device__ __forceinline__ unsigned cvtpk(float lo, float hi) { typedef float f2 __attribute__((ext_vector_type(2))); typedef __bf16 b2 __attribute__((ext_vector_type(2))); f2 v = {lo, hi}; b2 r = __builtin_convertvector(v, b2); return __builtin_bit_cast(unsigned, r); }

__device__ __forceinline__ void k_frags(const bf16_t* ktile, bf16x8 (&kf)[4]) {
#pragma unroll
    for (int d0 = 0; d0 < 4; ++d0) kf[d0] = *(const bf16x8*)(ktile + d0 * 512);
}
__device__ __forceinline__ f32x16 qk_ct(const bf16x8 (&kf)[4], const bf16_t* ql, const f32x16& c) {
    bf16x8 q[4];
#pragma unroll
    for (int d0 = 0; d0 < 4; ++d0) q[d0] = *(const bf16x8*)(ql + d0 * 512);
    f32x16 S = __builtin_amdgcn_mfma_f32_32x32x16_bf16(kf[0], q[0], c, 0, 0, 0);
#pragma unroll
    for (int d0 = 1; d0 < 4; ++d0) S = __builtin_amdgcn_mfma_f32_32x32x16_bf16(kf[d0], q[d0], S, 0, 0, 0);
    return S;
}
template <bool MASKED, class VF>
__device__ __forceinline__ void tile_pass1_f(const bf16x8 (&kf)[4], const bf16_t* qf, const f32x16& c1, const VF& valid, const bool (&colon)[2], float (&m)[2], float (&l)[2]) {
#pragma unroll
    for (int ct = 0; ct < 2; ++ct) {
        f32x16 S = qk_ct(kf, qf + ct * 2048, c1);
        float mx = -INFINITY;
#pragma unroll
        for (int r = 0; r < 16; ++r) { if (MASKED) S[r] = valid(ct, r) ? S[r] : -INFINITY; mx = fmaxf(mx, S[r]); }
        mx = hmax(mx);
        const float mn = fmaxf(m[ct], mx); float sum = 0.f;
#pragma unroll
        for (int r = 0; r < 16; ++r) sum += __builtin_amdgcn_exp2f(S[r] - mn);
        if (colon[ct]) { l[ct] = l[ct] * __builtin_amdgcn_exp2f(m[ct] - mn) + sum; m[ct] = mn; }
    }
}
template <bool MASKED, bool HOOK, class VF, class PH>
__device__ __forceinline__ void tile_pass2_p(const bf16x8 (&kf)[4], const bf16_t* qf, const f32x16& crv, const float (&lm)[2], const VF& valid, u32x4 (&pb)[2][2], const PH& ph) {
#pragma unroll
    for (int ct = 0; ct < 2; ++ct) {
        f32x16 c2;
#pragma unroll
        for (int r = 0; r < 16; ++r) c2[r] = crv[r] + lm[ct];
        const f32x16 S = qk_ct(kf, qf + ct * 2048, c2);
        float pr[16];
#pragma unroll
        for (int r = 0; r < 16; ++r) { pr[r] = __builtin_amdgcn_exp2f(S[r]); if (MASKED) pr[r] = valid(ct, r) ? pr[r] : 0.f; }
        if (HOOK) ph(ct, pr);
#pragma unroll
        for (int s = 0; s < 2; ++s) pb[ct][s] = (u32x4){cvtpk(pr[8 * s], pr[8 * s + 1]), cvtpk(pr[8 * s + 2], pr[8 * s + 3]), cvtpk(pr[8 * s + 4], pr[8 * s + 5]), cvtpk(pr[8 * s + 6], pr[8 * s + 7])};
    }
}
template <bool MASKED, class VF>
__device__ __forceinline__ void tile_online_p(const bf16x8 (&kf)[4], const bf16_t* qf, float slope, float base, const bool (&sb)[2], const VF& valid,
                                              float (&mref)[2], bool (&ini)[2], float (&l)[2], f32x16 (&o)[2][2], u32x4 (&pb)[2][2]) {
    f32x16 S[2];
#pragma unroll
    for (int ct = 0; ct < 2; ++ct) {
        const float lm = sb[ct] ? base - mref[ct] : -INFINITY;
        f32x16 c;
#pragma unroll
        for (int r = 0; r < 16; ++r) c[r] = fmaf(slope, (float)NSA_CR(r), lm);
        S[ct] = qk_ct(kf, qf + ct * 2048, c);
    }
    float mx[2]; bool need[2];
#pragma unroll
    for (int ct = 0; ct < 2; ++ct) {
        float m_ = -INFINITY;
#pragma unroll
        for (int r = 0; r < 16; ++r) { if (MASKED) S[ct][r] = valid(ct, r) ? S[ct][r] : -INFINITY; m_ = fmaxf(m_, S[ct][r]); }
        mx[ct] = hmax(m_);
        need[ct] = ini[ct] ? (mx[ct] > 8.f) : (mx[ct] > -INFINITY);
    }
    if (__any(need[0] || need[1])) {
#pragma unroll
        for (int ct = 0; ct < 2; ++ct) {
            const float delta = need[ct] ? mx[ct] : 0.f, f = (need[ct] && ini[ct]) ? __builtin_amdgcn_exp2f(-delta) : 1.f;
            mref[ct] += delta; l[ct] *= f; ini[ct] = ini[ct] || need[ct];
#pragma unroll
            for (int d0 = 0; d0 < 2; ++d0) o[ct][d0] *= f;
#pragma unroll
            for (int r = 0; r < 16; ++r) S[ct][r] -= delta;
        }
    }
#pragma unroll
    for (int ct = 0; ct < 2; ++ct) {
        float pr[16]; float s0 = 0.f, s1 = 0.f;
#pragma unroll
        for (int r = 0; r < 16; r += 2) { pr[r] = __builtin_amdgcn_exp2f(S[ct][r]); pr[r + 1] = __builtin_amdgcn_exp2f(S[ct][r + 1]); s0 += pr[r]; s1 += pr[r + 1]; }
        l[ct] += s0 + s1;
#pragma unroll
        for (int s = 0; s < 2; ++s) pb[ct][s] = (u32x4){cvtpk(pr[8 * s], pr[8 * s + 1]), cvtpk(pr[8 * s + 2], pr[8 * s + 3]), cvtpk(pr[8 * s + 4], pr[8 * s + 5]), cvtpk(pr[8 * s + 6], pr[8 * s + 7])};
    }
}
__device__ __forceinline__ void tile_pass2_v(const bf16x8 (&vf)[2][2], const u32x4 (&pb)[2][2], f32x16 (&o)[2][2]) {
#pragma unroll
    for (int d0 = 0; d0 < 2; ++d0)
#pragma unroll
        for (int s = 0; s < 2; ++s)
#pragma unroll
            for (int ct = 0; ct < 2; ++ct) o[ct][d0] = __builtin_amdgcn_mfma_f32_32x32x16_bf16(vf[d0][s], __builtin_bit_cast(bf16x8, pb[ct][s]), o[ct][d0], 0, 0, 0);
}
__device__ __forceinline__ void v_frags(const bf16_t* vt, bf16x8 (&vf)[2][2]) {
#pragma unroll
    for (int d0 = 0; d0 < 2; ++d0)
#pragma unroll
        for (int s = 0; s < 2; ++s) vf[d0][s] = *(const bf16x8*)(vt + (d0 * 2 + s) * 512);
}
__device__ __forceinline__ void glds16(const void* gsrc, unsigned lds_dst) { unsigned keep;
    asm volatile("s_mov_b32 %0, m0\n\ts_mov_b32 m0, %2\n\ts_nop 0\n\tglobal_load_lds_dwordx4 %1, off\n\ts_mov_b32 m0, %0" : "=&s"(keep) : "v"(gsrc), "s"(lds_dst) : "memory"); }
__device__ __forceinline__ void dma4(const bf16_t* tile, unsigned slot) {
#pragma unroll
    for (int i = 0; i < 4; ++i) glds16(tile + i * 512, slot + i * 1024);
}

struct LaneC { int c32, hi, hc, head, qi0, qi1, tc0, tc1; float slope2; };
__device__ __forceinline__ LaneC lanec(int lane_, int t0, int hkv) {
    int lane = lane_; asm volatile("" : "+v"(lane));
    LaneC L; L.c32 = lane & 31; L.hi = lane >> 5; L.hc = lane & 3; L.head = hkv * 4 + L.hc; L.qi0 = L.c32 >> 2; L.qi1 = 8 + L.qi0; L.tc0 = t0 + L.qi0; L.tc1 = t0 + L.qi1;
    L.slope2 = exp2f(-(float)(L.head + 1)) * LOG2E; return L;
}
__device__ __forceinline__ float gate_of(const bf16_t* U, size_t rowb, int tcol, int head, int which) { return 1.f / (1.f + __expf(-bf2f(U[(rowb + tcol) * UC + C_NG + head * 3 + which]))); }

__device__ __forceinline__ void item(const Params& p, unsigned char* wl, int it, int lane_) {
    const int B_ = it >> 3, w_ = it & 7, x_ = B_ & 7, k_ = (x_ & 1) * 32 + (B_ >> 3), bh = x_ >> 1, qt = (w_ >> 2) ? 511 - (k_ * 4 + (w_ & 3)) : k_ * 4 + (w_ & 3);
    const int b = bh >> 1, hkv = bh & 1, t0 = qt * 16, cur = t0 >> 6;
    const bf16_t* U = (const bf16_t*)(p.ws + WS_U);
    const size_t rowb = (size_t)b * SEQ;
    float* G = (float*)wl; unsigned* selm = (unsigned*)(wl + 16384); unsigned* uni = selm + 64;
    const bf16_t* qf;
    lds_fence();
    {
        const LaneC L = lanec(lane_, t0, hkv);
        bf16_t* ql = (bf16_t*)(wl + 8192) + (lane_ & 63) * 8; qf = ql;
#pragma unroll
        for (int ct = 0; ct < 2; ++ct) {
            const bf16_t* qrow = U + (rowb + (ct ? L.tc1 : L.tc0)) * UC;
#pragma unroll
            for (int d0 = 0; d0 < 4; ++d0) *(bf16x8*)(ql + (ct * 4 + d0) * 512) = *(const bf16x8*)(qrow + C_NQ + L.head * 64 + 16 * d0 + 8 * L.hi);
        }
    }
    f32x16 o[2][2];
#pragma unroll
    for (int ct = 0; ct < 2; ++ct)
#pragma unroll
        for (int d0 = 0; d0 < 2; ++d0) o[ct][d0] = (f32x16){};
    auto nohook = [](int, float*) {};
    lds_fence();
    for (int i = (lane_ & 63); i < 2048; i += 64) ((unsigned*)wl)[i] = 0u;
    for (int i = (lane_ & 63); i < 68; i += 64) selm[i] = 0u;
    lds_fence();
    {
        const LaneC L = lanec(lane_, t0, hkv);
        const int hi = L.hi, c32 = L.c32;
        const bf16_t* KC = (const bf16_t*)(p.ws + WS_KC) + (size_t)(b * 2 + hkv) * 16 * 2048 + (lane_ & 63) * 8;
        const bf16_t* VCt = (const bf16_t*)(p.ws + WS_VC) + (size_t)(b * 2 + hkv) * 16 * 2048 + (lane_ & 63) * 8;
        const int tc[2] = {L.tc0, L.tc1}, qi[2] = {L.qi0, L.qi1};
        int nv[2];
#pragma unroll
        for (int ct = 0; ct < 2; ++ct) nv[ct] = tc[ct] >= 31 ? min((tc[ct] - 31) / 16 + 1, NCMP) : 0;
        const int tl = t0 + 15, nvmax = tl >= 31 ? min((tl - 31) / 16 + 1, NCMP) : 0, ntl = (nvmax + 31) >> 5, nvmin = t0 >= 31 ? min((t0 - 31) / 16 + 1, NCMP) : 0;
        const float sl16 = L.slope2 * 16.f;
        float m[2] = {-30000.f, -30000.f}, l[2] = {0.f, 0.f};
        f32x16 crv;
#pragma unroll
        for (int r = 0; r < 16; ++r) crv[r] = sl16 * (float)NSA_CR(r);
        const bool on2[2] = {true, true};
        bf16x8 kfn[4];
        if (ntl > 0) k_frags(KC, kfn);
#pragma unroll 1
        for (int nt = 0; nt < ntl; ++nt) {
            const int nb = 32 * nt + 4 * hi; const float base = sl16 * (float)nb;
            auto valid = [&](int ct, int r) { return nb + NSA_CR(r) < nv[ct]; };
            bf16x8 kf[4];
#pragma unroll
            for (int d0 = 0; d0 < 4; ++d0) kf[d0] = kfn[d0];
            if (nt + 1 < ntl) k_frags(KC + (nt + 1) * 2048, kfn);
            f32x16 c1;
#pragma unroll
            for (int r = 0; r < 16; ++r) c1[r] = crv[r] + base;
            if (32 * nt + 32 <= nvmin) tile_pass1_f<false>(kf, qf, c1, valid, on2, m, l); else tile_pass1_f<true>(kf, qf, c1, valid, on2, m, l);
        }
        float lmc[2];
#pragma unroll
        for (int ct = 0; ct < 2; ++ct) { const float lt = hsum(l[ct]); lmc[ct] = lt > 0.f ? -__builtin_amdgcn_logf(lt) - m[ct] : -INFINITY; }
        if (ntl > 0) k_frags(KC, kfn);
#pragma unroll 1
        for (int nt = 0; nt < ntl; ++nt) {
            const int nb = 32 * nt + 4 * hi; const float base = sl16 * (float)nb;
            auto valid = [&](int ct, int r) { return nb + NSA_CR(r) < nv[ct]; };
            auto hook = [&](int ct, float* pr) {
#pragma unroll
                for (int k = 0; k < 4; ++k) { float g4 = (pr[4 * k] + pr[4 * k + 1]) + (pr[4 * k + 2] + pr[4 * k + 3]), e = pr[4 * k + 3];
                    g4 += quad_xor1(g4); g4 += quad_xor2(g4); e += quad_xor1(e); e += quad_xor2(e);
                    const int j = 8 * nt + 2 * k + hi;
                    if (L.hc == 0) { atomicAdd(&G[qi[ct] * 128 + j], g4); if (j + 1 < 128) atomicAdd(&G[qi[ct] * 128 + j + 1], e); } } };
            bf16x8 kf[4], vf[2][2];
#pragma unroll
            for (int d0 = 0; d0 < 4; ++d0) kf[d0] = kfn[d0];
            v_frags(VCt + nt * 2048, vf);
            if (nt + 1 < ntl) k_frags(KC + (nt + 1) * 2048, kfn);
            const float lm[2] = {lmc[0] + base, lmc[1] + base};
            u32x4 pb[2][2];
            if (32 * nt + 32 <= nvmin) tile_pass2_p<false, true>(kf, qf, crv, lm, valid, pb, hook); else tile_pass2_p<true, true>(kf, qf, crv, lm, valid, pb, hook);
            tile_pass2_v(vf, pb, o);
        }
        float* AOF = (float*)(p.ws + WS_AOF);
#pragma unroll
        for (int ct = 0; ct < 2; ++ct) { const float gcv = gate_of(U, rowb, tc[ct], L.head, 0); float* orow = AOF + (rowb + tc[ct]) * 512 + L.head * 64 + 4 * hi;
#pragma unroll
            for (int d0 = 0; d0 < 2; ++d0) {
#pragma unroll
                for (int k = 0; k < 4; ++k) *(f32x4*)(orow + 32 * d0 + 8 * k) = (f32x4){o[ct][d0][4 * k] * gcv, o[ct][d0][4 * k + 1] * gcv, o[ct][d0][4 * k + 2] * gcv, o[ct][d0][4 * k + 3] * gcv};
                o[ct][d0] = (f32x16){}; } }
    }
    lds_fence();
    {
        int lane = lane_; asm volatile("" : "+v"(lane));
        unsigned u0 = 0u, u1 = 0u, u2 = 0u, u3 = 0u;
        const int j0 = lane, j1 = lane + 64;
        const bool f0 = (j0 == 0) || (j0 == cur) || (j0 == cur - 1), f1 = (j1 == cur) || (j1 == cur - 1);
        const bool ok0 = j0 <= cur, ok1 = j1 <= cur;
#pragma unroll 1
        for (int q = 0; q < 16; q += 2) {
            unsigned ka0, ka1, kb0, kb1;
            { const float i0 = G[q * 128 + lane], i1 = G[q * 128 + 64 + lane], i2 = G[(q + 1) * 128 + lane], i3 = G[(q + 1) * 128 + 64 + lane];
              ka0 = ok0 ? ((__float_as_uint(i0 + (f0 ? 1e4f : 0.f)) & ~127u) | (unsigned)(127 - j0)) : 0u;
              ka1 = ok1 ? ((__float_as_uint(i1 + (f1 ? 1e4f : 0.f)) & ~127u) | (unsigned)(127 - j1)) : 0u;
              kb0 = ok0 ? ((__float_as_uint(i2 + (f0 ? 1e4f : 0.f)) & ~127u) | (unsigned)(127 - j0)) : 0u;
              kb1 = ok1 ? ((__float_as_uint(i3 + (f1 ? 1e4f : 0.f)) & ~127u) | (unsigned)(127 - j1)) : 0u; }
            unsigned pa = 0u, pb = 0u;
#pragma unroll
            for (int bit = 30; bit >= 0; --bit) {
                const unsigned ca = pa | (1u << bit), cb = pb | (1u << bit);
                const int na = __popcll(__ballot(ka0 >= ca)) + __popcll(__ballot(ka1 >= ca));
                const int nb = __popcll(__ballot(kb0 >= cb)) + __popcll(__ballot(kb1 >= cb));
                pa = na >= 16 ? ca : pa; pb = nb >= 16 ? cb : pb;
            }
            const unsigned long long a0 = __ballot(ok0 && ka0 >= pa), a1 = __ballot(ok1 && ka1 >= pa), b0 = __ballot(ok0 && kb0 >= pb), b1 = __ballot(ok1 && kb1 >= pb);
            if (lane == 0) { selm[q * 4 + 0] = (unsigned)a0; selm[q * 4 + 1] = (unsigned)(a0 >> 32); selm[q * 4 + 2] = (unsigned)a1; selm[q * 4 + 3] = (unsigned)(a1 >> 32);
                selm[q * 4 + 4] = (unsigned)b0; selm[q * 4 + 5] = (unsigned)(b0 >> 32); selm[q * 4 + 6] = (unsigned)b1; selm[q * 4 + 7] = (unsigned)(b1 >> 32); }
            u0 |= (unsigned)a0 | (unsigned)b0; u1 |= (unsigned)(a0 >> 32) | (unsigned)(b0 >> 32); u2 |= (unsigned)a1 | (unsigned)b1; u3 |= (unsigned)(a1 >> 32) | (unsigned)(b1 >> 32);
        }
        if (lane == 0) { uni[0] = u0; uni[1] = u1; uni[2] = u2; uni[3] = u3; }
    }
    lds_fence();
#pragma unroll 1
    for (int br = 0; br < 2; ++br) {
        const LaneC L = lanec(lane_, t0, hkv);
        const int hi = L.hi; const float slope2 = L.slope2;
        const int tc[2] = {L.tc0, L.tc1}, qi[2] = {L.qi0, L.qi1};
        unsigned short* tl = (unsigned short*)(wl + 16896);
        int ntile = 0;
        if (br == 0) {
            const unsigned um0 = __builtin_amdgcn_readfirstlane(uni[0]), um1 = __builtin_amdgcn_readfirstlane(uni[1]), um2 = __builtin_amdgcn_readfirstlane(uni[2]), um3 = __builtin_amdgcn_readfirstlane(uni[3]);
#pragma unroll 1
            for (int j = cur; j >= 0; --j) { const int ws_ = j >> 5; const unsigned uw = ws_ == 0 ? um0 : ws_ == 1 ? um1 : ws_ == 2 ? um2 : um3;
                if ((uw >> (j & 31)) & 1u) { tl[ntile] = (unsigned short)(2 * j); tl[ntile + 1] = (unsigned short)(2 * j + 1); ntile += 2; } }
        } else {
            const int lo_t = (t0 - 511 > 0 ? t0 - 511 : 0) >> 5, hi_t = (t0 + 15) >> 5;
#pragma unroll 1
            for (int kt = hi_t; kt >= lo_t; --kt) { tl[ntile] = (unsigned short)kt; ++ntile; }
        }
        lds_fence();
        const bf16_t* Kb = (const bf16_t*)(p.ws + (br ? WS_KFW : WS_KFS)) + (size_t)(b * 2 + hkv) * 64 * SEQ + (lane_ & 63) * 8;
        static_assert(WS_VFS - WS_KFS == WS_VFW - WS_KFW, "V images sit at one constant distance behind the K images");
        constexpr size_t VOFF = (WS_VFS - WS_KFS) / 2;
        const unsigned slot = (unsigned)__builtin_amdgcn_readfirstlane((unsigned)(uintptr_t)wl);
        const bf16_t* kl = (const bf16_t*)wl + (lane_ & 63) * 8; const bf16_t* vl = (const bf16_t*)(wl + 4096) + (lane_ & 63) * 8;
        float mref[2] = {0.f, 0.f}, l[2] = {0.f, 0.f}; bool ini[2] = {false, false};
        if (ntile > 0) { const int t_ = __builtin_amdgcn_readfirstlane((int)tl[0]); dma4(Kb + (size_t)t_ * 2048, slot); dma4(Kb + (size_t)t_ * 2048 + VOFF, slot + 4096); }
#pragma unroll 1
        for (int idx = 0; idx < ntile; ++idx) {
            const int tile = __builtin_amdgcn_readfirstlane((int)tl[idx]);
            const bool more = idx + 1 < ntile; const int tnext = more ? __builtin_amdgcn_readfirstlane((int)tl[idx + 1]) : 0;
            asm volatile("s_waitcnt vmcnt(4)" ::: "memory");
            bf16x8 kf[4]; k_frags(kl, kf);
            const int tokb = 32 * tile, tb = tokb + 4 * hi; const float base = slope2 * (float)(tb - t0);
            bool sb[2] = {true, true}; bool interior;
            if (br == 0) { const int j = tile >> 1, ws_ = j >> 5, bp = j & 31;
#pragma unroll
                for (int ct = 0; ct < 2; ++ct) sb[ct] = (selm[qi[ct] * 4 + ws_] >> bp) & 1u;
                interior = (j < cur);
            } else interior = (tokb + 31 <= t0 && tokb >= t0 + 15 - 511);
            const int wlo = br ? 511 : (1 << 30);
            auto valid = [&](int ct, int r) { const int tok = tb + NSA_CR(r); return tok <= tc[ct] && tok >= tc[ct] - wlo; };
            asm volatile("s_waitcnt lgkmcnt(0)" ::: "memory");
            if (more) dma4(Kb + (size_t)tnext * 2048, slot);
            u32x4 pb[2][2];
            if (interior) tile_online_p<false>(kf, qf, slope2, base, sb, valid, mref, ini, l, o, pb); else tile_online_p<true>(kf, qf, slope2, base, sb, valid, mref, ini, l, o, pb);
            if (more) asm volatile("s_waitcnt vmcnt(4)" ::: "memory"); else asm volatile("s_waitcnt vmcnt(0)" ::: "memory");
            bf16x8 vf[2][2]; v_frags(vl, vf);
            asm volatile("s_waitcnt lgkmcnt(0)" ::: "memory");
            if (more) dma4(Kb + (size_t)tnext * 2048 + VOFF, slot + 4096);
            tile_pass2_v(vf, pb, o);
        }
        {
            float* AOF = (float*)(p.ws + WS_AOF); bf16_t* AO = (bf16_t*)(p.ws + WS_AO);
#pragma unroll
            for (int ct = 0; ct < 2; ++ct) { const float lt = hsum(l[ct]); const float cw = lt > 0.f ? gate_of(U, rowb, tc[ct], L.head, 1 + br) / lt : 0.f;
                float* frow = AOF + (rowb + tc[ct]) * 512 + L.head * 64 + 4 * hi; bf16_t* orow = AO + (rowb + tc[ct]) * DM + 512 + L.head * 64 + 4 * hi;
#pragma unroll
                for (int d0 = 0; d0 < 2; ++d0) {
#pragma unroll
                    for (int k = 0; k < 4; ++k) { const f32x4 a = *(const f32x4*)(frow + 32 * d0 + 8 * k);
                        const f32x4 v = {a[0] + cw * o[ct][d0][4 * k], a[1] + cw * o[ct][d0][4 * k + 1], a[2] + cw * o[ct][d0][4 * k + 2], a[3] + cw * o[ct][d0][4 * k + 3]};
                        if (br == 0) *(f32x4*)(frow + 32 * d0 + 8 * k) = v;
                        else { u32x2 w2; w2.x = cvtpk(v[0], v[1]); w2.y = cvtpk(v[2], v[3]); *(u32x2*)(orow + 32 * d0 + 8 * k) = w2; } }
                    o[ct][d0] = (f32x16){}; } }
        }
        lds_fence();
    }
}
#undef NSA_CR
}

__device__ __forceinline__ float diff_lambda(const Params& p, int lane) {
    const float a = p.in[9][lane] * p.in[10][lane], c = p.in[11][lane] * p.in[12][lane];
    return __expf(wave_sum(a)) - __expf(wave_sum(c)) + 0.2f;
}
__device__ __forceinline__ void diffc_rows8(const Params& p, int row0, int lane, float lam) {
    const int h = lane >> 4, l16 = lane & 15;
    const bf16_t* oc = (const bf16_t*)(p.ws + WS_OC) + ((size_t)row0 * 4 + h) * 256 + 8 * l16;
    bf16_t* ao = (bf16_t*)(p.ws + WS_AO) + (size_t)row0 * DM + h * 128 + 8 * l16;
    const f32x4 g0 = *(const f32x4*)(p.in[13] + 8 * l16), g1 = *(const f32x4*)(p.in[13] + 8 * l16 + 4);
    const float g[8] = {g0.x * 0.8f, g0.y * 0.8f, g0.z * 0.8f, g0.w * 0.8f, g1.x * 0.8f, g1.y * 0.8f, g1.z * 0.8f, g1.w * 0.8f};
    u32x4 a[8], c[8];
#pragma unroll
    for (int i = 0; i < 8; ++i) { a[i] = *(const u32x4*)(oc + (size_t)i * 1024); c[i] = *(const u32x4*)(oc + (size_t)i * 1024 + 128); }
#pragma unroll
    for (int i = 0; i < 8; ++i) { float x[8], y[8]; unpack8(a[i], x); unpack8(c[i], y); float ss = 0.f;
#pragma unroll
        for (int e = 0; e < 8; ++e) { x[e] -= lam * y[e]; ss += x[e] * x[e]; }
        ss += nsa::quad_xor1(ss); ss += nsa::quad_xor2(ss);
        ss += __int_as_float(__builtin_amdgcn_update_dpp(0, __float_as_int(ss), 0x141, 0xf, 0xf, true));
        ss += __int_as_float(__builtin_amdgcn_update_dpp(0, __float_as_int(ss), 0x140, 0xf, 0xf, true));
        const float rstd = rsqrtf(ss * (1.f / 128.f) + 1e-6f);
        u32x4 o; o.x = pk2(x[0] * rstd * g[0], x[1] * rstd * g[1]); o.y = pk2(x[2] * rstd * g[2], x[3] * rstd * g[3]); o.z = pk2(x[4] * rstd * g[4], x[5] * rstd * g[5]); o.w = pk2(x[6] * rstd * g[6], x[7] * rstd * g[7]);
        *(u32x4*)(ao + (size_t)i * DM) = o; }
}

__device__ __forceinline__ void stage4(const Params& p, unsigned char* smem) {
    const int tid = opaque_tid(), wid = tid >> 6, lane = tid & 63;
    const int gw = blockIdx.x * NW + wid, NGW = gridDim.x * NW;
    for (int it = gw; it < 2048; it += NGW) nsa::item(p, smem + wid * nsa::WL_BYTES, it, lane);
    const float lam = diff_lambda(p, lane);
    for (int it = gw; it < M / 8; it += NGW) diffc_rows8(p, it * 8, lane, lam);
}

__device__ __forceinline__ void stage5(const Params& p, unsigned char* smem) {
    pg8::Gemm g{(const bf16_t*)(p.ws + WS_AO), DM};
    pg8::StaticOrder S; S.init(M, DM, gridDim.x, blockIdx.x, (const bf16_t*)(p.ws + WS_WTOUT));
    EpiBf16Out E{(bf16_t*)(p.ws + WS_MIX), DM, 0, 1.f, nullptr};
    pg8::gemm_phase((PG8_LAS unsigned char*)smem, g, S, E);
}

__device__ __forceinline__ void stage6(const Params& p, unsigned char* smem) {
    int tid_ = threadIdx.x; asm volatile("" : "+v"(tid_));
    const int tid = tid_, wid = tid >> 6, lane = tid & 63;
    const float* mod = (const float*)(p.ws + WS_MOD); const bf16_t* mix = (const bf16_t*)(p.ws + WS_MIX); const bf16x8* wrh = (const bf16x8*)(p.ws + WS_WR); const bf16x8* wrl = wrh + 1024 * 80 / 8;
    bf16_t* h2 = (bf16_t*)(p.ws + WS_H2); bf16_t* x1b = (bf16_t*)(p.ws + WS_MIX);
    int* cnt = (int*)(p.ws + WS_CTL) + CTL_CNT; int* toke = (int*)(p.ws + WS_TOKE); int* tokp = (int*)(p.ws + WS_TOKP); float* tokw = (float*)(p.ws + WS_TOKW);
    float* hq = (float*)smem;
    float* part = (float*)(smem + 65792);
    float* lgs = (float*)(smem + 65792 + 40960);
    for (int chunk = blockIdx.x; chunk < M / 64; chunk += gridDim.x) {
        const int row0 = chunk * 64, b = row0 / SEQ; const float* mb = mod + b * 6144;
        f32x4 ggt[4], gsc[4], shv[4];
#pragma unroll
        for (int j = 0; j < 4; ++j) { const int col = lane * 4 + 256 * j;
            ggt[j] = *(const f32x4*)(p.in[5] + col) * *(const f32x4*)(mb + 2048 + col);
            gsc[j] = *(const f32x4*)(p.in[6] + col) * (*(const f32x4*)(mb + 4096 + col) + 1.f);
            shv[j] = *(const f32x4*)(mb + 3072 + col); }
        u32x2 pm[2][4]; f32x4 px[2][4];
#define S6_LOAD(T) { _Pragma("unroll") for (int rr = 0; rr < 2; ++rr) { const size_t ro = (size_t)(row0 + 16 * (T) + 2 * wid + rr) * DM + lane * 4; \
            _Pragma("unroll") for (int j = 0; j < 4; ++j) { pm[rr][j] = __builtin_nontemporal_load((const u32x2*)(mix + ro + 256 * j)); px[rr][j] = __builtin_nontemporal_load((const f32x4*)(p.in[0] + ro + 256 * j)); } } }
        S6_LOAD(0)
#pragma unroll 1
        for (int t = 0; t < 4; ++t) {
#pragma unroll
            for (int rr = 0; rr < 2; ++rr) {
                const int lr = 2 * wid + rr, row = row0 + 16 * t + lr;
                f32x4 v[4], x1[4]; float ss = 0.f;
#pragma unroll
                for (int j = 0; j < 4; ++j) { const u32x2 mw = pm[rr][j];
                    v[j] = (f32x4){__uint_as_float(mw.x << 16), __uint_as_float(mw.x & 0xffff0000u), __uint_as_float(mw.y << 16), __uint_as_float(mw.y & 0xffff0000u)};
                    ss += v[j].x * v[j].x + v[j].y * v[j].y + v[j].z * v[j].z + v[j].w * v[j].w; }
                const float rstd = rsqrtf(wave_sum(ss) * (1.f / DM) + 1e-6f); float s2 = 0.f;
#pragma unroll
                for (int j = 0; j < 4; ++j) { const int col = lane * 4 + 256 * j;
                    x1[j] = px[rr][j] + ggt[j] * (v[j] * rstd);
                    { u32x2 xo; xo.x = pk2(x1[j].x, x1[j].y); xo.y = pk2(x1[j].z, x1[j].w); __builtin_nontemporal_store(xo, (u32x2*)(x1b + (size_t)row * DM + col)); }
                    s2 += x1[j].x * x1[j].x + x1[j].y * x1[j].y + x1[j].z * x1[j].z + x1[j].w * x1[j].w; }
                const float rstd2 = rsqrtf(wave_sum(s2) * (1.f / DM) + 1e-6f);
#pragma unroll
                for (int j = 0; j < 4; ++j) { const int col = lane * 4 + 256 * j;
                    const f32x4 h = x1[j] * rstd2 * gsc[j] + shv[j];
                    *(f32x4*)(hq + lr * 1028 + col) = h;
                    u32x2 o; o.x = pk2(h.x, h.y); o.y = pk2(h.z, h.w); *(u32x2*)(h2 + (size_t)row * DM + col) = o; }
            }
            if (t < 3) S6_LOAD(t + 1)
            __syncthreads();
            {
                const int r = lane & 15, q = lane >> 4;
                f32x4 acc[5];
#pragma unroll
                for (int j = 0; j < 5; ++j) acc[j] = (f32x4){0.f, 0.f, 0.f, 0.f};
#pragma unroll 2
                for (int s = 0; s < 4; ++s) {
                    const f32x4 a0 = *(const f32x4*)(hq + r * 1028 + 128 * wid + 32 * s + 8 * q), a1 = *(const f32x4*)(hq + r * 1028 + 128 * wid + 32 * s + 8 * q + 4);
                    u32x4 ahw, alw;
                    { const unsigned h0 = pk2(a0.x, a0.y), h1 = pk2(a0.z, a0.w), h2_ = pk2(a1.x, a1.y), h3 = pk2(a1.z, a1.w);
                      ahw = (u32x4){h0, h1, h2_, h3};
                      alw.x = pk2(a0.x - __uint_as_float(h0 << 16), a0.y - __uint_as_float(h0 & 0xffff0000u)); alw.y = pk2(a0.z - __uint_as_float(h1 << 16), a0.w - __uint_as_float(h1 & 0xffff0000u));
                      alw.z = pk2(a1.x - __uint_as_float(h2_ << 16), a1.y - __uint_as_float(h2_ & 0xffff0000u)); alw.w = pk2(a1.z - __uint_as_float(h3 << 16), a1.w - __uint_as_float(h3 & 0xffff0000u)); }
                    const bf16x8 ah = __builtin_bit_cast(bf16x8, ahw), al = __builtin_bit_cast(bf16x8, alw);
                    bf16x8 bh[5], bl[5];
#pragma unroll
                    for (int j = 0; j < 5; ++j) { bh[j] = wrh[((wid * 4 + s) * 5 + j) * 64 + lane]; bl[j] = wrl[((wid * 4 + s) * 5 + j) * 64 + lane]; }
#pragma unroll
                    for (int j = 0; j < 5; ++j) { acc[j] = __builtin_amdgcn_mfma_f32_16x16x32_bf16(ah, bh[j], acc[j], 0, 0, 0);
                        acc[j] = __builtin_amdgcn_mfma_f32_16x16x32_bf16(ah, bl[j], acc[j], 0, 0, 0); acc[j] = __builtin_amdgcn_mfma_f32_16x16x32_bf16(al, bh[j], acc[j], 0, 0, 0); }
                }
#pragma unroll
                for (int j = 0; j < 5; ++j)
#pragma unroll
                    for (int i = 0; i < 4; ++i) part[(wid * 16 + 4 * q + i) * 80 + 16 * j + r] = acc[j][i];
            }
            __syncthreads();
            for (int idx = tid; idx < 1280; idx += NT) { float s = 0.f;
#pragma unroll
                for (int w = 0; w < 8; ++w) s += part[w * 1280 + idx];
                lgs[t * 1280 + idx] = s; }
        }
#undef S6_LOAD
        __syncthreads();
        if (tid < 64) { const int t = row0 + tid; const float* lg = lgs + tid * 80;
            float best = -3e38f; int grp = 0; float l8[8];
#pragma unroll
            for (int i = 0; i < 8; ++i) { l8[i] = lg[64 + i] + p.in[22][i]; if (l8[i] > best) { best = l8[i]; grp = i; } }
            float den = 0.f;
#pragma unroll
            for (int i = 0; i < 8; ++i) den += __expf(l8[i] - best);
            const float pg = 1.f / den;
            float v1 = -3e38f, v2 = -3e38f; int i1 = 0, i2 = 0;
#pragma unroll
            for (int i = 0; i < 8; ++i) { const float v = lg[grp * 8 + i] + p.in[24][grp * 8 + i];
                if (v > v1) { v2 = v1; i2 = i1; v1 = v; i1 = i; } else if (v > v2) { v2 = v; i2 = i; } }
            const float e2 = __expf(v2 - v1), w1 = pg / (1.f + e2), w2 = pg * e2 / (1.f + e2);
            const int ea = grp * 8 + i1, eb = grp * 8 + i2;
            const int xg = chunk & 7;
            const int pa = atomicAdd(&cnt[(xg * 64 + ea) * 16], 1), pb = atomicAdd(&cnt[(xg * 64 + eb) * 16], 1);
            toke[t * 2] = ea; toke[t * 2 + 1] = eb; tokp[t * 2] = pa; tokp[t * 2 + 1] = pb; tokw[t * 2] = w1; tokw[t * 2 + 1] = w2;
            int* elist = (int*)(p.ws + WS_ELIST); elist[ea * 16384 + xg * 2048 + pa] = t; elist[eb * 16384 + xg * 2048 + pb] = t; }
        __syncthreads();
    }
}

__device__ __forceinline__ void expert_bases(const Params& p, int* lb) {
    const int* cntg = (const int*)(p.ws + WS_CTL) + CTL_CNT;
    __syncthreads();
    if (threadIdx.x < 64) {
        const int e = threadIdx.x; int c8[8];
#pragma unroll
        for (int x = 0; x < 8; ++x) c8[x] = cntg[(x * 64 + e) * 16];
        int cnt = 0;
#pragma unroll
        for (int x = 0; x < 8; ++x) { lb[832 + e * 8 + x] = cnt; cnt += c8[x]; }
        lb[768 + e] = cnt;
        const int pad = (cnt + 255) >> 8; int incl = pad;
#pragma unroll
        for (int d = 1; d < 64; d <<= 1) { const int t = __shfl_up(incl, d); if (e >= d) incl += t; }
        const int tb = incl - pad;
        lb[e] = tb * 256;
        if (e == 63) lb[64] = incl;
        for (int t = 0; t < pad; ++t) { lb[128 + tb + t] = e; lb[320 + tb + t] = (cnt - t * 256) <= 128 ? 1 : 0; }
    }
    __syncthreads();
    if (threadIdx.x < 64) {
        const int lane = threadIdx.x, nt = lb[64];
        unsigned long long bf[3], bh[3]; bool hf[3], ok[3];
#pragma unroll
        for (int c = 0; c < 3; ++c) { const int tile = 64 * c + lane; ok[c] = tile < nt; hf[c] = ok[c] && lb[320 + tile] != 0; bh[c] = __ballot(hf[c]); bf[c] = __ballot(ok[c] && !hf[c]); }
        const int nfull = __popcll(bf[0]) + __popcll(bf[1]) + __popcll(bf[2]);
        const unsigned long long lt = (1ull << lane) - 1ull;
        int fb = 0, hb = 0;
#pragma unroll
        for (int c = 0; c < 3; ++c) { if (ok[c]) lb[512 + (hf[c] ? nfull + hb + __popcll(bh[c] & lt) : fb + __popcll(bf[c] & lt))] = 64 * c + lane;
            fb += __popcll(bf[c]); hb += __popcll(bh[c]); }
    }
    __syncthreads();
}
__device__ __forceinline__ int xcd_major_id() { const int G = gridDim.x, c = blockIdx.x; return (G % 8 == 0) ? (c % 8) * (G / 8) + c / 8 : c; }
struct MoeOrder {
    int ntiles, nN, G, c; const int* lb; const char* wbase; size_t estride; const int* elist; const int* cnt;
    unsigned* sig;
    unsigned* wait;
    const int* tokt;
    __device__ __forceinline__ bool next(int i, pg8::Unit& u) const {
        const int L = i * G + c; if (L >= ntiles * nN) return false;
        u.pm = lb[512 + L / nN]; u.pn = L % nN; const int e = lb[128 + u.pm]; u.bbase = wbase + (size_t)e * estride;
        u.half = lb[320 + u.pm]; u.slot = i; return true; }
    __device__ __forceinline__ unsigned arow(const pg8::Unit& u, int r) const {
        if (tokt) return (unsigned)tokt[u.slot * 256 + r];
        if (elist) { const int e = lb[128 + u.pm], off = u.pm * 256 - lb[e] + r;
            if (off >= lb[768 + e]) return 0u;
            int x = 0;
#pragma unroll
            for (int i = 1; i < 8; ++i) x += (off >= lb[832 + e * 8 + i]) ? 1 : 0;
            return (unsigned)elist[e * 16384 + x * 2048 + (off - lb[832 + e * 8 + x])]; }
        return (unsigned)(u.pm * 256 + r); }
    __device__ __forceinline__ void a_ready(const pg8::Unit& u) const {
        if (!wait) return;
        unsigned sp = 0;
        while (__hip_atomic_load(wait + u.pm, __ATOMIC_RELAXED, __HIP_MEMORY_SCOPE_AGENT) < 4u) { __builtin_amdgcn_s_sleep(2); if (++sp > (1u << 22)) break; }
        __builtin_amdgcn_fence(__ATOMIC_ACQUIRE, "agent");
    }
    __device__ __forceinline__ void done(const pg8::Unit& u) const {
        if (!sig) return;
        asm volatile("s_waitcnt vmcnt(0)" ::: "memory");
        __builtin_amdgcn_s_barrier();
        if (threadIdx.x == 0) { __builtin_amdgcn_fence(__ATOMIC_RELEASE, "agent"); asm volatile("s_waitcnt vmcnt(0)" ::: "memory");
            (void)__hip_atomic_fetch_add(sig + u.pm, 1u, __ATOMIC_RELAXED, __HIP_MEMORY_SCOPE_AGENT); }
    }
};

struct EpiGateUp {
    static constexpr bool PERM = true;
    bf16_t* O;
    __device__ __forceinline__ void operator()(const f32x4 (&acc)[2][2][4][2], const pg8::Unit& u, int wr, int wc, int fr, int fq) const {
        const int row0 = u.pm * 256 + wr * 64 + fr, col0 = (u.pn * 256 + wc * 32 + 8 * fq) / 2;
#pragma unroll
        for (int ai = 0; ai < 2; ++ai) { if (ai == 1 && u.half) break;
#pragma unroll
            for (int m = 0; m < 4; ++m) { bf16_t* rowp = O + (size_t)(row0 + ai * 128 + m * 16) * 512 + col0;
#pragma unroll
                for (int bj = 0; bj < 2; ++bj) { const f32x4 v0 = acc[ai][bj][m][0], v1 = acc[ai][bj][m][1];
                    u32x2 w; w.x = pg8::cvt_pk_bf16(silu_f(v0[0]) * v0[1], silu_f(v0[2]) * v0[3]); w.y = pg8::cvt_pk_bf16(silu_f(v1[0]) * v1[1], silu_f(v1[2]) * v1[3]);
                    *(u32x2*)(rowp + bj * 64) = w; } } }
    }
};
__device__ __forceinline__ void stage10(const Params& p, unsigned char* smem) {
    int* lb = (int*)(smem + 131072); expert_bases(p, lb);
    pg8::Gemm g{(const bf16_t*)(p.ws + WS_H2), DM};
    MoeOrder S{lb[64], 4, (int)gridDim.x, xcd_major_id(), lb, (const char*)(p.ws + WS_WTGU), (size_t)1024 * 1024 * 2, (const int*)(p.ws + WS_ELIST), (const int*)(p.ws + WS_CTL), nullptr, nullptr, nullptr};
    { int* tokt = lb + 1408; const int tid_ = opaque_tid();
      for (int idx = tid_; idx < 768; idx += NT) { pg8::Unit u_; if (S.next(idx >> 8, u_)) tokt[idx] = (int)S.arow(u_, idx & 255); }
      __syncthreads(); S.tokt = tokt; }
    EpiGateUp E{(bf16_t*)(p.ws + WS_HID)};
    pg8::gemm_phase((PG8_LAS unsigned char*)smem, g, S, E);
}

__device__ __forceinline__ void stage11(const Params& p, unsigned char* smem) {
    int* lb = (int*)(smem + 131072); expert_bases(p, lb);
    pg8::Gemm g{(const bf16_t*)(p.ws + WS_HID), 512};
    MoeOrder S{lb[64], 4, (int)gridDim.x, xcd_major_id(), lb, (const char*)(p.ws + WS_WTDN), (size_t)1024 * 512 * 2, nullptr, (const int*)(p.ws + WS_CTL), nullptr, nullptr, nullptr};
    EpiBf16Out E{(bf16_t*)(p.ws + WS_Y), DM, 0, 1.f, nullptr};
    pg8::gemm_phase((PG8_LAS unsigned char*)smem, g, S, E);
}

__device__ __forceinline__ void stage12(const Params& p, unsigned char* smem) {
    int* lb = (int*)(smem + 131072); expert_bases(p, lb);
    const int tid = opaque_tid(), wid = tid >> 6, lane = tid & 63;
    const float* mod = (const float*)(p.ws + WS_MOD); const bf16_t* Y = (const bf16_t*)(p.ws + WS_Y); const bf16_t* X1 = (const bf16_t*)(p.ws + WS_MIX);
    const int* toke = (const int*)(p.ws + WS_TOKE); const int* tokp = (const int*)(p.ws + WS_TOKP); const float* tokw = (const float*)(p.ws + WS_TOKW);
    for (int rg = blockIdx.x * NW + wid; rg < M / 8; rg += gridDim.x * NW) {
        const int rowb = rg * 8, b = rowb / SEQ, xg = (rowb >> 6) & 7;
        int yr = 0; float tw = 0.f;
        if (lane < 16) { const int te = toke[rowb * 2 + lane]; yr = lb[te] + lb[832 + te * 8 + xg] + tokp[rowb * 2 + lane]; tw = tokw[rowb * 2 + lane]; }
        f32x4 ggt[2][2];
#pragma unroll
        for (int j = 0; j < 2; ++j)
#pragma unroll
            for (int h = 0; h < 2; ++h) { const int col = lane * 8 + 512 * j + 4 * h; ggt[j][h] = *(const f32x4*)(p.in[7] + col) * *(const f32x4*)(mod + b * 6144 + 5120 + col); }
        u32x4 ya[2][2], yb[2][2], xv[2][2];
#define S12_LOAD(I, BF) { const int r0 = __builtin_amdgcn_readlane(yr, 2 * (I)), r1 = __builtin_amdgcn_readlane(yr, 2 * (I) + 1); \
            _Pragma("unroll") for (int j = 0; j < 2; ++j) { const int col = lane * 8 + 512 * j; \
                ya[BF][j] = __builtin_nontemporal_load((const u32x4*)(Y + (size_t)r0 * DM + col)); yb[BF][j] = __builtin_nontemporal_load((const u32x4*)(Y + (size_t)r1 * DM + col)); \
                xv[BF][j] = __builtin_nontemporal_load((const u32x4*)(X1 + (size_t)(rowb + (I)) * DM + col)); } }
        S12_LOAD(0, 0)
#pragma unroll
        for (int i = 0; i < 8; ++i) {
            if (i + 1 < 8) { if ((i + 1) & 1) S12_LOAD(i + 1, 1) else S12_LOAD(i + 1, 0) }
            const float w0 = __int_as_float(__builtin_amdgcn_readlane(__float_as_int(tw), 2 * i)), w1 = __int_as_float(__builtin_amdgcn_readlane(__float_as_int(tw), 2 * i + 1));
            float f[2][8], xf[2][8]; float ss = 0.f;
#pragma unroll
            for (int j = 0; j < 2; ++j) { float a[8], c[8]; unpack8(ya[i & 1][j], a); unpack8(yb[i & 1][j], c); unpack8(xv[i & 1][j], xf[j]);
#pragma unroll
                for (int e = 0; e < 8; ++e) { f[j][e] = a[e] * w0 + c[e] * w1; ss += f[j][e] * f[j][e]; } }
            const float rstd = rsqrtf(wave_sum(ss) * (1.f / DM) + 1e-6f);
#pragma unroll
            for (int j = 0; j < 2; ++j)
#pragma unroll
                for (int h = 0; h < 2; ++h) { const int col = lane * 8 + 512 * j + 4 * h;
                    const f32x4 fv = {f[j][4 * h], f[j][4 * h + 1], f[j][4 * h + 2], f[j][4 * h + 3]};
                    const f32x4 xq = {xf[j][4 * h], xf[j][4 * h + 1], xf[j][4 * h + 2], xf[j][4 * h + 3]};
                    __builtin_nontemporal_store(xq + ggt[j][h] * (fv * rstd), (f32x4*)(p.out + (size_t)(rowb + i) * DM + col)); }
        }
#undef S12_LOAD
    }
}

#define GAS __attribute__((address_space(1)))
#define LAS __attribute__((address_space(3)))
#define XB_TMO      128
#define XB_XCNT(j)  (256  + 64 * (j))
#define XB_XSUB(j)  (1280 + 64 * (j))
#define XB_XGEN(j)  (2304 + 64 * (j))
#define XB_TOP      3328
#define XB_TOPGEN   3392
#define XCD_BAR_WORDS 3456
#define XB_SPIN_CAP (1u << 18)
__device__ __forceinline__ unsigned xb_ld(unsigned* p)              { return __hip_atomic_load(p, __ATOMIC_RELAXED, __HIP_MEMORY_SCOPE_AGENT); }
__device__ __forceinline__ unsigned xb_add(unsigned* p, unsigned v) { return __hip_atomic_fetch_add(p, v, __ATOMIC_RELAXED, __HIP_MEMORY_SCOPE_AGENT); }
__device__ __forceinline__ unsigned xb_xcc_id() { return (unsigned)__builtin_amdgcn_s_getreg((3 << 11) | 20) & 0xFu; }
#define XB_SPIN(cond, bar) do { unsigned _sp = 0; while (cond) { __builtin_amdgcn_s_sleep(1); \
    if ((++_sp & 255u) == 0u) { if (xb_ld(&(bar)[XB_TMO])) break; if (_sp > XB_SPIN_CAP) { atomicAdd(&(bar)[XB_TMO], 1u); break; } } } } while (0)
struct XcdBarrier { unsigned* bar; unsigned x; volatile LAS unsigned* st; };
__device__ __forceinline__ XcdBarrier xcd_barrier_post(unsigned* bar, volatile LAS unsigned* st) {
    XcdBarrier b; b.bar = bar; b.x = xb_xcc_id(); b.st = st;
    if (threadIdx.x == 0) (void)xb_add(&bar[XB_XCNT(b.x)], 1u);
    return b;
}
__device__ __forceinline__ void xcd_barrier_complete(unsigned* bar, unsigned x, unsigned& nloc, unsigned& nx) {
    const unsigned G = gridDim.x * gridDim.y * gridDim.z;
    unsigned sum, cnt, mine, sp = 0u;
    for (;;) {
        sum = 0u; cnt = 0u; mine = 0u;
#pragma unroll
        for (unsigned j = 0; j < 16; ++j) { const unsigned c = xb_ld(&bar[XB_XCNT(j)]); sum += c; cnt += (c > 0u) ? 1u : 0u; mine = (j == x) ? c : mine; }
        if (sum == G) break;
        __builtin_amdgcn_s_sleep(1);
        if ((++sp & 255u) == 0u) { if (xb_ld(&bar[XB_TMO])) break; if (sp > XB_SPIN_CAP) { atomicAdd(&bar[XB_TMO], 1u); break; } }
    }
    nloc = mine > 0u ? mine : 1u; nx = cnt > 0u ? cnt : 1u;
}
__device__ __forceinline__ void xcd_barrier(const XcdBarrier& b) {
    asm volatile("s_waitcnt vmcnt(0)" ::: "memory");
    __syncthreads();
    if (threadIdx.x == 0) {
        unsigned* bar = b.bar;
        __builtin_amdgcn_s_waitcnt(0);
        unsigned nloc = b.st[0], nx = b.st[1];
        if (nloc == 0u) { xcd_barrier_complete(bar, b.x, nloc, nx); b.st[0] = nloc; b.st[1] = nx; }
        const unsigned old = xb_add(&bar[XB_XSUB(b.x)], 1u);
        const unsigned gen = old / nloc;
        if (old + 1u == (gen + 1u) * nloc) {
            __builtin_amdgcn_fence(__ATOMIC_RELEASE, "agent");
            asm volatile("s_waitcnt vmcnt(0)" ::: "memory");
            const unsigned og = xb_add(&bar[XB_TOP], 1u);
            const unsigned tg = og / nx;
            if (og + 1u == (tg + 1u) * nx) xb_add(&bar[XB_TOPGEN], 1u);
            else XB_SPIN(xb_ld(&bar[XB_TOPGEN]) == tg, bar);
            __builtin_amdgcn_fence(__ATOMIC_ACQUIRE, "agent");
            xb_add(&bar[XB_XGEN(b.x)], 1u);
            asm volatile("s_waitcnt vmcnt(0)" ::: "memory");
        } else {
            XB_SPIN(xb_ld(&bar[XB_XGEN(b.x)]) == gen, bar);
            __builtin_amdgcn_fence(__ATOMIC_ACQUIRE, "agent");
            asm volatile("s_waitcnt vmcnt(0)" ::: "memory");
        }
    }
    __syncthreads();
}

__device__ __forceinline__ void ctr_barrier(unsigned* base, unsigned epoch) {
    asm volatile("s_waitcnt vmcnt(0)" ::: "memory");
    __syncthreads();
    if (threadIdx.x == 0) {
        __builtin_amdgcn_fence(__ATOMIC_RELEASE, "agent");
        asm volatile("s_waitcnt vmcnt(0)" ::: "memory");
        const unsigned G = gridDim.x, ngrp = (G % 8u == 0u) ? 8u : 1u, g = blockIdx.x % ngrp, per = G / ngrp;
        unsigned* sub = base + 64u * g; unsigned* gen = base + 64u * (8u + g); unsigned* top = base + 64u * 16u;
        const unsigned old = __hip_atomic_fetch_add(sub, 1u, __ATOMIC_RELAXED, __HIP_MEMORY_SCOPE_AGENT);
        if (old + 1u == epoch * per) {
            const unsigned ot = __hip_atomic_fetch_add(top, 1u, __ATOMIC_RELAXED, __HIP_MEMORY_SCOPE_AGENT);
            if (ot + 1u == epoch * ngrp) { for (unsigned j = 0; j < ngrp; ++j) __hip_atomic_store(base + 64u * (8u + j), epoch, __ATOMIC_RELAXED, __HIP_MEMORY_SCOPE_AGENT); }
        }
        unsigned sp = 0;
        while (__hip_atomic_load(gen, __ATOMIC_RELAXED, __HIP_MEMORY_SCOPE_AGENT) < epoch) { __builtin_amdgcn_s_sleep(1); if (++sp > (1u << 22)) break; }
        __builtin_amdgcn_fence(__ATOMIC_ACQUIRE, "agent");
        asm volatile("s_waitcnt vmcnt(0)" ::: "memory");
    }
    __syncthreads();
}
constexpr int NSTAGE = 13;
template <int S> __device__ __forceinline__ void run_stage(const Params& p, unsigned char* smem) {
    if constexpr (S == 0) stage0(p, smem);
    else if constexpr (S == 1) stage1(p, (int)blockIdx.x, (int)gridDim.x);
    else if constexpr (S == 2) stage2(p, smem);
    else if constexpr (S == 3) stage3(p, smem);
    else if constexpr (S == 4) stage4(p, smem);
    else if constexpr (S == 5) stage5(p, smem);
    else if constexpr (S == 6) stage6(p, smem);
    else if constexpr (S == 10) stage10(p, smem);
    else if constexpr (S == 11) stage11(p, smem);
    else if constexpr (S == 12) stage12(p, smem);
}
typedef const __attribute__((address_space(4))) Params* KParams;
template <int S> __device__ __forceinline__ void run_stage_k(unsigned char* smem) {
    KParams kp = (KParams)__builtin_amdgcn_kernarg_segment_ptr();
    asm volatile("" : "+s"(kp));
    Params lp;
#pragma unroll
    for (int i = 0; i < 28; ++i) lp.in[i] = kp->in[i];
    lp.out = kp->out; lp.ws = kp->ws;
    run_stage<S>(lp, smem);
}
#if MK_FUSED
constexpr int CTL_BAR_WORD = 4096;
constexpr int CTL_ZERO_BYTES = 65536 + 49152;
__global__ void __launch_bounds__(NT, 2) mk(Params p) {
    extern __shared__ __attribute__((aligned(16))) unsigned char smem[];
#define CTR() ((unsigned*)(((KParams)__builtin_amdgcn_kernarg_segment_ptr())->ws + WS_CTL) + CTL_BAR_WORD)
    run_stage_k<0>(smem); ctr_barrier(CTR(), 1u);
    run_stage_k<2>(smem); ctr_barrier(CTR(), 2u);
    run_stage_k<3>(smem); ctr_barrier(CTR(), 3u);
    run_stage_k<4>(smem); ctr_barrier(CTR(), 4u);
    run_stage_k<5>(smem); ctr_barrier(CTR(), 5u);
    run_stage_k<6>(smem); ctr_barrier(CTR(), 6u);
    run_stage_k<10>(smem); ctr_barrier(CTR(), 7u);
    run_stage_k<11>(smem); ctr_barrier(CTR(), 8u);
    run_stage_k<12>(smem);
#undef CTR
}
#else
template <int S> __global__ void __launch_bounds__(NT, 2) mk1(Params p) {
    extern __shared__ __attribute__((aligned(16))) unsigned char smem[];
    run_stage<S>(p, smem);
}
template <int S> static void launch_stage(const Params& p, int cus, hipStream_t stream) {
    static int grid = 0;
    if (grid == 0) { int per_cu = 0;
        (void)hipFuncSetAttribute((const void*)mk1<S>, hipFuncAttributeMaxDynamicSharedMemorySize, LDS_BYTES);
        (void)hipOccupancyMaxActiveBlocksPerMultiprocessor(&per_cu, (const void*)mk1<S>, NT, LDS_BYTES);
        if (per_cu < 1) per_cu = 1;
        grid = cus * per_cu; (void)hipGetLastError(); }
    hipLaunchKernelGGL(mk1<S>, dim3(grid), dim3(NT), LDS_BYTES, stream, p);
}
#endif

extern "C" void kernel_launch(void* const* d_in, const int* in_sizes, int n_in, void* d_out, int out_size, void* d_ws, size_t ws_size, hipStream_t stream) {
    static int grid = 0, cus = 0;
    if (grid == 0) {
        if (n_in != 28 || out_size != M * DM || ws_size < WS_END) { fprintf(stderr, "kernel_launch: unexpected shapes (n_in %d out %d ws %zu)\n", n_in, out_size, ws_size); grid = -1; return; }
        int dev = 0;
        (void)hipGetDevice(&dev); (void)hipDeviceGetAttribute(&cus, hipDeviceAttributeMultiprocessorCount, dev);
        grid = cus;
#if MK_FUSED
        int per_cu = 0;
        (void)hipFuncSetAttribute((const void*)mk, hipFuncAttributeMaxDynamicSharedMemorySize, LDS_BYTES);
        (void)hipOccupancyMaxActiveBlocksPerMultiprocessor(&per_cu, (const void*)mk, NT, LDS_BYTES);
        if (per_cu < 1) fprintf(stderr, "kernel_launch: occupancy query reports %d workgroups per CU\n", per_cu);
        grid = cus;
#endif
        (void)hipGetLastError();
    }
    if (grid < 0) return;
    Params p{};
    for (int i = 0; i < 28; ++i) p.in[i] = (const float*)d_in[i];
    p.out = (float*)d_out; p.ws = (unsigned char*)d_ws;
#if MK_FUSED
    (void)hipMemsetAsync((char*)d_ws + WS_CTL, 0, CTL_ZERO_BYTES, stream);
    hipLaunchKernelGGL(mk, dim3(grid), dim3(NT), LDS_BYTES, stream, p);
#else
    (void)hipMemsetAsync((char*)d_ws + WS_CTL, 0, 65536 + 49152, stream);
    launch_stage<0>(p, cus, stream); launch_stage<1>(p, cus, stream); launch_stage<2>(p, cus, stream); launch_stage<3>(p, cus, stream);
    launch_stage<4>(p, cus, stream); launch_stage<5>(p, cus, stream); launch_stage<6>(p, cus, stream);
    launch_stage<10>(p, cus, stream); launch_stage<11>(p, cus, stream);
    launch_stage<12>(p, cus, stream);
#endif
}
```
